# Optimizing an MI355X kernel written in HIP

```python
import jax
import jax.numpy as jnp
from jax import lax
import numpy as np


D_MODEL = 1024
BATCH = 2
SEQ = 8192
DEPTH = 2

GRID_W = 64
CTX_LEN = 256
EPS = 1e-6

A_HEADS = 4
A_HEAD_DIM = 128
A_WIDTH = A_HEADS * A_HEAD_DIM
A_IN = 5 * A_WIDTH
A_CHUNK = 64
POOL_WINDOWS = (2, 4, 8, 16)
B_GROUP = 128
B_WIDTH = B_GROUP * len(POOL_WINDOWS)
AB_IN = A_IN + B_WIDTH
AB_MIX = A_WIDTH + B_WIDTH
C_HEADS = 8
C_HEAD_DIM = 64
C_WIDTH = C_HEADS * C_HEAD_DIM
NA_ROWS_MAX = 8
NA_COLS = 16
D_HEADS = 8
MLA_Q_RANK = 256
MLA_KV_RANK = 128
MLA_NOPE = 64
MLA_ROPE = 32
MLA_V = 64
D_WIDTH = D_HEADS * MLA_V
CD_IN = 3 * C_WIDTH + MLA_Q_RANK + MLA_KV_RANK + MLA_ROPE
CD_MIX = C_WIDTH + D_WIDTH
ROPE_THETA = 10000.0
ATTN_BLOCK = 128
MOE_GROUPS = 4
MOE_EXPERTS_PER_GROUP = 8
MOE_TOPK = 2
MOE_HIDDEN = 256

N_AB_LAYERS = (DEPTH + 1) // 2
N_CD_LAYERS = DEPTH // 2

kernel_name = 'hybrid_hgrn2_pool_natten_mla_hmoe_diffusion'


def rmsnorm(x, g):
    xf = x.astype(jnp.float32)
    y = xf * lax.rsqrt(jnp.mean(xf * xf, axis=-1, keepdims=True) + EPS)
    return (y * g.astype(jnp.float32)).astype(x.dtype)


def ada_modulate(x, g, shift, scale):
    return rmsnorm(x, g) * (1.0 + scale) + shift


def _heads(a, n_heads):
    b, n, _ = a.shape
    return a.reshape(b, n, n_heads, -1).transpose(0, 2, 1, 3)


def _merge(a):
    b, h, n, d = a.shape
    return a.transpose(0, 2, 1, 3).reshape(b, n, h * d)


def axial_rope(x, pos_r, pos_c):
    half = x.shape[-1] // 2
    n_freq = half // 2
    inv = ROPE_THETA ** (-jnp.arange(n_freq, dtype=jnp.float32) / n_freq)

    def rot(xa, pos):
        ang = pos[:, None] * inv[None, :]
        cos, sin = jnp.cos(ang), jnp.sin(ang)
        x1, x2 = xa[..., :n_freq], xa[..., n_freq:]
        return jnp.concatenate([x1 * cos - x2 * sin, x1 * sin + x2 * cos], axis=-1)

    xf = x.astype(jnp.float32)
    return jnp.concatenate([rot(xf[..., :half], pos_r), rot(xf[..., half:], pos_c)], axis=-1).astype(x.dtype)


def gla_chunk_scan(q, k, v, logf, s0):
    b_, h, n, _ = q.shape
    nc = n // A_CHUNK

    def chunks(a):
        return jnp.moveaxis(a.reshape(b_, h, nc, A_CHUNK, a.shape[-1]), 2, 0)

    incl = jnp.tril(jnp.ones((A_CHUNK, A_CHUNK), dtype=bool))

    def step(s, inp):
        qc, kc, vc, gc = inp
        bcum = jnp.cumsum(gc, axis=2)
        o_inter = jnp.einsum('bhtd,bhde->bhte', qc * jnp.exp(bcum), s)
        diff = bcum[:, :, :, None, :] - bcum[:, :, None, :, :]
        decay = jnp.exp(jnp.where(incl[:, :, None], diff, -jnp.inf))
        att = jnp.einsum('bhtd,bhsd,bhtsd->bhts', qc, kc, decay)
        o = o_inter + jnp.einsum('bhts,bhse->bhte', att, vc)
        b_last = bcum[:, :, -1:, :]
        s_new = jnp.exp(b_last[:, :, 0, :, None]) * s + jnp.einsum('bhsd,bhse->bhde', kc * jnp.exp(b_last - bcum), vc)
        return s_new, o

    s_fin, o = lax.scan(step, s0, (chunks(q), chunks(k), chunks(v), chunks(logf)))
    o = jnp.moveaxis(o, 0, 2).reshape(b_, h, n, v.shape[-1])
    return o, s_fin


def hgrn2_inputs(u, lb):
    uf = u.astype(jnp.float32)
    q, f_fwd, f_bwd, i, g = jnp.split(uf, 5, axis=-1)
    dirs = []
    for d, fz in enumerate((f_fwd, f_bwd)):
        f = lb[d] + (1.0 - lb[d]) * jax.nn.sigmoid(fz)
        dirs.append((_heads(1.0 - f, A_HEADS), _heads(jnp.log(f), A_HEADS)))
    return _heads(jax.nn.silu(q), A_HEADS), _heads(i, A_HEADS), dirs, g


def hgrn2_bidir(u_ctx, u_lat, lb, onorm_g):
    q_c, i_c, dirs_c, g_c = hgrn2_inputs(u_ctx, lb)
    q_l, i_l, dirs_l, g_l = hgrn2_inputs(u_lat, lb)
    (kf_c, gf_c), (kb_c, gb_c) = dirs_c
    (kf_l, gf_l), (kb_l, gb_l) = dirs_l
    s0 = jnp.zeros(q_c.shape[:2] + (A_HEAD_DIM, A_HEAD_DIM), jnp.float32)

    def flip(a):
        return jnp.flip(a, axis=2)

    o_cf, s_cf = gla_chunk_scan(q_c, kf_c, i_c, gf_c, s0)
    o_lf, _ = gla_chunk_scan(q_l, kf_l, i_l, gf_l, s_cf)
    o_cb, s_cb = gla_chunk_scan(flip(q_c), flip(kb_c), flip(i_c), flip(gb_c), s0)
    o_lb, _ = gla_chunk_scan(flip(q_l), flip(kb_l), flip(i_l), flip(gb_l), s_cb)

    def readout(o, g, dtype):
        return (_merge(rmsnorm(o, onorm_g)) * jax.nn.silu(g)).astype(dtype)

    return readout(o_cf + flip(o_cb), g_c, u_ctx.dtype), readout(o_lf + flip(o_lb), g_l, u_lat.dtype)


def multiscale_pool(u, w, scale):
    b_, n, _ = u.shape
    uf = u.astype(jnp.float32)
    cs = jnp.concatenate([jnp.zeros((b_, 1, B_WIDTH), jnp.float32), jnp.cumsum(uf, axis=1)], axis=1)
    t = jnp.arange(n)
    outs = []
    for gi, win in enumerate(POOL_WINDOWS):
        sl = slice(gi * B_GROUP, (gi + 1) * B_GROUP)
        lo = jnp.clip(t - win // 2, 0, n)
        hi = jnp.clip(t + win - win // 2, 0, n)
        mean = (cs[:, hi, sl] - cs[:, lo, sl]) / (hi - lo).astype(jnp.float32)[None, :, None]
        outs.append(jnp.einsum('bnc,cd->bnd', mean - uf[:, :, sl], w[gi].astype(jnp.float32)))
    return (jnp.concatenate(outs, axis=-1) * scale.astype(jnp.float32)).astype(u.dtype)


def ab_mixer(h_ctx, h_lat, need_ctx, w_in, w_out, lb, onorm_g, pool_w, pool_scale):
    u_ctx = h_ctx @ w_in
    u_lat = h_lat @ w_in
    a_ctx, a_lat = hgrn2_bidir(u_ctx[..., :A_IN], u_lat[..., :A_IN], lb, onorm_g)
    o_lat = jnp.concatenate([a_lat, multiscale_pool(u_lat[..., A_IN:], pool_w, pool_scale)], axis=-1) @ w_out
    o_ctx = None
    if need_ctx:
        o_ctx = jnp.concatenate([a_ctx, multiscale_pool(u_ctx[..., A_IN:], pool_w, pool_scale)], axis=-1) @ w_out
    return o_ctx, o_lat


def dense_attention(q, k, v, scale):
    s = jnp.einsum('bhqd,bhkd->bhqk', q, k).astype(jnp.float32) * scale
    p = jax.nn.softmax(s, axis=-1).astype(v.dtype)
    return jnp.einsum('bhqk,bhkd->bhqd', p, v)


def neighbourhood_attention(q_lat, k_lat, v_lat, k_ctx, v_ctx, rpb):
    b_, h, n, dh = q_lat.shape
    rows = n // GRID_W
    wr = min(NA_ROWS_MAX, rows)
    scale = dh ** -0.5
    kg = k_lat.reshape(b_, h, rows, GRID_W, dh)
    vg = v_lat.reshape(b_, h, rows, GRID_W, dh)
    qg = jnp.moveaxis(q_lat.reshape(b_, h, rows, GRID_W, dh), 2, 0)
    col = jnp.arange(GRID_W)
    col_start = jnp.clip(col - NA_COLS // 2, 0, GRID_W - NA_COLS)
    col_idx = col_start[:, None] + jnp.arange(NA_COLS)[None, :]
    dc = col_idx - col[:, None] + (NA_COLS - 1)
    rpb_f = rpb.astype(jnp.float32)
    n_loc = wr * NA_COLS

    def row_block(args):
        r, q_row = args
        rs = jnp.clip(r - wr // 2, 0, rows - wr)
        k_win = lax.dynamic_slice_in_dim(kg, rs, wr, axis=2)[:, :, :, col_idx]
        v_win = lax.dynamic_slice_in_dim(vg, rs, wr, axis=2)[:, :, :, col_idx]
        dr = rs + jnp.arange(wr) - r + (NA_ROWS_MAX - 1)
        bias = rpb_f[:, dr[None, :, None], dc[:, None, :]]
        s_loc = jnp.einsum('bhqd,bhrqjd->bhqrj', q_row, k_win).astype(jnp.float32) * scale + bias
        s_ctx = jnp.einsum('bhqd,bhkd->bhqk', q_row, k_ctx).astype(jnp.float32) * scale
        s = jnp.concatenate([s_loc.reshape(b_, h, GRID_W, n_loc), s_ctx], axis=-1)
        p = jax.nn.softmax(s, axis=-1).astype(v_lat.dtype)
        p_loc = p[..., :n_loc].reshape(b_, h, GRID_W, wr, NA_COLS)
        return (jnp.einsum('bhqrj,bhrqjd->bhqd', p_loc, v_win)
                + jnp.einsum('bhqk,bhkd->bhqd', p[..., n_loc:], v_ctx))

    o = lax.map(row_block, (jnp.arange(rows), qg))
    return jnp.moveaxis(o, 0, 2).reshape(b_, h, n, dh)


def mla_q(cq, q_norm_g, w_uq, pos):
    q = _heads(rmsnorm(cq, q_norm_g) @ w_uq, D_HEADS)
    q_nope, q_rope = q[..., :MLA_NOPE], q[..., MLA_NOPE:]
    if pos is not None:
        q_rope = axial_rope(q_rope, pos[0], pos[1])
    return jnp.concatenate([q_nope, q_rope], axis=-1)


def mla_kv(ckv, k_rope, kv_norm_g, w_ukv, pos):
    kv = _heads(rmsnorm(ckv, kv_norm_g) @ w_ukv, D_HEADS)
    k_nope, v = kv[..., :MLA_NOPE], kv[..., MLA_NOPE:]
    kr = k_rope[:, None]
    if pos is not None:
        kr = axial_rope(kr, pos[0], pos[1])
    kr = jnp.broadcast_to(kr, k_nope.shape[:3] + (MLA_ROPE,))
    return jnp.concatenate([k_nope, kr], axis=-1), v


def blocked_attention(q, k_all, v_all, scale):
    b_, h, n, dq = q.shape
    nb = n // ATTN_BLOCK
    qb = jnp.moveaxis(q.reshape(b_, h, nb, ATTN_BLOCK, dq), 2, 0)
    o = lax.map(lambda q_blk: dense_attention(q_blk, k_all, v_all, scale), qb)
    return jnp.moveaxis(o, 0, 2).reshape(b_, h, n, v_all.shape[-1])


def split_cd(u):
    b_, n, _ = u.shape
    qkv = u[..., :3 * C_WIDTH].reshape(b_, n, 3, C_HEADS, C_HEAD_DIM).transpose(2, 0, 3, 1, 4)
    o = 3 * C_WIDTH
    cq = u[..., o:o + MLA_Q_RANK]
    ckv = u[..., o + MLA_Q_RANK:o + MLA_Q_RANK + MLA_KV_RANK]
    kr = u[..., o + MLA_Q_RANK + MLA_KV_RANK:]
    return qkv[0], qkv[1], qkv[2], cq, ckv, kr


def cd_mixer(h_ctx, h_lat, need_ctx, w_in, w_out, rpb, q_norm_g, w_uq, kv_norm_g, w_ukv):
    n_lat = h_lat.shape[1]
    t = jnp.arange(n_lat)
    pos = ((t // GRID_W).astype(jnp.float32), (t % GRID_W).astype(jnp.float32))
    nq_c, nk_c, nv_c, cq_c, ckv_c, kr_c = split_cd(h_ctx @ w_in)
    nq_l, nk_l, nv_l, cq_l, ckv_l, kr_l = split_cd(h_lat @ w_in)
    d_scale = (MLA_NOPE + MLA_ROPE) ** -0.5
    c_lat = neighbourhood_attention(nq_l, nk_l, nv_l, nk_c, nv_c, rpb)
    dk_c, dv_c = mla_kv(ckv_c, kr_c, kv_norm_g, w_ukv, None)
    dk_l, dv_l = mla_kv(ckv_l, kr_l, kv_norm_g, w_ukv, pos)
    dq_l = mla_q(cq_l, q_norm_g, w_uq, pos)
    d_lat = blocked_attention(dq_l, jnp.concatenate([dk_c, dk_l], axis=2), jnp.concatenate([dv_c, dv_l], axis=2), d_scale)
    o_lat = jnp.concatenate([_merge(c_lat), _merge(d_lat)], axis=-1) @ w_out
    o_ctx = None
    if need_ctx:
        c_c = dense_attention(nq_c, nk_c, nv_c, C_HEAD_DIM ** -0.5)
        d_c = dense_attention(mla_q(cq_c, q_norm_g, w_uq, None), dk_c, dv_c, d_scale)
        o_ctx = jnp.concatenate([_merge(c_c), _merge(d_c)], axis=-1) @ w_out
    return o_ctx, o_lat


def hier_moe(h, w_rg, b_rg, w_re, b_re, w_gate, w_up, w_down):
    b_, n, d = h.shape
    x = h.reshape(-1, d)
    tok = x.shape[0]
    g_prob = jax.nn.softmax((x @ w_rg + b_rg).astype(jnp.float32), axis=-1)
    g_p, g_idx = lax.top_k(g_prob, 1)
    e_logits = (x @ w_re + b_re).astype(jnp.float32).reshape(tok, MOE_GROUPS, MOE_EXPERTS_PER_GROUP)
    e_logits = jnp.take_along_axis(e_logits, g_idx[:, :, None], axis=1)[:, 0]
    e_p, e_idx = lax.top_k(jax.nn.softmax(e_logits, axis=-1), MOE_TOPK)
    e_p = e_p / jnp.sum(e_p, axis=-1, keepdims=True)
    e_w = jnp.sum(jax.nn.one_hot(e_idx, MOE_EXPERTS_PER_GROUP, dtype=jnp.float32) * e_p[..., None], axis=1)
    comb = (g_p[:, :, None] * jax.nn.one_hot(g_idx[:, 0], MOE_GROUPS, dtype=jnp.float32)[:, :, None]
            * e_w[:, None, :]).astype(h.dtype)
    y = jnp.zeros_like(x)
    for g in range(MOE_GROUPS):
        a = jax.nn.silu(jnp.einsum('td,edf->tef', x, w_gate[g])) * jnp.einsum('td,edf->tef', x, w_up[g])
        y = y + jnp.einsum('tef,efd->td', a * comb[:, g, :, None], w_down[g])
    return y.reshape(b_, n, d)


def setup_inputs(seed: int = 0) -> dict:
    key = jax.random.key(seed)
    ks = jax.random.split(key, 32)
    counter = [0]

    def nrm(shape, scale):
        k = ks[counter[0]]
        counter[0] += 1
        return jax.random.normal(k, shape, jnp.float32) * scale

    def gain(shape):
        return 1.0 + nrm(shape, 0.02)

    G, E, F = MOE_GROUPS, MOE_EXPERTS_PER_GROUP, MOE_HIDDEN
    return {
        'x': nrm((BATCH, SEQ, D_MODEL), 1.0),
        'c': nrm((BATCH, D_MODEL), 1.0),
        'ctx': nrm((BATCH, CTX_LEN, D_MODEL), 1.0),
        'c_ctx': nrm((D_MODEL,), 1.0),
        'ada_w': nrm((DEPTH, D_MODEL, 6 * D_MODEL), 0.5 * D_MODEL ** -0.5),
        'ada_b': nrm((DEPTH, 6 * D_MODEL), 0.02),
        'norm1_g': gain((DEPTH, D_MODEL)),
        'norm2_g': gain((DEPTH, D_MODEL)),
        'ab_w_in': nrm((N_AB_LAYERS, D_MODEL, AB_IN), D_MODEL ** -0.5),
        'ab_w_out': nrm((N_AB_LAYERS, AB_MIX, D_MODEL), AB_MIX ** -0.5),
        'hgrn_lb_logits': nrm((2, N_AB_LAYERS + 1, A_WIDTH), 0.1),
        'hgrn_onorm_g': gain((N_AB_LAYERS, A_HEAD_DIM)),
        'pool_w': nrm((N_AB_LAYERS, len(POOL_WINDOWS), B_GROUP, B_GROUP), B_GROUP ** -0.5),
        'pool_scale': gain((N_AB_LAYERS, B_WIDTH)),
        'cd_w_in': nrm((N_CD_LAYERS, D_MODEL, CD_IN), D_MODEL ** -0.5),
        'cd_w_out': nrm((N_CD_LAYERS, CD_MIX, D_MODEL), CD_MIX ** -0.5),
        'na_rpb': nrm((N_CD_LAYERS, C_HEADS, 2 * NA_ROWS_MAX - 1, 2 * NA_COLS - 1), 0.1),
        'mla_q_norm_g': gain((N_CD_LAYERS, MLA_Q_RANK)),
        'mla_w_uq': nrm((N_CD_LAYERS, MLA_Q_RANK, D_HEADS * (MLA_NOPE + MLA_ROPE)), MLA_Q_RANK ** -0.5),
        'mla_kv_norm_g': gain((N_CD_LAYERS, MLA_KV_RANK)),
        'mla_w_ukv': nrm((N_CD_LAYERS, MLA_KV_RANK, D_HEADS * (MLA_NOPE + MLA_V)), MLA_KV_RANK ** -0.5),
        'moe_w_rg': nrm((DEPTH, D_MODEL, G), D_MODEL ** -0.5),
        'moe_b_rg': nrm((DEPTH, G), 0.01),
        'moe_w_re': nrm((DEPTH, D_MODEL, G * E), D_MODEL ** -0.5),
        'moe_b_re': nrm((DEPTH, G * E), 0.01),
        'moe_w_gate': nrm((DEPTH, G, E, D_MODEL, F), D_MODEL ** -0.5),
        'moe_w_up': nrm((DEPTH, G, E, D_MODEL, F), D_MODEL ** -0.5),
        'moe_w_down': nrm((DEPTH, G, E, F, D_MODEL), F ** -0.5),
        'final_norm_g': gain((D_MODEL,)),
    }


def reference(x, c, ctx, c_ctx, ada_w, ada_b, norm1_g, norm2_g, ab_w_in, ab_w_out, hgrn_lb_logits,
              hgrn_onorm_g, pool_w, pool_scale, cd_w_in, cd_w_out, na_rpb, mla_q_norm_g, mla_w_uq,
              mla_kv_norm_g, mla_w_ukv, moe_w_rg, moe_b_rg, moe_w_re, moe_b_re, moe_w_gate, moe_w_up,
              moe_w_down, final_norm_g):
    lb_all = jnp.cumsum(jax.nn.softmax(hgrn_lb_logits.astype(jnp.float32), axis=1), axis=1)
    xc = ctx
    for layer in range(DEPTH):
        last = layer == DEPTH - 1
        k = layer // 2
        m_lat = (jax.nn.silu(c) @ ada_w[layer] + ada_b[layer])[:, None, :]
        m_ctx = (jax.nn.silu(c_ctx) @ ada_w[layer] + ada_b[layer])[None, None, :]
        sh1, sc1, g1, sh2, sc2, g2 = jnp.split(m_lat, 6, axis=-1)
        sh1c, sc1c, g1c, sh2c, sc2c, g2c = jnp.split(m_ctx, 6, axis=-1)
        h_lat = ada_modulate(x, norm1_g[layer], sh1, sc1)
        h_ctx = ada_modulate(xc, norm1_g[layer], sh1c, sc1c)
        if layer % 2 == 0:
            o_ctx, o_lat = ab_mixer(h_ctx, h_lat, not last, ab_w_in[k], ab_w_out[k], lb_all[:, k],
                                    hgrn_onorm_g[k], pool_w[k], pool_scale[k])
        else:
            o_ctx, o_lat = cd_mixer(h_ctx, h_lat, not last, cd_w_in[k], cd_w_out[k], na_rpb[k],
                                    mla_q_norm_g[k], mla_w_uq[k], mla_kv_norm_g[k], mla_w_ukv[k])
        moe_p = (moe_w_rg[layer], moe_b_rg[layer], moe_w_re[layer], moe_b_re[layer],
                 moe_w_gate[layer], moe_w_up[layer], moe_w_down[layer])
        x = x + g1 * o_lat
        x = x + g2 * hier_moe(ada_modulate(x, norm2_g[layer], sh2, sc2), *moe_p)
        if not last:
            xc = xc + g1c * o_ctx
            xc = xc + g2c * hier_moe(ada_modulate(xc, norm2_g[layer], sh2c, sc2c), *moe_p)
    return rmsnorm(x, final_norm_g)
```

```cpp
#include <hip/hip_runtime.h>
#include <stdint.h>
#include <cstdio>

typedef unsigned short bf16_t;
typedef float f32x4 __attribute__((ext_vector_type(4)));

constexpr int D = 1024, NB = 2, SEQ = 8192, CT = 256;
constexpr int NLAT = NB * SEQ;
constexpr int NCTX = NB * CT;
constexpr int MROWS = NLAT + NCTX;
constexpr int NKEY = CT + SEQ;
constexpr float EPS = 1e-6f;
constexpr float LOG2E = 1.4426950408889634f;
constexpr float NA_QSCALE = 0.125f * LOG2E;
constexpr float MLA_QSCALE = 0.10206207261596577f * LOG2E;

constexpr size_t alignup(size_t x) { return (x + 255) & ~(size_t)255; }
constexpr size_t WS_CTL      = 0;
constexpr size_t WS_MODS     = 65536;
constexpr size_t WS_LB       = WS_MODS + alignup(2 * 3 * 6144 * 4);
constexpr size_t WS_XC       = WS_LB + 4096;
constexpr size_t WS_ROUTE_E  = WS_XC + (size_t)NCTX * D * 4;
constexpr size_t WS_ROUTE_W  = WS_ROUTE_E + alignup((size_t)MROWS * 2 * 4);
constexpr size_t WS_RSTD_Q   = WS_ROUTE_W + alignup((size_t)MROWS * 2 * 4);
constexpr size_t WS_RSTD_KV  = WS_RSTD_Q + alignup((size_t)NLAT * 4);
constexpr size_t WS_ODIR_CTX = WS_RSTD_KV + alignup((size_t)MROWS * 4);
constexpr size_t WS_WT_ABIN  = WS_ODIR_CTX + (size_t)2 * NCTX * 512 * 4;
constexpr size_t WS_WT_ABOUT = WS_WT_ABIN + (size_t)3072 * 1024 * 2;
constexpr size_t WS_WT_CDIN  = WS_WT_ABOUT + (size_t)1024 * 1024 * 2;
constexpr size_t WS_WT_CDOUT = WS_WT_CDIN + (size_t)2048 * 1024 * 2;
constexpr size_t WS_WT_UQ    = WS_WT_CDOUT + (size_t)1024 * 1024 * 2;
constexpr size_t WS_WT_UKV   = WS_WT_UQ + (size_t)768 * 256 * 2;
constexpr size_t WS_WT_POOL  = WS_WT_UKV + (size_t)1024 * 128 * 2;
constexpr size_t WS_WMOE     = WS_WT_POOL + (size_t)4 * 128 * 128 * 2;
constexpr size_t WS_H        = WS_WMOE + (size_t)32 * 512 * 1024 * 2 + (size_t)32 * 1024 * 256 * 2;
constexpr size_t WS_A        = WS_H + (size_t)MROWS * D * 2;
constexpr size_t WS_U        = WS_A + (size_t)MROWS * D * 2;
constexpr size_t USLOT       = (size_t)MROWS * 512 * 2;
constexpr size_t WS_LF       = WS_U + 6 * USLOT;
constexpr size_t WS_END      = WS_LF + (size_t)2 * MROWS * 512 * 4;
constexpr size_t WS_NQ   = WS_U;
constexpr size_t WS_NK   = WS_NQ + (size_t)NLAT * 512 * 2;
constexpr size_t WS_NV   = WS_NK + USLOT;
constexpr size_t WS_CQ   = WS_NV + USLOT;
constexpr size_t WS_CKV  = WS_CQ + (size_t)NLAT * 256 * 2;
constexpr size_t WS_KR   = WS_CKV + (size_t)MROWS * 128 * 2;
constexpr size_t WS_DQ   = WS_KR + (size_t)MROWS * 32 * 4;
constexpr size_t WS_L1END = WS_DQ + (size_t)NLAT * 768 * 2;
static_assert(WS_L1END <= WS_LF, "layer-1 overlay too big");
constexpr size_t WS_DK   = WS_LF;
constexpr size_t WS_DV   = WS_DK + (size_t)MROWS * 1024 * 2;
static_assert(WS_DV + (size_t)MROWS * 512 * 2 <= WS_END, "dk/dv overlay too big");
constexpr size_t WS_YBUF = WS_LF;

__device__ __forceinline__ float bf2f(bf16_t h) { return __uint_as_float(((unsigned)h) << 16); }
__device__ __forceinline__ bf16_t f2bf(float f) { unsigned u = __float_as_uint(f); u += 0x7FFFu + ((u >> 16) & 1u); return (bf16_t)(u >> 16); }
__device__ __forceinline__ unsigned pack2(float a, float b) { return (unsigned)f2bf(a) | ((unsigned)f2bf(b) << 16); }
__device__ __forceinline__ float sigmoidf_(float x) { return 1.f / (1.f + __expf(-x)); }
__device__ __forceinline__ float siluf_(float x) { return x / (1.f + __expf(-x)); }
__device__ __forceinline__ float wave_sum(float v) {
#pragma unroll
  for (int o = 1; o < 64; o <<= 1) v += __shfl_xor(v, o);
  return v;
}
__device__ __forceinline__ int row_vec(int m) { return m < NLAT ? (m >> 13) : 2; }
__device__ __forceinline__ void row_bkey(int m, int& b, int& key) {
  if (m < NLAT) { b = m >> 13; key = CT + (m & 8191); } else { const int mm = m - NLAT; b = mm >> 8; key = mm & 255; }
}

__global__ __launch_bounds__(512) void k_ada(const float* __restrict__ c, const float* __restrict__ cctx, const float* __restrict__ ada_w,
                                             const float* __restrict__ ada_b, float* __restrict__ mods) {
  const int l = blockIdx.y, n0 = blockIdx.x * 64, j = threadIdx.x & 63, kg = threadIdx.x >> 6;
  __shared__ float sv[3][1024];
  __shared__ float red[8][3][64];
  for (int i = threadIdx.x; i < 1024; i += 512) { sv[0][i] = siluf_(c[i]); sv[1][i] = siluf_(c[1024 + i]); sv[2][i] = siluf_(cctx[i]); }
  __syncthreads();
  const float* W = ada_w + (size_t)l * 1024 * 6144 + n0 + j;
  float a0 = 0.f, a1 = 0.f, a2 = 0.f;
  for (int k = kg * 128; k < kg * 128 + 128; ++k) { const float w = W[(size_t)k * 6144]; a0 += sv[0][k] * w; a1 += sv[1][k] * w; a2 += sv[2][k] * w; }
  red[kg][0][j] = a0; red[kg][1][j] = a1; red[kg][2][j] = a2;
  __syncthreads();
  if (threadIdx.x < 192) {
    const int v = threadIdx.x >> 6, jj = threadIdx.x & 63; float s = 0.f;
    for (int g = 0; g < 8; ++g) s += red[g][v][jj];
    mods[(size_t)(l * 3 + v) * 6144 + n0 + jj] = s + ada_b[l * 6144 + n0 + jj];
  }
}
__global__ void k_lb(const float* __restrict__ logits, float* __restrict__ lb) {
  const int i = blockIdx.x * blockDim.x + threadIdx.x;
  if (i < 1024) { const int d = i >> 9, cc = i & 511; const float l0 = logits[(d * 2 + 0) * 512 + cc], l1 = logits[(d * 2 + 1) * 512 + cc]; lb[i] = 1.f / (1.f + expf(l1 - l0)); }
}

struct ConvArgs { const float* src; bf16_t* dst; const float* kscale; int K, N, Npad, mode; size_t sbs, dbs; };
__device__ __forceinline__ int moe_gu_row(int sel, int hidden) {
  const int nt = hidden >> 6, hl = hidden & 63, wc = hl >> 5, i2 = (hl >> 4) & 1, cc = hl & 15;
  return nt * 128 + wc * 64 + (sel * 2 + i2) * 16 + cc;
}
__global__ __launch_bounds__(512) void k_convT(ConvArgs a) {
  __shared__ float tile[64][65];
  const float* src = a.src + blockIdx.z * a.sbs; bf16_t* dst = a.dst + blockIdx.z * a.dbs;
  const int n0 = blockIdx.x * 64, k0 = blockIdx.y * 64, tx = threadIdx.x & 63, ty = threadIdx.x >> 6;
#pragma unroll
  for (int i = 0; i < 8; ++i) {
    const int k = k0 + ty + 8 * i, n = n0 + tx; float v = 0.f;
    if (n < a.N) { v = src[(size_t)k * a.N + n]; if (a.kscale) v *= a.kscale[k]; }
    tile[ty + 8 * i][tx] = v;
  }
  __syncthreads();
#pragma unroll
  for (int i = 0; i < 8; ++i) {
    const int nl = ty + 8 * i, n = n0 + nl;
    if (n < a.Npad) { int row = n; if (a.mode == 1) row = moe_gu_row(0, n); else if (a.mode == 2) row = moe_gu_row(1, n);
      dst[(size_t)row * a.K + k0 + tx] = f2bf(tile[tx][nl]); }
  }
}

__global__ __launch_bounds__(512) void k_norm_mod(const float* __restrict__ lat, const float* __restrict__ ctxr, const float* __restrict__ gain,
                                                  const float* __restrict__ modl, int sh_off, int sc_off, bf16_t* __restrict__ out, int nrows) {
  const int lane = threadIdx.x & 63, gw = blockIdx.x * 8 + (threadIdx.x >> 6);
  for (int row = gw; row < nrows; row += gridDim.x * 8) {
    const float* src = row < NLAT ? lat + (size_t)row * D : ctxr + (size_t)(row - NLAT) * D;
    const float* mv = modl + row_vec(row) * 6144;
    f32x4 x[4]; float ss = 0.f;
#pragma unroll
    for (int j = 0; j < 4; ++j) { x[j] = ((const f32x4*)src)[lane + 64 * j]; ss += x[j].x * x[j].x + x[j].y * x[j].y + x[j].z * x[j].z + x[j].w * x[j].w; }
    const float rstd = 1.f / sqrtf(wave_sum(ss) * (1.f / D) + EPS);
#pragma unroll
    for (int j = 0; j < 4; ++j) {
      const int n = (lane + 64 * j) * 4;
      const f32x4 g = *(const f32x4*)(gain + n), sc = *(const f32x4*)(mv + sc_off + n), sh = *(const f32x4*)(mv + sh_off + n);
      const f32x4 h = x[j] * rstd * g * (sc + 1.f) + sh;
      uint2 o; o.x = pack2(h.x, h.y); o.y = pack2(h.z, h.w);
      *(uint2*)(out + (size_t)row * D + n) = o;
    }
  }
}

struct EpiABIn {
  bf16_t* U; float* LF; const float* lb;
  __device__ __forceinline__ void apply(int m, int n, f32x4 v) const {
    const int seg = n >> 9, cn = n & 511; float o[4] = {v.x, v.y, v.z, v.w};
    bf16_t* dst;
    if (seg == 0) { dst = U; for (int i = 0; i < 4; ++i) o[i] = siluf_(o[i]); }
    else if (seg == 1 || seg == 2) { const int d = seg - 1; dst = U + (size_t)(1 + d) * MROWS * 512;
      f32x4 lg;
#pragma unroll
      for (int i = 0; i < 4; ++i) { const float l = lb[d * 512 + cn + i]; const float k = (1.f - l) * sigmoidf_(-o[i]); o[i] = k; lg[i] = log1pf(-k); }
      *(f32x4*)(LF + ((size_t)d * MROWS + m) * 512 + cn) = lg; }
    else if (seg == 3) dst = U + (size_t)3 * MROWS * 512;
    else if (seg == 4) { dst = U + (size_t)4 * MROWS * 512; for (int i = 0; i < 4; ++i) o[i] = siluf_(o[i]); }
    else dst = U + (size_t)5 * MROWS * 512;
    uint2 w; w.x = pack2(o[0], o[1]); w.y = pack2(o[2], o[3]);
    *(uint2*)(dst + (size_t)m * 512 + cn) = w;
  }
};
struct EpiPool {
  bf16_t* A; const float* scale; int gi; int pad;
  __device__ __forceinline__ void apply(int m, int n, f32x4 v) const {
    const int cn = gi * 128 + n; const f32x4 s = *(const f32x4*)(scale + cn); v = v * s;
    uint2 w; w.x = pack2(v.x, v.y); w.y = pack2(v.z, v.w);
    *(uint2*)(A + (size_t)m * D + 512 + cn) = w;
  }
};
struct EpiOutRes {
  const float* base_lat; const float* base_ctx; float* out_lat; float* out_ctx; const float* modl; int g_off; int pad;
  __device__ __forceinline__ void apply(int m, int n, f32x4 v) const {
    const f32x4 g = *(const f32x4*)(modl + row_vec(m) * 6144 + g_off + n);
    if (m < NLAT) { const f32x4 b = *(const f32x4*)(base_lat + (size_t)m * D + n); *(f32x4*)(out_lat + (size_t)m * D + n) = b + g * v; }
    else { const size_t o = (size_t)(m - NLAT) * D + n; const f32x4 b = *(const f32x4*)(base_ctx + o); *(f32x4*)(out_ctx + o) = b + g * v; }
  }
};
struct EpiCDIn {
  bf16_t *nq, *nk, *nv, *cq, *ckv; float* kr;
  __device__ __forceinline__ void apply(int m, int n, f32x4 v) const {
    int b, key; row_bkey(m, b, key);
    if (n < 1536) {
      const int which = n >> 9, hh = (n & 511) >> 6, dd = n & 63;
      if (which == 0) { if (m >= NLAT) return; v = v * NA_QSCALE;
        uint2 w; w.x = pack2(v.x, v.y); w.y = pack2(v.z, v.w);
        *(uint2*)(nq + (((size_t)(b * 8 + hh) * SEQ + (m & 8191)) * 64 + dd)) = w; }
      else { bf16_t* dst = which == 1 ? nk : nv; uint2 w; w.x = pack2(v.x, v.y); w.y = pack2(v.z, v.w);
        *(uint2*)(dst + (((size_t)(b * 8 + hh) * NKEY + key) * 64 + dd)) = w; }
    } else if (n < 1792) { if (m >= NLAT) return; uint2 w; w.x = pack2(v.x, v.y); w.y = pack2(v.z, v.w); *(uint2*)(cq + (size_t)m * 256 + (n - 1536)) = w; }
    else if (n < 1920) { uint2 w; w.x = pack2(v.x, v.y); w.y = pack2(v.z, v.w); *(uint2*)(ckv + (size_t)m * 128 + (n - 1792)) = w; }
    else if (n < 1952) { *(f32x4*)(kr + (size_t)m * 32 + (n - 1920)) = v; }
  }
};
struct EpiMlaQ {
  bf16_t* dq; const float* rstd;
  __device__ __forceinline__ void apply(int m, int n, f32x4 v) const {
    const int hh = n / 96, off = n - hh * 96; v = v * (rstd[m] * MLA_QSCALE);
    uint2 w; w.x = pack2(v.x, v.y); w.y = pack2(v.z, v.w);
    *(uint2*)(dq + (((size_t)((m >> 13) * 8 + hh) * SEQ + (m & 8191)) * 96 + off)) = w;
  }
};
struct EpiMlaKV {
  bf16_t *dk, *dv; const float* rstd;
  __device__ __forceinline__ void apply(int m, int n, f32x4 v) const {
    int b, key; row_bkey(m, b, key);
    const int hh = n >> 7, off = n & 127; v = v * rstd[m];
    uint2 w; w.x = pack2(v.x, v.y); w.y = pack2(v.z, v.w);
    if (off < 64) *(uint2*)(dk + (((size_t)(b * 8 + hh) * NKEY + key) * 128 + off)) = w;
    else *(uint2*)(dv + (((size_t)(b * 8 + hh) * NKEY + key) * 64 + (off - 64))) = w;
  }
};

template <class Epi>
__global__ __launch_bounds__(256) void k_gemm_naive(const bf16_t* __restrict__ A, int lda, const bf16_t* __restrict__ Bt, int ldb, int M, int N, int K, Epi epi) {
  __shared__ float As[32][68];
  __shared__ float Bs[32][68];
  const int m0 = blockIdx.y * 64, n0 = blockIdx.x * 64, t = threadIdx.x, tx = t & 15, ty = t >> 4;
  float acc[4][4];
#pragma unroll
  for (int i = 0; i < 4; ++i)
#pragma unroll
    for (int j = 0; j < 4; ++j) acc[i][j] = 0.f;
  const int lr = t >> 2, lk = (t & 3) * 8;
  for (int k0 = 0; k0 < K; k0 += 32) {
    uint4 ra = make_uint4(0, 0, 0, 0), rb = make_uint4(0, 0, 0, 0);
    if (m0 + lr < M) ra = *(const uint4*)(A + (size_t)(m0 + lr) * lda + k0 + lk);
    if (n0 + lr < N) rb = *(const uint4*)(Bt + (size_t)(n0 + lr) * ldb + k0 + lk);
    const unsigned wa[4] = {ra.x, ra.y, ra.z, ra.w}, wb[4] = {rb.x, rb.y, rb.z, rb.w};
#pragma unroll
    for (int i = 0; i < 4; ++i) {
      As[lk + 2 * i][lr] = __uint_as_float(wa[i] << 16); As[lk + 2 * i + 1][lr] = __uint_as_float(wa[i] & 0xFFFF0000u);
      Bs[lk + 2 * i][lr] = __uint_as_float(wb[i] << 16); Bs[lk + 2 * i + 1][lr] = __uint_as_float(wb[i] & 0xFFFF0000u);
    }
    __syncthreads();
#pragma unroll 8
    for (int kk = 0; kk < 32; ++kk) {
      const f32x4 a = *(const f32x4*)&As[kk][ty * 4], b = *(const f32x4*)&Bs[kk][tx * 4];
      const float av[4] = {a.x, a.y, a.z, a.w}, bv[4] = {b.x, b.y, b.z, b.w};
#pragma unroll
      for (int i = 0; i < 4; ++i)
#pragma unroll
        for (int j = 0; j < 4; ++j) acc[i][j] += av[i] * bv[j];
    }
    __syncthreads();
  }
#pragma unroll
  for (int i = 0; i < 4; ++i) {
    const int m = m0 + ty * 4 + i, n = n0 + tx * 4;
    if (m < M && n < N) { f32x4 v = {acc[i][0], acc[i][1], acc[i][2], acc[i][3]}; epi.apply(m, n, v); }
  }
}
template <class Epi>
static void launch_gemm_naive(hipStream_t st, const bf16_t* A, int lda, const bf16_t* Bt, int ldb, int M, int N, int K, Epi epi) {
  hipLaunchKernelGGL((k_gemm_naive<Epi>), dim3((N + 63) / 64, (M + 63) / 64), dim3(256), 0, st, A, lda, Bt, ldb, M, N, K, epi);
}

__device__ __forceinline__ int hgrn_step_row(int b, int dir, int s) {
  if (s < CT) return NLAT + b * CT + (dir ? (CT - 1 - s) : s);
  const int ls = s - CT; return b * SEQ + (dir ? (SEQ - 1 - ls) : ls);
}
__global__ __launch_bounds__(128) void k_hgrn_naive(const bf16_t* __restrict__ U, const float* __restrict__ LF, float* __restrict__ odir_lat, float* __restrict__ odir_ctx) {
  const int bid = blockIdx.x, dir = bid & 1, h = (bid >> 1) & 3, b = bid >> 3, e = threadIdx.x;
  __shared__ float sf[32][128];
  __shared__ float sk[32][128];
  __shared__ float sq[32][128];
  float Sreg[128];
#pragma unroll
  for (int d = 0; d < 128; ++d) Sreg[d] = 0.f;
  const bf16_t* Uq = U; const bf16_t* Uk = U + (size_t)(1 + dir) * MROWS * 512; const bf16_t* Uv = U + (size_t)3 * MROWS * 512;
  const float* lf = LF + (size_t)dir * MROWS * 512;
  for (int s0 = 0; s0 < NKEY; s0 += 32) {
    __syncthreads();
    for (int i = 0; i < 32; ++i) {
      const size_t off = (size_t)hgrn_step_row(b, dir, s0 + i) * 512 + h * 128 + e;
      sf[i][e] = expf(lf[off]); sk[i][e] = bf2f(Uk[off]); sq[i][e] = bf2f(Uq[off]);
    }
    __syncthreads();
    for (int i = 0; i < 32; ++i) {
      const int row = hgrn_step_row(b, dir, s0 + i);
      const float v = bf2f(Uv[(size_t)row * 512 + h * 128 + e]); float o = 0.f;
#pragma unroll
      for (int d = 0; d < 128; ++d) { Sreg[d] = sf[i][d] * Sreg[d] + sk[i][d] * v; o += Sreg[d] * sq[i][d]; }
      if (row < NLAT) odir_lat[((size_t)dir * NLAT + row) * 512 + h * 128 + e] = o;
      else odir_ctx[((size_t)dir * NCTX + (row - NLAT)) * 512 + h * 128 + e] = o;
    }
  }
}
__global__ __launch_bounds__(512) void k_hgrn_out(const float* __restrict__ odir_lat, const float* __restrict__ odir_ctx, const bf16_t* __restrict__ Ug,
                                                  const float* __restrict__ onorm_g, bf16_t* __restrict__ A) {
  const int lane = threadIdx.x & 63, gw = blockIdx.x * 8 + (threadIdx.x >> 6);
  for (int row = gw; row < MROWS; row += gridDim.x * 8) {
    const float* pf = row < NLAT ? odir_lat + (size_t)row * 512 : odir_ctx + (size_t)(row - NLAT) * 512;
    const float* pb = row < NLAT ? odir_lat + ((size_t)NLAT + row) * 512 : odir_ctx + ((size_t)NCTX + (row - NLAT)) * 512;
    const int c0 = lane * 8; float o[8]; float ss = 0.f;
#pragma unroll
    for (int i = 0; i < 8; ++i) { o[i] = pf[c0 + i] + pb[c0 + i]; ss += o[i] * o[i]; }
    ss += __shfl_xor(ss, 1); ss += __shfl_xor(ss, 2); ss += __shfl_xor(ss, 4); ss += __shfl_xor(ss, 8);
    const float rstd = 1.f / sqrtf(ss * (1.f / 128.f) + EPS);
    const uint4 gr = *(const uint4*)(Ug + (size_t)row * 512 + c0); const unsigned gw4[4] = {gr.x, gr.y, gr.z, gr.w};
    unsigned w[4];
#pragma unroll
    for (int i = 0; i < 4; ++i) {
      const float g0 = __uint_as_float(gw4[i] << 16), g1 = __uint_as_float(gw4[i] & 0xFFFF0000u);
      const int e0 = (c0 + 2 * i) & 127;
      w[i] = pack2(o[2 * i] * rstd * onorm_g[e0] * g0, o[2 * i + 1] * rstd * onorm_g[e0 + 1] * g1);
    }
    *(uint4*)(A + (size_t)row * D + c0) = make_uint4(w[0], w[1], w[2], w[3]);
  }
}
__global__ __launch_bounds__(512) void k_pool_prep(const bf16_t* __restrict__ Up, bf16_t* __restrict__ pd) {
  const int c = threadIdx.x;
  for (int row = blockIdx.x; row < MROWS; row += gridDim.x) {
    int base, t, n; if (row < NLAT) { base = row & ~8191; t = row & 8191; n = SEQ; } else { const int mm = row - NLAT; base = NLAT + (mm & ~255); t = mm & 255; n = CT; }
    const int gi = c >> 7, win = 2 << gi; int lo = t - win / 2, hi = t + win - win / 2; lo = lo < 0 ? 0 : lo; hi = hi > n ? n : hi;
    float s = 0.f; for (int r = lo; r < hi; ++r) s += bf2f(Up[(size_t)(base + r) * 512 + c]);
    pd[(size_t)row * 512 + c] = f2bf(s / (float)(hi - lo) - bf2f(Up[(size_t)row * 512 + c]));
  }
}

__global__ __launch_bounds__(512) void k_router(const float* __restrict__ lat, const float* __restrict__ ctxr, const float* __restrict__ gain, const float* __restrict__ modl,
                                                const float* __restrict__ wrg, const float* __restrict__ brg, const float* __restrict__ wre, const float* __restrict__ bre,
                                                bf16_t* __restrict__ out, int* __restrict__ re, float* __restrict__ rw, int nrows) {
  __shared__ float hs[8][1024];
  const int lane = threadIdx.x & 63, wv = threadIdx.x >> 6, gw = blockIdx.x * 8 + wv;
  const float* wp = lane < 4 ? wrg + lane : wre + ((lane - 4) & 31); const int wst = lane < 4 ? 4 : 32;
  const float bias = lane < 4 ? brg[lane] : bre[(lane - 4) & 31];
  for (int row = gw; row < nrows; row += gridDim.x * 8) {
    const float* src = row < NLAT ? lat + (size_t)row * D : ctxr + (size_t)(row - NLAT) * D;
    const float* mv = modl + row_vec(row) * 6144;
    f32x4 x[4]; float ss = 0.f;
#pragma unroll
    for (int j = 0; j < 4; ++j) { x[j] = ((const f32x4*)src)[lane + 64 * j]; ss += x[j].x * x[j].x + x[j].y * x[j].y + x[j].z * x[j].z + x[j].w * x[j].w; }
    const float rstd = 1.f / sqrtf(wave_sum(ss) * (1.f / D) + EPS);
#pragma unroll
    for (int j = 0; j < 4; ++j) {
      const int n = (lane + 64 * j) * 4;
      const f32x4 g = *(const f32x4*)(gain + n), sc = *(const f32x4*)(mv + 4096 + n), sh = *(const f32x4*)(mv + 3072 + n);
      const f32x4 h = x[j] * rstd * g * (sc + 1.f) + sh;
      uint2 o; o.x = pack2(h.x, h.y); o.y = pack2(h.z, h.w);
      *(uint2*)(out + (size_t)row * D + n) = o;
      *(f32x4*)&hs[wv][n] = h;
    }
    __builtin_amdgcn_wave_barrier();
    float acc = 0.f;
#pragma unroll 8
    for (int k = 0; k < 1024; ++k) acc += hs[wv][k] * wp[(size_t)k * wst];
    acc += bias;
    __builtin_amdgcn_wave_barrier();
    float gl[4];
#pragma unroll
    for (int i = 0; i < 4; ++i) gl[i] = __shfl(acc, i);
    int gi = 0; float gm = gl[0];
#pragma unroll
    for (int i = 1; i < 4; ++i) if (gl[i] > gm) { gm = gl[i]; gi = i; }
    float gs = 0.f;
#pragma unroll
    for (int i = 0; i < 4; ++i) gs += expf(gl[i] - gm);
    const float gp = 1.f / gs;
    float el[8];
#pragma unroll
    for (int i = 0; i < 8; ++i) el[i] = __shfl(acc, 4 + gi * 8 + i);
    int e1 = 0; float m1 = el[0];
#pragma unroll
    for (int i = 1; i < 8; ++i) if (el[i] > m1) { m1 = el[i]; e1 = i; }
    int e2 = 0; float m2 = -3.0e38f;
#pragma unroll
    for (int i = 0; i < 8; ++i) if (i != e1 && el[i] > m2) { m2 = el[i]; e2 = i; }
    const float w1 = 1.f / (1.f + expf(m2 - m1)), w2 = 1.f - w1;
    if (lane == 0) { re[row * 2] = gi * 8 + e1; re[row * 2 + 1] = gi * 8 + e2; rw[row * 2] = gp * w1; rw[row * 2 + 1] = gp * w2; }
  }
}

__global__ __launch_bounds__(256) void k_moe_naive(const bf16_t* __restrict__ H, const int* __restrict__ re, const float* __restrict__ rw,
                                                   const float* __restrict__ Wg, const float* __restrict__ Wu, const float* __restrict__ Wd, bf16_t* __restrict__ Y) {
  const int row = blockIdx.x, f = threadIdx.x;
  __shared__ float hs[1024];
  __shared__ float as_[256];
  for (int i = f; i < 1024; i += 256) hs[i] = bf2f(H[(size_t)row * D + i]);
  __syncthreads();
  for (int slot = 0; slot < 2; ++slot) {
    const int e = re[row * 2 + slot]; const float w = rw[row * 2 + slot];
    const float* wg = Wg + (size_t)e * 1024 * 256 + f; const float* wu = Wu + (size_t)e * 1024 * 256 + f;
    float g = 0.f, u = 0.f;
#pragma unroll 8
    for (int k = 0; k < 1024; ++k) { g += hs[k] * wg[(size_t)k * 256]; u += hs[k] * wu[(size_t)k * 256]; }
    as_[f] = siluf_(g) * u * w;
    __syncthreads();
    const float* wd = Wd + (size_t)e * 256 * 1024;
    float y[4] = {0.f, 0.f, 0.f, 0.f};
#pragma unroll 4
    for (int k = 0; k < 256; ++k) { const float a = as_[k];
#pragma unroll
      for (int i = 0; i < 4; ++i) y[i] += a * wd[(size_t)k * 1024 + f + 256 * i]; }
#pragma unroll
    for (int i = 0; i < 4; ++i) Y[((size_t)row * 2 + slot) * D + f + 256 * i] = f2bf(y[i]);
    __syncthreads();
  }
}

__global__ __launch_bounds__(512) void k_combine_norm(float* __restrict__ lat, float* __restrict__ ctxr, const bf16_t* __restrict__ Y, const float* __restrict__ modl_cur,
                                                      const float* __restrict__ gain, const float* __restrict__ modl_next, bf16_t* __restrict__ hout, int nrows, int final_) {
  const int lane = threadIdx.x & 63, gw = blockIdx.x * 8 + (threadIdx.x >> 6);
  for (int row = gw; row < nrows; row += gridDim.x * 8) {
    float* src = row < NLAT ? lat + (size_t)row * D : ctxr + (size_t)(row - NLAT) * D;
    const int v = row_vec(row);
    f32x4 x[4]; float ss = 0.f;
#pragma unroll
    for (int j = 0; j < 4; ++j) {
      const int n = (lane + 64 * j) * 4;
      const f32x4 g2 = *(const f32x4*)(modl_cur + v * 6144 + 5120 + n);
      const uint2 y0 = *(const uint2*)(Y + ((size_t)row * 2) * D + n), y1 = *(const uint2*)(Y + ((size_t)row * 2 + 1) * D + n);
      f32x4 ys;
      ys.x = __uint_as_float(y0.x << 16) + __uint_as_float(y1.x << 16); ys.y = __uint_as_float(y0.x & 0xFFFF0000u) + __uint_as_float(y1.x & 0xFFFF0000u);
      ys.z = __uint_as_float(y0.y << 16) + __uint_as_float(y1.y << 16); ys.w = __uint_as_float(y0.y & 0xFFFF0000u) + __uint_as_float(y1.y & 0xFFFF0000u);
      x[j] = ((const f32x4*)src)[lane + 64 * j] + g2 * ys;
      ss += x[j].x * x[j].x + x[j].y * x[j].y + x[j].z * x[j].z + x[j].w * x[j].w;
    }
    const float rstd = 1.f / sqrtf(wave_sum(ss) * (1.f / D) + EPS);
#pragma unroll
    for (int j = 0; j < 4; ++j) {
      const int n = (lane + 64 * j) * 4;
      const f32x4 g = *(const f32x4*)(gain + n);
      if (final_) { ((f32x4*)src)[lane + 64 * j] = x[j] * rstd * g; }
      else {
        ((f32x4*)src)[lane + 64 * j] = x[j];
        const f32x4 sc = *(const f32x4*)(modl_next + v * 6144 + 1024 + n), sh = *(const f32x4*)(modl_next + v * 6144 + n);
        const f32x4 h = x[j] * rstd * g * (sc + 1.f) + sh;
        uint2 o; o.x = pack2(h.x, h.y); o.y = pack2(h.z, h.w);
        *(uint2*)(hout + (size_t)row * D + n) = o;
      }
    }
  }
}

__global__ __launch_bounds__(512) void k_rowssq(const bf16_t* __restrict__ cq, const bf16_t* __restrict__ ckv, float* __restrict__ rq, float* __restrict__ rkv) {
  const int lane = threadIdx.x & 63, gw = blockIdx.x * 8 + (threadIdx.x >> 6);
  for (int row = gw; row < MROWS; row += gridDim.x * 8) {
    { const unsigned w = *(const unsigned*)(ckv + (size_t)row * 128 + lane * 2); const float a = __uint_as_float(w << 16), b = __uint_as_float(w & 0xFFFF0000u);
      const float ss = wave_sum(a * a + b * b); if (lane == 0) rkv[row] = 1.f / sqrtf(ss * (1.f / 128.f) + EPS); }
    if (row < NLAT) { const uint2 w = *(const uint2*)(cq + (size_t)row * 256 + lane * 4);
      const float a = __uint_as_float(w.x << 16), b = __uint_as_float(w.x & 0xFFFF0000u), c = __uint_as_float(w.y << 16), d = __uint_as_float(w.y & 0xFFFF0000u);
      const float ss = wave_sum(a * a + b * b + c * c + d * d); if (lane == 0) rq[row] = 1.f / sqrtf(ss * (1.f / 256.f) + EPS); }
  }
}
__device__ __forceinline__ float rope_inv(int i) { return exp2f(-(float)i * (13.287712379549449f / 8.f)); }
__global__ __launch_bounds__(256) void k_kr_rope(const float* __restrict__ kr, bf16_t* __restrict__ dk) {
  const int idx = blockIdx.x * 256 + threadIdx.x; if (idx >= MROWS * 32) return;
  const int m = idx >> 5, j = idx & 31; int b, key; row_bkey(m, b, key);
  float val = kr[idx];
  if (m < NLAT) {
    const int t = m & 8191; const int half = j >> 4, jj = j & 15, i = jj & 7;
    const float pos = half ? (float)(t & 63) : (float)(t >> 6);
    const float ang = pos * rope_inv(i); float sn, cs; sincosf(ang, &sn, &cs);
    const float x1 = kr[(size_t)m * 32 + half * 16 + i], x2 = kr[(size_t)m * 32 + half * 16 + 8 + i];
    val = (jj < 8) ? (x1 * cs - x2 * sn) : (x1 * sn + x2 * cs);
  }
  const bf16_t o = f2bf(val);
#pragma unroll
  for (int hh = 0; hh < 8; ++hh) dk[((size_t)(b * 8 + hh) * NKEY + key) * 128 + 64 + j] = o;
}

__global__ __launch_bounds__(64) void k_na_naive(const bf16_t* __restrict__ nq, const bf16_t* __restrict__ nk, const bf16_t* __restrict__ nv, const float* __restrict__ rpb,
                                                 bf16_t* __restrict__ A) {
  const int t = blockIdx.x * 64 + threadIdx.x, hh = blockIdx.y, b = blockIdx.z;
  const int r = t >> 6, c = t & 63;
  int rs = r - 4; rs = rs < 0 ? 0 : (rs > 120 ? 120 : rs);
  int cs = c - 8; cs = cs < 0 ? 0 : (cs > 48 ? 48 : cs);
  float q[64], o[64];
  const bf16_t* qp = nq + ((size_t)(b * 8 + hh) * SEQ + t) * 64;
#pragma unroll
  for (int d = 0; d < 64; ++d) { q[d] = bf2f(qp[d]); o[d] = 0.f; }
  const bf16_t* Kb = nk + (size_t)(b * 8 + hh) * NKEY * 64; const bf16_t* Vb = nv + (size_t)(b * 8 + hh) * NKEY * 64;
  float mx = -3.0e38f, l = 0.f;
  for (int kk = 0; kk < 128 + CT; ++kk) {
    int key; float bias = 0.f;
    if (kk < 128) { const int kr_ = rs + (kk >> 4), kc = cs + (kk & 15); key = CT + kr_ * 64 + kc; bias = rpb[(hh * 15 + (kr_ - r + 7)) * 31 + (kc - c + 15)] * LOG2E; }
    else key = kk - 128;
    const bf16_t* kp = Kb + (size_t)key * 64; float s = bias;
#pragma unroll
    for (int d = 0; d < 64; d += 2) { const unsigned w = *(const unsigned*)(kp + d); s += q[d] * __uint_as_float(w << 16) + q[d + 1] * __uint_as_float(w & 0xFFFF0000u); }
    const float mn = fmaxf(mx, s), alpha = exp2f(mx - mn), p = exp2f(s - mn);
    l = l * alpha + p; mx = mn;
    const bf16_t* vp = Vb + (size_t)key * 64;
#pragma unroll
    for (int d = 0; d < 64; d += 2) { const unsigned w = *(const unsigned*)(vp + d); o[d] = o[d] * alpha + p * __uint_as_float(w << 16); o[d + 1] = o[d + 1] * alpha + p * __uint_as_float(w & 0xFFFF0000u); }
  }
  const float il = 1.f / l;
  bf16_t* op = A + (size_t)(b * SEQ + t) * D + hh * 64;
#pragma unroll
  for (int d = 0; d < 64; d += 2) *(unsigned*)(op + d) = pack2(o[d] * il, o[d + 1] * il);
}
__global__ __launch_bounds__(64) void k_mla_naive(const bf16_t* __restrict__ dq, const bf16_t* __restrict__ dk, const bf16_t* __restrict__ dv, bf16_t* __restrict__ A) {
  const int t = blockIdx.x * 64 + threadIdx.x, hh = blockIdx.y, b = blockIdx.z;
  float q[96], o[64];
  const bf16_t* qp = dq + ((size_t)(b * 8 + hh) * SEQ + t) * 96;
#pragma unroll
  for (int d = 0; d < 96; ++d) q[d] = bf2f(qp[d]);
#pragma unroll
  for (int half = 0; half < 2; ++half) {
    const float pos = half ? (float)(t & 63) : (float)(t >> 6);
#pragma unroll
    for (int i = 0; i < 8; ++i) { float sn, cs; sincosf(pos * rope_inv(i), &sn, &cs);
      const float x1 = q[64 + half * 16 + i], x2 = q[64 + half * 16 + 8 + i];
      q[64 + half * 16 + i] = x1 * cs - x2 * sn; q[64 + half * 16 + 8 + i] = x1 * sn + x2 * cs; }
  }
#pragma unroll
  for (int d = 0; d < 64; ++d) o[d] = 0.f;
  const bf16_t* Kb = dk + (size_t)(b * 8 + hh) * NKEY * 128; const bf16_t* Vb = dv + (size_t)(b * 8 + hh) * NKEY * 64;
  float mx = -3.0e38f, l = 0.f;
  for (int k0 = 0; k0 < NKEY; k0 += 8) {
    float s[8]; float bm = -3.0e38f;
#pragma unroll
    for (int j = 0; j < 8; ++j) { const bf16_t* kp = Kb + (size_t)(k0 + j) * 128; float a = 0.f;
#pragma unroll
      for (int d = 0; d < 96; d += 2) { const unsigned w = *(const unsigned*)(kp + d); a += q[d] * __uint_as_float(w << 16) + q[d + 1] * __uint_as_float(w & 0xFFFF0000u); }
      s[j] = a; bm = fmaxf(bm, a); }
    const float mn = fmaxf(mx, bm), alpha = exp2f(mx - mn); mx = mn; l *= alpha;
#pragma unroll
    for (int d = 0; d < 64; ++d) o[d] *= alpha;
#pragma unroll
    for (int j = 0; j < 8; ++j) { const float p = exp2f(s[j] - mn); l += p; const bf16_t* vp = Vb + (size_t)(k0 + j) * 64;
#pragma unroll
      for (int d = 0; d < 64; d += 2) { const unsigned w = *(const unsigned*)(vp + d); o[d] += p * __uint_as_float(w << 16); o[d + 1] += p * __uint_as_float(w & 0xFFFF0000u); } }
  }
  const float il = 1.f / l;
  bf16_t* op = A + (size_t)(b * SEQ + t) * D + 512 + hh * 64;
#pragma unroll
  for (int d = 0; d < 64; d += 2) *(unsigned*)(op + d) = pack2(o[d] * il, o[d + 1] * il);
}

static void conv(hipStream_t st, const float* src, bf16_t* dst, const float* kscale, int K, int N, int Npad, int mode, int batch, size_t sbs, size_t dbs) {
  ConvArgs a; a.src = src; a.dst = dst; a.kscale = kscale; a.K = K; a.N = N; a.Npad = Npad; a.mode = mode; a.sbs = sbs; a.dbs = dbs;
  hipLaunchKernelGGL(k_convT, dim3((Npad + 63) / 64, K / 64, batch), dim3(512), 0, st, a);
}

extern "C" void kernel_launch(void* const* d_in, const int* in_sizes, int n_in, void* d_out, int out_size, void* d_ws, size_t ws_size, hipStream_t stream) {
  if (n_in != 29 || in_sizes[0] != NLAT * D || out_size != NLAT * D || ws_size < WS_END) {
    fprintf(stderr, "kernel_launch: unexpected shapes (n_in %d, in0 %d, out %d, ws %zu, need %zu)\n", n_in, n_in > 0 ? in_sizes[0] : -1, out_size, ws_size, (size_t)WS_END);
    return;
  }
  const float* x = (const float*)d_in[0]; const float* c = (const float*)d_in[1]; const float* ctx = (const float*)d_in[2]; const float* c_ctx = (const float*)d_in[3];
  const float* ada_w = (const float*)d_in[4]; const float* ada_b = (const float*)d_in[5]; const float* norm1_g = (const float*)d_in[6]; const float* norm2_g = (const float*)d_in[7];
  const float* ab_w_in = (const float*)d_in[8]; const float* ab_w_out = (const float*)d_in[9]; const float* lb_logits = (const float*)d_in[10]; const float* onorm_g = (const float*)d_in[11];
  const float* pool_w = (const float*)d_in[12]; const float* pool_scale = (const float*)d_in[13]; const float* cd_w_in = (const float*)d_in[14]; const float* cd_w_out = (const float*)d_in[15];
  const float* na_rpb = (const float*)d_in[16]; const float* q_norm_g = (const float*)d_in[17]; const float* w_uq = (const float*)d_in[18]; const float* kv_norm_g = (const float*)d_in[19];
  const float* w_ukv = (const float*)d_in[20]; const float* w_rg = (const float*)d_in[21]; const float* b_rg = (const float*)d_in[22]; const float* w_re = (const float*)d_in[23];
  const float* b_re = (const float*)d_in[24]; const float* w_gate = (const float*)d_in[25]; const float* w_up = (const float*)d_in[26]; const float* w_down = (const float*)d_in[27];
  const float* final_g = (const float*)d_in[28];
  char* ws = (char*)d_ws; float* out = (float*)d_out;
  float* mods = (float*)(ws + WS_MODS); float* lb = (float*)(ws + WS_LB); float* xc = (float*)(ws + WS_XC);
  int* route_e = (int*)(ws + WS_ROUTE_E); float* route_w = (float*)(ws + WS_ROUTE_W); float* rstd_q = (float*)(ws + WS_RSTD_Q); float* rstd_kv = (float*)(ws + WS_RSTD_KV);
  float* odir_ctx = (float*)(ws + WS_ODIR_CTX);
  bf16_t* wt_abin = (bf16_t*)(ws + WS_WT_ABIN); bf16_t* wt_about = (bf16_t*)(ws + WS_WT_ABOUT); bf16_t* wt_cdin = (bf16_t*)(ws + WS_WT_CDIN); bf16_t* wt_cdout = (bf16_t*)(ws + WS_WT_CDOUT);
  bf16_t* wt_uq = (bf16_t*)(ws + WS_WT_UQ); bf16_t* wt_ukv = (bf16_t*)(ws + WS_WT_UKV); bf16_t* wt_pool = (bf16_t*)(ws + WS_WT_POOL);
  bf16_t* hbuf = (bf16_t*)(ws + WS_H); bf16_t* abuf = (bf16_t*)(ws + WS_A); bf16_t* U = (bf16_t*)(ws + WS_U); float* LF = (float*)(ws + WS_LF);
  bf16_t* nq = (bf16_t*)(ws + WS_NQ); bf16_t* nk = (bf16_t*)(ws + WS_NK); bf16_t* nv = (bf16_t*)(ws + WS_NV); bf16_t* cq = (bf16_t*)(ws + WS_CQ); bf16_t* ckv = (bf16_t*)(ws + WS_CKV);
  float* kr = (float*)(ws + WS_KR); bf16_t* dq = (bf16_t*)(ws + WS_DQ); bf16_t* dk = (bf16_t*)(ws + WS_DK); bf16_t* dv = (bf16_t*)(ws + WS_DV); bf16_t* ybuf = (bf16_t*)(ws + WS_YBUF);
  const float* mods0 = mods; const float* mods1 = mods + 3 * 6144;

  hipLaunchKernelGGL(k_ada, dim3(96, 2), dim3(512), 0, stream, c, c_ctx, ada_w, ada_b, mods);
  hipLaunchKernelGGL(k_lb, dim3(4), dim3(256), 0, stream, lb_logits, lb);
  conv(stream, ab_w_in, wt_abin, nullptr, 1024, 3072, 3072, 0, 1, 0, 0);
  conv(stream, ab_w_out, wt_about, nullptr, 1024, 1024, 1024, 0, 1, 0, 0);
  conv(stream, cd_w_in, wt_cdin, nullptr, 1024, 1952, 2048, 0, 1, 0, 0);
  conv(stream, cd_w_out, wt_cdout, nullptr, 1024, 1024, 1024, 0, 1, 0, 0);
  conv(stream, w_uq, wt_uq, q_norm_g, 256, 768, 768, 0, 1, 0, 0);
  conv(stream, w_ukv, wt_ukv, kv_norm_g, 128, 1024, 1024, 0, 1, 0, 0);
  conv(stream, pool_w, wt_pool, nullptr, 128, 128, 128, 0, 4, (size_t)128 * 128, (size_t)128 * 128);

  hipLaunchKernelGGL(k_norm_mod, dim3(1024), dim3(512), 0, stream, x, ctx, norm1_g, mods0, 0, 1024, hbuf, MROWS);
  { EpiABIn e; e.U = U; e.LF = LF; e.lb = lb; launch_gemm_naive(stream, hbuf, D, wt_abin, 1024, MROWS, 3072, 1024, e); }
  hipLaunchKernelGGL(k_hgrn_naive, dim3(16), dim3(128), 0, stream, U, LF, out  , odir_ctx);
  hipLaunchKernelGGL(k_hgrn_out, dim3(1024), dim3(512), 0, stream, out, odir_ctx, U + 4 * (size_t)MROWS * 512, onorm_g, abuf);
  hipLaunchKernelGGL(k_pool_prep, dim3(2048), dim3(512), 0, stream, U + 5 * (size_t)MROWS * 512, hbuf  );
  for (int gi = 0; gi < 4; ++gi) { EpiPool e; e.pad = 0; e.A = abuf; e.scale = pool_scale; e.gi = gi; launch_gemm_naive(stream, hbuf + gi * 128, 512, wt_pool + (size_t)gi * 128 * 128, 128, MROWS, 128, 128, e); }
  { EpiOutRes e; e.pad = 0; e.base_lat = x; e.base_ctx = ctx; e.out_lat = out; e.out_ctx = xc; e.modl = mods0; e.g_off = 2048; launch_gemm_naive(stream, abuf, D, wt_about, 1024, MROWS, 1024, 1024, e); }
  hipLaunchKernelGGL(k_router, dim3(1024), dim3(512), 0, stream, out, xc, norm2_g, mods0, w_rg, b_rg, w_re, b_re, hbuf, route_e, route_w, MROWS);
  hipLaunchKernelGGL(k_moe_naive, dim3(MROWS), dim3(256), 0, stream, hbuf, route_e, route_w, w_gate, w_up, w_down, ybuf);
  hipLaunchKernelGGL(k_combine_norm, dim3(1024), dim3(512), 0, stream, out, xc, ybuf, mods0, norm1_g + 1024, mods1, hbuf, MROWS, 0);

  { EpiCDIn e; e.nq = nq; e.nk = nk; e.nv = nv; e.cq = cq; e.ckv = ckv; e.kr = kr; launch_gemm_naive(stream, hbuf, D, wt_cdin, 1024, MROWS, 2048, 1024, e); }
  hipLaunchKernelGGL(k_rowssq, dim3(1024), dim3(512), 0, stream, cq, ckv, rstd_q, rstd_kv);
  { EpiMlaQ e; e.dq = dq; e.rstd = rstd_q; launch_gemm_naive(stream, cq, 256, wt_uq, 256, NLAT, 768, 256, e); }
  { EpiMlaKV e; e.dk = dk; e.dv = dv; e.rstd = rstd_kv; launch_gemm_naive(stream, ckv, 128, wt_ukv, 128, MROWS, 1024, 128, e); }
  hipLaunchKernelGGL(k_kr_rope, dim3((MROWS * 32 + 255) / 256), dim3(256), 0, stream, kr, dk);
  hipLaunchKernelGGL(k_na_naive, dim3(SEQ / 64, 8, NB), dim3(64), 0, stream, nq, nk, nv, na_rpb, abuf);
  hipLaunchKernelGGL(k_mla_naive, dim3(SEQ / 64, 8, NB), dim3(64), 0, stream, dq, dk, dv, abuf);
  { EpiOutRes e; e.pad = 0; e.base_lat = out; e.base_ctx = xc; e.out_lat = out; e.out_ctx = xc; e.modl = mods1; e.g_off = 2048; launch_gemm_naive(stream, abuf, D, wt_cdout, 1024, NLAT, 1024, 1024, e); }
  hipLaunchKernelGGL(k_router, dim3(1024), dim3(512), 0, stream, out, xc, norm2_g + 1024, mods1, w_rg + 1024 * 4, b_rg + 4, w_re + 1024 * 32, b_re + 32, hbuf, route_e, route_w, NLAT);
  hipLaunchKernelGGL(k_moe_naive, dim3(NLAT), dim3(256), 0, stream, hbuf, route_e, route_w, w_gate + (size_t)32 * 1024 * 256, w_up + (size_t)32 * 1024 * 256, w_down + (size_t)32 * 256 * 1024, ybuf);
  hipLaunchKernelGGL(k_combine_norm, dim3(1024), dim3(512), 0, stream, out, xc, ybuf, mods1, final_g, mods1, hbuf, NLAT, 1);
}
```

```cpp
#include <hip/hip_runtime.h>
#include <stdint.h>
#include <cstdio>
#include <cstring>

typedef unsigned short bf16_t;
typedef float f32x4 __attribute__((ext_vector_type(4)));

constexpr int D = 1024, NB = 2, SEQ = 8192, CT = 256;
constexpr int NLAT = NB * SEQ;
constexpr int NCTX = NB * CT;
constexpr int MROWS = NLAT + NCTX;
constexpr int NKEY = CT + SEQ;
constexpr float EPS = 1e-6f;
constexpr float LOG2E = 1.4426950408889634f;
constexpr float NA_QSCALE = 0.125f * LOG2E;
constexpr float MLA_QSCALE = 0.10206207261596577f * LOG2E;

constexpr size_t alignup(size_t x) { return (x + 255) & ~(size_t)255; }
constexpr size_t WS_CTL      = 0;
constexpr size_t WS_MODS     = 65536;
constexpr size_t WS_LB       = WS_MODS + alignup(2 * 3 * 6144 * 4);
constexpr size_t WS_XC       = WS_LB + 4096;
constexpr size_t WS_ROUTE_E  = WS_XC + (size_t)NCTX * D * 4;
constexpr size_t WS_ROUTE_W  = WS_ROUTE_E + alignup((size_t)MROWS * 2 * 4);
constexpr size_t WS_RSTD_Q   = WS_ROUTE_W + alignup((size_t)MROWS * 2 * 4);
constexpr size_t WS_RSTD_KV  = WS_RSTD_Q + alignup((size_t)NLAT * 4);
constexpr size_t WS_ODIR_CTX = WS_RSTD_KV + alignup((size_t)MROWS * 4);
constexpr size_t WS_LIST     = WS_ODIR_CTX + (size_t)2 * NCTX * 512 * 4;
constexpr size_t WS_WT_ABIN  = WS_LIST + (size_t)32 * MROWS * 4;
constexpr size_t WS_WT_ABOUT = WS_WT_ABIN + (size_t)3072 * 1024 * 2;
constexpr size_t WS_WT_CDIN  = WS_WT_ABOUT + (size_t)1024 * 1024 * 2;
constexpr size_t WS_WT_CDOUT = WS_WT_CDIN + (size_t)2048 * 1024 * 2;
constexpr size_t WS_WT_UQ    = WS_WT_CDOUT + (size_t)1024 * 1024 * 2;
constexpr size_t WS_WT_UKV   = WS_WT_UQ + (size_t)768 * 256 * 2;
constexpr size_t WS_WT_POOL  = WS_WT_UKV + (size_t)1024 * 128 * 2;
constexpr size_t WS_WMOE     = WS_WT_POOL + (size_t)4 * 128 * 128 * 2;
constexpr size_t WS_H        = WS_WMOE + (size_t)32 * 512 * 1024 * 2 + (size_t)32 * 1024 * 256 * 2;
constexpr size_t WS_A        = WS_H + (size_t)MROWS * D * 2;
constexpr size_t WS_U        = WS_A + (size_t)MROWS * D * 2;
constexpr size_t USLOT       = (size_t)MROWS * 512 * 2;
constexpr size_t WS_LF       = WS_U + 6 * USLOT;
constexpr size_t WS_END      = WS_LF + (size_t)2 * MROWS * 512 * 4;
constexpr size_t WS_NQ   = WS_U;
constexpr size_t WS_NK   = WS_NQ + (size_t)NLAT * 512 * 2;
constexpr size_t WS_NV   = WS_NK + USLOT;
constexpr size_t WS_CQ   = WS_NV + USLOT;
constexpr size_t WS_CKV  = WS_CQ + (size_t)NLAT * 256 * 2;
constexpr size_t WS_KR   = WS_CKV + (size_t)MROWS * 128 * 2;
constexpr size_t WS_DQ   = WS_KR + (size_t)MROWS * 32 * 4;
constexpr size_t WS_L1END = WS_DQ + (size_t)NLAT * 768 * 2;
static_assert(WS_L1END <= WS_LF, "layer-1 overlay too big");
constexpr size_t WS_DK   = WS_LF;
constexpr size_t WS_DV   = WS_DK + (size_t)MROWS * 1024 * 2;
static_assert(WS_DV + (size_t)MROWS * 512 * 2 <= WS_END, "dk/dv overlay too big");
constexpr size_t WS_YBUF = WS_LF;
constexpr size_t WS_AMOE = WS_U;

__device__ __forceinline__ float bf2f(bf16_t h) { return __uint_as_float(((unsigned)h) << 16); }
__device__ __forceinline__ bf16_t f2bf(float f) { unsigned u = __float_as_uint(f); u += 0x7FFFu + ((u >> 16) & 1u); return (bf16_t)(u >> 16); }
__device__ __forceinline__ unsigned pack2(float a, float b) { return (unsigned)f2bf(a) | ((unsigned)f2bf(b) << 16); }
__device__ __forceinline__ float sigmoidf_(float x) { return 1.f / (1.f + __expf(-x)); }
__device__ __forceinline__ float siluf_(float x) { return x / (1.f + __expf(-x)); }
__device__ __forceinline__ float wave_sum(float v) {
#pragma unroll
  for (int o = 1; o < 64; o <<= 1) v += __shfl_xor(v, o);
  return v;
}
__device__ __forceinline__ int row_vec(int m) { return m < NLAT ? (m >> 13) : 2; }
__device__ __forceinline__ void row_bkey(int m, int& b, int& key) {
  if (m < NLAT) { b = m >> 13; key = CT + (m & 8191); } else { const int mm = m - NLAT; b = mm >> 8; key = mm & 255; }
}

__global__ __launch_bounds__(512) void k_ada(const float* __restrict__ c, const float* __restrict__ cctx, const float* __restrict__ ada_w,
                                             const float* __restrict__ ada_b, float* __restrict__ mods) {
  const int l = blockIdx.y, n0 = blockIdx.x * 64, j = threadIdx.x & 63, kg = threadIdx.x >> 6;
  __shared__ float sv[3][1024];
  __shared__ float red[8][3][64];
  for (int i = threadIdx.x; i < 1024; i += 512) { sv[0][i] = siluf_(c[i]); sv[1][i] = siluf_(c[1024 + i]); sv[2][i] = siluf_(cctx[i]); }
  __syncthreads();
  const float* W = ada_w + (size_t)l * 1024 * 6144 + n0 + j;
  float a0 = 0.f, a1 = 0.f, a2 = 0.f;
  for (int k = kg * 128; k < kg * 128 + 128; ++k) { const float w = W[(size_t)k * 6144]; a0 += sv[0][k] * w; a1 += sv[1][k] * w; a2 += sv[2][k] * w; }
  red[kg][0][j] = a0; red[kg][1][j] = a1; red[kg][2][j] = a2;
  __syncthreads();
  if (threadIdx.x < 192) {
    const int v = threadIdx.x >> 6, jj = threadIdx.x & 63; float s = 0.f;
    for (int g = 0; g < 8; ++g) s += red[g][v][jj];
    mods[(size_t)(l * 3 + v) * 6144 + n0 + jj] = s + ada_b[l * 6144 + n0 + jj];
  }
}
__global__ void k_lb(const float* __restrict__ logits, float* __restrict__ lb) {
  const int i = blockIdx.x * blockDim.x + threadIdx.x;
  if (i < 1024) { const int d = i >> 9, cc = i & 511; const float l0 = logits[(d * 2 + 0) * 512 + cc], l1 = logits[(d * 2 + 1) * 512 + cc]; lb[i] = 1.f / (1.f + expf(l1 - l0)); }
}

struct ConvArgs { const float* src; bf16_t* dst; const float* kscale; int K, N, Npad, mode; size_t sbs, dbs; };
__device__ __forceinline__ int moe_gu_row(int sel, int hidden) {
  const int nt = hidden >> 6, hl = hidden & 63, wc = hl >> 5, i2 = (hl >> 4) & 1, cc = hl & 15;
  return nt * 128 + wc * 64 + (sel * 2 + i2) * 16 + cc;
}
__global__ __launch_bounds__(512) void k_convT(ConvArgs a) {
  __shared__ float tile[64][65];
  const float* src = a.src + blockIdx.z * a.sbs; bf16_t* dst = a.dst + blockIdx.z * a.dbs;
  const int n0 = blockIdx.x * 64, k0 = blockIdx.y * 64, tx = threadIdx.x & 63, ty = threadIdx.x >> 6;
#pragma unroll
  for (int i = 0; i < 8; ++i) {
    const int k = k0 + ty + 8 * i, n = n0 + tx; float v = 0.f;
    if (n < a.N) { v = src[(size_t)k * a.N + n]; if (a.kscale) v *= a.kscale[k]; }
    tile[ty + 8 * i][tx] = v;
  }
  __syncthreads();
#pragma unroll
  for (int i = 0; i < 8; ++i) {
    const int nl = ty + 8 * i, n = n0 + nl;
    if (n < a.Npad) { int row = n; if (a.mode == 1) row = moe_gu_row(0, n); else if (a.mode == 2) row = moe_gu_row(1, n);
      dst[(size_t)row * a.K + k0 + tx] = f2bf(tile[tx][nl]); }
  }
}

__global__ __launch_bounds__(512) void k_norm_mod(const float* __restrict__ lat, const float* __restrict__ ctxr, const float* __restrict__ gain,
                                                  const float* __restrict__ modl, int sh_off, int sc_off, bf16_t* __restrict__ out, int nrows) {
  const int lane = threadIdx.x & 63, gw = blockIdx.x * 8 + (threadIdx.x >> 6);
  for (int row = gw; row < nrows; row += gridDim.x * 8) {
    const float* src = row < NLAT ? lat + (size_t)row * D : ctxr + (size_t)(row - NLAT) * D;
    const float* mv = modl + row_vec(row) * 6144;
    f32x4 x[4]; float ss = 0.f;
#pragma unroll
    for (int j = 0; j < 4; ++j) { x[j] = ((const f32x4*)src)[lane + 64 * j]; ss += x[j].x * x[j].x + x[j].y * x[j].y + x[j].z * x[j].z + x[j].w * x[j].w; }
    const float rstd = 1.f / sqrtf(wave_sum(ss) * (1.f / D) + EPS);
#pragma unroll
    for (int j = 0; j < 4; ++j) {
      const int n = (lane + 64 * j) * 4;
      const f32x4 g = *(const f32x4*)(gain + n), sc = *(const f32x4*)(mv + sc_off + n), sh = *(const f32x4*)(mv + sh_off + n);
      const f32x4 h = x[j] * rstd * g * (sc + 1.f) + sh;
      uint2 o; o.x = pack2(h.x, h.y); o.y = pack2(h.z, h.w);
      *(uint2*)(out + (size_t)row * D + n) = o;
    }
  }
}

struct EpiABIn {
  bf16_t* U; float* LF; const float* lb;
  __device__ __forceinline__ void apply(int m, int n, f32x4 v) const {
    const int seg = n >> 9, cn = n & 511; float o[4] = {v.x, v.y, v.z, v.w};
    bf16_t* dst;
    if (seg == 0) { dst = U; for (int i = 0; i < 4; ++i) o[i] = siluf_(o[i]); }
    else if (seg == 1 || seg == 2) { const int d = seg - 1; dst = U + (size_t)(1 + d) * MROWS * 512;
      f32x4 lg;
#pragma unroll
      for (int i = 0; i < 4; ++i) { const float l = lb[d * 512 + cn + i]; const float k = (1.f - l) * sigmoidf_(-o[i]); o[i] = k; lg[i] = log1pf(-k); }
      *(f32x4*)(LF + ((size_t)d * MROWS + m) * 512 + cn) = lg; }
    else if (seg == 3) dst = U + (size_t)3 * MROWS * 512;
    else if (seg == 4) { dst = U + (size_t)4 * MROWS * 512; for (int i = 0; i < 4; ++i) o[i] = siluf_(o[i]); }
    else dst = U + (size_t)5 * MROWS * 512;
    uint2 w; w.x = pack2(o[0], o[1]); w.y = pack2(o[2], o[3]);
    *(uint2*)(dst + (size_t)m * 512 + cn) = w;
  }
};
struct EpiPool {
  bf16_t* A; const float* scale; int gi; int pad;
  __device__ __forceinline__ void apply(int m, int n, f32x4 v) const {
    const int cn = gi * 128 + n; const f32x4 s = *(const f32x4*)(scale + cn); v = v * s;
    uint2 w; w.x = pack2(v.x, v.y); w.y = pack2(v.z, v.w);
    *(uint2*)(A + (size_t)m * D + 512 + cn) = w;
  }
};
struct EpiOutRes {
  const float* base_lat; const float* base_ctx; float* out_lat; float* out_ctx; const float* modl; int g_off; int pad;
  __device__ __forceinline__ void apply(int m, int n, f32x4 v) const {
    const f32x4 g = *(const f32x4*)(modl + row_vec(m) * 6144 + g_off + n);
    if (m < NLAT) { const f32x4 b = *(const f32x4*)(base_lat + (size_t)m * D + n); *(f32x4*)(out_lat + (size_t)m * D + n) = b + g * v; }
    else { const size_t o = (size_t)(m - NLAT) * D + n; const f32x4 b = *(const f32x4*)(base_ctx + o); *(f32x4*)(out_ctx + o) = b + g * v; }
  }
};
struct EpiCDIn {
  bf16_t *nq, *nk, *nv, *cq, *ckv; float* kr;
  __device__ __forceinline__ void apply(int m, int n, f32x4 v) const {
    int b, key; row_bkey(m, b, key);
    if (n < 1536) {
      const int which = n >> 9, hh = (n & 511) >> 6, dd = n & 63;
      if (which == 0) { if (m >= NLAT) return; v = v * NA_QSCALE;
        uint2 w; w.x = pack2(v.x, v.y); w.y = pack2(v.z, v.w);
        *(uint2*)(nq + (((size_t)(b * 8 + hh) * SEQ + (m & 8191)) * 64 + dd)) = w; }
      else { bf16_t* dst = which == 1 ? nk : nv; uint2 w; w.x = pack2(v.x, v.y); w.y = pack2(v.z, v.w);
        *(uint2*)(dst + (((size_t)(b * 8 + hh) * NKEY + key) * 64 + dd)) = w; }
    } else if (n < 1792) { if (m >= NLAT) return; uint2 w; w.x = pack2(v.x, v.y); w.y = pack2(v.z, v.w); *(uint2*)(cq + (size_t)m * 256 + (n - 1536)) = w; }
    else if (n < 1920) { uint2 w; w.x = pack2(v.x, v.y); w.y = pack2(v.z, v.w); *(uint2*)(ckv + (size_t)m * 128 + (n - 1792)) = w; }
    else if (n < 1952) { *(f32x4*)(kr + (size_t)m * 32 + (n - 1920)) = v; }
  }
};
struct EpiMlaQ {
  bf16_t* dq; const float* rstd;
  __device__ __forceinline__ void apply(int m, int n, f32x4 v) const {
    const int hh = n / 96, off = n - hh * 96; v = v * (rstd[m] * MLA_QSCALE);
    uint2 w; w.x = pack2(v.x, v.y); w.y = pack2(v.z, v.w);
    *(uint2*)(dq + (((size_t)((m >> 13) * 8 + hh) * SEQ + (m & 8191)) * 96 + off)) = w;
  }
};
struct EpiMlaKV {
  bf16_t *dk, *dv; const float* rstd;
  __device__ __forceinline__ void apply(int m, int n, f32x4 v) const {
    int b, key; row_bkey(m, b, key);
    const int hh = n >> 7, off = n & 127; v = v * rstd[m];
    uint2 w; w.x = pack2(v.x, v.y); w.y = pack2(v.z, v.w);
    if (off < 64) *(uint2*)(dk + (((size_t)(b * 8 + hh) * NKEY + key) * 128 + off)) = w;
    else *(uint2*)(dv + (((size_t)(b * 8 + hh) * NKEY + key) * 64 + (off - 64))) = w;
  }
};

template <class Epi>
__global__ __launch_bounds__(256) void k_gemm_naive(const bf16_t* __restrict__ A, int lda, const bf16_t* __restrict__ Bt, int ldb, int M, int N, int K, Epi epi) {
  __shared__ float As[32][68];
  __shared__ float Bs[32][68];
  const int m0 = blockIdx.y * 64, n0 = blockIdx.x * 64, t = threadIdx.x, tx = t & 15, ty = t >> 4;
  float acc[4][4];
#pragma unroll
  for (int i = 0; i < 4; ++i)
#pragma unroll
    for (int j = 0; j < 4; ++j) acc[i][j] = 0.f;
  const int lr = t >> 2, lk = (t & 3) * 8;
  for (int k0 = 0; k0 < K; k0 += 32) {
    uint4 ra = make_uint4(0, 0, 0, 0), rb = make_uint4(0, 0, 0, 0);
    if (m0 + lr < M) ra = *(const uint4*)(A + (size_t)(m0 + lr) * lda + k0 + lk);
    if (n0 + lr < N) rb = *(const uint4*)(Bt + (size_t)(n0 + lr) * ldb + k0 + lk);
    const unsigned wa[4] = {ra.x, ra.y, ra.z, ra.w}, wb[4] = {rb.x, rb.y, rb.z, rb.w};
#pragma unroll
    for (int i = 0; i < 4; ++i) {
      As[lk + 2 * i][lr] = __uint_as_float(wa[i] << 16); As[lk + 2 * i + 1][lr] = __uint_as_float(wa[i] & 0xFFFF0000u);
      Bs[lk + 2 * i][lr] = __uint_as_float(wb[i] << 16); Bs[lk + 2 * i + 1][lr] = __uint_as_float(wb[i] & 0xFFFF0000u);
    }
    __syncthreads();
#pragma unroll 8
    for (int kk = 0; kk < 32; ++kk) {
      const f32x4 a = *(const f32x4*)&As[kk][ty * 4], b = *(const f32x4*)&Bs[kk][tx * 4];
      const float av[4] = {a.x, a.y, a.z, a.w}, bv[4] = {b.x, b.y, b.z, b.w};
#pragma unroll
      for (int i = 0; i < 4; ++i)
#pragma unroll
        for (int j = 0; j < 4; ++j) acc[i][j] += av[i] * bv[j];
    }
    __syncthreads();
  }
#pragma unroll
  for (int i = 0; i < 4; ++i) {
    const int m = m0 + ty * 4 + i, n = n0 + tx * 4;
    if (m < M && n < N) { f32x4 v = {acc[i][0], acc[i][1], acc[i][2], acc[i][3]}; epi.apply(m, n, v); }
  }
}
template <class Epi>
static void launch_gemm_naive(hipStream_t st, const bf16_t* A, int lda, const bf16_t* Bt, int ldb, int M, int N, int K, Epi epi) {
  hipLaunchKernelGGL((k_gemm_naive<Epi>), dim3((N + 63) / 64, (M + 63) / 64), dim3(256), 0, st, A, lda, Bt, ldb, M, N, K, epi);
}

__device__ __forceinline__ int hgrn_step_row(int b, int dir, int s) {
  if (s < CT) return NLAT + b * CT + (dir ? (CT - 1 - s) : s);
  const int ls = s - CT; return b * SEQ + (dir ? (SEQ - 1 - ls) : ls);
}
__global__ __launch_bounds__(128) void k_hgrn_naive(const bf16_t* __restrict__ U, const float* __restrict__ LF, float* __restrict__ odir_lat, float* __restrict__ odir_ctx) {
  const int bid = blockIdx.x, dir = bid & 1, h = (bid >> 1) & 3, b = bid >> 3, e = threadIdx.x;
  __shared__ float sf[32][128];
  __shared__ float sk[32][128];
  __shared__ float sq[32][128];
  float Sreg[128];
#pragma unroll
  for (int d = 0; d < 128; ++d) Sreg[d] = 0.f;
  const bf16_t* Uq = U; const bf16_t* Uk = U + (size_t)(1 + dir) * MROWS * 512; const bf16_t* Uv = U + (size_t)3 * MROWS * 512;
  const float* lf = LF + (size_t)dir * MROWS * 512;
  for (int s0 = 0; s0 < NKEY; s0 += 32) {
    __syncthreads();
    for (int i = 0; i < 32; ++i) {
      const size_t off = (size_t)hgrn_step_row(b, dir, s0 + i) * 512 + h * 128 + e;
      sf[i][e] = expf(lf[off]); sk[i][e] = bf2f(Uk[off]); sq[i][e] = bf2f(Uq[off]);
    }
    __syncthreads();
    for (int i = 0; i < 32; ++i) {
      const int row = hgrn_step_row(b, dir, s0 + i);
      const float v = bf2f(Uv[(size_t)row * 512 + h * 128 + e]); float o = 0.f;
#pragma unroll
      for (int d = 0; d < 128; ++d) { Sreg[d] = sf[i][d] * Sreg[d] + sk[i][d] * v; o += Sreg[d] * sq[i][d]; }
      if (row < NLAT) odir_lat[((size_t)dir * NLAT + row) * 512 + h * 128 + e] = o;
      else odir_ctx[((size_t)dir * NCTX + (row - NLAT)) * 512 + h * 128 + e] = o;
    }
  }
}
__global__ __launch_bounds__(512) void k_hgrn_out(const float* __restrict__ odir_lat, const float* __restrict__ odir_ctx, const bf16_t* __restrict__ Ug,
                                                  const float* __restrict__ onorm_g, bf16_t* __restrict__ A) {
  const int lane = threadIdx.x & 63, gw = blockIdx.x * 8 + (threadIdx.x >> 6);
  for (int row = gw; row < MROWS; row += gridDim.x * 8) {
    const float* pf = row < NLAT ? odir_lat + (size_t)row * 512 : odir_ctx + (size_t)(row - NLAT) * 512;
    const float* pb = row < NLAT ? odir_lat + ((size_t)NLAT + row) * 512 : odir_ctx + ((size_t)NCTX + (row - NLAT)) * 512;
    const int c0 = lane * 8; float o[8]; float ss = 0.f;
#pragma unroll
    for (int i = 0; i < 8; ++i) { o[i] = pf[c0 + i] + pb[c0 + i]; ss += o[i] * o[i]; }
    ss += __shfl_xor(ss, 1); ss += __shfl_xor(ss, 2); ss += __shfl_xor(ss, 4); ss += __shfl_xor(ss, 8);
    const float rstd = 1.f / sqrtf(ss * (1.f / 128.f) + EPS);
    const uint4 gr = *(const uint4*)(Ug + (size_t)row * 512 + c0); const unsigned gw4[4] = {gr.x, gr.y, gr.z, gr.w};
    unsigned w[4];
#pragma unroll
    for (int i = 0; i < 4; ++i) {
      const float g0 = __uint_as_float(gw4[i] << 16), g1 = __uint_as_float(gw4[i] & 0xFFFF0000u);
      const int e0 = (c0 + 2 * i) & 127;
      w[i] = pack2(o[2 * i] * rstd * onorm_g[e0] * g0, o[2 * i + 1] * rstd * onorm_g[e0 + 1] * g1);
    }
    *(uint4*)(A + (size_t)row * D + c0) = make_uint4(w[0], w[1], w[2], w[3]);
  }
}
__global__ __launch_bounds__(512) void k_pool_prep(const bf16_t* __restrict__ Up, bf16_t* __restrict__ pd) {
  const int c = threadIdx.x;
  for (int row = blockIdx.x; row < MROWS; row += gridDim.x) {
    int base, t, n; if (row < NLAT) { base = row & ~8191; t = row & 8191; n = SEQ; } else { const int mm = row - NLAT; base = NLAT + (mm & ~255); t = mm & 255; n = CT; }
    const int gi = c >> 7, win = 2 << gi; int lo = t - win / 2, hi = t + win - win / 2; lo = lo < 0 ? 0 : lo; hi = hi > n ? n : hi;
    float s = 0.f; for (int r = lo; r < hi; ++r) s += bf2f(Up[(size_t)(base + r) * 512 + c]);
    pd[(size_t)row * 512 + c] = f2bf(s / (float)(hi - lo) - bf2f(Up[(size_t)row * 512 + c]));
  }
}

__global__ __launch_bounds__(512) void k_router(const float* __restrict__ lat, const float* __restrict__ ctxr, const float* __restrict__ gain, const float* __restrict__ modl,
                                                const float* __restrict__ wrg, const float* __restrict__ brg, const float* __restrict__ wre, const float* __restrict__ bre,
                                                bf16_t* __restrict__ out, int* __restrict__ re, float* __restrict__ rw, int nrows) {
  __shared__ float hs[8][1024];
  const int lane = threadIdx.x & 63, wv = threadIdx.x >> 6, gw = blockIdx.x * 8 + wv;
  const float* wp = lane < 4 ? wrg + lane : wre + ((lane - 4) & 31); const int wst = lane < 4 ? 4 : 32;
  const float bias = lane < 4 ? brg[lane] : bre[(lane - 4) & 31];
  for (int row = gw; row < nrows; row += gridDim.x * 8) {
    const float* src = row < NLAT ? lat + (size_t)row * D : ctxr + (size_t)(row - NLAT) * D;
    const float* mv = modl + row_vec(row) * 6144;
    f32x4 x[4]; float ss = 0.f;
#pragma unroll
    for (int j = 0; j < 4; ++j) { x[j] = ((const f32x4*)src)[lane + 64 * j]; ss += x[j].x * x[j].x + x[j].y * x[j].y + x[j].z * x[j].z + x[j].w * x[j].w; }
    const float rstd = 1.f / sqrtf(wave_sum(ss) * (1.f / D) + EPS);
#pragma unroll
    for (int j = 0; j < 4; ++j) {
      const int n = (lane + 64 * j) * 4;
      const f32x4 g = *(const f32x4*)(gain + n), sc = *(const f32x4*)(mv + 4096 + n), sh = *(const f32x4*)(mv + 3072 + n);
      const f32x4 h = x[j] * rstd * g * (sc + 1.f) + sh;
      uint2 o; o.x = pack2(h.x, h.y); o.y = pack2(h.z, h.w);
      *(uint2*)(out + (size_t)row * D + n) = o;
      *(f32x4*)&hs[wv][n] = h;
    }
    __builtin_amdgcn_wave_barrier();
    float acc = 0.f;
#pragma unroll 8
    for (int k = 0; k < 1024; ++k) acc += hs[wv][k] * wp[(size_t)k * wst];
    acc += bias;
    __builtin_amdgcn_wave_barrier();
    float gl[4];
#pragma unroll
    for (int i = 0; i < 4; ++i) gl[i] = __shfl(acc, i);
    int gi = 0; float gm = gl[0];
#pragma unroll
    for (int i = 1; i < 4; ++i) if (gl[i] > gm) { gm = gl[i]; gi = i; }
    float gs = 0.f;
#pragma unroll
    for (int i = 0; i < 4; ++i) gs += expf(gl[i] - gm);
    const float gp = 1.f / gs;
    float el[8];
#pragma unroll
    for (int i = 0; i < 8; ++i) el[i] = __shfl(acc, 4 + gi * 8 + i);
    int e1 = 0; float m1 = el[0];
#pragma unroll
    for (int i = 1; i < 8; ++i) if (el[i] > m1) { m1 = el[i]; e1 = i; }
    int e2 = 0; float m2 = -3.0e38f;
#pragma unroll
    for (int i = 0; i < 8; ++i) if (i != e1 && el[i] > m2) { m2 = el[i]; e2 = i; }
    const float w1 = 1.f / (1.f + expf(m2 - m1)), w2 = 1.f - w1;
    if (lane == 0) { re[row * 2] = gi * 8 + e1; re[row * 2 + 1] = gi * 8 + e2; rw[row * 2] = gp * w1; rw[row * 2 + 1] = gp * w2; }
  }
}

__global__ __launch_bounds__(256) void k_moe_naive(const bf16_t* __restrict__ H, const int* __restrict__ re, const float* __restrict__ rw,
                                                   const float* __restrict__ Wg, const float* __restrict__ Wu, const float* __restrict__ Wd, bf16_t* __restrict__ Y) {
  const int row = blockIdx.x, f = threadIdx.x;
  __shared__ float hs[1024];
  __shared__ float as_[256];
  for (int i = f; i < 1024; i += 256) hs[i] = bf2f(H[(size_t)row * D + i]);
  __syncthreads();
  for (int slot = 0; slot < 2; ++slot) {
    const int e = re[row * 2 + slot]; const float w = rw[row * 2 + slot];
    const float* wg = Wg + (size_t)e * 1024 * 256 + f; const float* wu = Wu + (size_t)e * 1024 * 256 + f;
    float g = 0.f, u = 0.f;
#pragma unroll 8
    for (int k = 0; k < 1024; ++k) { g += hs[k] * wg[(size_t)k * 256]; u += hs[k] * wu[(size_t)k * 256]; }
    as_[f] = siluf_(g) * u * w;
    __syncthreads();
    const float* wd = Wd + (size_t)e * 256 * 1024;
    float y[4] = {0.f, 0.f, 0.f, 0.f};
#pragma unroll 4
    for (int k = 0; k < 256; ++k) { const float a = as_[k];
#pragma unroll
      for (int i = 0; i < 4; ++i) y[i] += a * wd[(size_t)k * 1024 + f + 256 * i]; }
#pragma unroll
    for (int i = 0; i < 4; ++i) Y[((size_t)row * 2 + slot) * D + f + 256 * i] = f2bf(y[i]);
    __syncthreads();
  }
}

__global__ __launch_bounds__(512) void k_combine_norm(float* __restrict__ lat, float* __restrict__ ctxr, const bf16_t* __restrict__ Y, const float* __restrict__ modl_cur,
                                                      const float* __restrict__ gain, const float* __restrict__ modl_next, bf16_t* __restrict__ hout, int nrows, int final_) {
  const int lane = threadIdx.x & 63, gw = blockIdx.x * 8 + (threadIdx.x >> 6);
  for (int row = gw; row < nrows; row += gridDim.x * 8) {
    float* src = row < NLAT ? lat + (size_t)row * D : ctxr + (size_t)(row - NLAT) * D;
    const int v = row_vec(row);
    f32x4 x[4]; float ss = 0.f;
#pragma unroll
    for (int j = 0; j < 4; ++j) {
      const int n = (lane + 64 * j) * 4;
      const f32x4 g2 = *(const f32x4*)(modl_cur + v * 6144 + 5120 + n);
      const uint2 y0 = *(const uint2*)(Y + ((size_t)row * 2) * D + n), y1 = *(const uint2*)(Y + ((size_t)row * 2 + 1) * D + n);
      f32x4 ys;
      ys.x = __uint_as_float(y0.x << 16) + __uint_as_float(y1.x << 16); ys.y = __uint_as_float(y0.x & 0xFFFF0000u) + __uint_as_float(y1.x & 0xFFFF0000u);
      ys.z = __uint_as_float(y0.y << 16) + __uint_as_float(y1.y << 16); ys.w = __uint_as_float(y0.y & 0xFFFF0000u) + __uint_as_float(y1.y & 0xFFFF0000u);
      x[j] = ((const f32x4*)src)[lane + 64 * j] + g2 * ys;
      ss += x[j].x * x[j].x + x[j].y * x[j].y + x[j].z * x[j].z + x[j].w * x[j].w;
    }
    const float rstd = 1.f / sqrtf(wave_sum(ss) * (1.f / D) + EPS);
#pragma unroll
    for (int j = 0; j < 4; ++j) {
      const int n = (lane + 64 * j) * 4;
      const f32x4 g = *(const f32x4*)(gain + n);
      if (final_) { ((f32x4*)src)[lane + 64 * j] = x[j] * rstd * g; }
      else {
        ((f32x4*)src)[lane + 64 * j] = x[j];
        const f32x4 sc = *(const f32x4*)(modl_next + v * 6144 + 1024 + n), sh = *(const f32x4*)(modl_next + v * 6144 + n);
        const f32x4 h = x[j] * rstd * g * (sc + 1.f) + sh;
        uint2 o; o.x = pack2(h.x, h.y); o.y = pack2(h.z, h.w);
        *(uint2*)(hout + (size_t)row * D + n) = o;
      }
    }
  }
}

__global__ __launch_bounds__(512) void k_rowssq(const bf16_t* __restrict__ cq, const bf16_t* __restrict__ ckv, float* __restrict__ rq, float* __restrict__ rkv) {
  const int lane = threadIdx.x & 63, gw = blockIdx.x * 8 + (threadIdx.x >> 6);
  for (int row = gw; row < MROWS; row += gridDim.x * 8) {
    { const unsigned w = *(const unsigned*)(ckv + (size_t)row * 128 + lane * 2); const float a = __uint_as_float(w << 16), b = __uint_as_float(w & 0xFFFF0000u);
      const float ss = wave_sum(a * a + b * b); if (lane == 0) rkv[row] = 1.f / sqrtf(ss * (1.f / 128.f) + EPS); }
    if (row < NLAT) { const uint2 w = *(const uint2*)(cq + (size_t)row * 256 + lane * 4);
      const float a = __uint_as_float(w.x << 16), b = __uint_as_float(w.x & 0xFFFF0000u), c = __uint_as_float(w.y << 16), d = __uint_as_float(w.y & 0xFFFF0000u);
      const float ss = wave_sum(a * a + b * b + c * c + d * d); if (lane == 0) rq[row] = 1.f / sqrtf(ss * (1.f / 256.f) + EPS); }
  }
}
__device__ __forceinline__ float rope_inv(int i) { return exp2f(-(float)i * (13.287712379549449f / 8.f)); }
__global__ __launch_bounds__(256) void k_kr_rope(const float* __restrict__ kr, bf16_t* __restrict__ dk) {
  const int idx = blockIdx.x * 256 + threadIdx.x; if (idx >= MROWS * 32) return;
  const int m = idx >> 5, j = idx & 31; int b, key; row_bkey(m, b, key);
  float val = kr[idx];
  if (m < NLAT) {
    const int t = m & 8191; const int half = j >> 4, jj = j & 15, i = jj & 7;
    const float pos = half ? (float)(t & 63) : (float)(t >> 6);
    const float ang = pos * rope_inv(i); float sn, cs; sincosf(ang, &sn, &cs);
    const float x1 = kr[(size_t)m * 32 + half * 16 + i], x2 = kr[(size_t)m * 32 + half * 16 + 8 + i];
    val = (jj < 8) ? (x1 * cs - x2 * sn) : (x1 * sn + x2 * cs);
  }
  const bf16_t o = f2bf(val);
#pragma unroll
  for (int hh = 0; hh < 8; ++hh) dk[((size_t)(b * 8 + hh) * NKEY + key) * 128 + 64 + j] = o;
}

__global__ __launch_bounds__(64) void k_na_naive(const bf16_t* __restrict__ nq, const bf16_t* __restrict__ nk, const bf16_t* __restrict__ nv, const float* __restrict__ rpb,
                                                 bf16_t* __restrict__ A) {
  const int t = blockIdx.x * 64 + threadIdx.x, hh = blockIdx.y, b = blockIdx.z;
  const int r = t >> 6, c = t & 63;
  int rs = r - 4; rs = rs < 0 ? 0 : (rs > 120 ? 120 : rs);
  int cs = c - 8; cs = cs < 0 ? 0 : (cs > 48 ? 48 : cs);
  float q[64], o[64];
  const bf16_t* qp = nq + ((size_t)(b * 8 + hh) * SEQ + t) * 64;
#pragma unroll
  for (int d = 0; d < 64; ++d) { q[d] = bf2f(qp[d]); o[d] = 0.f; }
  const bf16_t* Kb = nk + (size_t)(b * 8 + hh) * NKEY * 64; const bf16_t* Vb = nv + (size_t)(b * 8 + hh) * NKEY * 64;
  float mx = -3.0e38f, l = 0.f;
  for (int kk = 0; kk < 128 + CT; ++kk) {
    int key; float bias = 0.f;
    if (kk < 128) { const int kr_ = rs + (kk >> 4), kc = cs + (kk & 15); key = CT + kr_ * 64 + kc; bias = rpb[(hh * 15 + (kr_ - r + 7)) * 31 + (kc - c + 15)] * LOG2E; }
    else key = kk - 128;
    const bf16_t* kp = Kb + (size_t)key * 64; float s = bias;
#pragma unroll
    for (int d = 0; d < 64; d += 2) { const unsigned w = *(const unsigned*)(kp + d); s += q[d] * __uint_as_float(w << 16) + q[d + 1] * __uint_as_float(w & 0xFFFF0000u); }
    const float mn = fmaxf(mx, s), alpha = exp2f(mx - mn), p = exp2f(s - mn);
    l = l * alpha + p; mx = mn;
    const bf16_t* vp = Vb + (size_t)key * 64;
#pragma unroll
    for (int d = 0; d < 64; d += 2) { const unsigned w = *(const unsigned*)(vp + d); o[d] = o[d] * alpha + p * __uint_as_float(w << 16); o[d + 1] = o[d + 1] * alpha + p * __uint_as_float(w & 0xFFFF0000u); }
  }
  const float il = 1.f / l;
  bf16_t* op = A + (size_t)(b * SEQ + t) * D + hh * 64;
#pragma unroll
  for (int d = 0; d < 64; d += 2) *(unsigned*)(op + d) = pack2(o[d] * il, o[d + 1] * il);
}
__global__ __launch_bounds__(64) void k_mla_naive(const bf16_t* __restrict__ dq, const bf16_t* __restrict__ dk, const bf16_t* __restrict__ dv, bf16_t* __restrict__ A) {
  const int t = blockIdx.x * 64 + threadIdx.x, hh = blockIdx.y, b = blockIdx.z;
  float q[96], o[64];
  const bf16_t* qp = dq + ((size_t)(b * 8 + hh) * SEQ + t) * 96;
#pragma unroll
  for (int d = 0; d < 96; ++d) q[d] = bf2f(qp[d]);
#pragma unroll
  for (int half = 0; half < 2; ++half) {
    const float pos = half ? (float)(t & 63) : (float)(t >> 6);
#pragma unroll
    for (int i = 0; i < 8; ++i) { float sn, cs; sincosf(pos * rope_inv(i), &sn, &cs);
      const float x1 = q[64 + half * 16 + i], x2 = q[64 + half * 16 + 8 + i];
      q[64 + half * 16 + i] = x1 * cs - x2 * sn; q[64 + half * 16 + 8 + i] = x1 * sn + x2 * cs; }
  }
#pragma unroll
  for (int d = 0; d < 64; ++d) o[d] = 0.f;
  const bf16_t* Kb = dk + (size_t)(b * 8 + hh) * NKEY * 128; const bf16_t* Vb = dv + (size_t)(b * 8 + hh) * NKEY * 64;
  float mx = -3.0e38f, l = 0.f;
  for (int k0 = 0; k0 < NKEY; k0 += 8) {
    float s[8]; float bm = -3.0e38f;
#pragma unroll
    for (int j = 0; j < 8; ++j) { const bf16_t* kp = Kb + (size_t)(k0 + j) * 128; float a = 0.f;
#pragma unroll
      for (int d = 0; d < 96; d += 2) { const unsigned w = *(const unsigned*)(kp + d); a += q[d] * __uint_as_float(w << 16) + q[d + 1] * __uint_as_float(w & 0xFFFF0000u); }
      s[j] = a; bm = fmaxf(bm, a); }
    const float mn = fmaxf(mx, bm), alpha = exp2f(mx - mn); mx = mn; l *= alpha;
#pragma unroll
    for (int d = 0; d < 64; ++d) o[d] *= alpha;
#pragma unroll
    for (int j = 0; j < 8; ++j) { const float p = exp2f(s[j] - mn); l += p; const bf16_t* vp = Vb + (size_t)(k0 + j) * 64;
#pragma unroll
      for (int d = 0; d < 64; d += 2) { const unsigned w = *(const unsigned*)(vp + d); o[d] += p * __uint_as_float(w << 16); o[d + 1] += p * __uint_as_float(w & 0xFFFF0000u); } }
  }
  const float il = 1.f / l;
  bf16_t* op = A + (size_t)(b * SEQ + t) * D + 512 + hh * 64;
#pragma unroll
  for (int d = 0; d < 64; d += 2) *(unsigned*)(op + d) = pack2(o[d] * il, o[d + 1] * il);
}

typedef short bf16x8 __attribute__((ext_vector_type(8)));
#define MFMA16(a, b, c) __builtin_amdgcn_mfma_f32_16x16x32_bf16(a, b, c, 0, 0, 0)

struct MP {
  const float* in[29];
  float* out; char* ws;
  int ph_lo, ph_hi;
};
constexpr int LDS_BYTES = 131072;
constexpr int CNT_OFF = 16384;

template <int MI, class Epi>
__device__ __forceinline__ void gemm_tile(const bf16_t* __restrict__ A, int lda, const int* __restrict__ gather, int gshift, int Mvalid,
                                          const bf16_t* __restrict__ Bt, int ldb, int K, int m0, int n0, char* lds, const Epi& epi) {
  constexpr int BM = 64 * MI, ABYTES = BM * 128, STAGE = ABYTES + 128 * 128;
  const int t = threadIdx.x, lane = t & 63, w = t >> 6, wm = w >> 1, wn = w & 1, l15 = lane & 15, lq = lane >> 4;
  const int c = t & 7, r = t >> 3;
  const bf16_t* ap[MI];
#pragma unroll
  for (int i = 0; i < MI; ++i) { int m = m0 + r + 64 * i; m = m < Mvalid ? m : Mvalid - 1; const int row = gather ? (gather[m] >> gshift) : m; ap[i] = A + (size_t)row * lda + c * 8; }
  const bf16_t* bp0 = Bt + (size_t)(n0 + r) * ldb + c * 8; const bf16_t* bp1 = bp0 + (size_t)64 * ldb;
  const int wofs = r * 128 + ((c ^ ((r >> 1) & 7)) << 4);
  const int sw = (l15 >> 1) & 7, x0 = (lq ^ sw) << 4, x1 = x0 ^ 64;
  const int arow = (wm * 16 * MI + l15) * 128, brow = ABYTES + (wn * 64 + l15) * 128;
  f32x4 acc[MI][4];
#pragma unroll
  for (int i = 0; i < MI; ++i)
#pragma unroll
    for (int j = 0; j < 4; ++j) acc[i][j] = (f32x4){0.f, 0.f, 0.f, 0.f};
  uint4 ra[MI], rb0, rb1;
  const int KT = K >> 6;
#pragma unroll
  for (int i = 0; i < MI; ++i) ra[i] = *(const uint4*)(ap[i]);
  rb0 = *(const uint4*)bp0; rb1 = *(const uint4*)bp1;
#pragma unroll
  for (int i = 0; i < MI; ++i) *(uint4*)(lds + wofs + i * 8192) = ra[i];
  *(uint4*)(lds + ABYTES + wofs) = rb0; *(uint4*)(lds + ABYTES + wofs + 8192) = rb1;
  __syncthreads();
  for (int kt = 0; kt < KT; ++kt) {
    char* cur = lds + (kt & 1) * STAGE; char* nxt = lds + ((kt + 1) & 1) * STAGE;
    const bool more = kt + 1 < KT;
    if (more) {
      const int k0 = (kt + 1) << 6;
#pragma unroll
      for (int i = 0; i < MI; ++i) ra[i] = *(const uint4*)(ap[i] + k0);
      rb0 = *(const uint4*)(bp0 + k0); rb1 = *(const uint4*)(bp1 + k0);
    }
#pragma unroll
    for (int ks = 0; ks < 2; ++ks) {
      const int xo = ks ? x1 : x0;
      bf16x8 af[MI], bfv[4];
#pragma unroll
      for (int i = 0; i < MI; ++i) af[i] = *(const bf16x8*)(cur + arow + i * 2048 + xo);
#pragma unroll
      for (int j = 0; j < 4; ++j) bfv[j] = *(const bf16x8*)(cur + brow + j * 2048 + xo);
#pragma unroll
      for (int i = 0; i < MI; ++i)
#pragma unroll
        for (int j = 0; j < 4; ++j) acc[i][j] = MFMA16(bfv[j], af[i], acc[i][j]);
    }
    if (more) {
#pragma unroll
      for (int i = 0; i < MI; ++i) *(uint4*)(nxt + wofs + i * 8192) = ra[i];
      *(uint4*)(nxt + ABYTES + wofs) = rb0; *(uint4*)(nxt + ABYTES + wofs + 8192) = rb1;
    }
    __syncthreads();
  }
  epi.tile(acc, m0 + wm * 16 * MI + l15, n0 + wn * 64 + lq * 4, Mvalid);
}
template <class E> struct EpiEach {
  E e;
  template <int MI> __device__ __forceinline__ void tile(const f32x4 (&acc)[MI][4], int mb, int nb, int Mvalid) const {
#pragma unroll
    for (int i = 0; i < MI; ++i) { const int m = mb + i * 16; if (m < Mvalid) {
#pragma unroll
      for (int j = 0; j < 4; ++j) e.apply(m, nb + j * 16, acc[i][j]); } }
  }
};
template <int MI, class E>
__device__ __forceinline__ void gemm_phase(const bf16_t* A, int lda, const bf16_t* Bt, int ldb, int M, int N, int K, const E& e, char* lds) {
  constexpr int BM = 64 * MI; const int ntm = (M + BM - 1) / BM, ntn = N >> 7;
  EpiEach<E> ee; ee.e = e;
  for (int tile = blockIdx.x; tile < ntm * ntn; tile += gridDim.x) { const int mt = tile / ntn, nt = tile - mt * ntn; gemm_tile<MI>(A, lda, nullptr, 0, M, Bt, ldb, K, mt * BM, nt * 128, lds, ee); }
}

template <int K>
__device__ __forceinline__ float row_rstd4(const bf16_t* rowp, int lq) {
  constexpr int PER = K / 4; float ss = 0.f;
#pragma unroll
  for (int i = 0; i < PER / 8; ++i) { const uint4 v = *(const uint4*)(rowp + lq * PER + i * 8); const unsigned wv[4] = {v.x, v.y, v.z, v.w};
#pragma unroll
    for (int q = 0; q < 4; ++q) { const float a = __uint_as_float(wv[q] << 16), b = __uint_as_float(wv[q] & 0xFFFF0000u); ss += a * a + b * b; } }
  ss += __shfl_xor(ss, 16); ss += __shfl_xor(ss, 32);
  return 1.f / sqrtf(ss * (1.f / K) + EPS);
}
struct EpiMlaQ2 {
  bf16_t* dq; const bf16_t* cq;
  template <int MI> __device__ __forceinline__ void tile(const f32x4 (&acc)[MI][4], int mb, int nb, int Mvalid) const {
#pragma unroll
    for (int i = 0; i < MI; ++i) { const int m = mb + i * 16; const float rs = row_rstd4<256>(cq + (size_t)m * 256, (nb >> 2) & 3) * MLA_QSCALE;
#pragma unroll
      for (int j = 0; j < 4; ++j) { const int n = nb + j * 16; const int hh = n / 96, off = n - hh * 96; const f32x4 v = acc[i][j] * rs;
        uint2 wv; wv.x = pack2(v.x, v.y); wv.y = pack2(v.z, v.w);
        *(uint2*)(dq + (((size_t)((m >> 13) * 8 + hh) * SEQ + (m & 8191)) * 96 + off)) = wv; } }
  }
};
struct EpiMlaKV2 {
  bf16_t *dk, *dv; const bf16_t* ckv;
  template <int MI> __device__ __forceinline__ void tile(const f32x4 (&acc)[MI][4], int mb, int nb, int Mvalid) const {
#pragma unroll
    for (int i = 0; i < MI; ++i) { const int m = mb + i * 16; const float rs = row_rstd4<128>(ckv + (size_t)m * 128, (nb >> 2) & 3);
      int b, key; row_bkey(m, b, key);
#pragma unroll
      for (int j = 0; j < 4; ++j) { const int n = nb + j * 16; const int hh = n >> 7, off = n & 127; const f32x4 v = acc[i][j] * rs;
        uint2 wv; wv.x = pack2(v.x, v.y); wv.y = pack2(v.z, v.w);
        if (off < 64) *(uint2*)(dk + (((size_t)(b * 8 + hh) * NKEY + key) * 128 + off)) = wv;
        else *(uint2*)(dv + (((size_t)(b * 8 + hh) * NKEY + key) * 64 + (off - 64))) = wv; } }
  }
};
struct EpiMoe1 {
  bf16_t* amoe; const int* list; const float* rw; int off_e, nt;
  template <int MI> __device__ __forceinline__ void tile(const f32x4 (&acc)[MI][4], int mb, int nb, int Mvalid) const {
    const int wn = (nb >> 6) & 1, lq = (nb >> 2) & 3;
#pragma unroll
    for (int i = 0; i < MI; ++i) { const int m = mb + i * 16; if (m < Mvalid) { const float wgt = rw[list[m]];
#pragma unroll
      for (int i2 = 0; i2 < 2; ++i2) { const f32x4 g = acc[i][i2], u = acc[i][2 + i2];
        const float a0 = siluf_(g.x) * u.x * wgt, a1 = siluf_(g.y) * u.y * wgt, a2 = siluf_(g.z) * u.z * wgt, a3 = siluf_(g.w) * u.w * wgt;
        uint2 wv; wv.x = pack2(a0, a1); wv.y = pack2(a2, a3);
        *(uint2*)(amoe + (size_t)(off_e + m) * 256 + nt * 64 + wn * 32 + i2 * 16 + lq * 4) = wv; } } }
  }
};
struct EpiMoe2 {
  bf16_t* Y; const int* list; int m_base;
  __device__ __forceinline__ void apply(int m, int n, f32x4 v) const {
    uint2 wv; wv.x = pack2(v.x, v.y); wv.y = pack2(v.z, v.w);
    *(uint2*)(Y + (size_t)list[m - m_base] * D + n) = wv;
  }
};

__device__ __forceinline__ void ph_ada(const MP& p, char* lds) {
  float* sv = (float*)lds;
  float* red = sv + 3 * 1024;
  const float* c = p.in[1]; const float* cctx = p.in[3]; float* mods = (float*)(p.ws + WS_MODS);
  const int j = threadIdx.x & 63, kg = threadIdx.x >> 6;
  for (int i = threadIdx.x; i < 1024; i += 512) { sv[i] = siluf_(c[i]); sv[1024 + i] = siluf_(c[1024 + i]); sv[2048 + i] = siluf_(cctx[i]); }
  __syncthreads();
  for (int item = blockIdx.x; item < 192; item += gridDim.x) {
    const int l = item / 96, n0 = (item % 96) * 64;
    const float* W = p.in[4] + (size_t)l * 1024 * 6144 + n0 + j;
    float a0 = 0.f, a1 = 0.f, a2 = 0.f;
#pragma unroll 8
    for (int k = kg * 128; k < kg * 128 + 128; ++k) { const float wv = W[(size_t)k * 6144]; a0 += sv[k] * wv; a1 += sv[1024 + k] * wv; a2 += sv[2048 + k] * wv; }
    red[(kg * 3 + 0) * 64 + j] = a0; red[(kg * 3 + 1) * 64 + j] = a1; red[(kg * 3 + 2) * 64 + j] = a2;
    __syncthreads();
    if (threadIdx.x < 192) { const int v = threadIdx.x >> 6, jj = threadIdx.x & 63; float s = 0.f;
      for (int g = 0; g < 8; ++g) s += red[(g * 3 + v) * 64 + jj];
      mods[(size_t)(l * 3 + v) * 6144 + n0 + jj] = s + p.in[5][l * 6144 + n0 + jj]; }
    __syncthreads();
  }
  if (blockIdx.x == gridDim.x - 1) { float* lb = (float*)(p.ws + WS_LB);
    for (int i = threadIdx.x; i < 1024; i += 512) { const int d = i >> 9, cc = i & 511; const float l0 = p.in[10][(d * 2) * 512 + cc], l1 = p.in[10][(d * 2 + 1) * 512 + cc]; lb[i] = 1.f / (1.f + expf(l1 - l0)); } }
}
__device__ __forceinline__ void conv_tiles(const float* src, bf16_t* dst, const float* kscale, int K, int N, int Npad, int mode, int batch, size_t sbs, size_t dbs, char* lds) {
  float* tile = (float*)lds;
  const int ntn = (Npad + 63) >> 6, ntk = K >> 6, per = ntn * ntk, tx = threadIdx.x & 63, ty = threadIdx.x >> 6;
  for (int item = blockIdx.x; item < per * batch; item += gridDim.x) {
    const int bz = item / per, rem = item - bz * per, kb = rem / ntn, nb = rem - kb * ntn, n0 = nb * 64, k0 = kb * 64;
    const float* s = src + bz * sbs; bf16_t* d = dst + bz * dbs;
#pragma unroll
    for (int i = 0; i < 8; ++i) { const int k = k0 + ty + 8 * i, n = n0 + tx; float v = 0.f;
      if (n < N) { v = s[(size_t)k * N + n]; if (kscale) v *= kscale[k]; }
      tile[(ty + 8 * i) * 65 + tx] = v; }
    __syncthreads();
#pragma unroll
    for (int i = 0; i < 8; ++i) { const int nl = ty + 8 * i, n = n0 + nl;
      if (n < Npad) { int row = n; if (mode == 1) row = moe_gu_row(0, n); else if (mode == 2) row = moe_gu_row(1, n);
        d[(size_t)row * K + k0 + tx] = f2bf(tile[tx * 65 + nl]); } }
    __syncthreads();
  }
}
__device__ __forceinline__ void ph_conv_small(const MP& p, char* lds) {
  char* ws = p.ws;
  conv_tiles(p.in[8], (bf16_t*)(ws + WS_WT_ABIN), nullptr, 1024, 3072, 3072, 0, 1, 0, 0, lds);
  conv_tiles(p.in[9], (bf16_t*)(ws + WS_WT_ABOUT), nullptr, 1024, 1024, 1024, 0, 1, 0, 0, lds);
  conv_tiles(p.in[14], (bf16_t*)(ws + WS_WT_CDIN), nullptr, 1024, 1952, 2048, 0, 1, 0, 0, lds);
  conv_tiles(p.in[15], (bf16_t*)(ws + WS_WT_CDOUT), nullptr, 1024, 1024, 1024, 0, 1, 0, 0, lds);
  conv_tiles(p.in[18], (bf16_t*)(ws + WS_WT_UQ), p.in[17], 256, 768, 768, 0, 1, 0, 0, lds);
  conv_tiles(p.in[20], (bf16_t*)(ws + WS_WT_UKV), p.in[19], 128, 1024, 1024, 0, 1, 0, 0, lds);
  conv_tiles(p.in[12], (bf16_t*)(ws + WS_WT_POOL), nullptr, 128, 128, 128, 0, 4, (size_t)128 * 128, (size_t)128 * 128, lds);
}
__device__ __forceinline__ void ph_conv_moe(const MP& p, int layer, char* lds) {
  bf16_t* wgu = (bf16_t*)(p.ws + WS_WMOE); bf16_t* wd = wgu + (size_t)32 * 512 * 1024;
  const size_t lo = (size_t)layer * 32 * 1024 * 256;
  conv_tiles(p.in[25] + lo, wgu, nullptr, 1024, 256, 256, 1, 32, (size_t)1024 * 256, (size_t)512 * 1024, lds);
  conv_tiles(p.in[26] + lo, wgu, nullptr, 1024, 256, 256, 2, 32, (size_t)1024 * 256, (size_t)512 * 1024, lds);
  conv_tiles(p.in[27] + lo, wd, nullptr, 256, 1024, 1024, 0, 32, (size_t)256 * 1024, (size_t)1024 * 256, lds);
}
__device__ __forceinline__ void ph_norm_mod(const float* lat, const float* ctxr, const float* gain, const float* modl, int sh_off, int sc_off, bf16_t* out, int nrows) {
  const int lane = threadIdx.x & 63, gw = blockIdx.x * 8 + (threadIdx.x >> 6);
  for (int row = gw; row < nrows; row += gridDim.x * 8) {
    const float* src = row < NLAT ? lat + (size_t)row * D : ctxr + (size_t)(row - NLAT) * D;
    const float* mv = modl + row_vec(row) * 6144;
    f32x4 x[4]; float ss = 0.f;
#pragma unroll
    for (int j = 0; j < 4; ++j) { x[j] = ((const f32x4*)src)[lane + 64 * j]; ss += x[j].x * x[j].x + x[j].y * x[j].y + x[j].z * x[j].z + x[j].w * x[j].w; }
    const float rstd = 1.f / sqrtf(wave_sum(ss) * (1.f / D) + EPS);
#pragma unroll
    for (int j = 0; j < 4; ++j) {
      const int n = (lane + 64 * j) * 4;
      const f32x4 g = *(const f32x4*)(gain + n), sc = *(const f32x4*)(mv + sc_off + n), sh = *(const f32x4*)(mv + sh_off + n);
      const f32x4 h = x[j] * rstd * g * (sc + 1.f) + sh;
      uint2 o; o.x = pack2(h.x, h.y); o.y = pack2(h.z, h.w);
      *(uint2*)(out + (size_t)row * D + n) = o;
    }
  }
}
__device__ __forceinline__ void ph_pool_prep(const bf16_t* Up, bf16_t* pd) {
  const int c = threadIdx.x;
  for (int row = blockIdx.x; row < MROWS; row += gridDim.x) {
    int base, t, n; if (row < NLAT) { base = row & ~8191; t = row & 8191; n = SEQ; } else { const int mm = row - NLAT; base = NLAT + (mm & ~255); t = mm & 255; n = CT; }
    const int gi = c >> 7, win = 2 << gi; int lo = t - win / 2, hi = t + win - win / 2; lo = lo < 0 ? 0 : lo; hi = hi > n ? n : hi;
    float s = 0.f; for (int r = lo; r < hi; ++r) s += bf2f(Up[(size_t)(base + r) * 512 + c]);
    pd[(size_t)row * 512 + c] = f2bf(s / (float)(hi - lo) - bf2f(Up[(size_t)row * 512 + c]));
  }
}
__device__ __forceinline__ void ph_router(const MP& p, int layer, int nrows, char* lds) {
  float* hs = (float*)lds;
  const float* lat = p.out; const float* ctxr = (const float*)(p.ws + WS_XC); const float* gain = p.in[7] + layer * 1024;
  const float* modl = (const float*)(p.ws + WS_MODS) + layer * 3 * 6144;
  const float* wrg = p.in[21] + layer * 1024 * 4; const float* brg = p.in[22] + layer * 4; const float* wre = p.in[23] + layer * 1024 * 32; const float* bre = p.in[24] + layer * 32;
  bf16_t* out = (bf16_t*)(p.ws + WS_H); float* rw = (float*)(p.ws + WS_ROUTE_W);
  int* cnt = (int*)(p.ws + WS_CTL + CNT_OFF) + layer * 32; int* list = (int*)(p.ws + WS_LIST);
  const int lane = threadIdx.x & 63, wv = threadIdx.x >> 6, gw = blockIdx.x * 8 + wv;
  const float* wp = lane < 4 ? wrg + lane : wre + ((lane - 4) & 31); const int wst = lane < 4 ? 4 : 32;
  const float bias = lane < 4 ? brg[lane] : bre[(lane - 4) & 31];
  for (int row = gw; row < nrows; row += gridDim.x * 8) {
    const float* src = row < NLAT ? lat + (size_t)row * D : ctxr + (size_t)(row - NLAT) * D;
    const float* mv = modl + row_vec(row) * 6144;
    f32x4 x[4]; float ss = 0.f;
#pragma unroll
    for (int j = 0; j < 4; ++j) { x[j] = ((const f32x4*)src)[lane + 64 * j]; ss += x[j].x * x[j].x + x[j].y * x[j].y + x[j].z * x[j].z + x[j].w * x[j].w; }
    const float rstd = 1.f / sqrtf(wave_sum(ss) * (1.f / D) + EPS);
#pragma unroll
    for (int j = 0; j < 4; ++j) {
      const int n = (lane + 64 * j) * 4;
      const f32x4 g = *(const f32x4*)(gain + n), sc = *(const f32x4*)(mv + 4096 + n), sh = *(const f32x4*)(mv + 3072 + n);
      const f32x4 h = x[j] * rstd * g * (sc + 1.f) + sh;
      uint2 o; o.x = pack2(h.x, h.y); o.y = pack2(h.z, h.w);
      *(uint2*)(out + (size_t)row * D + n) = o;
      *(f32x4*)&hs[wv * 1024 + n] = h;
    }
    __builtin_amdgcn_wave_barrier();
    float acc = 0.f;
#pragma unroll 8
    for (int k = 0; k < 1024; ++k) acc += hs[wv * 1024 + k] * wp[(size_t)k * wst];
    acc += bias;
    __builtin_amdgcn_wave_barrier();
    float gl[4];
#pragma unroll
    for (int i = 0; i < 4; ++i) gl[i] = __shfl(acc, i);
    int gi = 0; float gm = gl[0];
#pragma unroll
    for (int i = 1; i < 4; ++i) if (gl[i] > gm) { gm = gl[i]; gi = i; }
    float gs = 0.f;
#pragma unroll
    for (int i = 0; i < 4; ++i) gs += expf(gl[i] - gm);
    const float gp = 1.f / gs;
    float el[8];
#pragma unroll
    for (int i = 0; i < 8; ++i) el[i] = __shfl(acc, 4 + gi * 8 + i);
    int e1 = 0; float m1 = el[0];
#pragma unroll
    for (int i = 1; i < 8; ++i) if (el[i] > m1) { m1 = el[i]; e1 = i; }
    int e2 = 0; float m2 = -3.0e38f;
#pragma unroll
    for (int i = 0; i < 8; ++i) if (i != e1 && el[i] > m2) { m2 = el[i]; e2 = i; }
    const float w1 = 1.f / (1.f + expf(m2 - m1)), w2 = 1.f - w1;
    if (lane < 2) {
      const int e = gi * 8 + (lane ? e2 : e1);
      rw[row * 2 + lane] = gp * (lane ? w2 : w1);
      const int pos = atomicAdd(&cnt[e], 1);
      list[(size_t)e * MROWS + pos] = row * 2 + lane;
    }
  }
}
template <int BM>
__device__ __forceinline__ int moe_tables(const MP& p, int layer, int ntn, int* tb) {
  const int* cnt = (const int*)(p.ws + WS_CTL + CNT_OFF) + layer * 32;
  __syncthreads();
  if (threadIdx.x == 0) { int off = 0, ts = 0;
    for (int e = 0; e < 32; ++e) { const int c = __hip_atomic_load(&cnt[e], __ATOMIC_RELAXED, __HIP_MEMORY_SCOPE_AGENT); tb[e] = c; tb[32 + e] = off; tb[64 + e] = ts; off += c; ts += ((c + BM - 1) / BM) * ntn; }
    tb[96] = ts; }
  __syncthreads();
  return tb[96];
}
template <int MI>
__device__ __forceinline__ void ph_moe1(const MP& p, int layer, char* lds) {
  constexpr int BM = 64 * MI; int* tb = (int*)(lds + LDS_BYTES - 1024);
  const int total = moe_tables<BM>(p, layer, 4, tb);
  const bf16_t* H = (const bf16_t*)(p.ws + WS_H); const bf16_t* wgu = (const bf16_t*)(p.ws + WS_WMOE);
  for (int tile = blockIdx.x; tile < total; tile += gridDim.x) {
    int e = 0;
#pragma unroll 1
    for (int q = 1; q < 32; ++q) if (tb[64 + q] <= tile) e = q;
    const int lt = tile - tb[64 + e], mt = lt >> 2, nt = lt & 3;
    EpiMoe1 ep; ep.amoe = (bf16_t*)(p.ws + WS_AMOE); ep.list = (const int*)(p.ws + WS_LIST) + (size_t)e * MROWS; ep.rw = (const float*)(p.ws + WS_ROUTE_W); ep.off_e = tb[32 + e]; ep.nt = nt;
    gemm_tile<MI>(H, D, ep.list, 1, tb[e], wgu + (size_t)e * 512 * 1024, 1024, 1024, mt * BM, nt * 128, lds, ep);
  }
}
template <int MI>
__device__ __forceinline__ void ph_moe2(const MP& p, int layer, char* lds) {
  constexpr int BM = 64 * MI; int* tb = (int*)(lds + LDS_BYTES - 1024);
  const int total = moe_tables<BM>(p, layer, 8, tb);
  const bf16_t* wd = (const bf16_t*)(p.ws + WS_WMOE) + (size_t)32 * 512 * 1024;
  for (int tile = blockIdx.x; tile < total; tile += gridDim.x) {
    int e = 0;
#pragma unroll 1
    for (int q = 1; q < 32; ++q) if (tb[64 + q] <= tile) e = q;
    const int lt = tile - tb[64 + e], mt = lt >> 3, nt = lt & 7;
    EpiEach<EpiMoe2> ep; ep.e.Y = (bf16_t*)(p.ws + WS_YBUF); ep.e.list = (const int*)(p.ws + WS_LIST) + (size_t)e * MROWS; ep.e.m_base = 0;
    const bf16_t* A = (const bf16_t*)(p.ws + WS_AMOE) + (size_t)tb[32 + e] * 256;
    gemm_tile<MI>(A, 256, nullptr, 0, tb[e], wd + (size_t)e * 1024 * 256, 256, 256, mt * BM, nt * 128, lds, ep);
  }
}
__device__ __forceinline__ void ph_combine(const MP& p, int layer, int nrows, int final_) {
  float* lat = p.out; float* ctxr = (float*)(p.ws + WS_XC); const bf16_t* Y = (const bf16_t*)(p.ws + WS_YBUF);
  const float* modl_cur = (const float*)(p.ws + WS_MODS) + layer * 3 * 6144; const float* modl_next = (const float*)(p.ws + WS_MODS) + 3 * 6144;
  const float* gain = final_ ? p.in[28] : p.in[6] + 1024; bf16_t* hout = (bf16_t*)(p.ws + WS_H);
  const int lane = threadIdx.x & 63, gw = blockIdx.x * 8 + (threadIdx.x >> 6);
  for (int row = gw; row < nrows; row += gridDim.x * 8) {
    float* src = row < NLAT ? lat + (size_t)row * D : ctxr + (size_t)(row - NLAT) * D;
    const int v = row_vec(row);
    f32x4 x[4]; float ss = 0.f;
#pragma unroll
    for (int j = 0; j < 4; ++j) {
      const int n = (lane + 64 * j) * 4;
      const f32x4 g2 = *(const f32x4*)(modl_cur + v * 6144 + 5120 + n);
      const uint2 y0 = *(const uint2*)(Y + ((size_t)row * 2) * D + n), y1 = *(const uint2*)(Y + ((size_t)row * 2 + 1) * D + n);
      f32x4 ys;
      ys.x = __uint_as_float(y0.x << 16) + __uint_as_float(y1.x << 16); ys.y = __uint_as_float(y0.x & 0xFFFF0000u) + __uint_as_float(y1.x & 0xFFFF0000u);
      ys.z = __uint_as_float(y0.y << 16) + __uint_as_float(y1.y << 16); ys.w = __uint_as_float(y0.y & 0xFFFF0000u) + __uint_as_float(y1.y & 0xFFFF0000u);
      x[j] = ((const f32x4*)src)[lane + 64 * j] + g2 * ys;
      ss += x[j].x * x[j].x + x[j].y * x[j].y + x[j].z * x[j].z + x[j].w * x[j].w;
    }
    const float rstd = 1.f / sqrtf(wave_sum(ss) * (1.f / D) + EPS);
#pragma unroll
    for (int j = 0; j < 4; ++j) {
      const int n = (lane + 64 * j) * 4;
      const f32x4 g = *(const f32x4*)(gain + n);
      if (final_) { ((f32x4*)src)[lane + 64 * j] = x[j] * rstd * g; }
      else {
        ((f32x4*)src)[lane + 64 * j] = x[j];
        const f32x4 sc = *(const f32x4*)(modl_next + v * 6144 + 1024 + n), sh = *(const f32x4*)(modl_next + v * 6144 + n);
        const f32x4 h = x[j] * rstd * g * (sc + 1.f) + sh;
        uint2 o; o.x = pack2(h.x, h.y); o.y = pack2(h.z, h.w);
        *(uint2*)(hout + (size_t)row * D + n) = o;
      }
    }
  }
}
__device__ __forceinline__ void ph_kr_rope(const float* kr, bf16_t* dk) {
  for (int idx = blockIdx.x * 512 + threadIdx.x; idx < MROWS * 32; idx += gridDim.x * 512) {
    const int m = idx >> 5, j = idx & 31; int b, key; row_bkey(m, b, key);
    float val = kr[idx];
    if (m < NLAT) {
      const int t = m & 8191; const int half = j >> 4, jj = j & 15, i = jj & 7;
      const float pos = half ? (float)(t & 63) : (float)(t >> 6);
      float sn, cs; sincosf(pos * rope_inv(i), &sn, &cs);
      const float x1 = kr[(size_t)m * 32 + half * 16 + i], x2 = kr[(size_t)m * 32 + half * 16 + 8 + i];
      val = (jj < 8) ? (x1 * cs - x2 * sn) : (x1 * sn + x2 * cs);
    }
    const bf16_t o = f2bf(val);
#pragma unroll
    for (int hh = 0; hh < 8; ++hh) dk[((size_t)(b * 8 + hh) * NKEY + key) * 128 + 64 + j] = o;
  }
}

__device__ __forceinline__ void grid_sync(int) {}

enum { PH_PRE = 0, PH_N1_0, PH_G1_0, PH_POOLPREP, PH_POOL, PH_G2_0, PH_ROUTE_0, PH_MOE1_0, PH_MOE2_0, PH_COMB_0, PH_G1_1, PH_MLAUP, PH_G2_1, PH_ROUTE_1, PH_MOE1_1, PH_MOE2_1, PH_FINAL, PH_COUNT };

__global__ __launch_bounds__(512) void mega(MP p) {
  extern __shared__ __attribute__((aligned(16))) char smem[];
  char* ws = p.ws; const int bar = 0;
  const float* mods0 = (const float*)(ws + WS_MODS); const float* mods1 = mods0 + 3 * 6144;
  bf16_t* hbuf = (bf16_t*)(ws + WS_H); bf16_t* abuf = (bf16_t*)(ws + WS_A); bf16_t* U = (bf16_t*)(ws + WS_U); float* xc = (float*)(ws + WS_XC);
  if (p.ph_lo <= PH_PRE && PH_PRE < p.ph_hi) { ph_ada(p, smem); ph_conv_small(p, smem); ph_conv_moe(p, 0, smem);
    if (PH_PRE + 1 < p.ph_hi) grid_sync(bar);
  }
  if (p.ph_lo <= PH_N1_0 && PH_N1_0 < p.ph_hi) { ph_norm_mod(p.in[0], p.in[2], p.in[6], mods0, 0, 1024, hbuf, MROWS);
    if (PH_N1_0 + 1 < p.ph_hi) grid_sync(bar);
  }
  if (p.ph_lo <= PH_G1_0 && PH_G1_0 < p.ph_hi) { { EpiABIn e; e.U = U; e.LF = (float*)(ws + WS_LF); e.lb = (const float*)(ws + WS_LB);
        gemm_phase<4>(hbuf, D, (const bf16_t*)(ws + WS_WT_ABIN), 1024, MROWS, 3072, 1024, e, smem); }
    if (PH_G1_0 + 1 < p.ph_hi) grid_sync(bar);
  }
  if (p.ph_lo <= PH_POOLPREP && PH_POOLPREP < p.ph_hi) { ph_pool_prep(U + 5 * (size_t)MROWS * 512, hbuf);
    if (PH_POOLPREP + 1 < p.ph_hi) grid_sync(bar);
  }
  if (p.ph_lo <= PH_POOL && PH_POOL < p.ph_hi) {
        for (int gi = 0; gi < 4; ++gi) { EpiPool e; e.A = abuf; e.scale = p.in[13]; e.gi = gi; e.pad = 0;
          gemm_phase<4>(hbuf + gi * 128, 512, (const bf16_t*)(ws + WS_WT_POOL) + (size_t)gi * 128 * 128, 128, MROWS, 128, 128, e, smem); }
    if (PH_POOL + 1 < p.ph_hi) grid_sync(bar);
  }
  if (p.ph_lo <= PH_G2_0 && PH_G2_0 < p.ph_hi) { { EpiOutRes e; e.base_lat = p.in[0]; e.base_ctx = p.in[2]; e.out_lat = p.out; e.out_ctx = xc; e.modl = mods0; e.g_off = 2048; e.pad = 0;
        gemm_phase<2>(abuf, D, (const bf16_t*)(ws + WS_WT_ABOUT), 1024, MROWS, 1024, 1024, e, smem); }
    if (PH_G2_0 + 1 < p.ph_hi) grid_sync(bar);
  }
  if (p.ph_lo <= PH_ROUTE_0 && PH_ROUTE_0 < p.ph_hi) { ph_router(p, 0, MROWS, smem);
    if (PH_ROUTE_0 + 1 < p.ph_hi) grid_sync(bar);
  }
  if (p.ph_lo <= PH_MOE1_0 && PH_MOE1_0 < p.ph_hi) { ph_moe1<4>(p, 0, smem);
    if (PH_MOE1_0 + 1 < p.ph_hi) grid_sync(bar);
  }
  if (p.ph_lo <= PH_MOE2_0 && PH_MOE2_0 < p.ph_hi) { ph_moe2<4>(p, 0, smem);
    if (PH_MOE2_0 + 1 < p.ph_hi) grid_sync(bar);
  }
  if (p.ph_lo <= PH_COMB_0 && PH_COMB_0 < p.ph_hi) { ph_combine(p, 0, MROWS, 0); ph_conv_moe(p, 1, smem);
    if (PH_COMB_0 + 1 < p.ph_hi) grid_sync(bar);
  }
  if (p.ph_lo <= PH_G1_1 && PH_G1_1 < p.ph_hi) { { EpiCDIn e; e.nq = (bf16_t*)(ws + WS_NQ); e.nk = (bf16_t*)(ws + WS_NK); e.nv = (bf16_t*)(ws + WS_NV); e.cq = (bf16_t*)(ws + WS_CQ); e.ckv = (bf16_t*)(ws + WS_CKV); e.kr = (float*)(ws + WS_KR);
        gemm_phase<4>(hbuf, D, (const bf16_t*)(ws + WS_WT_CDIN), 1024, MROWS, 2048, 1024, e, smem); }
    if (PH_G1_1 + 1 < p.ph_hi) grid_sync(bar);
  }
  if (p.ph_lo <= PH_MLAUP && PH_MLAUP < p.ph_hi) { {
        { EpiMlaQ2 e; e.dq = (bf16_t*)(ws + WS_DQ); e.cq = (const bf16_t*)(ws + WS_CQ); const int ntn = 6;
          for (int tile = blockIdx.x; tile < (NLAT / 256) * ntn; tile += gridDim.x) { const int mt = tile / ntn, nt = tile - mt * ntn;
            gemm_tile<4>(e.cq, 256, nullptr, 0, NLAT, (const bf16_t*)(ws + WS_WT_UQ), 256, 256, mt * 256, nt * 128, smem, e); } }
        { EpiMlaKV2 e; e.dk = (bf16_t*)(ws + WS_DK); e.dv = (bf16_t*)(ws + WS_DV); e.ckv = (const bf16_t*)(ws + WS_CKV); const int ntn = 8;
          for (int tile = blockIdx.x; tile < (MROWS / 256) * ntn; tile += gridDim.x) { const int mt = tile / ntn, nt = tile - mt * ntn;
            gemm_tile<4>(e.ckv, 128, nullptr, 0, MROWS, (const bf16_t*)(ws + WS_WT_UKV), 128, 128, mt * 256, nt * 128, smem, e); } }
        ph_kr_rope((const float*)(ws + WS_KR), (bf16_t*)(ws + WS_DK));
      }
    if (PH_MLAUP + 1 < p.ph_hi) grid_sync(bar);
  }
  if (p.ph_lo <= PH_G2_1 && PH_G2_1 < p.ph_hi) { { EpiOutRes e; e.base_lat = p.out; e.base_ctx = xc; e.out_lat = p.out; e.out_ctx = xc; e.modl = mods1; e.g_off = 2048; e.pad = 0;
        gemm_phase<2>(abuf, D, (const bf16_t*)(ws + WS_WT_CDOUT), 1024, NLAT, 1024, 1024, e, smem); }
    if (PH_G2_1 + 1 < p.ph_hi) grid_sync(bar);
  }
  if (p.ph_lo <= PH_ROUTE_1 && PH_ROUTE_1 < p.ph_hi) { ph_router(p, 1, NLAT, smem);
    if (PH_ROUTE_1 + 1 < p.ph_hi) grid_sync(bar);
  }
  if (p.ph_lo <= PH_MOE1_1 && PH_MOE1_1 < p.ph_hi) { ph_moe1<4>(p, 1, smem);
    if (PH_MOE1_1 + 1 < p.ph_hi) grid_sync(bar);
  }
  if (p.ph_lo <= PH_MOE2_1 && PH_MOE2_1 < p.ph_hi) { ph_moe2<4>(p, 1, smem);
    if (PH_MOE2_1 + 1 < p.ph_hi) grid_sync(bar);
  }
  if (p.ph_lo <= PH_FINAL && PH_FINAL < p.ph_hi) { ph_combine(p, 1, NLAT, 1);
    if (PH_FINAL + 1 < p.ph_hi) grid_sync(bar);
  }
}

static void run_phases(hipStream_t st, MP p, int lo, int hi) {
  for (int ph = lo; ph < hi; ++ph) { p.ph_lo = ph; p.ph_hi = ph + 1; hipLaunchKernelGGL(mega, dim3(256), dim3(512), LDS_BYTES, st, p); }
}

extern "C" void kernel_launch(void* const* d_in, const int* in_sizes, int n_in, void* d_out, int out_size, void* d_ws, size_t ws_size, hipStream_t stream) {
  static int ok = 0;
  if (!ok) {
    if (n_in != 29 || in_sizes[0] != NLAT * D || out_size != NLAT * D || ws_size < WS_END) {
      fprintf(stderr, "kernel_launch: unexpected shapes (n_in %d, in0 %d, out %d, ws %zu, need %zu)\n", n_in, n_in > 0 ? in_sizes[0] : -1, out_size, ws_size, (size_t)WS_END);
      return; }
    if (hipFuncSetAttribute((const void*)mega, hipFuncAttributeMaxDynamicSharedMemorySize, LDS_BYTES) != hipSuccess) { fprintf(stderr, "kernel_launch: hipFuncSetAttribute failed\n"); return; }
    ok = 1;
  }
  char* ws = (char*)d_ws; float* out = (float*)d_out;
  MP p; memset(&p, 0, sizeof(p));
  for (int i = 0; i < 29; ++i) p.in[i] = (const float*)d_in[i];
  p.out = out; p.ws = ws;
  hipMemsetAsync(ws + WS_CTL, 0, 65536, stream);
  float* odir_ctx = (float*)(ws + WS_ODIR_CTX);
  bf16_t* abuf = (bf16_t*)(ws + WS_A); bf16_t* U = (bf16_t*)(ws + WS_U); float* LF = (float*)(ws + WS_LF);
  bf16_t* nq = (bf16_t*)(ws + WS_NQ); bf16_t* nk = (bf16_t*)(ws + WS_NK); bf16_t* nv = (bf16_t*)(ws + WS_NV);
  bf16_t* dq = (bf16_t*)(ws + WS_DQ); bf16_t* dk = (bf16_t*)(ws + WS_DK); bf16_t* dv = (bf16_t*)(ws + WS_DV);

  run_phases(stream, p, PH_PRE, PH_POOLPREP);
  hipLaunchKernelGGL(k_hgrn_naive, dim3(16), dim3(128), 0, stream, U, LF, out  , odir_ctx);
  hipLaunchKernelGGL(k_hgrn_out, dim3(1024), dim3(512), 0, stream, out, odir_ctx, U + 4 * (size_t)MROWS * 512, (const float*)d_in[11], abuf);
  run_phases(stream, p, PH_POOLPREP, PH_MLAUP + 1);
  hipLaunchKernelGGL(k_na_naive, dim3(SEQ / 64, 8, NB), dim3(64), 0, stream, nq, nk, nv, (const float*)d_in[16], abuf);
  hipLaunchKernelGGL(k_mla_naive, dim3(SEQ / 64, 8, NB), dim3(64), 0, stream, dq, dk, dv, abuf);
  run_phases(stream, p, PH_G2_1, PH_COUNT);
}
```

```cpp
#include <hip/hip_runtime.h>
#include <stdint.h>
#include <cstdio>
#include <cstring>

typedef unsigned short bf16_t;
typedef float f32x4 __attribute__((ext_vector_type(4)));

constexpr int D = 1024, NB = 2, SEQ = 8192, CT = 256;
constexpr int NLAT = NB * SEQ;
constexpr int NCTX = NB * CT;
constexpr int MROWS = NLAT + NCTX;
constexpr int NKEY = CT + SEQ;
constexpr float EPS = 1e-6f;
constexpr float LOG2E = 1.4426950408889634f;
constexpr float NA_QSCALE = 0.125f * LOG2E;
constexpr float MLA_QSCALE = 0.10206207261596577f * LOG2E;

constexpr size_t alignup(size_t x) { return (x + 255) & ~(size_t)255; }
constexpr size_t WS_CTL      = 0;
constexpr size_t WS_MODS     = 65536;
constexpr size_t WS_LB       = WS_MODS + alignup(2 * 3 * 6144 * 4);
constexpr size_t WS_XC       = WS_LB + 4096;
constexpr size_t WS_ROUTE_E  = WS_XC + (size_t)NCTX * D * 4;
constexpr size_t WS_ROUTE_W  = WS_ROUTE_E + alignup((size_t)MROWS * 2 * 4);
constexpr size_t WS_RSTD_Q   = WS_ROUTE_W + alignup((size_t)MROWS * 2 * 4);
constexpr size_t WS_RSTD_KV  = WS_RSTD_Q + alignup((size_t)NLAT * 4);
constexpr size_t WS_ODIR_CTX = WS_RSTD_KV + alignup((size_t)MROWS * 4);
constexpr size_t WS_LIST     = WS_ODIR_CTX + (size_t)2 * NCTX * 512 * 4;
constexpr size_t WS_ALAST    = WS_LIST + (size_t)32 * MROWS * 4;
constexpr size_t WS_WT_ABIN  = WS_ALAST + (size_t)2 * (MROWS / 64) * 512 * 4;
constexpr size_t WS_WT_ABOUT = WS_WT_ABIN + (size_t)3072 * 1024 * 2;
constexpr size_t WS_WT_CDIN  = WS_WT_ABOUT + (size_t)1024 * 1024 * 2;
constexpr size_t WS_WT_CDOUT = WS_WT_CDIN + (size_t)2048 * 1024 * 2;
constexpr size_t WS_WT_UQ    = WS_WT_CDOUT + (size_t)1024 * 1024 * 2;
constexpr size_t WS_WT_UKV   = WS_WT_UQ + (size_t)768 * 256 * 2;
constexpr size_t WS_WT_POOL  = WS_WT_UKV + (size_t)1024 * 128 * 2;
constexpr size_t WS_WMOE     = WS_WT_POOL + (size_t)4 * 128 * 128 * 2;
constexpr size_t WS_H        = WS_WMOE + (size_t)32 * 512 * 1024 * 2 + (size_t)32 * 1024 * 256 * 2;
constexpr size_t WS_A        = WS_H + (size_t)MROWS * D * 2;
constexpr size_t WS_U        = WS_A + (size_t)MROWS * D * 2;
constexpr size_t USLOT       = (size_t)MROWS * 512 * 2;
constexpr size_t WS_LF       = WS_U + 6 * USLOT;
constexpr size_t WS_END      = WS_LF + (size_t)2 * MROWS * 512 * 4;
constexpr size_t WS_NQ   = WS_U;
constexpr size_t WS_NK   = WS_NQ + (size_t)NLAT * 512 * 2;
constexpr size_t WS_NV   = WS_NK + USLOT;
constexpr size_t WS_CQ   = WS_NV + USLOT;
constexpr size_t WS_CKV  = WS_CQ + (size_t)NLAT * 256 * 2;
constexpr size_t WS_KR   = WS_CKV + (size_t)MROWS * 128 * 2;
constexpr size_t WS_DQ   = WS_KR + (size_t)MROWS * 32 * 4;
constexpr size_t WS_L1END = WS_DQ + (size_t)NLAT * 768 * 2;
static_assert(WS_L1END <= WS_LF, "layer-1 overlay too big");
constexpr size_t WS_DK   = WS_LF;
constexpr size_t WS_DV   = WS_DK + (size_t)MROWS * 1024 * 2;
static_assert(WS_DV + (size_t)MROWS * 512 * 2 <= WS_END, "dk/dv overlay too big");
constexpr size_t WS_YBUF = WS_LF;
constexpr size_t WS_AMOE = WS_U;

__device__ __forceinline__ float bf2f(bf16_t h) { return __uint_as_float(((unsigned)h) << 16); }
__device__ __forceinline__ bf16_t f2bf(float f) { unsigned u = __float_as_uint(f); u += 0x7FFFu + ((u >> 16) & 1u); return (bf16_t)(u >> 16); }
__device__ __forceinline__ unsigned pack2(float a, float b) { return (unsigned)f2bf(a) | ((unsigned)f2bf(b) << 16); }
__device__ __forceinline__ float sigmoidf_(float x) { return 1.f / (1.f + __expf(-x)); }
__device__ __forceinline__ float siluf_(float x) { return x / (1.f + __expf(-x)); }
__device__ __forceinline__ float wave_sum(float v) {
#pragma unroll
  for (int o = 1; o < 64; o <<= 1) v += __shfl_xor(v, o);
  return v;
}
__device__ __forceinline__ int row_vec(int m) { return m < NLAT ? (m >> 13) : 2; }
__device__ __forceinline__ void row_bkey(int m, int& b, int& key) {
  if (m < NLAT) { b = m >> 13; key = CT + (m & 8191); } else { const int mm = m - NLAT; b = mm >> 8; key = mm & 255; }
}

__global__ __launch_bounds__(512) void k_ada(const float* __restrict__ c, const float* __restrict__ cctx, const float* __restrict__ ada_w,
                                             const float* __restrict__ ada_b, float* __restrict__ mods) {
  const int l = blockIdx.y, n0 = blockIdx.x * 64, j = threadIdx.x & 63, kg = threadIdx.x >> 6;
  __shared__ float sv[3][1024];
  __shared__ float red[8][3][64];
  for (int i = threadIdx.x; i < 1024; i += 512) { sv[0][i] = siluf_(c[i]); sv[1][i] = siluf_(c[1024 + i]); sv[2][i] = siluf_(cctx[i]); }
  __syncthreads();
  const float* W = ada_w + (size_t)l * 1024 * 6144 + n0 + j;
  float a0 = 0.f, a1 = 0.f, a2 = 0.f;
  for (int k = kg * 128; k < kg * 128 + 128; ++k) { const float w = W[(size_t)k * 6144]; a0 += sv[0][k] * w; a1 += sv[1][k] * w; a2 += sv[2][k] * w; }
  red[kg][0][j] = a0; red[kg][1][j] = a1; red[kg][2][j] = a2;
  __syncthreads();
  if (threadIdx.x < 192) {
    const int v = threadIdx.x >> 6, jj = threadIdx.x & 63; float s = 0.f;
    for (int g = 0; g < 8; ++g) s += red[g][v][jj];
    mods[(size_t)(l * 3 + v) * 6144 + n0 + jj] = s + ada_b[l * 6144 + n0 + jj];
  }
}
__global__ void k_lb(const float* __restrict__ logits, float* __restrict__ lb) {
  const int i = blockIdx.x * blockDim.x + threadIdx.x;
  if (i < 1024) { const int d = i >> 9, cc = i & 511; const float l0 = logits[(d * 2 + 0) * 512 + cc], l1 = logits[(d * 2 + 1) * 512 + cc]; lb[i] = 1.f / (1.f + expf(l1 - l0)); }
}

struct ConvArgs { const float* src; bf16_t* dst; const float* kscale; int K, N, Npad, mode; size_t sbs, dbs; };
__device__ __forceinline__ int moe_gu_row(int sel, int hidden) {
  const int nt = hidden >> 6, hl = hidden & 63, wc = hl >> 5, i2 = (hl >> 4) & 1, cc = hl & 15;
  return nt * 128 + wc * 64 + (sel * 2 + i2) * 16 + cc;
}
__global__ __launch_bounds__(512) void k_convT(ConvArgs a) {
  __shared__ float tile[64][65];
  const float* src = a.src + blockIdx.z * a.sbs; bf16_t* dst = a.dst + blockIdx.z * a.dbs;
  const int n0 = blockIdx.x * 64, k0 = blockIdx.y * 64, tx = threadIdx.x & 63, ty = threadIdx.x >> 6;
#pragma unroll
  for (int i = 0; i < 8; ++i) {
    const int k = k0 + ty + 8 * i, n = n0 + tx; float v = 0.f;
    if (n < a.N) { v = src[(size_t)k * a.N + n]; if (a.kscale) v *= a.kscale[k]; }
    tile[ty + 8 * i][tx] = v;
  }
  __syncthreads();
#pragma unroll
  for (int i = 0; i < 8; ++i) {
    const int nl = ty + 8 * i, n = n0 + nl;
    if (n < a.Npad) { int row = n; if (a.mode == 1) row = moe_gu_row(0, n); else if (a.mode == 2) row = moe_gu_row(1, n);
      dst[(size_t)row * a.K + k0 + tx] = f2bf(tile[tx][nl]); }
  }
}

__global__ __launch_bounds__(512) void k_norm_mod(const float* __restrict__ lat, const float* __restrict__ ctxr, const float* __restrict__ gain,
                                                  const float* __restrict__ modl, int sh_off, int sc_off, bf16_t* __restrict__ out, int nrows) {
  const int lane = threadIdx.x & 63, gw = blockIdx.x * 8 + (threadIdx.x >> 6);
  for (int row = gw; row < nrows; row += gridDim.x * 8) {
    const float* src = row < NLAT ? lat + (size_t)row * D : ctxr + (size_t)(row - NLAT) * D;
    const float* mv = modl + row_vec(row) * 6144;
    f32x4 x[4]; float ss = 0.f;
#pragma unroll
    for (int j = 0; j < 4; ++j) { x[j] = ((const f32x4*)src)[lane + 64 * j]; ss += x[j].x * x[j].x + x[j].y * x[j].y + x[j].z * x[j].z + x[j].w * x[j].w; }
    const float rstd = 1.f / sqrtf(wave_sum(ss) * (1.f / D) + EPS);
#pragma unroll
    for (int j = 0; j < 4; ++j) {
      const int n = (lane + 64 * j) * 4;
      const f32x4 g = *(const f32x4*)(gain + n), sc = *(const f32x4*)(mv + sc_off + n), sh = *(const f32x4*)(mv + sh_off + n);
      const f32x4 h = x[j] * rstd * g * (sc + 1.f) + sh;
      uint2 o; o.x = pack2(h.x, h.y); o.y = pack2(h.z, h.w);
      *(uint2*)(out + (size_t)row * D + n) = o;
    }
  }
}

struct EpiABIn {
  bf16_t* U; float* LF; const float* lb;
  __device__ __forceinline__ void apply(int m, int n, f32x4 v) const {
    const int seg = n >> 9, cn = n & 511; float o[4] = {v.x, v.y, v.z, v.w};
    bf16_t* dst;
    if (seg == 0) { dst = U; for (int i = 0; i < 4; ++i) o[i] = siluf_(o[i]); }
    else if (seg == 1 || seg == 2) { const int d = seg - 1; dst = U + (size_t)(1 + d) * MROWS * 512;
      f32x4 lg;
#pragma unroll
      for (int i = 0; i < 4; ++i) { const float l = lb[d * 512 + cn + i]; const float k = (1.f - l) * sigmoidf_(-o[i]); o[i] = k; lg[i] = log1pf(-k); }
      *(f32x4*)(LF + ((size_t)d * MROWS + m) * 512 + cn) = lg; }
    else if (seg == 3) dst = U + (size_t)3 * MROWS * 512;
    else if (seg == 4) { dst = U + (size_t)4 * MROWS * 512; for (int i = 0; i < 4; ++i) o[i] = siluf_(o[i]); }
    else dst = U + (size_t)5 * MROWS * 512;
    uint2 w; w.x = pack2(o[0], o[1]); w.y = pack2(o[2], o[3]);
    *(uint2*)(dst + (size_t)m * 512 + cn) = w;
  }
};
struct EpiPool {
  bf16_t* A; const float* scale; int gi; int pad;
  __device__ __forceinline__ void apply(int m, int n, f32x4 v) const {
    const int cn = gi * 128 + n; const f32x4 s = *(const f32x4*)(scale + cn); v = v * s;
    uint2 w; w.x = pack2(v.x, v.y); w.y = pack2(v.z, v.w);
    *(uint2*)(A + (size_t)m * D + 512 + cn) = w;
  }
};
struct EpiOutRes {
  const float* base_lat; const float* base_ctx; float* out_lat; float* out_ctx; const float* modl; int g_off; int pad;
  __device__ __forceinline__ void apply(int m, int n, f32x4 v) const {
    const f32x4 g = *(const f32x4*)(modl + row_vec(m) * 6144 + g_off + n);
    if (m < NLAT) { const f32x4 b = *(const f32x4*)(base_lat + (size_t)m * D + n); *(f32x4*)(out_lat + (size_t)m * D + n) = b + g * v; }
    else { const size_t o = (size_t)(m - NLAT) * D + n; const f32x4 b = *(const f32x4*)(base_ctx + o); *(f32x4*)(out_ctx + o) = b + g * v; }
  }
};
struct EpiCDIn {
  bf16_t *nq, *nk, *nv, *cq, *ckv; float* kr;
  __device__ __forceinline__ void apply(int m, int n, f32x4 v) const {
    int b, key; row_bkey(m, b, key);
    if (n < 1536) {
      const int which = n >> 9, hh = (n & 511) >> 6, dd = n & 63;
      if (which == 0) { if (m >= NLAT) return; v = v * NA_QSCALE;
        uint2 w; w.x = pack2(v.x, v.y); w.y = pack2(v.z, v.w);
        *(uint2*)(nq + (((size_t)(b * 8 + hh) * SEQ + (m & 8191)) * 64 + dd)) = w; }
      else { bf16_t* dst = which == 1 ? nk : nv; uint2 w; w.x = pack2(v.x, v.y); w.y = pack2(v.z, v.w);
        *(uint2*)(dst + (((size_t)(b * 8 + hh) * NKEY + key) * 64 + dd)) = w; }
    } else if (n < 1792) { if (m >= NLAT) return; uint2 w; w.x = pack2(v.x, v.y); w.y = pack2(v.z, v.w); *(uint2*)(cq + (size_t)m * 256 + (n - 1536)) = w; }
    else if (n < 1920) { uint2 w; w.x = pack2(v.x, v.y); w.y = pack2(v.z, v.w); *(uint2*)(ckv + (size_t)m * 128 + (n - 1792)) = w; }
    else if (n < 1952) { *(f32x4*)(kr + (size_t)m * 32 + (n - 1920)) = v; }
  }
};
struct EpiMlaQ {
  bf16_t* dq; const float* rstd;
  __device__ __forceinline__ void apply(int m, int n, f32x4 v) const {
    const int hh = n / 96, off = n - hh * 96; v = v * (rstd[m] * MLA_QSCALE);
    uint2 w; w.x = pack2(v.x, v.y); w.y = pack2(v.z, v.w);
    *(uint2*)(dq + (((size_t)((m >> 13) * 8 + hh) * SEQ + (m & 8191)) * 96 + off)) = w;
  }
};
struct EpiMlaKV {
  bf16_t *dk, *dv; const float* rstd;
  __device__ __forceinline__ void apply(int m, int n, f32x4 v) const {
    int b, key; row_bkey(m, b, key);
    const int hh = n >> 7, off = n & 127; v = v * rstd[m];
    uint2 w; w.x = pack2(v.x, v.y); w.y = pack2(v.z, v.w);
    if (off < 64) *(uint2*)(dk + (((size_t)(b * 8 + hh) * NKEY + key) * 128 + off)) = w;
    else *(uint2*)(dv + (((size_t)(b * 8 + hh) * NKEY + key) * 64 + (off - 64))) = w;
  }
};

template <class Epi>
__global__ __launch_bounds__(256) void k_gemm_naive(const bf16_t* __restrict__ A, int lda, const bf16_t* __restrict__ Bt, int ldb, int M, int N, int K, Epi epi) {
  __shared__ float As[32][68];
  __shared__ float Bs[32][68];
  const int m0 = blockIdx.y * 64, n0 = blockIdx.x * 64, t = threadIdx.x, tx = t & 15, ty = t >> 4;
  float acc[4][4];
#pragma unroll
  for (int i = 0; i < 4; ++i)
#pragma unroll
    for (int j = 0; j < 4; ++j) acc[i][j] = 0.f;
  const int lr = t >> 2, lk = (t & 3) * 8;
  for (int k0 = 0; k0 < K; k0 += 32) {
    uint4 ra = make_uint4(0, 0, 0, 0), rb = make_uint4(0, 0, 0, 0);
    if (m0 + lr < M) ra = *(const uint4*)(A + (size_t)(m0 + lr) * lda + k0 + lk);
    if (n0 + lr < N) rb = *(const uint4*)(Bt + (size_t)(n0 + lr) * ldb + k0 + lk);
    const unsigned wa[4] = {ra.x, ra.y, ra.z, ra.w}, wb[4] = {rb.x, rb.y, rb.z, rb.w};
#pragma unroll
    for (int i = 0; i < 4; ++i) {
      As[lk + 2 * i][lr] = __uint_as_float(wa[i] << 16); As[lk + 2 * i + 1][lr] = __uint_as_float(wa[i] & 0xFFFF0000u);
      Bs[lk + 2 * i][lr] = __uint_as_float(wb[i] << 16); Bs[lk + 2 * i + 1][lr] = __uint_as_float(wb[i] & 0xFFFF0000u);
    }
    __syncthreads();
#pragma unroll 8
    for (int kk = 0; kk < 32; ++kk) {
      const f32x4 a = *(const f32x4*)&As[kk][ty * 4], b = *(const f32x4*)&Bs[kk][tx * 4];
      const float av[4] = {a.x, a.y, a.z, a.w}, bv[4] = {b.x, b.y, b.z, b.w};
#pragma unroll
      for (int i = 0; i < 4; ++i)
#pragma unroll
        for (int j = 0; j < 4; ++j) acc[i][j] += av[i] * bv[j];
    }
    __syncthreads();
  }
#pragma unroll
  for (int i = 0; i < 4; ++i) {
    const int m = m0 + ty * 4 + i, n = n0 + tx * 4;
    if (m < M && n < N) { f32x4 v = {acc[i][0], acc[i][1], acc[i][2], acc[i][3]}; epi.apply(m, n, v); }
  }
}
template <class Epi>
static void launch_gemm_naive(hipStream_t st, const bf16_t* A, int lda, const bf16_t* Bt, int ldb, int M, int N, int K, Epi epi) {
  hipLaunchKernelGGL((k_gemm_naive<Epi>), dim3((N + 63) / 64, (M + 63) / 64), dim3(256), 0, st, A, lda, Bt, ldb, M, N, K, epi);
}

__device__ __forceinline__ int hgrn_step_row(int b, int dir, int s) {
  if (s < CT) return NLAT + b * CT + (dir ? (CT - 1 - s) : s);
  const int ls = s - CT; return b * SEQ + (dir ? (SEQ - 1 - ls) : ls);
}
__global__ __launch_bounds__(128) void k_hgrn_naive(const bf16_t* __restrict__ U, const float* __restrict__ LF, float* __restrict__ odir_lat, float* __restrict__ odir_ctx) {
  const int bid = blockIdx.x, dir = bid & 1, h = (bid >> 1) & 3, b = bid >> 3, e = threadIdx.x;
  __shared__ float sf[32][128];
  __shared__ float sk[32][128];
  __shared__ float sq[32][128];
  float Sreg[128];
#pragma unroll
  for (int d = 0; d < 128; ++d) Sreg[d] = 0.f;
  const bf16_t* Uq = U; const bf16_t* Uk = U + (size_t)(1 + dir) * MROWS * 512; const bf16_t* Uv = U + (size_t)3 * MROWS * 512;
  const float* lf = LF + (size_t)dir * MROWS * 512;
  for (int s0 = 0; s0 < NKEY; s0 += 32) {
    __syncthreads();
    for (int i = 0; i < 32; ++i) {
      const size_t off = (size_t)hgrn_step_row(b, dir, s0 + i) * 512 + h * 128 + e;
      sf[i][e] = expf(lf[off]); sk[i][e] = bf2f(Uk[off]); sq[i][e] = bf2f(Uq[off]);
    }
    __syncthreads();
    for (int i = 0; i < 32; ++i) {
      const int row = hgrn_step_row(b, dir, s0 + i);
      const float v = bf2f(Uv[(size_t)row * 512 + h * 128 + e]); float o = 0.f;
#pragma unroll
      for (int d = 0; d < 128; ++d) { Sreg[d] = sf[i][d] * Sreg[d] + sk[i][d] * v; o += Sreg[d] * sq[i][d]; }
      if (row < NLAT) odir_lat[((size_t)dir * NLAT + row) * 512 + h * 128 + e] = o;
      else odir_ctx[((size_t)dir * NCTX + (row - NLAT)) * 512 + h * 128 + e] = o;
    }
  }
}
__global__ __launch_bounds__(512) void k_hgrn_out(const float* __restrict__ odir_lat, const float* __restrict__ odir_ctx, const bf16_t* __restrict__ Ug,
                                                  const float* __restrict__ onorm_g, bf16_t* __restrict__ A) {
  const int lane = threadIdx.x & 63, gw = blockIdx.x * 8 + (threadIdx.x >> 6);
  for (int row = gw; row < MROWS; row += gridDim.x * 8) {
    const float* pf = row < NLAT ? odir_lat + (size_t)row * 512 : odir_ctx + (size_t)(row - NLAT) * 512;
    const float* pb = row < NLAT ? odir_lat + ((size_t)NLAT + row) * 512 : odir_ctx + ((size_t)NCTX + (row - NLAT)) * 512;
    const int c0 = lane * 8; float o[8]; float ss = 0.f;
#pragma unroll
    for (int i = 0; i < 8; ++i) { o[i] = pf[c0 + i] + pb[c0 + i]; ss += o[i] * o[i]; }
    ss += __shfl_xor(ss, 1); ss += __shfl_xor(ss, 2); ss += __shfl_xor(ss, 4); ss += __shfl_xor(ss, 8);
    const float rstd = 1.f / sqrtf(ss * (1.f / 128.f) + EPS);
    const uint4 gr = *(const uint4*)(Ug + (size_t)row * 512 + c0); const unsigned gw4[4] = {gr.x, gr.y, gr.z, gr.w};
    unsigned w[4];
#pragma unroll
    for (int i = 0; i < 4; ++i) {
      const float g0 = __uint_as_float(gw4[i] << 16), g1 = __uint_as_float(gw4[i] & 0xFFFF0000u);
      const int e0 = (c0 + 2 * i) & 127;
      w[i] = pack2(o[2 * i] * rstd * onorm_g[e0] * g0, o[2 * i + 1] * rstd * onorm_g[e0 + 1] * g1);
    }
    *(uint4*)(A + (size_t)row * D + c0) = make_uint4(w[0], w[1], w[2], w[3]);
  }
}
__global__ __launch_bounds__(512) void k_pool_prep(const bf16_t* __restrict__ Up, bf16_t* __restrict__ pd) {
  const int c = threadIdx.x;
  for (int row = blockIdx.x; row < MROWS; row += gridDim.x) {
    int base, t, n; if (row < NLAT) { base = row & ~8191; t = row & 8191; n = SEQ; } else { const int mm = row - NLAT; base = NLAT + (mm & ~255); t = mm & 255; n = CT; }
    const int gi = c >> 7, win = 2 << gi; int lo = t - win / 2, hi = t + win - win / 2; lo = lo < 0 ? 0 : lo; hi = hi > n ? n : hi;
    float s = 0.f; for (int r = lo; r < hi; ++r) s += bf2f(Up[(size_t)(base + r) * 512 + c]);
    pd[(size_t)row * 512 + c] = f2bf(s / (float)(hi - lo) - bf2f(Up[(size_t)row * 512 + c]));
  }
}

__global__ __launch_bounds__(512) void k_router(const float* __restrict__ lat, const float* __restrict__ ctxr, const float* __restrict__ gain, const float* __restrict__ modl,
                                                const float* __restrict__ wrg, const float* __restrict__ brg, const float* __restrict__ wre, const float* __restrict__ bre,
                                                bf16_t* __restrict__ out, int* __restrict__ re, float* __restrict__ rw, int nrows) {
  __shared__ float hs[8][1024];
  const int lane = threadIdx.x & 63, wv = threadIdx.x >> 6, gw = blockIdx.x * 8 + wv;
  const float* wp = lane < 4 ? wrg + lane : wre + ((lane - 4) & 31); const int wst = lane < 4 ? 4 : 32;
  const float bias = lane < 4 ? brg[lane] : bre[(lane - 4) & 31];
  for (int row = gw; row < nrows; row += gridDim.x * 8) {
    const float* src = row < NLAT ? lat + (size_t)row * D : ctxr + (size_t)(row - NLAT) * D;
    const float* mv = modl + row_vec(row) * 6144;
    f32x4 x[4]; float ss = 0.f;
#pragma unroll
    for (int j = 0; j < 4; ++j) { x[j] = ((const f32x4*)src)[lane + 64 * j]; ss += x[j].x * x[j].x + x[j].y * x[j].y + x[j].z * x[j].z + x[j].w * x[j].w; }
    const float rstd = 1.f / sqrtf(wave_sum(ss) * (1.f / D) + EPS);
#pragma unroll
    for (int j = 0; j < 4; ++j) {
      const int n = (lane + 64 * j) * 4;
      const f32x4 g = *(const f32x4*)(gain + n), sc = *(const f32x4*)(mv + 4096 + n), sh = *(const f32x4*)(mv + 3072 + n);
      const f32x4 h = x[j] * rstd * g * (sc + 1.f) + sh;
      uint2 o; o.x = pack2(h.x, h.y); o.y = pack2(h.z, h.w);
      *(uint2*)(out + (size_t)row * D + n) = o;
      *(f32x4*)&hs[wv][n] = h;
    }
    __builtin_amdgcn_wave_barrier();
    float acc = 0.f;
#pragma unroll 8
    for (int k = 0; k < 1024; ++k) acc += hs[wv][k] * wp[(size_t)k * wst];
    acc += bias;
    __builtin_amdgcn_wave_barrier();
    float gl[4];
#pragma unroll
    for (int i = 0; i < 4; ++i) gl[i] = __shfl(acc, i);
    int gi = 0; float gm = gl[0];
#pragma unroll
    for (int i = 1; i < 4; ++i) if (gl[i] > gm) { gm = gl[i]; gi = i; }
    float gs = 0.f;
#pragma unroll
    for (int i = 0; i < 4; ++i) gs += expf(gl[i] - gm);
    const float gp = 1.f / gs;
    float el[8];
#pragma unroll
    for (int i = 0; i < 8; ++i) el[i] = __shfl(acc, 4 + gi * 8 + i);
    int e1 = 0; float m1 = el[0];
#pragma unroll
    for (int i = 1; i < 8; ++i) if (el[i] > m1) { m1 = el[i]; e1 = i; }
    int e2 = 0; float m2 = -3.0e38f;
#pragma unroll
    for (int i = 0; i < 8; ++i) if (i != e1 && el[i] > m2) { m2 = el[i]; e2 = i; }
    const float w1 = 1.f / (1.f + expf(m2 - m1)), w2 = 1.f - w1;
    if (lane == 0) { re[row * 2] = gi * 8 + e1; re[row * 2 + 1] = gi * 8 + e2; rw[row * 2] = gp * w1; rw[row * 2 + 1] = gp * w2; }
  }
}

__global__ __launch_bounds__(256) void k_moe_naive(const bf16_t* __restrict__ H, const int* __restrict__ re, const float* __restrict__ rw,
                                                   const float* __restrict__ Wg, const float* __restrict__ Wu, const float* __restrict__ Wd, bf16_t* __restrict__ Y) {
  const int row = blockIdx.x, f = threadIdx.x;
  __shared__ float hs[1024];
  __shared__ float as_[256];
  for (int i = f; i < 1024; i += 256) hs[i] = bf2f(H[(size_t)row * D + i]);
  __syncthreads();
  for (int slot = 0; slot < 2; ++slot) {
    const int e = re[row * 2 + slot]; const float w = rw[row * 2 + slot];
    const float* wg = Wg + (size_t)e * 1024 * 256 + f; const float* wu = Wu + (size_t)e * 1024 * 256 + f;
    float g = 0.f, u = 0.f;
#pragma unroll 8
    for (int k = 0; k < 1024; ++k) { g += hs[k] * wg[(size_t)k * 256]; u += hs[k] * wu[(size_t)k * 256]; }
    as_[f] = siluf_(g) * u * w;
    __syncthreads();
    const float* wd = Wd + (size_t)e * 256 * 1024;
    float y[4] = {0.f, 0.f, 0.f, 0.f};
#pragma unroll 4
    for (int k = 0; k < 256; ++k) { const float a = as_[k];
#pragma unroll
      for (int i = 0; i < 4; ++i) y[i] += a * wd[(size_t)k * 1024 + f + 256 * i]; }
#pragma unroll
    for (int i = 0; i < 4; ++i) Y[((size_t)row * 2 + slot) * D + f + 256 * i] = f2bf(y[i]);
    __syncthreads();
  }
}

__global__ __launch_bounds__(512) void k_combine_norm(float* __restrict__ lat, float* __restrict__ ctxr, const bf16_t* __restrict__ Y, const float* __restrict__ modl_cur,
                                                      const float* __restrict__ gain, const float* __restrict__ modl_next, bf16_t* __restrict__ hout, int nrows, int final_) {
  const int lane = threadIdx.x & 63, gw = blockIdx.x * 8 + (threadIdx.x >> 6);
  for (int row = gw; row < nrows; row += gridDim.x * 8) {
    float* src = row < NLAT ? lat + (size_t)row * D : ctxr + (size_t)(row - NLAT) * D;
    const int v = row_vec(row);
    f32x4 x[4]; float ss = 0.f;
#pragma unroll
    for (int j = 0; j < 4; ++j) {
      const int n = (lane + 64 * j) * 4;
      const f32x4 g2 = *(const f32x4*)(modl_cur + v * 6144 + 5120 + n);
      const uint2 y0 = *(const uint2*)(Y + ((size_t)row * 2) * D + n), y1 = *(const uint2*)(Y + ((size_t)row * 2 + 1) * D + n);
      f32x4 ys;
      ys.x = __uint_as_float(y0.x << 16) + __uint_as_float(y1.x << 16); ys.y = __uint_as_float(y0.x & 0xFFFF0000u) + __uint_as_float(y1.x & 0xFFFF0000u);
      ys.z = __uint_as_float(y0.y << 16) + __uint_as_float(y1.y << 16); ys.w = __uint_as_float(y0.y & 0xFFFF0000u) + __uint_as_float(y1.y & 0xFFFF0000u);
      x[j] = ((const f32x4*)src)[lane + 64 * j] + g2 * ys;
      ss += x[j].x * x[j].x + x[j].y * x[j].y + x[j].z * x[j].z + x[j].w * x[j].w;
    }
    const float rstd = 1.f / sqrtf(wave_sum(ss) * (1.f / D) + EPS);
#pragma unroll
    for (int j = 0; j < 4; ++j) {
      const int n = (lane + 64 * j) * 4;
      const f32x4 g = *(const f32x4*)(gain + n);
      if (final_) { ((f32x4*)src)[lane + 64 * j] = x[j] * rstd * g; }
      else {
        ((f32x4*)src)[lane + 64 * j] = x[j];
        const f32x4 sc = *(const f32x4*)(modl_next + v * 6144 + 1024 + n), sh = *(const f32x4*)(modl_next + v * 6144 + n);
        const f32x4 h = x[j] * rstd * g * (sc + 1.f) + sh;
        uint2 o; o.x = pack2(h.x, h.y); o.y = pack2(h.z, h.w);
        *(uint2*)(hout + (size_t)row * D + n) = o;
      }
    }
  }
}

__global__ __launch_bounds__(512) void k_rowssq(const bf16_t* __restrict__ cq, const bf16_t* __restrict__ ckv, float* __restrict__ rq, float* __restrict__ rkv) {
  const int lane = threadIdx.x & 63, gw = blockIdx.x * 8 + (threadIdx.x >> 6);
  for (int row = gw; row < MROWS; row += gridDim.x * 8) {
    { const unsigned w = *(const unsigned*)(ckv + (size_t)row * 128 + lane * 2); const float a = __uint_as_float(w << 16), b = __uint_as_float(w & 0xFFFF0000u);
      const float ss = wave_sum(a * a + b * b); if (lane == 0) rkv[row] = 1.f / sqrtf(ss * (1.f / 128.f) + EPS); }
    if (row < NLAT) { const uint2 w = *(const uint2*)(cq + (size_t)row * 256 + lane * 4);
      const float a = __uint_as_float(w.x << 16), b = __uint_as_float(w.x & 0xFFFF0000u), c = __uint_as_float(w.y << 16), d = __uint_as_float(w.y & 0xFFFF0000u);
      const float ss = wave_sum(a * a + b * b + c * c + d * d); if (lane == 0) rq[row] = 1.f / sqrtf(ss * (1.f / 256.f) + EPS); }
  }
}
__device__ __forceinline__ float rope_inv(int i) { return exp2f(-(float)i * (13.287712379549449f / 8.f)); }
__global__ __launch_bounds__(256) void k_kr_rope(const float* __restrict__ kr, bf16_t* __restrict__ dk) {
  const int idx = blockIdx.x * 256 + threadIdx.x; if (idx >= MROWS * 32) return;
  const int m = idx >> 5, j = idx & 31; int b, key; row_bkey(m, b, key);
  float val = kr[idx];
  if (m < NLAT) {
    const int t = m & 8191; const int half = j >> 4, jj = j & 15, i = jj & 7;
    const float pos = half ? (float)(t & 63) : (float)(t >> 6);
    const float ang = pos * rope_inv(i); float sn, cs; sincosf(ang, &sn, &cs);
    const float x1 = kr[(size_t)m * 32 + half * 16 + i], x2 = kr[(size_t)m * 32 + half * 16 + 8 + i];
    val = (jj < 8) ? (x1 * cs - x2 * sn) : (x1 * sn + x2 * cs);
  }
  const bf16_t o = f2bf(val);
#pragma unroll
  for (int hh = 0; hh < 8; ++hh) dk[((size_t)(b * 8 + hh) * NKEY + key) * 128 + 64 + j] = o;
}

__global__ __launch_bounds__(64) void k_na_naive(const bf16_t* __restrict__ nq, const bf16_t* __restrict__ nk, const bf16_t* __restrict__ nv, const float* __restrict__ rpb,
                                                 bf16_t* __restrict__ A) {
  const int t = blockIdx.x * 64 + threadIdx.x, hh = blockIdx.y, b = blockIdx.z;
  const int r = t >> 6, c = t & 63;
  int rs = r - 4; rs = rs < 0 ? 0 : (rs > 120 ? 120 : rs);
  int cs = c - 8; cs = cs < 0 ? 0 : (cs > 48 ? 48 : cs);
  float q[64], o[64];
  const bf16_t* qp = nq + ((size_t)(b * 8 + hh) * SEQ + t) * 64;
#pragma unroll
  for (int d = 0; d < 64; ++d) { q[d] = bf2f(qp[d]); o[d] = 0.f; }
  const bf16_t* Kb = nk + (size_t)(b * 8 + hh) * NKEY * 64; const bf16_t* Vb = nv + (size_t)(b * 8 + hh) * NKEY * 64;
  float mx = -3.0e38f, l = 0.f;
  for (int kk = 0; kk < 128 + CT; ++kk) {
    int key; float bias = 0.f;
    if (kk < 128) { const int kr_ = rs + (kk >> 4), kc = cs + (kk & 15); key = CT + kr_ * 64 + kc; bias = rpb[(hh * 15 + (kr_ - r + 7)) * 31 + (kc - c + 15)] * LOG2E; }
    else key = kk - 128;
    const bf16_t* kp = Kb + (size_t)key * 64; float s = bias;
#pragma unroll
    for (int d = 0; d < 64; d += 2) { const unsigned w = *(const unsigned*)(kp + d); s += q[d] * __uint_as_float(w << 16) + q[d + 1] * __uint_as_float(w & 0xFFFF0000u); }
    const float mn = fmaxf(mx, s), alpha = exp2f(mx - mn), p = exp2f(s - mn);
    l = l * alpha + p; mx = mn;
    const bf16_t* vp = Vb + (size_t)key * 64;
#pragma unroll
    for (int d = 0; d < 64; d += 2) { const unsigned w = *(const unsigned*)(vp + d); o[d] = o[d] * alpha + p * __uint_as_float(w << 16); o[d + 1] = o[d + 1] * alpha + p * __uint_as_float(w & 0xFFFF0000u); }
  }
  const float il = 1.f / l;
  bf16_t* op = A + (size_t)(b * SEQ + t) * D + hh * 64;
#pragma unroll
  for (int d = 0; d < 64; d += 2) *(unsigned*)(op + d) = pack2(o[d] * il, o[d + 1] * il);
}
__global__ __launch_bounds__(64) void k_mla_naive(const bf16_t* __restrict__ dq, const bf16_t* __restrict__ dk, const bf16_t* __restrict__ dv, bf16_t* __restrict__ A) {
  const int t = blockIdx.x * 64 + threadIdx.x, hh = blockIdx.y, b = blockIdx.z;
  float q[96], o[64];
  const bf16_t* qp = dq + ((size_t)(b * 8 + hh) * SEQ + t) * 96;
#pragma unroll
  for (int d = 0; d < 96; ++d) q[d] = bf2f(qp[d]);
#pragma unroll
  for (int half = 0; half < 2; ++half) {
    const float pos = half ? (float)(t & 63) : (float)(t >> 6);
#pragma unroll
    for (int i = 0; i < 8; ++i) { float sn, cs; sincosf(pos * rope_inv(i), &sn, &cs);
      const float x1 = q[64 + half * 16 + i], x2 = q[64 + half * 16 + 8 + i];
      q[64 + half * 16 + i] = x1 * cs - x2 * sn; q[64 + half * 16 + 8 + i] = x1 * sn + x2 * cs; }
  }
#pragma unroll
  for (int d = 0; d < 64; ++d) o[d] = 0.f;
  const bf16_t* Kb = dk + (size_t)(b * 8 + hh) * NKEY * 128; const bf16_t* Vb = dv + (size_t)(b * 8 + hh) * NKEY * 64;
  float mx = -3.0e38f, l = 0.f;
  for (int k0 = 0; k0 < NKEY; k0 += 8) {
    float s[8]; float bm = -3.0e38f;
#pragma unroll
    for (int j = 0; j < 8; ++j) { const bf16_t* kp = Kb + (size_t)(k0 + j) * 128; float a = 0.f;
#pragma unroll
      for (int d = 0; d < 96; d += 2) { const unsigned w = *(const unsigned*)(kp + d); a += q[d] * __uint_as_float(w << 16) + q[d + 1] * __uint_as_float(w & 0xFFFF0000u); }
      s[j] = a; bm = fmaxf(bm, a); }
    const float mn = fmaxf(mx, bm), alpha = exp2f(mx - mn); mx = mn; l *= alpha;
#pragma unroll
    for (int d = 0; d < 64; ++d) o[d] *= alpha;
#pragma unroll
    for (int j = 0; j < 8; ++j) { const float p = exp2f(s[j] - mn); l += p; const bf16_t* vp = Vb + (size_t)(k0 + j) * 64;
#pragma unroll
      for (int d = 0; d < 64; d += 2) { const unsigned w = *(const unsigned*)(vp + d); o[d] += p * __uint_as_float(w << 16); o[d + 1] += p * __uint_as_float(w & 0xFFFF0000u); } }
  }
  const float il = 1.f / l;
  bf16_t* op = A + (size_t)(b * SEQ + t) * D + 512 + hh * 64;
#pragma unroll
  for (int d = 0; d < 64; d += 2) *(unsigned*)(op + d) = pack2(o[d] * il, o[d + 1] * il);
}

typedef short bf16x8 __attribute__((ext_vector_type(8)));
struct MP {
  const float* in[29];
  float* out; char* ws;
  int ph_lo, ph_hi;
};
constexpr int LDS_BYTES = 131072;
constexpr int CNT_OFF = 16384;
typedef short s16x4 __attribute__((ext_vector_type(4)));
typedef float f32x16 __attribute__((ext_vector_type(16)));
typedef unsigned u32x4 __attribute__((ext_vector_type(4)));
constexpr float ATT_THR = 11.5f;
constexpr int NCHUNK = MROWS / 64;

struct MK {
  int wv;
  __device__ __forceinline__ int tidx() const { int l = (int)__lane_id(); asm volatile("" : "+v"(l)); return (wv << 6) | l; }
#define MFMA16(a, b, c) __builtin_amdgcn_mfma_f32_16x16x32_bf16(a, b, c, 0, 0, 0)


template <int MI, class Epi>
__device__ __forceinline__ void gemm_tile(const bf16_t* __restrict__ A, int lda, const int* __restrict__ gather, int gshift, int Mvalid,
                                          const bf16_t* __restrict__ Bt, int ldb, int K, int m0, int n0, char* lds, const Epi& epi) {
  constexpr int BM = 64 * MI, ABYTES = BM * 128, STAGE = ABYTES + 128 * 128;
  const int t = tidx(), lane = t & 63, w = t >> 6, wm = w >> 1, wn = w & 1, l15 = lane & 15, lq = lane >> 4;
  const int c = t & 7, r = t >> 3;
  const bf16_t* ap[MI];
#pragma unroll
  for (int i = 0; i < MI; ++i) { int m = m0 + r + 64 * i; m = m < Mvalid ? m : Mvalid - 1; const int row = gather ? (gather[m] >> gshift) : m; ap[i] = A + (size_t)row * lda + c * 8; }
  const bf16_t* bp0 = Bt + (size_t)(n0 + r) * ldb + c * 8; const bf16_t* bp1 = bp0 + (size_t)64 * ldb;
  const int wofs = r * 128 + ((c ^ ((r >> 1) & 7)) << 4);
  const int sw = (l15 >> 1) & 7, x0 = (lq ^ sw) << 4, x1 = x0 ^ 64;
  const int arow = (wm * 16 * MI + l15) * 128, brow = ABYTES + (wn * 64 + l15) * 128;
  f32x4 acc[MI][4];
#pragma unroll
  for (int i = 0; i < MI; ++i)
#pragma unroll
    for (int j = 0; j < 4; ++j) acc[i][j] = (f32x4){0.f, 0.f, 0.f, 0.f};
  uint4 ra[MI], rb0, rb1;
  const int KT = K >> 6;
#pragma unroll
  for (int i = 0; i < MI; ++i) ra[i] = *(const uint4*)(ap[i]);
  rb0 = *(const uint4*)bp0; rb1 = *(const uint4*)bp1;
#pragma unroll
  for (int i = 0; i < MI; ++i) *(uint4*)(lds + wofs + i * 8192) = ra[i];
  *(uint4*)(lds + ABYTES + wofs) = rb0; *(uint4*)(lds + ABYTES + wofs + 8192) = rb1;
  __syncthreads();
  for (int kt = 0; kt < KT; ++kt) {
    char* cur = lds + (kt & 1) * STAGE; char* nxt = lds + ((kt + 1) & 1) * STAGE;
    const bool more = kt + 1 < KT;
    if (more) {
      const int k0 = (kt + 1) << 6;
#pragma unroll
      for (int i = 0; i < MI; ++i) ra[i] = *(const uint4*)(ap[i] + k0);
      rb0 = *(const uint4*)(bp0 + k0); rb1 = *(const uint4*)(bp1 + k0);
    }
#pragma unroll
    for (int ks = 0; ks < 2; ++ks) {
      const int xo = ks ? x1 : x0;
      bf16x8 af[MI], bfv[4];
#pragma unroll
      for (int i = 0; i < MI; ++i) af[i] = *(const bf16x8*)(cur + arow + i * 2048 + xo);
#pragma unroll
      for (int j = 0; j < 4; ++j) bfv[j] = *(const bf16x8*)(cur + brow + j * 2048 + xo);
#pragma unroll
      for (int i = 0; i < MI; ++i)
#pragma unroll
        for (int j = 0; j < 4; ++j) acc[i][j] = MFMA16(bfv[j], af[i], acc[i][j]);
    }
    if (more) {
#pragma unroll
      for (int i = 0; i < MI; ++i) *(uint4*)(nxt + wofs + i * 8192) = ra[i];
      *(uint4*)(nxt + ABYTES + wofs) = rb0; *(uint4*)(nxt + ABYTES + wofs + 8192) = rb1;
    }
    __syncthreads();
  }
  epi.tile(acc, m0 + wm * 16 * MI + l15, n0 + wn * 64 + lq * 4, Mvalid);
}
template <class E> struct EpiEach {
  E e;
  template <int MI> __device__ __forceinline__ void tile(const f32x4 (&acc)[MI][4], int mb, int nb, int Mvalid) const {
#pragma unroll
    for (int i = 0; i < MI; ++i) { const int m = mb + i * 16; if (m < Mvalid) {
#pragma unroll
      for (int j = 0; j < 4; ++j) e.apply(m, nb + j * 16, acc[i][j]); } }
  }
};
template <int MI, class E>
__device__ __forceinline__ void gemm_phase(const bf16_t* A, int lda, const bf16_t* Bt, int ldb, int M, int N, int K, const E& e, char* lds) {
  constexpr int BM = 64 * MI; const int ntm = (M + BM - 1) / BM, ntn = N >> 7;
  EpiEach<E> ee; ee.e = e;
  for (int tile = blockIdx.x; tile < ntm * ntn; tile += gridDim.x) { const int mt = tile / ntn, nt = tile - mt * ntn; gemm_tile<MI>(A, lda, nullptr, 0, M, Bt, ldb, K, mt * BM, nt * 128, lds, ee); }
}

template <int K>
static __device__ __forceinline__ float row_rstd4(const bf16_t* rowp, int lq) {
  constexpr int PER = K / 4; float ss = 0.f;
#pragma unroll
  for (int i = 0; i < PER / 8; ++i) { const uint4 v = *(const uint4*)(rowp + lq * PER + i * 8); const unsigned wv[4] = {v.x, v.y, v.z, v.w};
#pragma unroll
    for (int q = 0; q < 4; ++q) { const float a = __uint_as_float(wv[q] << 16), b = __uint_as_float(wv[q] & 0xFFFF0000u); ss += a * a + b * b; } }
  ss += __shfl_xor(ss, 16); ss += __shfl_xor(ss, 32);
  return 1.f / sqrtf(ss * (1.f / K) + EPS);
}
struct EpiMlaQ2 {
  bf16_t* dq; const bf16_t* cq;
  template <int MI> __device__ __forceinline__ void tile(const f32x4 (&acc)[MI][4], int mb, int nb, int Mvalid) const {
#pragma unroll
    for (int i = 0; i < MI; ++i) { const int m = mb + i * 16; const float rs = row_rstd4<256>(cq + (size_t)m * 256, (nb >> 2) & 3) * MLA_QSCALE;
#pragma unroll
      for (int j = 0; j < 4; ++j) { const int n = nb + j * 16; const int hh = n / 96, off = n - hh * 96; const f32x4 v = acc[i][j] * rs;
        uint2 wv; wv.x = pack2(v.x, v.y); wv.y = pack2(v.z, v.w);
        *(uint2*)(dq + (((size_t)((m >> 13) * 8 + hh) * SEQ + (m & 8191)) * 96 + off)) = wv; } }
  }
};
struct EpiMlaKV2 {
  bf16_t *dk, *dv; const bf16_t* ckv;
  template <int MI> __device__ __forceinline__ void tile(const f32x4 (&acc)[MI][4], int mb, int nb, int Mvalid) const {
#pragma unroll
    for (int i = 0; i < MI; ++i) { const int m = mb + i * 16; const float rs = row_rstd4<128>(ckv + (size_t)m * 128, (nb >> 2) & 3);
      int b, key; row_bkey(m, b, key);
#pragma unroll
      for (int j = 0; j < 4; ++j) { const int n = nb + j * 16; const int hh = n >> 7, off = n & 127; const f32x4 v = acc[i][j] * rs;
        uint2 wv; wv.x = pack2(v.x, v.y); wv.y = pack2(v.z, v.w);
        if (off < 64) *(uint2*)(dk + (((size_t)(b * 8 + hh) * NKEY + key) * 128 + off)) = wv;
        else *(uint2*)(dv + (((size_t)(b * 8 + hh) * NKEY + key) * 64 + (off - 64))) = wv; } }
  }
};
struct EpiMoe1 {
  bf16_t* amoe; const int* list; const float* rw; int off_e, nt;
  template <int MI> __device__ __forceinline__ void tile(const f32x4 (&acc)[MI][4], int mb, int nb, int Mvalid) const {
    const int wn = (nb >> 6) & 1, lq = (nb >> 2) & 3;
#pragma unroll
    for (int i = 0; i < MI; ++i) { const int m = mb + i * 16; if (m < Mvalid) { const float wgt = rw[list[m]];
#pragma unroll
      for (int i2 = 0; i2 < 2; ++i2) { const f32x4 g = acc[i][i2], u = acc[i][2 + i2];
        const float a0 = siluf_(g.x) * u.x * wgt, a1 = siluf_(g.y) * u.y * wgt, a2 = siluf_(g.z) * u.z * wgt, a3 = siluf_(g.w) * u.w * wgt;
        uint2 wv; wv.x = pack2(a0, a1); wv.y = pack2(a2, a3);
        *(uint2*)(amoe + (size_t)(off_e + m) * 256 + nt * 64 + wn * 32 + i2 * 16 + lq * 4) = wv; } } }
  }
};
struct EpiMoe2 {
  bf16_t* Y; const int* list; int m_base;
  __device__ __forceinline__ void apply(int m, int n, f32x4 v) const {
    uint2 wv; wv.x = pack2(v.x, v.y); wv.y = pack2(v.z, v.w);
    *(uint2*)(Y + (size_t)list[m - m_base] * D + n) = wv;
  }
};

__device__ __forceinline__ void ph_ada(const MP& p, char* lds) {
  float* sv = (float*)lds;
  float* red = sv + 3 * 1024;
  const float* c = p.in[1]; const float* cctx = p.in[3]; float* mods = (float*)(p.ws + WS_MODS);
  const int j = tidx() & 63, kg = tidx() >> 6;
  for (int i = tidx(); i < 1024; i += 512) { sv[i] = siluf_(c[i]); sv[1024 + i] = siluf_(c[1024 + i]); sv[2048 + i] = siluf_(cctx[i]); }
  __syncthreads();
  for (int item = blockIdx.x; item < 192; item += gridDim.x) {
    const int l = item / 96, n0 = (item % 96) * 64;
    const float* W = p.in[4] + (size_t)l * 1024 * 6144 + n0 + j;
    float a0 = 0.f, a1 = 0.f, a2 = 0.f;
#pragma unroll 8
    for (int k = kg * 128; k < kg * 128 + 128; ++k) { const float wv = W[(size_t)k * 6144]; a0 += sv[k] * wv; a1 += sv[1024 + k] * wv; a2 += sv[2048 + k] * wv; }
    red[(kg * 3 + 0) * 64 + j] = a0; red[(kg * 3 + 1) * 64 + j] = a1; red[(kg * 3 + 2) * 64 + j] = a2;
    __syncthreads();
    if (tidx() < 192) { const int v = tidx() >> 6, jj = tidx() & 63; float s = 0.f;
      for (int g = 0; g < 8; ++g) s += red[(g * 3 + v) * 64 + jj];
      mods[(size_t)(l * 3 + v) * 6144 + n0 + jj] = s + p.in[5][l * 6144 + n0 + jj]; }
    __syncthreads();
  }
  if (blockIdx.x == gridDim.x - 1) { float* lb = (float*)(p.ws + WS_LB);
    for (int i = tidx(); i < 1024; i += 512) { const int d = i >> 9, cc = i & 511; const float l0 = p.in[10][(d * 2) * 512 + cc], l1 = p.in[10][(d * 2 + 1) * 512 + cc]; lb[i] = 1.f / (1.f + expf(l1 - l0)); } }
}
__device__ __forceinline__ void conv_tiles(const float* src, bf16_t* dst, const float* kscale, int K, int N, int Npad, int mode, int batch, size_t sbs, size_t dbs, char* lds) {
  float* tile = (float*)lds;
  const int ntn = (Npad + 63) >> 6, ntk = K >> 6, per = ntn * ntk, tx = tidx() & 63, ty = tidx() >> 6;
  for (int item = blockIdx.x; item < per * batch; item += gridDim.x) {
    const int bz = item / per, rem = item - bz * per, kb = rem / ntn, nb = rem - kb * ntn, n0 = nb * 64, k0 = kb * 64;
    const float* s = src + bz * sbs; bf16_t* d = dst + bz * dbs;
#pragma unroll
    for (int i = 0; i < 8; ++i) { const int k = k0 + ty + 8 * i, n = n0 + tx; float v = 0.f;
      if (n < N) { v = s[(size_t)k * N + n]; if (kscale) v *= kscale[k]; }
      tile[(ty + 8 * i) * 65 + tx] = v; }
    __syncthreads();
#pragma unroll
    for (int i = 0; i < 8; ++i) { const int nl = ty + 8 * i, n = n0 + nl;
      if (n < Npad) { int row = n; if (mode == 1) row = moe_gu_row(0, n); else if (mode == 2) row = moe_gu_row(1, n);
        d[(size_t)row * K + k0 + tx] = f2bf(tile[tx * 65 + nl]); } }
    __syncthreads();
  }
}
__device__ __forceinline__ void ph_conv_small(const MP& p, char* lds) {
  char* ws = p.ws;
  conv_tiles(p.in[8], (bf16_t*)(ws + WS_WT_ABIN), nullptr, 1024, 3072, 3072, 0, 1, 0, 0, lds);
  conv_tiles(p.in[9], (bf16_t*)(ws + WS_WT_ABOUT), nullptr, 1024, 1024, 1024, 0, 1, 0, 0, lds);
  conv_tiles(p.in[14], (bf16_t*)(ws + WS_WT_CDIN), nullptr, 1024, 1952, 2048, 0, 1, 0, 0, lds);
  conv_tiles(p.in[15], (bf16_t*)(ws + WS_WT_CDOUT), nullptr, 1024, 1024, 1024, 0, 1, 0, 0, lds);
  conv_tiles(p.in[18], (bf16_t*)(ws + WS_WT_UQ), p.in[17], 256, 768, 768, 0, 1, 0, 0, lds);
  conv_tiles(p.in[20], (bf16_t*)(ws + WS_WT_UKV), p.in[19], 128, 1024, 1024, 0, 1, 0, 0, lds);
  conv_tiles(p.in[12], (bf16_t*)(ws + WS_WT_POOL), nullptr, 128, 128, 128, 0, 4, (size_t)128 * 128, (size_t)128 * 128, lds);
}
__device__ __forceinline__ void ph_conv_moe(const MP& p, int layer, char* lds) {
  bf16_t* wgu = (bf16_t*)(p.ws + WS_WMOE); bf16_t* wd = wgu + (size_t)32 * 512 * 1024;
  const size_t lo = (size_t)layer * 32 * 1024 * 256;
  conv_tiles(p.in[25] + lo, wgu, nullptr, 1024, 256, 256, 1, 32, (size_t)1024 * 256, (size_t)512 * 1024, lds);
  conv_tiles(p.in[26] + lo, wgu, nullptr, 1024, 256, 256, 2, 32, (size_t)1024 * 256, (size_t)512 * 1024, lds);
  conv_tiles(p.in[27] + lo, wd, nullptr, 256, 1024, 1024, 0, 32, (size_t)256 * 1024, (size_t)1024 * 256, lds);
}
__device__ __forceinline__ void ph_norm_mod(const float* lat, const float* ctxr, const float* gain, const float* modl, int sh_off, int sc_off, bf16_t* out, int nrows) {
  const int lane = tidx() & 63, gw = blockIdx.x * 8 + (tidx() >> 6);
  for (int row = gw; row < nrows; row += gridDim.x * 8) {
    const float* src = row < NLAT ? lat + (size_t)row * D : ctxr + (size_t)(row - NLAT) * D;
    const float* mv = modl + row_vec(row) * 6144;
    f32x4 x[4]; float ss = 0.f;
#pragma unroll
    for (int j = 0; j < 4; ++j) { x[j] = ((const f32x4*)src)[lane + 64 * j]; ss += x[j].x * x[j].x + x[j].y * x[j].y + x[j].z * x[j].z + x[j].w * x[j].w; }
    const float rstd = 1.f / sqrtf(wave_sum(ss) * (1.f / D) + EPS);
#pragma unroll
    for (int j = 0; j < 4; ++j) {
      const int n = (lane + 64 * j) * 4;
      const f32x4 g = *(const f32x4*)(gain + n), sc = *(const f32x4*)(mv + sc_off + n), sh = *(const f32x4*)(mv + sh_off + n);
      const f32x4 h = x[j] * rstd * g * (sc + 1.f) + sh;
      uint2 o; o.x = pack2(h.x, h.y); o.y = pack2(h.z, h.w);
      *(uint2*)(out + (size_t)row * D + n) = o;
    }
  }
}
__device__ __forceinline__ void ph_pool_prep(const bf16_t* Up, bf16_t* pd) {
  const int c = tidx();
  for (int row = blockIdx.x; row < MROWS; row += gridDim.x) {
    int base, t, n; if (row < NLAT) { base = row & ~8191; t = row & 8191; n = SEQ; } else { const int mm = row - NLAT; base = NLAT + (mm & ~255); t = mm & 255; n = CT; }
    const int gi = c >> 7, win = 2 << gi; int lo = t - win / 2, hi = t + win - win / 2; lo = lo < 0 ? 0 : lo; hi = hi > n ? n : hi;
    float s = 0.f; for (int r = lo; r < hi; ++r) s += bf2f(Up[(size_t)(base + r) * 512 + c]);
    pd[(size_t)row * 512 + c] = f2bf(s / (float)(hi - lo) - bf2f(Up[(size_t)row * 512 + c]));
  }
}
__device__ __forceinline__ void ph_router(const MP& p, int layer, int nrows, char* lds) {
  float* hs = (float*)lds;
  const float* lat = p.out; const float* ctxr = (const float*)(p.ws + WS_XC); const float* gain = p.in[7] + layer * 1024;
  const float* modl = (const float*)(p.ws + WS_MODS) + layer * 3 * 6144;
  const float* wrg = p.in[21] + layer * 1024 * 4; const float* brg = p.in[22] + layer * 4; const float* wre = p.in[23] + layer * 1024 * 32; const float* bre = p.in[24] + layer * 32;
  bf16_t* out = (bf16_t*)(p.ws + WS_H); float* rw = (float*)(p.ws + WS_ROUTE_W);
  int* cnt = (int*)(p.ws + WS_CTL + CNT_OFF) + layer * 32; int* list = (int*)(p.ws + WS_LIST);
  const int lane = tidx() & 63, wv = tidx() >> 6, gw = blockIdx.x * 8 + wv;
  const float* wp = lane < 4 ? wrg + lane : wre + ((lane - 4) & 31); const int wst = lane < 4 ? 4 : 32;
  const float bias = lane < 4 ? brg[lane] : bre[(lane - 4) & 31];
  for (int row = gw; row < nrows; row += gridDim.x * 8) {
    const float* src = row < NLAT ? lat + (size_t)row * D : ctxr + (size_t)(row - NLAT) * D;
    const float* mv = modl + row_vec(row) * 6144;
    f32x4 x[4]; float ss = 0.f;
#pragma unroll
    for (int j = 0; j < 4; ++j) { x[j] = ((const f32x4*)src)[lane + 64 * j]; ss += x[j].x * x[j].x + x[j].y * x[j].y + x[j].z * x[j].z + x[j].w * x[j].w; }
    const float rstd = 1.f / sqrtf(wave_sum(ss) * (1.f / D) + EPS);
#pragma unroll
    for (int j = 0; j < 4; ++j) {
      const int n = (lane + 64 * j) * 4;
      const f32x4 g = *(const f32x4*)(gain + n), sc = *(const f32x4*)(mv + 4096 + n), sh = *(const f32x4*)(mv + 3072 + n);
      const f32x4 h = x[j] * rstd * g * (sc + 1.f) + sh;
      uint2 o; o.x = pack2(h.x, h.y); o.y = pack2(h.z, h.w);
      *(uint2*)(out + (size_t)row * D + n) = o;
      *(f32x4*)&hs[wv * 1024 + n] = h;
    }
    __builtin_amdgcn_wave_barrier();
    float acc = 0.f;
#pragma unroll 8
    for (int k = 0; k < 1024; ++k) acc += hs[wv * 1024 + k] * wp[(size_t)k * wst];
    acc += bias;
    __builtin_amdgcn_wave_barrier();
    float gl[4];
#pragma unroll
    for (int i = 0; i < 4; ++i) gl[i] = __shfl(acc, i);
    int gi = 0; float gm = gl[0];
#pragma unroll
    for (int i = 1; i < 4; ++i) if (gl[i] > gm) { gm = gl[i]; gi = i; }
    float gs = 0.f;
#pragma unroll
    for (int i = 0; i < 4; ++i) gs += expf(gl[i] - gm);
    const float gp = 1.f / gs;
    float el[8];
#pragma unroll
    for (int i = 0; i < 8; ++i) el[i] = __shfl(acc, 4 + gi * 8 + i);
    int e1 = 0; float m1 = el[0];
#pragma unroll
    for (int i = 1; i < 8; ++i) if (el[i] > m1) { m1 = el[i]; e1 = i; }
    int e2 = 0; float m2 = -3.0e38f;
#pragma unroll
    for (int i = 0; i < 8; ++i) if (i != e1 && el[i] > m2) { m2 = el[i]; e2 = i; }
    const float w1 = 1.f / (1.f + expf(m2 - m1)), w2 = 1.f - w1;
    if (lane < 2) {
      const int e = gi * 8 + (lane ? e2 : e1);
      rw[row * 2 + lane] = gp * (lane ? w2 : w1);
      const int pos = atomicAdd(&cnt[e], 1);
      list[(size_t)e * MROWS + pos] = row * 2 + lane;
    }
  }
}
template <int BM>
__device__ __forceinline__ int moe_tables(const MP& p, int layer, int ntn, int* tb) {
  const int* cnt = (const int*)(p.ws + WS_CTL + CNT_OFF) + layer * 32;
  __syncthreads();
  if (tidx() == 0) { int off = 0, ts = 0;
    for (int e = 0; e < 32; ++e) { const int c = __hip_atomic_load(&cnt[e], __ATOMIC_RELAXED, __HIP_MEMORY_SCOPE_AGENT); tb[e] = c; tb[32 + e] = off; tb[64 + e] = ts; off += c; ts += ((c + BM - 1) / BM) * ntn; }
    tb[96] = ts; }
  __syncthreads();
  return tb[96];
}
template <int MI>
__device__ __forceinline__ void ph_moe1(const MP& p, int layer, char* lds) {
  constexpr int BM = 64 * MI; int* tb = (int*)(lds + LDS_BYTES - 1024);
  const int total = moe_tables<BM>(p, layer, 4, tb);
  const bf16_t* H = (const bf16_t*)(p.ws + WS_H); const bf16_t* wgu = (const bf16_t*)(p.ws + WS_WMOE);
  for (int tile = blockIdx.x; tile < total; tile += gridDim.x) {
    int e = 0;
#pragma unroll 1
    for (int q = 1; q < 32; ++q) if (tb[64 + q] <= tile) e = q;
    const int lt = tile - tb[64 + e], mt = lt >> 2, nt = lt & 3;
    EpiMoe1 ep; ep.amoe = (bf16_t*)(p.ws + WS_AMOE); ep.list = (const int*)(p.ws + WS_LIST) + (size_t)e * MROWS; ep.rw = (const float*)(p.ws + WS_ROUTE_W); ep.off_e = tb[32 + e]; ep.nt = nt;
    gemm_tile<MI>(H, D, ep.list, 1, tb[e], wgu + (size_t)e * 512 * 1024, 1024, 1024, mt * BM, nt * 128, lds, ep);
  }
}
template <int MI>
__device__ __forceinline__ void ph_moe2(const MP& p, int layer, char* lds) {
  constexpr int BM = 64 * MI; int* tb = (int*)(lds + LDS_BYTES - 1024);
  const int total = moe_tables<BM>(p, layer, 8, tb);
  const bf16_t* wd = (const bf16_t*)(p.ws + WS_WMOE) + (size_t)32 * 512 * 1024;
  for (int tile = blockIdx.x; tile < total; tile += gridDim.x) {
    int e = 0;
#pragma unroll 1
    for (int q = 1; q < 32; ++q) if (tb[64 + q] <= tile) e = q;
    const int lt = tile - tb[64 + e], mt = lt >> 3, nt = lt & 7;
    EpiEach<EpiMoe2> ep; ep.e.Y = (bf16_t*)(p.ws + WS_YBUF); ep.e.list = (const int*)(p.ws + WS_LIST) + (size_t)e * MROWS; ep.e.m_base = 0;
    const bf16_t* A = (const bf16_t*)(p.ws + WS_AMOE) + (size_t)tb[32 + e] * 256;
    gemm_tile<MI>(A, 256, nullptr, 0, tb[e], wd + (size_t)e * 1024 * 256, 256, 256, mt * BM, nt * 128, lds, ep);
  }
}
__device__ __forceinline__ void ph_combine(const MP& p, int layer, int nrows, int final_) {
  float* lat = p.out; float* ctxr = (float*)(p.ws + WS_XC); const bf16_t* Y = (const bf16_t*)(p.ws + WS_YBUF);
  const float* modl_cur = (const float*)(p.ws + WS_MODS) + layer * 3 * 6144; const float* modl_next = (const float*)(p.ws + WS_MODS) + 3 * 6144;
  const float* gain = final_ ? p.in[28] : p.in[6] + 1024; bf16_t* hout = (bf16_t*)(p.ws + WS_H);
  const int lane = tidx() & 63, gw = blockIdx.x * 8 + (tidx() >> 6);
  for (int row = gw; row < nrows; row += gridDim.x * 8) {
    float* src = row < NLAT ? lat + (size_t)row * D : ctxr + (size_t)(row - NLAT) * D;
    const int v = row_vec(row);
    f32x4 x[4]; float ss = 0.f;
#pragma unroll
    for (int j = 0; j < 4; ++j) {
      const int n = (lane + 64 * j) * 4;
      const f32x4 g2 = *(const f32x4*)(modl_cur + v * 6144 + 5120 + n);
      const uint2 y0 = *(const uint2*)(Y + ((size_t)row * 2) * D + n), y1 = *(const uint2*)(Y + ((size_t)row * 2 + 1) * D + n);
      f32x4 ys;
      ys.x = __uint_as_float(y0.x << 16) + __uint_as_float(y1.x << 16); ys.y = __uint_as_float(y0.x & 0xFFFF0000u) + __uint_as_float(y1.x & 0xFFFF0000u);
      ys.z = __uint_as_float(y0.y << 16) + __uint_as_float(y1.y << 16); ys.w = __uint_as_float(y0.y & 0xFFFF0000u) + __uint_as_float(y1.y & 0xFFFF0000u);
      x[j] = ((const f32x4*)src)[lane + 64 * j] + g2 * ys;
      ss += x[j].x * x[j].x + x[j].y * x[j].y + x[j].z * x[j].z + x[j].w * x[j].w;
    }
    const float rstd = 1.f / sqrtf(wave_sum(ss) * (1.f / D) + EPS);
#pragma unroll
    for (int j = 0; j < 4; ++j) {
      const int n = (lane + 64 * j) * 4;
      const f32x4 g = *(const f32x4*)(gain + n);
      if (final_) { ((f32x4*)src)[lane + 64 * j] = x[j] * rstd * g; }
      else {
        ((f32x4*)src)[lane + 64 * j] = x[j];
        const f32x4 sc = *(const f32x4*)(modl_next + v * 6144 + 1024 + n), sh = *(const f32x4*)(modl_next + v * 6144 + n);
        const f32x4 h = x[j] * rstd * g * (sc + 1.f) + sh;
        uint2 o; o.x = pack2(h.x, h.y); o.y = pack2(h.z, h.w);
        *(uint2*)(hout + (size_t)row * D + n) = o;
      }
    }
  }
}
__device__ __forceinline__ void ph_kr_rope(const float* kr, bf16_t* dk) {
  for (int idx = blockIdx.x * 512 + tidx(); idx < MROWS * 32; idx += gridDim.x * 512) {
    const int m = idx >> 5, j = idx & 31; int b, key; row_bkey(m, b, key);
    float val = kr[idx];
    if (m < NLAT) {
      const int t = m & 8191; const int half = j >> 4, jj = j & 15, i = jj & 7;
      const float pos = half ? (float)(t & 63) : (float)(t >> 6);
      float sn, cs; sincosf(pos * rope_inv(i), &sn, &cs);
      const float x1 = kr[(size_t)m * 32 + half * 16 + i], x2 = kr[(size_t)m * 32 + half * 16 + 8 + i];
      val = (jj < 8) ? (x1 * cs - x2 * sn) : (x1 * sn + x2 * cs);
    }
    const bf16_t o = f2bf(val);
#pragma unroll
    for (int hh = 0; hh < 8; ++hh) dk[((size_t)(b * 8 + hh) * NKEY + key) * 128 + 64 + j] = o;
  }
}

#define MFMA32(a, b, c) __builtin_amdgcn_mfma_f32_32x32x16_bf16(a, b, c, 0, 0, 0)
#define KSWZ(row, colB) ((row) * 256 + ((colB) ^ (((row) & 7) << 4)))
#define SBAR() __builtin_amdgcn_sched_barrier(0)
__device__ __forceinline__ int crow(int r, int hi) { return (r & 3) + 8 * (r >> 2) + 4 * hi; }
__device__ __forceinline__ unsigned cvtpk(float lo, float hi) { unsigned r; asm volatile("v_cvt_pk_bf16_f32 %0, %1, %2" : "=v"(r) : "v"(lo), "v"(hi)); return r; }

__device__ __forceinline__ void att_partialSM(f32x16& p0, f32x16& p1, float& m_reg, float& mn, float& alpha) {
  float pmax = p0[0];
#pragma unroll
  for (int r = 1; r < 16; ++r) pmax = fmaxf(pmax, p0[r]);
#pragma unroll
  for (int r = 0; r < 16; ++r) pmax = fmaxf(pmax, p1[r]);
  { auto rr = __builtin_amdgcn_permlane32_swap(__float_as_uint(pmax), __float_as_uint(pmax), false, false);
    pmax = fmaxf(__uint_as_float(rr[0]), __uint_as_float(rr[1])); }
  if (__builtin_expect(__all(pmax - m_reg <= ATT_THR), 1)) { mn = m_reg; alpha = 1.f; }
  else { mn = fmaxf(m_reg, pmax); alpha = __builtin_amdgcn_exp2f(m_reg - mn); m_reg = mn; }
#pragma unroll
  for (int r = 0; r < 16; ++r) p0[r] = __builtin_amdgcn_exp2f(p0[r] - mn);
#pragma unroll
  for (int r = 0; r < 16; ++r) p1[r] = p1[r] - mn;
}
__device__ __forceinline__ void att_finishSM(f32x16& p0, f32x16& p1, float alpha, float& l_reg, bf16x8& pa0, bf16x8& pa1, bf16x8& pa2, bf16x8& pa3) {
#pragma unroll
  for (int r = 0; r < 16; ++r) p1[r] = __builtin_amdgcn_exp2f(p1[r]);
  float ps = 0.f;
#pragma unroll
  for (int r = 0; r < 16; ++r) ps += p0[r];
#pragma unroll
  for (int r = 0; r < 16; ++r) ps += p1[r];
  { auto rr = __builtin_amdgcn_permlane32_swap(__float_as_uint(ps), __float_as_uint(ps), false, false);
    ps = __uint_as_float(rr[0]) + __uint_as_float(rr[1]); }
  l_reg = l_reg * alpha + ps;
#define PK4(P, BASE, OUT) do { unsigned a0 = cvtpk(P[BASE + 0], P[BASE + 1]), a1 = cvtpk(P[BASE + 2], P[BASE + 3]);   \
    unsigned b0 = cvtpk(P[BASE + 4], P[BASE + 5]), b1 = cvtpk(P[BASE + 6], P[BASE + 7]);                              \
    auto r0 = __builtin_amdgcn_permlane32_swap(a0, b0, false, false); auto r1 = __builtin_amdgcn_permlane32_swap(a1, b1, false, false); \
    u32x4 w = {r0[0], r1[0], r0[1], r1[1]}; OUT = *reinterpret_cast<bf16x8*>(&w); } while (0)
  PK4(p0, 0, pa0); PK4(p0, 8, pa1); PK4(p1, 0, pa2); PK4(p1, 8, pa3);
}
template <int ND0>
__device__ __forceinline__ void att_qkt(f32x16& p0, f32x16& p1, const char* Ks, const bf16x8* qr, int r32, int hi) {
#pragma unroll
  for (int r = 0; r < 16; ++r) { p0[r] = 0.f; p1[r] = 0.f; }
#pragma unroll
  for (int d0 = 0; d0 < ND0; ++d0) { const int cb = (d0 * 16 + hi * 8) * 2;
    const bf16x8 b0 = *reinterpret_cast<const bf16x8*>(Ks + KSWZ(r32, cb));
    const bf16x8 b1 = *reinterpret_cast<const bf16x8*>(Ks + KSWZ(32 + r32, cb));
    p0 = MFMA32(b0, qr[d0], p0);
    p1 = MFMA32(b1, qr[d0], p1); }
}
__device__ __forceinline__ int v_st64(int k, int c) { const int kk = (k & ~0xC) | ((k & 4) << 1) | ((k & 8) >> 1); return ((kk >> 3) * 2 + (c >> 5)) * 512 + ((kk & 7) * 32 + (c & 31)) * 2; }
__device__ __forceinline__ int v_rd_base(int lane) { return ((lane & 3) << 3) | (((lane >> 2) & 3) << 6) | (((lane >> 4) & 1) << 5) | (((lane >> 5) & 1) << 8); }
static constexpr int v_rd_off64(int d0, int ks, int half) { return d0 * 512 + ks * 2048 + half * 1024; }
template <int OFF> __device__ __forceinline__ s16x4 tr_read(int vb) {
  s16x4 r; asm volatile("ds_read_b64_tr_b16 %0, %1 offset:%2" : "=&v"(r) : "v"(vb), "i"(OFF) : "memory"); return r;
}
template <int D0> __device__ __forceinline__ void pv_one64(f32x16& od, int vb, bf16x8 pa0, bf16x8 pa1, bf16x8 pa2, bf16x8 pa3) {
  const s16x4 l0 = tr_read<v_rd_off64(D0, 0, 0)>(vb), h0 = tr_read<v_rd_off64(D0, 0, 1)>(vb), l1 = tr_read<v_rd_off64(D0, 1, 0)>(vb), h1 = tr_read<v_rd_off64(D0, 1, 1)>(vb);
  const s16x4 l2 = tr_read<v_rd_off64(D0, 2, 0)>(vb), h2 = tr_read<v_rd_off64(D0, 2, 1)>(vb), l3 = tr_read<v_rd_off64(D0, 3, 0)>(vb), h3 = tr_read<v_rd_off64(D0, 3, 1)>(vb);
  asm volatile("s_waitcnt lgkmcnt(0)" ::: "memory"); SBAR();
#define PKV(L, H) (bf16x8){L[0], L[1], L[2], L[3], H[0], H[1], H[2], H[3]}
  od = MFMA32(pa0, PKV(l0, h0), od);
  od = MFMA32(pa1, PKV(l1, h1), od);
  od = MFMA32(pa2, PKV(l2, h2), od);
  od = MFMA32(pa3, PKV(l3, h3), od);
}

__device__ __forceinline__ void mla_block(const bf16_t* __restrict__ Qb, const bf16_t* __restrict__ Kh, const bf16_t* __restrict__ Vh, bf16_t* __restrict__ Ob, int t0, char* lds) {
  constexpr int SHM_V = 64 * 64 * 2, SHM_K = 64 * 128 * 2, NT = NKEY / 64;
  const int tid = tidx(), wid = tid >> 6, lane = tid & 63, r32 = lane & 31, hi = lane >> 5;
  char* V_lds = lds; char* K_lds = lds + 2 * SHM_V;
  float* wsf = (float*)(lds + 2 * SHM_V + 2 * SHM_K) + wid * 64; float* li_l = wsf; float* al_l = wsf + 32;
  float m_reg = -1e30f, l_reg = 0.f; f32x16 o[2];
#pragma unroll
  for (int r = 0; r < 16; ++r) { o[0][r] = 0.f; o[1][r] = 0.f; }
  bf16x8 qr[6];
  { const bf16_t* Qw = Qb + (size_t)(wid * 32 + r32) * 96;
#pragma unroll
    for (int d0 = 0; d0 < 4; ++d0) qr[d0] = *(const bf16x8*)(Qw + d0 * 16 + hi * 8);
    const int t = t0 + wid * 32 + r32;
#pragma unroll
    for (int g = 0; g < 2; ++g) {
      const bf16x8 x1 = *(const bf16x8*)(Qw + 64 + g * 16), x2 = *(const bf16x8*)(Qw + 64 + g * 16 + 8);
      const float pos = g ? (float)(t & 63) : (float)(t >> 6);
      unsigned wv[4];
#pragma unroll
      for (int i = 0; i < 8; i += 2) {
        float o2[2];
#pragma unroll
        for (int q = 0; q < 2; ++q) { const float ang = pos * rope_inv(i + q); const float sn = __sinf(ang), cs = __cosf(ang);
          const float a = bf2f((bf16_t)x1[i + q]), b = bf2f((bf16_t)x2[i + q]);
          o2[q] = hi ? (a * sn + b * cs) : (a * cs - b * sn); }
        wv[i >> 1] = pack2(o2[0], o2[1]);
      }
      u32x4 w4 = {wv[0], wv[1], wv[2], wv[3]}; qr[4 + g] = *reinterpret_cast<bf16x8*>(&w4);
    }
  }
  const int kq0 = tid, kq1 = tid < 256 ? 512 + tid : tid;
  const int kr0 = kq0 / 12, kc0 = (kq0 - kr0 * 12) * 8, kr1 = kq1 / 12, kc1 = (kq1 - kr1 * 12) * 8; const bool k2 = tid < 256;
  const int kw0 = KSWZ(kr0, kc0 * 2), kw1 = KSWZ(kr1, kc1 * 2);
  const int vk = tid >> 3, vc = (tid & 7) * 8, vst = v_st64(vk, vc);
  const int vb0 = (int)(uintptr_t)V_lds + v_rd_base(lane);
  const int ko0 = kr0 * 128 + kc0, ko1 = kr1 * 128 + kc1, vo = vk * 64 + vc;
  uint4 sv_0, sk0_0, sk1_0, sv_1, sk0_1, sk1_1;
#define SLOAD(i, kk0) do { sv_##i = *(const uint4*)(Vh + ((kk0) * 64 + vo)); sk0_##i = *(const uint4*)(Kh + ((kk0) * 128 + ko0)); sk1_##i = *(const uint4*)(Kh + ((kk0) * 128 + ko1)); } while (0)
#define SWRITE(b, i) do { *(uint4*)(V_lds + (b) * SHM_V + vst) = sv_##i; *(uint4*)(K_lds + (b) * SHM_K + kw0) = sk0_##i; if (k2) *(uint4*)(K_lds + (b) * SHM_K + kw1) = sk1_##i; } while (0)
#define SWAIT() asm volatile("s_waitcnt vmcnt(3)" ::: "memory")
#define RESC(a) do { if (__any((a) < 1.f)) { if (hi == 0) al_l[r32] = (a); asm volatile("s_waitcnt lgkmcnt(0)" ::: "memory"); \
    _Pragma("unroll") for (int d = 0; d < 2; ++d) _Pragma("unroll") for (int r = 0; r < 16; ++r) o[d][r] *= al_l[crow(r, hi)]; } } while (0)
#define PV2(vb) do { pv_one64<0>(o[0], (vb), pa0, pa1, pa2, pa3); pv_one64<1>(o[1], (vb), pa0, pa1, pa2, pa3); } while (0)
  f32x16 pA0, pA1, pB0, pB1; float mnA, mnB, alA, alB; bf16x8 pa0, pa1, pa2, pa3;
  SLOAD(0, 0); asm volatile("s_waitcnt vmcnt(0)" ::: "memory"); SWRITE(0, 0); __syncthreads();
  att_qkt<6>(pA0, pA1, K_lds, qr, r32, hi); att_partialSM(pA0, pA1, m_reg, mnA, alA);
  SLOAD(1, 64); SLOAD(0, 128);
  SWAIT(); SWRITE(1, 1); __syncthreads();
  for (int j = 1; j + 1 < NT; j += 2) {
    SBAR(); att_qkt<6>(pB0, pB1, K_lds + SHM_K, qr, r32, hi);
    att_finishSM(pA0, pA1, alA, l_reg, pa0, pa1, pa2, pa3); SBAR();
    SLOAD(1, (j + 2) * 64); SBAR();
    PV2(vb0); att_partialSM(pB0, pB1, m_reg, mnB, alB);
    __syncthreads(); SWAIT(); SWRITE(0, 0);
    RESC(alB); __syncthreads();
    SBAR(); att_qkt<6>(pA0, pA1, K_lds, qr, r32, hi);
    att_finishSM(pB0, pB1, alB, l_reg, pa0, pa1, pa2, pa3); SBAR();
    if (j + 3 < NT) SLOAD(0, (j + 3) * 64); SBAR();
    PV2(vb0 + SHM_V); att_partialSM(pA0, pA1, m_reg, mnA, alA);
    __syncthreads(); SWAIT(); SWRITE(1, 1);
    RESC(alA); __syncthreads();
  }
  SBAR(); att_qkt<6>(pB0, pB1, K_lds + SHM_K, qr, r32, hi);
  att_finishSM(pA0, pA1, alA, l_reg, pa0, pa1, pa2, pa3); SBAR();
  PV2(vb0); att_partialSM(pB0, pB1, m_reg, mnB, alB);
  __syncthreads(); RESC(alB);
  att_finishSM(pB0, pB1, alB, l_reg, pa0, pa1, pa2, pa3); SBAR();
  PV2(vb0 + SHM_V);
  if (hi == 0) li_l[r32] = l_reg; asm volatile("s_waitcnt lgkmcnt(0)" ::: "memory");
  bf16_t* Ow = Ob + (size_t)(wid * 32) * D;
#pragma unroll
  for (int r = 0; r < 16; ++r) { const int orow = crow(r, hi); const float rl = __builtin_amdgcn_rcpf(li_l[orow]);
#pragma unroll
    for (int d0 = 0; d0 < 2; ++d0) Ow[(size_t)orow * D + d0 * 32 + r32] = f2bf(o[d0][r] * rl); }
  __syncthreads();
#undef SLOAD
#undef SWRITE
#undef SWAIT
}
__device__ __forceinline__ void ph_mla(const MP& p, char* lds) {
  const bf16_t* dq = (const bf16_t*)(p.ws + WS_DQ); const bf16_t* dk = (const bf16_t*)(p.ws + WS_DK); const bf16_t* dv = (const bf16_t*)(p.ws + WS_DV);
  bf16_t* abuf = (bf16_t*)(p.ws + WS_A);
  for (int item = blockIdx.x; item < 512; item += gridDim.x) {
    const int bh = (item & 7) + 8 * (item >> 8), qb = (item >> 3) & 31, b = bh >> 3, h = bh & 7;
    mla_block(dq + ((size_t)bh * SEQ + qb * 256) * 96, dk + (size_t)bh * NKEY * 128, dv + (size_t)bh * NKEY * 64,
              abuf + (size_t)(b * SEQ + qb * 256) * D + 512 + h * 64, qb * 256, lds);
  }
}

__device__ __forceinline__ int hgrn_step_cid(int b, int dir, int s) {
  if (s < 4) return 256 + b * 4 + (dir ? 3 - s : s);
  return b * 128 + (dir ? 131 - s : s - 4);
}
__device__ __forceinline__ void ph_hgrn_a(const MP& p) {
  bf16_t* U = (bf16_t*)(p.ws + WS_U); float* LF = (float*)(p.ws + WS_LF); float* alast = (float*)(p.ws + WS_ALAST);
  bf16_t* KT = (bf16_t*)(p.ws + WS_A); bf16_t* VT = (bf16_t*)(p.ws + WS_H + USLOT);
  const int col = tidx(), h = col >> 7, dk = col & 127;
  for (int item = blockIdx.x; item < NCHUNK * 2; item += gridDim.x) {
    const int cid = item >> 1, dir = item & 1; const size_t row0 = (size_t)cid * 64;
    float* lf = LF + ((size_t)dir * MROWS + row0) * 512 + col;
    bf16_t* uk = U + (size_t)(1 + dir) * MROWS * 512 + row0 * 512 + col;
    float bc[64]; float run = 0.f;
    if (dir == 0) {
#pragma unroll
      for (int j = 0; j < 64; ++j) { run += lf[(size_t)j * 512]; bc[j] = run; }
    } else {
#pragma unroll
      for (int j = 63; j >= 0; --j) { run += lf[(size_t)j * 512]; bc[j] = run; }
    }
    alast[((size_t)dir * NCHUNK + cid) * 512 + col] = __expf(run);
    bf16_t* kt = KT + ((((size_t)dir * NCHUNK + cid) * 4 + h) * 128 + dk) * 64;
#pragma unroll
    for (int j8 = 0; j8 < 8; ++j8) {
      unsigned wv[4];
#pragma unroll
      for (int q = 0; q < 4; ++q) {
        const int j = j8 * 8 + 2 * q; const float e0 = run - bc[j], e1 = run - bc[j + 1];
        lf[(size_t)j * 512] = e0; lf[(size_t)(j + 1) * 512] = e1;
        const bf16_t k0 = f2bf(bf2f(uk[(size_t)j * 512]) * __expf(e0)), k1 = f2bf(bf2f(uk[(size_t)(j + 1) * 512]) * __expf(e1));
        uk[(size_t)j * 512] = k0; uk[(size_t)(j + 1) * 512] = k1; wv[q] = (unsigned)k0 | ((unsigned)k1 << 16);
      }
      *(uint4*)(kt + j8 * 8) = make_uint4(wv[0], wv[1], wv[2], wv[3]);
    }
    if (dir == 0) {
      const bf16_t* uv = U + (size_t)3 * MROWS * 512 + row0 * 512 + col; bf16_t* vt = VT + (((size_t)cid * 4 + h) * 128 + dk) * 64;
#pragma unroll
      for (int j8 = 0; j8 < 8; ++j8) {
        unsigned wv[4];
#pragma unroll
        for (int q = 0; q < 4; ++q) { const int j = j8 * 8 + 2 * q; wv[q] = (unsigned)uv[(size_t)j * 512] | ((unsigned)uv[(size_t)(j + 1) * 512] << 16); }
        *(uint4*)(vt + j8 * 8) = make_uint4(wv[0], wv[1], wv[2], wv[3]);
      }
    }
  }
}
__device__ __forceinline__ bf16_t* hgrn_sbuf(const MP& p, int bhd, int cid) {
  return cid < 256 ? (bf16_t*)p.out + ((size_t)bhd * 128 + (cid & 127)) * 16384 : (bf16_t*)(p.ws + WS_ODIR_CTX) + ((size_t)bhd * 4 + ((cid - 256) & 3)) * 16384;
}
__device__ __forceinline__ void ph_hgrn_b(const MP& p) {
  const int w = tidx() >> 6, lane = tidx() & 63, l15 = lane & 15, lq = lane >> 4;
  if (w < 4) {
    const bf16_t* KT = (const bf16_t*)(p.ws + WS_A); const bf16_t* VT = (const bf16_t*)(p.ws + WS_H + USLOT); const float* alast = (const float*)(p.ws + WS_ALAST);
    for (int item = blockIdx.x * 4 + w; item < 1024; item += gridDim.x * 4) {
      const int bhd = item >> 6, dkt = (item >> 3) & 7, dvt = item & 7, b = bhd >> 3, h = (bhd >> 1) & 3, dir = bhd & 1;
      f32x4 S = {0.f, 0.f, 0.f, 0.f};
      uint4 ka[4][2], vb[4][2]; float al[4];
#define HB_LOAD(s0) _Pragma("unroll") for (int u = 0; u < 4; ++u) { const int cid = hgrn_step_cid(b, dir, (s0) + u);                                   \
        const bf16_t* kt = KT + ((((size_t)dir * NCHUNK + cid) * 4 + h) * 128 + dkt * 16 + l15) * 64 + lq * 8;                                       \
        const bf16_t* vt = VT + (((size_t)cid * 4 + h) * 128 + dvt * 16 + l15) * 64 + lq * 8;                                                       \
        ka[u][0] = *(const uint4*)kt; ka[u][1] = *(const uint4*)(kt + 32); vb[u][0] = *(const uint4*)vt; vb[u][1] = *(const uint4*)(vt + 32);          \
        al[u] = alast[((size_t)dir * NCHUNK + cid) * 512 + h * 128 + dkt * 16 + l15]; }
      HB_LOAD(0);
      for (int s0 = 0; s0 < 132; s0 += 4) {
        uint4 kc[4][2], vc[4][2]; float ac[4];
#pragma unroll
        for (int u = 0; u < 4; ++u) { kc[u][0] = ka[u][0]; kc[u][1] = ka[u][1]; vc[u][0] = vb[u][0]; vc[u][1] = vb[u][1]; ac[u] = al[u]; }
        if (s0 + 4 < 132) { HB_LOAD(s0 + 4); }
#pragma unroll
        for (int u = 0; u < 4; ++u) {
          const int cid = hgrn_step_cid(b, dir, s0 + u);
          f32x4 T = {0.f, 0.f, 0.f, 0.f};
          T = MFMA16(*reinterpret_cast<bf16x8*>(&vc[u][0]), *reinterpret_cast<bf16x8*>(&kc[u][0]), T);
          T = MFMA16(*reinterpret_cast<bf16x8*>(&vc[u][1]), *reinterpret_cast<bf16x8*>(&kc[u][1]), T);
          const f32x4 Sp = S * ac[u];
          bf16_t* sb = hgrn_sbuf(p, bhd, cid) + (size_t)(dvt * 16 + lq * 4) * 128 + dkt * 16 + l15;
          sb[0] = f2bf(Sp.x); sb[128] = f2bf(Sp.y); sb[256] = f2bf(Sp.z); sb[384] = f2bf(Sp.w);
          S = Sp + T;
        }
      }
#undef HB_LOAD
    }
  }
}
__device__ __forceinline__ void ph_hgrn_c(const MP& p, char* lds) {
  const bf16_t* U = (const bf16_t*)(p.ws + WS_U); const float* LF = (const float*)(p.ws + WS_LF); const bf16_t* VT = (const bf16_t*)(p.ws + WS_H + USLOT);
  bf16_t* abuf = (bf16_t*)(p.ws + WS_A); const float* onorm = p.in[11];
  char* Qs = lds; char* Ks = lds + 16384; char* Ss = lds + 32768; char* Vs = lds + 65536; char* As = lds + 81920; float* red = (float*)(lds + 90112);
  const int t = tidx(), lane = t & 63, w = t >> 6, wm = w >> 1, wn = w & 1, l15 = lane & 15, lq = lane >> 4;
  const int srow = t >> 3, scb = (t & 7) * 16;
  for (int item = blockIdx.x; item < 8 * 132; item += gridDim.x) {
    const int bh = item / 132, cpos = item - bh * 132, b = bh >> 2, h = bh & 3;
    const int cid = cpos < 128 ? b * 128 + cpos : 256 + b * 4 + (cpos - 128); const size_t row0 = (size_t)cid * 64;
    f32x4 acc[4];
#pragma unroll
    for (int j = 0; j < 4; ++j) acc[j] = (f32x4){0.f, 0.f, 0.f, 0.f};
    for (int dir = 0; dir < 2; ++dir) {
      {
        const size_t go = (row0 + srow) * 512 + h * 128 + scb;
        const uint4 q0 = *(const uint4*)(U + go), q1 = *(const uint4*)(U + go + 8);
        const uint4 k0 = *(const uint4*)(U + (size_t)(1 + dir) * MROWS * 512 + go), k1 = *(const uint4*)(U + (size_t)(1 + dir) * MROWS * 512 + go + 8);
        const float* ep = LF + (size_t)dir * MROWS * 512 + go;
        const f32x4 e0 = *(const f32x4*)ep, e1 = *(const f32x4*)(ep + 4), e2 = *(const f32x4*)(ep + 8), e3 = *(const f32x4*)(ep + 12);
        const unsigned qw[8] = {q0.x, q0.y, q0.z, q0.w, q1.x, q1.y, q1.z, q1.w};
        const float ev[16] = {e0.x, e0.y, e0.z, e0.w, e1.x, e1.y, e1.z, e1.w, e2.x, e2.y, e2.z, e2.w, e3.x, e3.y, e3.z, e3.w};
        unsigned ow[8];
#pragma unroll
        for (int i = 0; i < 8; ++i) ow[i] = pack2(__uint_as_float(qw[i] << 16) * __expf(-ev[2 * i]), __uint_as_float(qw[i] & 0xFFFF0000u) * __expf(-ev[2 * i + 1]));
        const int c0 = scb >> 3, sw = srow & 15;
        *(uint4*)(Qs + srow * 256 + ((c0 ^ sw) << 4)) = make_uint4(ow[0], ow[1], ow[2], ow[3]);
        *(uint4*)(Qs + srow * 256 + (((c0 + 1) ^ sw) << 4)) = make_uint4(ow[4], ow[5], ow[6], ow[7]);
        *(uint4*)(Ks + srow * 256 + ((c0 ^ sw) << 4)) = k0;
        *(uint4*)(Ks + srow * 256 + (((c0 + 1) ^ sw) << 4)) = k1;
        const bf16_t* vt = VT + ((size_t)cid * 4 + h) * 8192;
#pragma unroll
        for (int i = 0; i < 2; ++i) { const int idx = t + 512 * i, r = idx >> 3, c = idx & 7; *(uint4*)(Vs + r * 128 + ((c ^ ((r >> 1) & 7)) << 4)) = *(const uint4*)(vt + (size_t)idx * 8); }
        const bf16_t* sb = hgrn_sbuf(p, bh * 2 + dir, cid);
#pragma unroll
        for (int i = 0; i < 4; ++i) { const int idx = t + 512 * i, r = idx >> 4, c = idx & 15; *(uint4*)(Ss + r * 256 + ((c ^ (r & 15)) << 4)) = *(const uint4*)(sb + (size_t)idx * 8); }
      }
      __syncthreads();
      bf16x8 af[4];
#pragma unroll
      for (int ks = 0; ks < 4; ++ks) af[ks] = *(const bf16x8*)(Qs + (wm * 16 + l15) * 256 + (((ks * 4 + lq) ^ l15) << 4));
      {
        f32x4 a2[2];
#pragma unroll
        for (int ni = 0; ni < 2; ++ni) { a2[ni] = (f32x4){0.f, 0.f, 0.f, 0.f};
#pragma unroll
          for (int ks = 0; ks < 4; ++ks) { const bf16x8 bf = *(const bf16x8*)(Ks + (wn * 32 + ni * 16 + l15) * 256 + (((ks * 4 + lq) ^ l15) << 4)); a2[ni] = MFMA16(bf, af[ks], a2[ni]); } }
        const int tt = wm * 16 + l15;
#pragma unroll
        for (int ni = 0; ni < 2; ++ni) { const int s0 = wn * 32 + ni * 16 + lq * 4; float v[4] = {a2[ni].x, a2[ni].y, a2[ni].z, a2[ni].w};
#pragma unroll
          for (int r = 0; r < 4; ++r) { const int s = s0 + r; const bool keep = dir ? (s >= tt) : (s <= tt); v[r] = keep ? v[r] : 0.f; }
          uint2 wv; wv.x = pack2(v[0], v[1]); wv.y = pack2(v[2], v[3]);
          *(uint2*)(As + tt * 128 + (((s0 >> 3) ^ ((tt >> 1) & 7)) << 4) + (s0 & 7) * 2) = wv; }
      }
#pragma unroll
      for (int ni = 0; ni < 4; ++ni) {
#pragma unroll
        for (int ks = 0; ks < 4; ++ks) { const bf16x8 bf = *(const bf16x8*)(Ss + (wn * 64 + ni * 16 + l15) * 256 + (((ks * 4 + lq) ^ l15) << 4)); acc[ni] = MFMA16(bf, af[ks], acc[ni]); } }
      __syncthreads();
      {
        const int tt = wm * 16 + l15; bf16x8 aa[2];
#pragma unroll
        for (int ks = 0; ks < 2; ++ks) aa[ks] = *(const bf16x8*)(As + tt * 128 + (((ks * 4 + lq) ^ ((tt >> 1) & 7)) << 4));
#pragma unroll
        for (int ni = 0; ni < 4; ++ni) { const int r = wn * 64 + ni * 16 + l15;
#pragma unroll
          for (int ks = 0; ks < 2; ++ks) { const bf16x8 bf = *(const bf16x8*)(Vs + r * 128 + (((ks * 4 + lq) ^ ((r >> 1) & 7)) << 4)); acc[ni] = MFMA16(bf, aa[ks], acc[ni]); } }
      }
      __syncthreads();
    }
    const int tt = wm * 16 + l15; float ss = 0.f;
#pragma unroll
    for (int ni = 0; ni < 4; ++ni) ss += acc[ni].x * acc[ni].x + acc[ni].y * acc[ni].y + acc[ni].z * acc[ni].z + acc[ni].w * acc[ni].w;
    ss += __shfl_xor(ss, 16); ss += __shfl_xor(ss, 32);
    if (lq == 0) red[tt * 2 + wn] = ss;
    __syncthreads();
    const float rstd = 1.f / sqrtf((red[tt * 2] + red[tt * 2 + 1]) * (1.f / 128.f) + EPS);
#pragma unroll
    for (int ni = 0; ni < 4; ++ni) {
      const int dv = wn * 64 + ni * 16 + lq * 4; const size_t go = (row0 + tt) * 512 + h * 128 + dv;
      const uint2 gw = *(const uint2*)(U + (size_t)4 * MROWS * 512 + go); const f32x4 on = *(const f32x4*)(onorm + dv);
      uint2 wv;
      wv.x = pack2(acc[ni].x * rstd * on.x * __uint_as_float(gw.x << 16), acc[ni].y * rstd * on.y * __uint_as_float(gw.x & 0xFFFF0000u));
      wv.y = pack2(acc[ni].z * rstd * on.z * __uint_as_float(gw.y << 16), acc[ni].w * rstd * on.w * __uint_as_float(gw.y & 0xFFFF0000u));
      *(uint2*)(abuf + (row0 + tt) * D + h * 128 + dv) = wv;
    }
    __syncthreads();
  }
}

#define XB_TMO      128
#define XB_XCNT(j)  (256  + 64 * (j))
#define XB_XSUB(j)  (1280 + 64 * (j))
#define XB_XGEN(j)  (2304 + 64 * (j))
#define XB_TOP      3328
#define XB_TOPGEN   3392
#define XCD_BAR_WORDS 3456
#define XB_SPIN_CAP (1u << 20)
#define LAS __attribute__((address_space(3)))
__device__ __forceinline__ unsigned xb_ld(unsigned* p)              { return __hip_atomic_load(p, __ATOMIC_RELAXED, __HIP_MEMORY_SCOPE_AGENT); }
__device__ __forceinline__ unsigned xb_add(unsigned* p, unsigned v) { return __hip_atomic_fetch_add(p, v, __ATOMIC_RELAXED, __HIP_MEMORY_SCOPE_AGENT); }
__device__ __forceinline__ unsigned xb_xcc_id() { return (unsigned)__builtin_amdgcn_s_getreg((3 << 11) | 20) & 0xFu; }
#define XB_SPIN(cond, bar) do { unsigned _sp = 0; while (cond) { __builtin_amdgcn_s_sleep(1); \
    if ((++_sp & 255u) == 0u) { if (xb_ld(&(bar)[XB_TMO])) break; if (_sp > XB_SPIN_CAP) { atomicAdd(&(bar)[XB_TMO], 1u); break; } } } } while (0)
struct XcdBarrier { unsigned* bar; unsigned x; volatile LAS unsigned* st; };
__device__ __forceinline__ XcdBarrier xcd_barrier_post(unsigned* bar, volatile LAS unsigned* st) {
  XcdBarrier b; b.bar = bar; b.x = xb_xcc_id(); b.st = st;
  if (tidx() == 0) (void)xb_add(&bar[XB_XCNT(b.x)], 1u);
  return b;
}
__device__ __forceinline__ void xcd_barrier_complete(unsigned* bar, unsigned x, unsigned& nloc, unsigned& nx) {
  const unsigned G = gridDim.x * gridDim.y * gridDim.z;
  unsigned sum, cnt, mine, sp = 0u;
  for (;;) {
    sum = 0u; cnt = 0u; mine = 0u;
#pragma unroll
    for (unsigned j = 0; j < 16; ++j) { const unsigned c = xb_ld(&bar[XB_XCNT(j)]); sum += c; cnt += (c > 0u) ? 1u : 0u; mine = (j == x) ? c : mine; }
    if (sum == G) break;
    __builtin_amdgcn_s_sleep(1);
    if ((++sp & 255u) == 0u) { if (xb_ld(&bar[XB_TMO])) break; if (sp > XB_SPIN_CAP) { atomicAdd(&bar[XB_TMO], 1u); break; } }
  }
  nloc = mine > 0u ? mine : 1u; nx = cnt > 0u ? cnt : 1u;
}
__device__ __forceinline__ void xcd_barrier(const XcdBarrier& b) {
  asm volatile("s_waitcnt vmcnt(0)" ::: "memory");
  __syncthreads();
  if (tidx() == 0) {
    unsigned* bar = b.bar;
    __builtin_amdgcn_s_waitcnt(0);
    unsigned nloc = b.st[0], nx = b.st[1];
    if (nloc == 0u) { xcd_barrier_complete(bar, b.x, nloc, nx); b.st[0] = nloc; b.st[1] = nx; }
    const unsigned old = xb_add(&bar[XB_XSUB(b.x)], 1u);
    const unsigned gen = old / nloc;
    if (old + 1u == (gen + 1u) * nloc) {
      __builtin_amdgcn_fence(__ATOMIC_RELEASE, "agent");
      asm volatile("s_waitcnt vmcnt(0)" ::: "memory");
      const unsigned og = xb_add(&bar[XB_TOP], 1u);
      const unsigned tg = og / nx;
      if (og + 1u == (tg + 1u) * nx) xb_add(&bar[XB_TOPGEN], 1u);
      else XB_SPIN(xb_ld(&bar[XB_TOPGEN]) == tg, bar);
      __builtin_amdgcn_fence(__ATOMIC_ACQUIRE, "agent");
      xb_add(&bar[XB_XGEN(b.x)], 1u);
      asm volatile("s_waitcnt vmcnt(0)" ::: "memory");
    } else {
      XB_SPIN(xb_ld(&bar[XB_XGEN(b.x)]) == gen, bar);
      __builtin_amdgcn_fence(__ATOMIC_ACQUIRE, "agent");
      asm volatile("s_waitcnt vmcnt(0)" ::: "memory");
    }
  }
  __syncthreads();
}

__device__ __forceinline__ void ph_na_simple(const MP& p) {
  const bf16_t* nq = (const bf16_t*)(p.ws + WS_NQ); const bf16_t* nk = (const bf16_t*)(p.ws + WS_NK); const bf16_t* nv = (const bf16_t*)(p.ws + WS_NV);
  const float* rpb = p.in[16]; bf16_t* A = (bf16_t*)(p.ws + WS_A);
  for (int item = blockIdx.x; item < 256; item += gridDim.x) {
    const int bh = item >> 4, t = (item & 15) * 512 + tidx(), b = bh >> 3, hh = bh & 7;
    const int r = t >> 6, c = t & 63;
    int rs = r - 4; rs = rs < 0 ? 0 : (rs > 120 ? 120 : rs);
    int cs = c - 8; cs = cs < 0 ? 0 : (cs > 48 ? 48 : cs);
    float q[64], o[64];
    const bf16_t* qp = nq + ((size_t)bh * SEQ + t) * 64;
#pragma unroll
    for (int d = 0; d < 64; ++d) { q[d] = bf2f(qp[d]); o[d] = 0.f; }
    const bf16_t* Kb = nk + (size_t)bh * NKEY * 64; const bf16_t* Vb = nv + (size_t)bh * NKEY * 64;
    float mx = -3.0e38f, l = 0.f;
    for (int kk = 0; kk < 128 + CT; ++kk) {
      int key; float bias = 0.f;
      if (kk < 128) { const int kr_ = rs + (kk >> 4), kc = cs + (kk & 15); key = CT + kr_ * 64 + kc; bias = rpb[(hh * 15 + (kr_ - r + 7)) * 31 + (kc - c + 15)] * LOG2E; }
      else key = kk - 128;
      const bf16_t* kp = Kb + (size_t)key * 64; float s = bias;
#pragma unroll
      for (int d = 0; d < 64; d += 2) { const unsigned w = *(const unsigned*)(kp + d); s += q[d] * __uint_as_float(w << 16) + q[d + 1] * __uint_as_float(w & 0xFFFF0000u); }
      const float mn = fmaxf(mx, s), alpha = exp2f(mx - mn), pe = exp2f(s - mn);
      l = l * alpha + pe; mx = mn;
      const bf16_t* vp = Vb + (size_t)key * 64;
#pragma unroll
      for (int d = 0; d < 64; d += 2) { const unsigned w = *(const unsigned*)(vp + d); o[d] = o[d] * alpha + pe * __uint_as_float(w << 16); o[d + 1] = o[d + 1] * alpha + pe * __uint_as_float(w & 0xFFFF0000u); }
    }
    const float il = 1.f / l;
    bf16_t* op = A + (size_t)(b * SEQ + t) * D + hh * 64;
#pragma unroll
    for (int d = 0; d < 64; d += 2) *(unsigned*)(op + d) = pack2(o[d] * il, o[d + 1] * il);
  }
}

};

enum { PH_PRE = 0, PH_N1_0, PH_G1_0, PH_HA, PH_HB, PH_HC, PH_G2_0, PH_ROUTE_0, PH_MOE1_0, PH_MOE2_0, PH_COMB_0, PH_G1_1, PH_MLAUP, PH_MLA, PH_G2_1, PH_ROUTE_1, PH_MOE1_1, PH_MOE2_1, PH_FINAL, PH_COUNT };

__global__ __launch_bounds__(512) void mega(MP p) {
  extern __shared__ __attribute__((aligned(16))) char smem[];
  char* ws = p.ws;
  MK k; k.wv = __builtin_amdgcn_readfirstlane((int)(threadIdx.x >> 6));
  volatile LAS unsigned* xbw = (volatile LAS unsigned*)(smem + LDS_BYTES - 16);
  if (k.tidx() == 0) { xbw[0] = 0u; xbw[1] = 0u; }
  __syncthreads();
  MK::XcdBarrier bar; bar.bar = (unsigned*)(ws + WS_CTL); bar.x = 0; bar.st = xbw;
  if (p.ph_hi - p.ph_lo > 1) bar = k.xcd_barrier_post((unsigned*)(ws + WS_CTL), xbw);
  const float* mods0 = (const float*)(ws + WS_MODS); const float* mods1 = mods0 + 3 * 6144;
  bf16_t* hbuf = (bf16_t*)(ws + WS_H); bf16_t* abuf = (bf16_t*)(ws + WS_A); bf16_t* U = (bf16_t*)(ws + WS_U); float* xc = (float*)(ws + WS_XC);
  if (p.ph_lo <= PH_PRE && PH_PRE < p.ph_hi) { k.ph_ada(p, smem); k.ph_conv_small(p, smem); k.ph_conv_moe(p, 0, smem);
    if (PH_PRE + 1 < p.ph_hi) k.xcd_barrier(bar);
  }
  if (p.ph_lo <= PH_N1_0 && PH_N1_0 < p.ph_hi) { k.ph_norm_mod(p.in[0], p.in[2], p.in[6], mods0, 0, 1024, hbuf, MROWS);
    if (PH_N1_0 + 1 < p.ph_hi) k.xcd_barrier(bar);
  }
  if (p.ph_lo <= PH_G1_0 && PH_G1_0 < p.ph_hi) { { EpiABIn e; e.U = U; e.LF = (float*)(ws + WS_LF); e.lb = (const float*)(ws + WS_LB);
        k.template gemm_phase<4>(hbuf, D, (const bf16_t*)(ws + WS_WT_ABIN), 1024, MROWS, 3072, 1024, e, smem); }
    if (PH_G1_0 + 1 < p.ph_hi) k.xcd_barrier(bar);
  }
  if (p.ph_lo <= PH_HA && PH_HA < p.ph_hi) { k.ph_hgrn_a(p); k.ph_pool_prep(U + 5 * (size_t)MROWS * 512, hbuf);
    if (PH_HA + 1 < p.ph_hi) k.xcd_barrier(bar);
  }
  if (p.ph_lo <= PH_HB && PH_HB < p.ph_hi) { k.ph_hgrn_b(p);
    if (PH_HB + 1 < p.ph_hi) k.xcd_barrier(bar);
  }
  if (p.ph_lo <= PH_HC && PH_HC < p.ph_hi) { k.ph_hgrn_c(p, smem);
    for (int gi = 0; gi < 4; ++gi) { EpiPool e; e.A = abuf; e.scale = p.in[13]; e.gi = gi; e.pad = 0;
      k.template gemm_phase<4>(hbuf + gi * 128, 512, (const bf16_t*)(ws + WS_WT_POOL) + (size_t)gi * 128 * 128, 128, MROWS, 128, 128, e, smem); }
    if (PH_HC + 1 < p.ph_hi) k.xcd_barrier(bar);
  }
  if (p.ph_lo <= PH_G2_0 && PH_G2_0 < p.ph_hi) { { EpiOutRes e; e.base_lat = p.in[0]; e.base_ctx = p.in[2]; e.out_lat = p.out; e.out_ctx = xc; e.modl = mods0; e.g_off = 2048; e.pad = 0;
        k.template gemm_phase<2>(abuf, D, (const bf16_t*)(ws + WS_WT_ABOUT), 1024, MROWS, 1024, 1024, e, smem); }
    if (PH_G2_0 + 1 < p.ph_hi) k.xcd_barrier(bar);
  }
  if (p.ph_lo <= PH_ROUTE_0 && PH_ROUTE_0 < p.ph_hi) { k.ph_router(p, 0, MROWS, smem);
    if (PH_ROUTE_0 + 1 < p.ph_hi) k.xcd_barrier(bar);
  }
  if (p.ph_lo <= PH_MOE1_0 && PH_MOE1_0 < p.ph_hi) { k.template ph_moe1<4>(p, 0, smem);
    if (PH_MOE1_0 + 1 < p.ph_hi) k.xcd_barrier(bar);
  }
  if (p.ph_lo <= PH_MOE2_0 && PH_MOE2_0 < p.ph_hi) { k.template ph_moe2<4>(p, 0, smem);
    if (PH_MOE2_0 + 1 < p.ph_hi) k.xcd_barrier(bar);
  }
  if (p.ph_lo <= PH_COMB_0 && PH_COMB_0 < p.ph_hi) { k.ph_combine(p, 0, MROWS, 0); k.ph_conv_moe(p, 1, smem);
    if (PH_COMB_0 + 1 < p.ph_hi) k.xcd_barrier(bar);
  }
  if (p.ph_lo <= PH_G1_1 && PH_G1_1 < p.ph_hi) { { EpiCDIn e; e.nq = (bf16_t*)(ws + WS_NQ); e.nk = (bf16_t*)(ws + WS_NK); e.nv = (bf16_t*)(ws + WS_NV); e.cq = (bf16_t*)(ws + WS_CQ); e.ckv = (bf16_t*)(ws + WS_CKV); e.kr = (float*)(ws + WS_KR);
        k.template gemm_phase<4>(hbuf, D, (const bf16_t*)(ws + WS_WT_CDIN), 1024, MROWS, 2048, 1024, e, smem); }
    if (PH_G1_1 + 1 < p.ph_hi) k.xcd_barrier(bar);
  }
  if (p.ph_lo <= PH_MLAUP && PH_MLAUP < p.ph_hi) { {
        { MK::EpiMlaQ2 e; e.dq = (bf16_t*)(ws + WS_DQ); e.cq = (const bf16_t*)(ws + WS_CQ); const int ntn = 6;
          for (int tile = blockIdx.x; tile < (NLAT / 256) * ntn; tile += gridDim.x) { const int mt = tile / ntn, nt = tile - mt * ntn;
            k.template gemm_tile<4>(e.cq, 256, nullptr, 0, NLAT, (const bf16_t*)(ws + WS_WT_UQ), 256, 256, mt * 256, nt * 128, smem, e); } }
        { MK::EpiMlaKV2 e; e.dk = (bf16_t*)(ws + WS_DK); e.dv = (bf16_t*)(ws + WS_DV); e.ckv = (const bf16_t*)(ws + WS_CKV); const int ntn = 8;
          for (int tile = blockIdx.x; tile < (MROWS / 256) * ntn; tile += gridDim.x) { const int mt = tile / ntn, nt = tile - mt * ntn;
            k.template gemm_tile<4>(e.ckv, 128, nullptr, 0, MROWS, (const bf16_t*)(ws + WS_WT_UKV), 128, 128, mt * 256, nt * 128, smem, e); } }
        k.ph_kr_rope((const float*)(ws + WS_KR), (bf16_t*)(ws + WS_DK));
      }
    if (PH_MLAUP + 1 < p.ph_hi) k.xcd_barrier(bar);
  }
  if (p.ph_lo <= PH_MLA && PH_MLA < p.ph_hi) { k.ph_mla(p, smem); k.ph_na_simple(p);
    if (PH_MLA + 1 < p.ph_hi) k.xcd_barrier(bar);
  }
  if (p.ph_lo <= PH_G2_1 && PH_G2_1 < p.ph_hi) { { EpiOutRes e; e.base_lat = p.out; e.base_ctx = xc; e.out_lat = p.out; e.out_ctx = xc; e.modl = mods1; e.g_off = 2048; e.pad = 0;
        k.template gemm_phase<2>(abuf, D, (const bf16_t*)(ws + WS_WT_CDOUT), 1024, NLAT, 1024, 1024, e, smem); }
    if (PH_G2_1 + 1 < p.ph_hi) k.xcd_barrier(bar);
  }
  if (p.ph_lo <= PH_ROUTE_1 && PH_ROUTE_1 < p.ph_hi) { k.ph_router(p, 1, NLAT, smem);
    if (PH_ROUTE_1 + 1 < p.ph_hi) k.xcd_barrier(bar);
  }
  if (p.ph_lo <= PH_MOE1_1 && PH_MOE1_1 < p.ph_hi) { k.template ph_moe1<4>(p, 1, smem);
    if (PH_MOE1_1 + 1 < p.ph_hi) k.xcd_barrier(bar);
  }
  if (p.ph_lo <= PH_MOE2_1 && PH_MOE2_1 < p.ph_hi) { k.template ph_moe2<4>(p, 1, smem);
    if (PH_MOE2_1 + 1 < p.ph_hi) k.xcd_barrier(bar);
  }
  if (p.ph_lo <= PH_FINAL && PH_FINAL < p.ph_hi) { k.ph_combine(p, 1, NLAT, 1);
    if (PH_FINAL + 1 < p.ph_hi) k.xcd_barrier(bar);
  }
}

static void run_phases(hipStream_t st, MP p, int lo, int hi) {
  for (int ph = lo; ph < hi; ++ph) { p.ph_lo = ph; p.ph_hi = ph + 1; hipLaunchKernelGGL(mega, dim3(256), dim3(512), LDS_BYTES, st, p); }
}

extern "C" void kernel_launch(void* const* d_in, const int* in_sizes, int n_in, void* d_out, int out_size, void* d_ws, size_t ws_size, hipStream_t stream) {
  static int ok = 0;
  if (!ok) {
    if (n_in != 29 || in_sizes[0] != NLAT * D || out_size != NLAT * D || ws_size < WS_END) {
      fprintf(stderr, "kernel_launch: unexpected shapes (n_in %d, in0 %d, out %d, ws %zu, need %zu)\n", n_in, n_in > 0 ? in_sizes[0] : -1, out_size, ws_size, (size_t)WS_END);
      return; }
    if (hipFuncSetAttribute((const void*)mega, hipFuncAttributeMaxDynamicSharedMemorySize, LDS_BYTES) != hipSuccess) { fprintf(stderr, "kernel_launch: hipFuncSetAttribute failed\n"); return; }
    ok = 1;
  }
  char* ws = (char*)d_ws; float* out = (float*)d_out;
  MP p; memset(&p, 0, sizeof(p));
  for (int i = 0; i < 29; ++i) p.in[i] = (const float*)d_in[i];
  p.out = out; p.ws = ws;
  hipMemsetAsync(ws + WS_CTL, 0, 65536, stream);
  float* odir_ctx = (float*)(ws + WS_ODIR_CTX);
  bf16_t* abuf = (bf16_t*)(ws + WS_A); bf16_t* U = (bf16_t*)(ws + WS_U); float* LF = (float*)(ws + WS_LF);
  bf16_t* nq = (bf16_t*)(ws + WS_NQ); bf16_t* nk = (bf16_t*)(ws + WS_NK); bf16_t* nv = (bf16_t*)(ws + WS_NV);
  bf16_t* dq = (bf16_t*)(ws + WS_DQ); bf16_t* dk = (bf16_t*)(ws + WS_DK); bf16_t* dv = (bf16_t*)(ws + WS_DV);

  p.ph_lo = 0; p.ph_hi = PH_COUNT;
  void* args[] = {&p};
  const hipError_t le = hipLaunchCooperativeKernel((const void*)mega, dim3(256), dim3(512), args, LDS_BYTES, stream);
  if (le != hipSuccess) fprintf(stderr, "kernel_launch: cooperative launch failed: %s\n", hipGetErrorString(le));
}
```

```cpp
#include <hip/hip_runtime.h>
#include <stdint.h>
#include <cstdio>
#include <cstring>

typedef unsigned short bf16_t;
typedef float f32x4 __attribute__((ext_vector_type(4)));

constexpr int D = 1024, NB = 2, SEQ = 8192, CT = 256;
constexpr int NLAT = NB * SEQ;
constexpr int NCTX = NB * CT;
constexpr int MROWS = NLAT + NCTX;
constexpr int NKEY = CT + SEQ;
constexpr float EPS = 1e-6f;
constexpr float LOG2E = 1.4426950408889634f;
constexpr float NA_QSCALE = 0.125f * LOG2E;
constexpr float MLA_QSCALE = 0.10206207261596577f * LOG2E;

constexpr size_t alignup(size_t x) { return (x + 255) & ~(size_t)255; }
constexpr size_t WS_CTL      = 0;
constexpr size_t WS_MODS     = 65536;
constexpr size_t WS_LB       = WS_MODS + alignup(2 * 3 * 6144 * 4);
constexpr size_t WS_XC       = WS_LB + 4096;
constexpr size_t WS_ROUTE_E  = WS_XC + (size_t)NCTX * D * 4;
constexpr size_t WS_ROUTE_W  = WS_ROUTE_E + alignup((size_t)MROWS * 2 * 4);
constexpr size_t WS_RSTD_Q   = WS_ROUTE_W + alignup((size_t)MROWS * 2 * 4);
constexpr size_t WS_RSTD_KV  = WS_RSTD_Q + alignup((size_t)NLAT * 4);
constexpr size_t WS_ODIR_CTX = WS_RSTD_KV + alignup((size_t)MROWS * 4);
constexpr size_t WS_LIST     = WS_ODIR_CTX + (size_t)2 * NCTX * 512 * 4;
constexpr size_t WS_ALAST    = WS_LIST + (size_t)32 * MROWS * 4;
constexpr size_t WS_WT_ABIN  = WS_ALAST + (size_t)2 * (MROWS / 64) * 512 * 4;
constexpr size_t WS_WT_ABOUT = WS_WT_ABIN + (size_t)3072 * 1024 * 2;
constexpr size_t WS_WT_CDIN  = WS_WT_ABOUT + (size_t)1024 * 1024 * 2;
constexpr size_t WS_WT_CDOUT = WS_WT_CDIN + (size_t)2048 * 1024 * 2;
constexpr size_t WS_WT_UQ    = WS_WT_CDOUT + (size_t)1024 * 1024 * 2;
constexpr size_t WS_WT_UKV   = WS_WT_UQ + (size_t)768 * 256 * 2;
constexpr size_t WS_WT_POOL  = WS_WT_UKV + (size_t)1024 * 128 * 2;
constexpr size_t WS_WMOE     = WS_WT_POOL + (size_t)4 * 128 * 128 * 2;
constexpr size_t WS_H        = WS_WMOE + (size_t)32 * 512 * 1024 * 2 + (size_t)32 * 1024 * 256 * 2;
constexpr size_t WS_A        = WS_H + (size_t)MROWS * D * 2;
constexpr size_t WS_U        = WS_A + (size_t)MROWS * D * 2;
constexpr size_t USLOT       = (size_t)MROWS * 512 * 2;
constexpr size_t WS_LF       = WS_U + 6 * USLOT;
constexpr size_t WS_END      = WS_LF + (size_t)2 * MROWS * 512 * 4;
constexpr size_t WS_NQ   = WS_U;
constexpr size_t WS_NK   = WS_NQ + (size_t)NLAT * 512 * 2;
constexpr size_t WS_NV   = WS_NK + USLOT;
constexpr size_t WS_CQ   = WS_NV + USLOT;
constexpr size_t WS_CKV  = WS_CQ + (size_t)NLAT * 256 * 2;
constexpr size_t WS_KR   = WS_CKV + (size_t)MROWS * 128 * 2;
constexpr size_t WS_DQ   = WS_KR + (size_t)MROWS * 32 * 4;
constexpr size_t WS_L1END = WS_DQ + (size_t)NLAT * 768 * 2;
static_assert(WS_L1END <= WS_LF, "layer-1 overlay too big");
constexpr size_t WS_DK   = WS_LF;
constexpr size_t WS_DV   = WS_DK + (size_t)MROWS * 1024 * 2;
static_assert(WS_DV + (size_t)MROWS * 512 * 2 <= WS_END, "dk/dv overlay too big");
constexpr size_t WS_YBUF = WS_LF;
constexpr size_t WS_AMOE = WS_U;

__device__ __forceinline__ float bf2f(bf16_t h) { return __uint_as_float(((unsigned)h) << 16); }
__device__ __forceinline__ unsigned pack2(float a, float b) { unsigned r; asm("v_cvt_pk_bf16_f32 %0, %1, %2" : "=v"(r) : "v"(a), "v"(b)); return r; }
__device__ __forceinline__ bf16_t f2bf(float f) { return (bf16_t)(pack2(f, 0.f) & 0xFFFFu); }
__device__ __forceinline__ float sigmoidf_(float x) { return __builtin_amdgcn_rcpf(1.f + __expf(-x)); }
__device__ __forceinline__ float siluf_(float x) { return x * __builtin_amdgcn_rcpf(1.f + __expf(-x)); }
__device__ __forceinline__ float wave_sum(float v) {
#pragma unroll
  for (int o = 1; o < 64; o <<= 1) v += __shfl_xor(v, o);
  return v;
}
__device__ __forceinline__ int row_vec(int m) { return m < NLAT ? (m >> 13) : 2; }
__device__ __forceinline__ void row_bkey(int m, int& b, int& key) {
  if (m < NLAT) { b = m >> 13; key = CT + (m & 8191); } else { const int mm = m - NLAT; b = mm >> 8; key = mm & 255; }
}

__global__ __launch_bounds__(512) void k_ada(const float* __restrict__ c, const float* __restrict__ cctx, const float* __restrict__ ada_w,
                                             const float* __restrict__ ada_b, float* __restrict__ mods) {
  const int l = blockIdx.y, n0 = blockIdx.x * 64, j = threadIdx.x & 63, kg = threadIdx.x >> 6;
  __shared__ float sv[3][1024];
  __shared__ float red[8][3][64];
  for (int i = threadIdx.x; i < 1024; i += 512) { sv[0][i] = siluf_(c[i]); sv[1][i] = siluf_(c[1024 + i]); sv[2][i] = siluf_(cctx[i]); }
  __syncthreads();
  const float* W = ada_w + (size_t)l * 1024 * 6144 + n0 + j;
  float a0 = 0.f, a1 = 0.f, a2 = 0.f;
  for (int k = kg * 128; k < kg * 128 + 128; ++k) { const float w = W[(size_t)k * 6144]; a0 += sv[0][k] * w; a1 += sv[1][k] * w; a2 += sv[2][k] * w; }
  red[kg][0][j] = a0; red[kg][1][j] = a1; red[kg][2][j] = a2;
  __syncthreads();
  if (threadIdx.x < 192) {
    const int v = threadIdx.x >> 6, jj = threadIdx.x & 63; float s = 0.f;
    for (int g = 0; g < 8; ++g) s += red[g][v][jj];
    mods[(size_t)(l * 3 + v) * 6144 + n0 + jj] = s + ada_b[l * 6144 + n0 + jj];
  }
}
__global__ void k_lb(const float* __restrict__ logits, float* __restrict__ lb) {
  const int i = blockIdx.x * blockDim.x + threadIdx.x;
  if (i < 1024) { const int d = i >> 9, cc = i & 511; const float l0 = logits[(d * 2 + 0) * 512 + cc], l1 = logits[(d * 2 + 1) * 512 + cc]; lb[i] = 1.f / (1.f + expf(l1 - l0)); }
}

struct ConvArgs { const float* src; bf16_t* dst; const float* kscale; int K, N, Npad, mode; size_t sbs, dbs; };
__device__ __forceinline__ int moe_gu_row(int sel, int hidden) {
  const int nt = hidden >> 6, hl = hidden & 63, wc = hl >> 5, i2 = (hl >> 4) & 1, cc = hl & 15;
  return nt * 128 + wc * 64 + (sel * 2 + i2) * 16 + cc;
}
__global__ __launch_bounds__(512) void k_convT(ConvArgs a) {
  __shared__ float tile[64][65];
  const float* src = a.src + blockIdx.z * a.sbs; bf16_t* dst = a.dst + blockIdx.z * a.dbs;
  const int n0 = blockIdx.x * 64, k0 = blockIdx.y * 64, tx = threadIdx.x & 63, ty = threadIdx.x >> 6;
#pragma unroll
  for (int i = 0; i < 8; ++i) {
    const int k = k0 + ty + 8 * i, n = n0 + tx; float v = 0.f;
    if (n < a.N) { v = src[(size_t)k * a.N + n]; if (a.kscale) v *= a.kscale[k]; }
    tile[ty + 8 * i][tx] = v;
  }
  __syncthreads();
#pragma unroll
  for (int i = 0; i < 8; ++i) {
    const int nl = ty + 8 * i, n = n0 + nl;
    if (n < a.Npad) { int row = n; if (a.mode == 1) row = moe_gu_row(0, n); else if (a.mode == 2) row = moe_gu_row(1, n);
      dst[(size_t)row * a.K + k0 + tx] = f2bf(tile[tx][nl]); }
  }
}

__global__ __launch_bounds__(512) void k_norm_mod(const float* __restrict__ lat, const float* __restrict__ ctxr, const float* __restrict__ gain,
                                                  const float* __restrict__ modl, int sh_off, int sc_off, bf16_t* __restrict__ out, int nrows) {
  const int lane = threadIdx.x & 63, gw = blockIdx.x * 8 + (threadIdx.x >> 6);
  for (int row = gw; row < nrows; row += gridDim.x * 8) {
    const float* src = row < NLAT ? lat + (size_t)row * D : ctxr + (size_t)(row - NLAT) * D;
    const float* mv = modl + row_vec(row) * 6144;
    f32x4 x[4]; float ss = 0.f;
#pragma unroll
    for (int j = 0; j < 4; ++j) { x[j] = ((const f32x4*)src)[lane + 64 * j]; ss += x[j].x * x[j].x + x[j].y * x[j].y + x[j].z * x[j].z + x[j].w * x[j].w; }
    const float rstd = 1.f / sqrtf(wave_sum(ss) * (1.f / D) + EPS);
#pragma unroll
    for (int j = 0; j < 4; ++j) {
      const int n = (lane + 64 * j) * 4;
      const f32x4 g = *(const f32x4*)(gain + n), sc = *(const f32x4*)(mv + sc_off + n), sh = *(const f32x4*)(mv + sh_off + n);
      const f32x4 h = x[j] * rstd * g * (sc + 1.f) + sh;
      uint2 o; o.x = pack2(h.x, h.y); o.y = pack2(h.z, h.w);
      *(uint2*)(out + (size_t)row * D + n) = o;
    }
  }
}

struct EpiABIn {
  bf16_t* U; float* LF; const float* lb;
  __device__ __forceinline__ void apply(int m, int n, f32x4 v) const {
    const int seg = n >> 9, cn = n & 511; float o[4] = {v.x, v.y, v.z, v.w};
    bf16_t* dst;
    if (seg == 0) { dst = U; for (int i = 0; i < 4; ++i) o[i] = siluf_(o[i]); }
    else if (seg == 1 || seg == 2) { const int d = seg - 1; dst = U + (size_t)(1 + d) * MROWS * 512;
      f32x4 lg;
#pragma unroll
      for (int i = 0; i < 4; ++i) { const float l = lb[d * 512 + cn + i]; const float k = (1.f - l) * sigmoidf_(-o[i]); o[i] = k; lg[i] = __logf(1.f - k); }
      *(f32x4*)(LF + ((size_t)d * MROWS + m) * 512 + cn) = lg; }
    else if (seg == 3) dst = U + (size_t)3 * MROWS * 512;
    else if (seg == 4) { dst = U + (size_t)4 * MROWS * 512; for (int i = 0; i < 4; ++i) o[i] = siluf_(o[i]); }
    else dst = U + (size_t)5 * MROWS * 512;
    uint2 w; w.x = pack2(o[0], o[1]); w.y = pack2(o[2], o[3]);
    *(uint2*)(dst + (size_t)m * 512 + cn) = w;
  }
};
struct EpiPool {
  bf16_t* A; const float* scale; int gi; int pad;
  __device__ __forceinline__ void apply(int m, int n, f32x4 v) const {
    const int cn = gi * 128 + n; const f32x4 s = *(const f32x4*)(scale + cn); v = v * s;
    uint2 w; w.x = pack2(v.x, v.y); w.y = pack2(v.z, v.w);
    *(uint2*)(A + (size_t)m * D + 512 + cn) = w;
  }
};
struct EpiOutRes {
  const float* base_lat; const float* base_ctx; float* out_lat; float* out_ctx; const float* modl; int g_off; int pad;
  __device__ __forceinline__ void apply(int m, int n, f32x4 v) const {
    const f32x4 g = *(const f32x4*)(modl + row_vec(m) * 6144 + g_off + n);
    if (m < NLAT) { const f32x4 b = *(const f32x4*)(base_lat + (size_t)m * D + n); *(f32x4*)(out_lat + (size_t)m * D + n) = b + g * v; }
    else { const size_t o = (size_t)(m - NLAT) * D + n; const f32x4 b = *(const f32x4*)(base_ctx + o); *(f32x4*)(out_ctx + o) = b + g * v; }
  }
};
struct EpiCDIn {
  bf16_t *nq, *nk, *nv, *cq, *ckv; float* kr;
  __device__ __forceinline__ void apply(int m, int n, f32x4 v) const {
    int b, key; row_bkey(m, b, key);
    if (n < 1536) {
      const int which = n >> 9, hh = (n & 511) >> 6, dd = n & 63;
      if (which == 0) { if (m >= NLAT) return; v = v * NA_QSCALE;
        uint2 w; w.x = pack2(v.x, v.y); w.y = pack2(v.z, v.w);
        *(uint2*)(nq + (((size_t)(b * 8 + hh) * SEQ + (m & 8191)) * 64 + dd)) = w; }
      else { bf16_t* dst = which == 1 ? nk : nv; uint2 w; w.x = pack2(v.x, v.y); w.y = pack2(v.z, v.w);
        *(uint2*)(dst + (((size_t)(b * 8 + hh) * NKEY + key) * 64 + dd)) = w; }
    } else if (n < 1792) { if (m >= NLAT) return; uint2 w; w.x = pack2(v.x, v.y); w.y = pack2(v.z, v.w); *(uint2*)(cq + (size_t)m * 256 + (n - 1536)) = w; }
    else if (n < 1920) { uint2 w; w.x = pack2(v.x, v.y); w.y = pack2(v.z, v.w); *(uint2*)(ckv + (size_t)m * 128 + (n - 1792)) = w; }
    else if (n < 1952) { *(f32x4*)(kr + (size_t)m * 32 + (n - 1920)) = v; }
  }
};
struct EpiMlaQ {
  bf16_t* dq; const float* rstd;
  __device__ __forceinline__ void apply(int m, int n, f32x4 v) const {
    const int hh = n / 96, off = n - hh * 96; v = v * (rstd[m] * MLA_QSCALE);
    uint2 w; w.x = pack2(v.x, v.y); w.y = pack2(v.z, v.w);
    *(uint2*)(dq + (((size_t)((m >> 13) * 8 + hh) * SEQ + (m & 8191)) * 96 + off)) = w;
  }
};
struct EpiMlaKV {
  bf16_t *dk, *dv; const float* rstd;
  __device__ __forceinline__ void apply(int m, int n, f32x4 v) const {
    int b, key; row_bkey(m, b, key);
    const int hh = n >> 7, off = n & 127; v = v * rstd[m];
    uint2 w; w.x = pack2(v.x, v.y); w.y = pack2(v.z, v.w);
    if (off < 64) *(uint2*)(dk + (((size_t)(b * 8 + hh) * NKEY + key) * 128 + off)) = w;
    else *(uint2*)(dv + (((size_t)(b * 8 + hh) * NKEY + key) * 64 + (off - 64))) = w;
  }
};

template <class Epi>
__global__ __launch_bounds__(256) void k_gemm_naive(const bf16_t* __restrict__ A, int lda, const bf16_t* __restrict__ Bt, int ldb, int M, int N, int K, Epi epi) {
  __shared__ float As[32][68];
  __shared__ float Bs[32][68];
  const int m0 = blockIdx.y * 64, n0 = blockIdx.x * 64, t = threadIdx.x, tx = t & 15, ty = t >> 4;
  float acc[4][4];
#pragma unroll
  for (int i = 0; i < 4; ++i)
#pragma unroll
    for (int j = 0; j < 4; ++j) acc[i][j] = 0.f;
  const int lr = t >> 2, lk = (t & 3) * 8;
  for (int k0 = 0; k0 < K; k0 += 32) {
    uint4 ra = make_uint4(0, 0, 0, 0), rb = make_uint4(0, 0, 0, 0);
    if (m0 + lr < M) ra = *(const uint4*)(A + (size_t)(m0 + lr) * lda + k0 + lk);
    if (n0 + lr < N) rb = *(const uint4*)(Bt + (size_t)(n0 + lr) * ldb + k0 + lk);
    const unsigned wa[4] = {ra.x, ra.y, ra.z, ra.w}, wb[4] = {rb.x, rb.y, rb.z, rb.w};
#pragma unroll
    for (int i = 0; i < 4; ++i) {
      As[lk + 2 * i][lr] = __uint_as_float(wa[i] << 16); As[lk + 2 * i + 1][lr] = __uint_as_float(wa[i] & 0xFFFF0000u);
      Bs[lk + 2 * i][lr] = __uint_as_float(wb[i] << 16); Bs[lk + 2 * i + 1][lr] = __uint_as_float(wb[i] & 0xFFFF0000u);
    }
    __syncthreads();
#pragma unroll 8
    for (int kk = 0; kk < 32; ++kk) {
      const f32x4 a = *(const f32x4*)&As[kk][ty * 4], b = *(const f32x4*)&Bs[kk][tx * 4];
      const float av[4] = {a.x, a.y, a.z, a.w}, bv[4] = {b.x, b.y, b.z, b.w};
#pragma unroll
      for (int i = 0; i < 4; ++i)
#pragma unroll
        for (int j = 0; j < 4; ++j) acc[i][j] += av[i] * bv[j];
    }
    __syncthreads();
  }
#pragma unroll
  for (int i = 0; i < 4; ++i) {
    const int m = m0 + ty * 4 + i, n = n0 + tx * 4;
    if (m < M && n < N) { f32x4 v = {acc[i][0], acc[i][1], acc[i][2], acc[i][3]}; epi.apply(m, n, v); }
  }
}
template <class Epi>
static void launch_gemm_naive(hipStream_t st, const bf16_t* A, int lda, const bf16_t* Bt, int ldb, int M, int N, int K, Epi epi) {
  hipLaunchKernelGGL((k_gemm_naive<Epi>), dim3((N + 63) / 64, (M + 63) / 64), dim3(256), 0, st, A, lda, Bt, ldb, M, N, K, epi);
}

__device__ __forceinline__ int hgrn_step_row(int b, int dir, int s) {
  if (s < CT) return NLAT + b * CT + (dir ? (CT - 1 - s) : s);
  const int ls = s - CT; return b * SEQ + (dir ? (SEQ - 1 - ls) : ls);
}
__global__ __launch_bounds__(128) void k_hgrn_naive(const bf16_t* __restrict__ U, const float* __restrict__ LF, float* __restrict__ odir_lat, float* __restrict__ odir_ctx) {
  const int bid = blockIdx.x, dir = bid & 1, h = (bid >> 1) & 3, b = bid >> 3, e = threadIdx.x;
  __shared__ float sf[32][128];
  __shared__ float sk[32][128];
  __shared__ float sq[32][128];
  float Sreg[128];
#pragma unroll
  for (int d = 0; d < 128; ++d) Sreg[d] = 0.f;
  const bf16_t* Uq = U; const bf16_t* Uk = U + (size_t)(1 + dir) * MROWS * 512; const bf16_t* Uv = U + (size_t)3 * MROWS * 512;
  const float* lf = LF + (size_t)dir * MROWS * 512;
  for (int s0 = 0; s0 < NKEY; s0 += 32) {
    __syncthreads();
    for (int i = 0; i < 32; ++i) {
      const size_t off = (size_t)hgrn_step_row(b, dir, s0 + i) * 512 + h * 128 + e;
      sf[i][e] = expf(lf[off]); sk[i][e] = bf2f(Uk[off]); sq[i][e] = bf2f(Uq[off]);
    }
    __syncthreads();
    for (int i = 0; i < 32; ++i) {
      const int row = hgrn_step_row(b, dir, s0 + i);
      const float v = bf2f(Uv[(size_t)row * 512 + h * 128 + e]); float o = 0.f;
#pragma unroll
      for (int d = 0; d < 128; ++d) { Sreg[d] = sf[i][d] * Sreg[d] + sk[i][d] * v; o += Sreg[d] * sq[i][d]; }
      if (row < NLAT) odir_lat[((size_t)dir * NLAT + row) * 512 + h * 128 + e] = o;
      else odir_ctx[((size_t)dir * NCTX + (row - NLAT)) * 512 + h * 128 + e] = o;
    }
  }
}
__global__ __launch_bounds__(512) void k_hgrn_out(const float* __restrict__ odir_lat, const float* __restrict__ odir_ctx, const bf16_t* __restrict__ Ug,
                                                  const float* __restrict__ onorm_g, bf16_t* __restrict__ A) {
  const int lane = threadIdx.x & 63, gw = blockIdx.x * 8 + (threadIdx.x >> 6);
  for (int row = gw; row < MROWS; row += gridDim.x * 8) {
    const float* pf = row < NLAT ? odir_lat + (size_t)row * 512 : odir_ctx + (size_t)(row - NLAT) * 512;
    const float* pb = row < NLAT ? odir_lat + ((size_t)NLAT + row) * 512 : odir_ctx + ((size_t)NCTX + (row - NLAT)) * 512;
    const int c0 = lane * 8; float o[8]; float ss = 0.f;
#pragma unroll
    for (int i = 0; i < 8; ++i) { o[i] = pf[c0 + i] + pb[c0 + i]; ss += o[i] * o[i]; }
    ss += __shfl_xor(ss, 1); ss += __shfl_xor(ss, 2); ss += __shfl_xor(ss, 4); ss += __shfl_xor(ss, 8);
    const float rstd = 1.f / sqrtf(ss * (1.f / 128.f) + EPS);
    const uint4 gr = *(const uint4*)(Ug + (size_t)row * 512 + c0); const unsigned gw4[4] = {gr.x, gr.y, gr.z, gr.w};
    unsigned w[4];
#pragma unroll
    for (int i = 0; i < 4; ++i) {
      const float g0 = __uint_as_float(gw4[i] << 16), g1 = __uint_as_float(gw4[i] & 0xFFFF0000u);
      const int e0 = (c0 + 2 * i) & 127;
      w[i] = pack2(o[2 * i] * rstd * onorm_g[e0] * g0, o[2 * i + 1] * rstd * onorm_g[e0 + 1] * g1);
    }
    *(uint4*)(A + (size_t)row * D + c0) = make_uint4(w[0], w[1], w[2], w[3]);
  }
}
__global__ __launch_bounds__(512) void k_pool_prep(const bf16_t* __restrict__ Up, bf16_t* __restrict__ pd) {
  const int c = threadIdx.x;
  for (int row = blockIdx.x; row < MROWS; row += gridDim.x) {
    int base, t, n; if (row < NLAT) { base = row & ~8191; t = row & 8191; n = SEQ; } else { const int mm = row - NLAT; base = NLAT + (mm & ~255); t = mm & 255; n = CT; }
    const int gi = c >> 7, win = 2 << gi; int lo = t - win / 2, hi = t + win - win / 2; lo = lo < 0 ? 0 : lo; hi = hi > n ? n : hi;
    float s = 0.f; for (int r = lo; r < hi; ++r) s += bf2f(Up[(size_t)(base + r) * 512 + c]);
    pd[(size_t)row * 512 + c] = f2bf(s / (float)(hi - lo) - bf2f(Up[(size_t)row * 512 + c]));
  }
}

__global__ __launch_bounds__(512) void k_router(const float* __restrict__ lat, const float* __restrict__ ctxr, const float* __restrict__ gain, const float* __restrict__ modl,
                                                const float* __restrict__ wrg, const float* __restrict__ brg, const float* __restrict__ wre, const float* __restrict__ bre,
                                                bf16_t* __restrict__ out, int* __restrict__ re, float* __restrict__ rw, int nrows) {
  __shared__ float hs[8][1024];
  const int lane = threadIdx.x & 63, wv = threadIdx.x >> 6, gw = blockIdx.x * 8 + wv;
  const float* wp = lane < 4 ? wrg + lane : wre + ((lane - 4) & 31); const int wst = lane < 4 ? 4 : 32;
  const float bias = lane < 4 ? brg[lane] : bre[(lane - 4) & 31];
  for (int row = gw; row < nrows; row += gridDim.x * 8) {
    const float* src = row < NLAT ? lat + (size_t)row * D : ctxr + (size_t)(row - NLAT) * D;
    const float* mv = modl + row_vec(row) * 6144;
    f32x4 x[4]; float ss = 0.f;
#pragma unroll
    for (int j = 0; j < 4; ++j) { x[j] = ((const f32x4*)src)[lane + 64 * j]; ss += x[j].x * x[j].x + x[j].y * x[j].y + x[j].z * x[j].z + x[j].w * x[j].w; }
    const float rstd = 1.f / sqrtf(wave_sum(ss) * (1.f / D) + EPS);
#pragma unroll
    for (int j = 0; j < 4; ++j) {
      const int n = (lane + 64 * j) * 4;
      const f32x4 g = *(const f32x4*)(gain + n), sc = *(const f32x4*)(mv + 4096 + n), sh = *(const f32x4*)(mv + 3072 + n);
      const f32x4 h = x[j] * rstd * g * (sc + 1.f) + sh;
      uint2 o; o.x = pack2(h.x, h.y); o.y = pack2(h.z, h.w);
      *(uint2*)(out + (size_t)row * D + n) = o;
      *(f32x4*)&hs[wv][n] = h;
    }
    __builtin_amdgcn_wave_barrier();
    float acc = 0.f;
#pragma unroll 8
    for (int k = 0; k < 1024; ++k) acc += hs[wv][k] * wp[(size_t)k * wst];
    acc += bias;
    __builtin_amdgcn_wave_barrier();
    float gl[4];
#pragma unroll
    for (int i = 0; i < 4; ++i) gl[i] = __shfl(acc, i);
    int gi = 0; float gm = gl[0];
#pragma unroll
    for (int i = 1; i < 4; ++i) if (gl[i] > gm) { gm = gl[i]; gi = i; }
    float gs = 0.f;
#pragma unroll
    for (int i = 0; i < 4; ++i) gs += expf(gl[i] - gm);
    const float gp = 1.f / gs;
    float el[8];
#pragma unroll
    for (int i = 0; i < 8; ++i) el[i] = __shfl(acc, 4 + gi * 8 + i);
    int e1 = 0; float m1 = el[0];
#pragma unroll
    for (int i = 1; i < 8; ++i) if (el[i] > m1) { m1 = el[i]; e1 = i; }
    int e2 = 0; float m2 = -3.0e38f;
#pragma unroll
    for (int i = 0; i < 8; ++i) if (i != e1 && el[i] > m2) { m2 = el[i]; e2 = i; }
    const float w1 = 1.f / (1.f + expf(m2 - m1)), w2 = 1.f - w1;
    if (lane == 0) { re[row * 2] = gi * 8 + e1; re[row * 2 + 1] = gi * 8 + e2; rw[row * 2] = gp * w1; rw[row * 2 + 1] = gp * w2; }
  }
}

__global__ __launch_bounds__(256) void k_moe_naive(const bf16_t* __restrict__ H, const int* __restrict__ re, const float* __restrict__ rw,
                                                   const float* __restrict__ Wg, const float* __restrict__ Wu, const float* __restrict__ Wd, bf16_t* __restrict__ Y) {
  const int row = blockIdx.x, f = threadIdx.x;
  __shared__ float hs[1024];
  __shared__ float as_[256];
  for (int i = f; i < 1024; i += 256) hs[i] = bf2f(H[(size_t)row * D + i]);
  __syncthreads();
  for (int slot = 0; slot < 2; ++slot) {
    const int e = re[row * 2 + slot]; const float w = rw[row * 2 + slot];
    const float* wg = Wg + (size_t)e * 1024 * 256 + f; const float* wu = Wu + (size_t)e * 1024 * 256 + f;
    float g = 0.f, u = 0.f;
#pragma unroll 8
    for (int k = 0; k < 1024; ++k) { g += hs[k] * wg[(size_t)k * 256]; u += hs[k] * wu[(size_t)k * 256]; }
    as_[f] = siluf_(g) * u * w;
    __syncthreads();
    const float* wd = Wd + (size_t)e * 256 * 1024;
    float y[4] = {0.f, 0.f, 0.f, 0.f};
#pragma unroll 4
    for (int k = 0; k < 256; ++k) { const float a = as_[k];
#pragma unroll
      for (int i = 0; i < 4; ++i) y[i] += a * wd[(size_t)k * 1024 + f + 256 * i]; }
#pragma unroll
    for (int i = 0; i < 4; ++i) Y[((size_t)row * 2 + slot) * D + f + 256 * i] = f2bf(y[i]);
    __syncthreads();
  }
}

__global__ __launch_bounds__(512) void k_combine_norm(float* __restrict__ lat, float* __restrict__ ctxr, const bf16_t* __restrict__ Y, const float* __restrict__ modl_cur,
                                                      const float* __restrict__ gain, const float* __restrict__ modl_next, bf16_t* __restrict__ hout, int nrows, int final_) {
  const int lane = threadIdx.x & 63, gw = blockIdx.x * 8 + (threadIdx.x >> 6);
  for (int row = gw; row < nrows; row += gridDim.x * 8) {
    float* src = row < NLAT ? lat + (size_t)row * D : ctxr + (size_t)(row - NLAT) * D;
    const int v = row_vec(row);
    f32x4 x[4]; float ss = 0.f;
#pragma unroll
    for (int j = 0; j < 4; ++j) {
      const int n = (lane + 64 * j) * 4;
      const f32x4 g2 = *(const f32x4*)(modl_cur + v * 6144 + 5120 + n);
      const uint2 y0 = *(const uint2*)(Y + ((size_t)row * 2) * D + n), y1 = *(const uint2*)(Y + ((size_t)row * 2 + 1) * D + n);
      f32x4 ys;
      ys.x = __uint_as_float(y0.x << 16) + __uint_as_float(y1.x << 16); ys.y = __uint_as_float(y0.x & 0xFFFF0000u) + __uint_as_float(y1.x & 0xFFFF0000u);
      ys.z = __uint_as_float(y0.y << 16) + __uint_as_float(y1.y << 16); ys.w = __uint_as_float(y0.y & 0xFFFF0000u) + __uint_as_float(y1.y & 0xFFFF0000u);
      x[j] = ((const f32x4*)src)[lane + 64 * j] + g2 * ys;
      ss += x[j].x * x[j].x + x[j].y * x[j].y + x[j].z * x[j].z + x[j].w * x[j].w;
    }
    const float rstd = 1.f / sqrtf(wave_sum(ss) * (1.f / D) + EPS);
#pragma unroll
    for (int j = 0; j < 4; ++j) {
      const int n = (lane + 64 * j) * 4;
      const f32x4 g = *(const f32x4*)(gain + n);
      if (final_) { ((f32x4*)src)[lane + 64 * j] = x[j] * rstd * g; }
      else {
        ((f32x4*)src)[lane + 64 * j] = x[j];
        const f32x4 sc = *(const f32x4*)(modl_next + v * 6144 + 1024 + n), sh = *(const f32x4*)(modl_next + v * 6144 + n);
        const f32x4 h = x[j] * rstd * g * (sc + 1.f) + sh;
        uint2 o; o.x = pack2(h.x, h.y); o.y = pack2(h.z, h.w);
        *(uint2*)(hout + (size_t)row * D + n) = o;
      }
    }
  }
}

__global__ __launch_bounds__(512) void k_rowssq(const bf16_t* __restrict__ cq, const bf16_t* __restrict__ ckv, float* __restrict__ rq, float* __restrict__ rkv) {
  const int lane = threadIdx.x & 63, gw = blockIdx.x * 8 + (threadIdx.x >> 6);
  for (int row = gw; row < MROWS; row += gridDim.x * 8) {
    { const unsigned w = *(const unsigned*)(ckv + (size_t)row * 128 + lane * 2); const float a = __uint_as_float(w << 16), b = __uint_as_float(w & 0xFFFF0000u);
      const float ss = wave_sum(a * a + b * b); if (lane == 0) rkv[row] = 1.f / sqrtf(ss * (1.f / 128.f) + EPS); }
    if (row < NLAT) { const uint2 w = *(const uint2*)(cq + (size_t)row * 256 + lane * 4);
      const float a = __uint_as_float(w.x << 16), b = __uint_as_float(w.x & 0xFFFF0000u), c = __uint_as_float(w.y << 16), d = __uint_as_float(w.y & 0xFFFF0000u);
      const float ss = wave_sum(a * a + b * b + c * c + d * d); if (lane == 0) rq[row] = 1.f / sqrtf(ss * (1.f / 256.f) + EPS); }
  }
}
__device__ __forceinline__ float rope_inv(int i) { return exp2f(-(float)i * (13.287712379549449f / 8.f)); }
__global__ __launch_bounds__(256) void k_kr_rope(const float* __restrict__ kr, bf16_t* __restrict__ dk) {
  const int idx = blockIdx.x * 256 + threadIdx.x; if (idx >= MROWS * 32) return;
  const int m = idx >> 5, j = idx & 31; int b, key; row_bkey(m, b, key);
  float val = kr[idx];
  if (m < NLAT) {
    const int t = m & 8191; const int half = j >> 4, jj = j & 15, i = jj & 7;
    const float pos = half ? (float)(t & 63) : (float)(t >> 6);
    const float ang = pos * rope_inv(i); float sn, cs; sincosf(ang, &sn, &cs);
    const float x1 = kr[(size_t)m * 32 + half * 16 + i], x2 = kr[(size_t)m * 32 + half * 16 + 8 + i];
    val = (jj < 8) ? (x1 * cs - x2 * sn) : (x1 * sn + x2 * cs);
  }
  const bf16_t o = f2bf(val);
#pragma unroll
  for (int hh = 0; hh < 8; ++hh) dk[((size_t)(b * 8 + hh) * NKEY + key) * 128 + 64 + j] = o;
}

__global__ __launch_bounds__(64) void k_na_naive(const bf16_t* __restrict__ nq, const bf16_t* __restrict__ nk, const bf16_t* __restrict__ nv, const float* __restrict__ rpb,
                                                 bf16_t* __restrict__ A) {
  const int t = blockIdx.x * 64 + threadIdx.x, hh = blockIdx.y, b = blockIdx.z;
  const int r = t >> 6, c = t & 63;
  int rs = r - 4; rs = rs < 0 ? 0 : (rs > 120 ? 120 : rs);
  int cs = c - 8; cs = cs < 0 ? 0 : (cs > 48 ? 48 : cs);
  float q[64], o[64];
  const bf16_t* qp = nq + ((size_t)(b * 8 + hh) * SEQ + t) * 64;
#pragma unroll
  for (int d = 0; d < 64; ++d) { q[d] = bf2f(qp[d]); o[d] = 0.f; }
  const bf16_t* Kb = nk + (size_t)(b * 8 + hh) * NKEY * 64; const bf16_t* Vb = nv + (size_t)(b * 8 + hh) * NKEY * 64;
  float mx = -3.0e38f, l = 0.f;
  for (int kk = 0; kk < 128 + CT; ++kk) {
    int key; float bias = 0.f;
    if (kk < 128) { const int kr_ = rs + (kk >> 4), kc = cs + (kk & 15); key = CT + kr_ * 64 + kc; bias = rpb[(hh * 15 + (kr_ - r + 7)) * 31 + (kc - c + 15)] * LOG2E; }
    else key = kk - 128;
    const bf16_t* kp = Kb + (size_t)key * 64; float s = bias;
#pragma unroll
    for (int d = 0; d < 64; d += 2) { const unsigned w = *(const unsigned*)(kp + d); s += q[d] * __uint_as_float(w << 16) + q[d + 1] * __uint_as_float(w & 0xFFFF0000u); }
    const float mn = fmaxf(mx, s), alpha = exp2f(mx - mn), p = exp2f(s - mn);
    l = l * alpha + p; mx = mn;
    const bf16_t* vp = Vb + (size_t)key * 64;
#pragma unroll
    for (int d = 0; d < 64; d += 2) { const unsigned w = *(const unsigned*)(vp + d); o[d] = o[d] * alpha + p * __uint_as_float(w << 16); o[d + 1] = o[d + 1] * alpha + p * __uint_as_float(w & 0xFFFF0000u); }
  }
  const float il = 1.f / l;
  bf16_t* op = A + (size_t)(b * SEQ + t) * D + hh * 64;
#pragma unroll
  for (int d = 0; d < 64; d += 2) *(unsigned*)(op + d) = pack2(o[d] * il, o[d + 1] * il);
}
__global__ __launch_bounds__(64) void k_mla_naive(const bf16_t* __restrict__ dq, const bf16_t* __restrict__ dk, const bf16_t* __restrict__ dv, bf16_t* __restrict__ A) {
  const int t = blockIdx.x * 64 + threadIdx.x, hh = blockIdx.y, b = blockIdx.z;
  float q[96], o[64];
  const bf16_t* qp = dq + ((size_t)(b * 8 + hh) * SEQ + t) * 96;
#pragma unroll
  for (int d = 0; d < 96; ++d) q[d] = bf2f(qp[d]);
#pragma unroll
  for (int half = 0; half < 2; ++half) {
    const float pos = half ? (float)(t & 63) : (float)(t >> 6);
#pragma unroll
    for (int i = 0; i < 8; ++i) { float sn, cs; sincosf(pos * rope_inv(i), &sn, &cs);
      const float x1 = q[64 + half * 16 + i], x2 = q[64 + half * 16 + 8 + i];
      q[64 + half * 16 + i] = x1 * cs - x2 * sn; q[64 + half * 16 + 8 + i] = x1 * sn + x2 * cs; }
  }
#pragma unroll
  for (int d = 0; d < 64; ++d) o[d] = 0.f;
  const bf16_t* Kb = dk + (size_t)(b * 8 + hh) * NKEY * 128; const bf16_t* Vb = dv + (size_t)(b * 8 + hh) * NKEY * 64;
  float mx = -3.0e38f, l = 0.f;
  for (int k0 = 0; k0 < NKEY; k0 += 8) {
    float s[8]; float bm = -3.0e38f;
#pragma unroll
    for (int j = 0; j < 8; ++j) { const bf16_t* kp = Kb + (size_t)(k0 + j) * 128; float a = 0.f;
#pragma unroll
      for (int d = 0; d < 96; d += 2) { const unsigned w = *(const unsigned*)(kp + d); a += q[d] * __uint_as_float(w << 16) + q[d + 1] * __uint_as_float(w & 0xFFFF0000u); }
      s[j] = a; bm = fmaxf(bm, a); }
    const float mn = fmaxf(mx, bm), alpha = exp2f(mx - mn); mx = mn; l *= alpha;
#pragma unroll
    for (int d = 0; d < 64; ++d) o[d] *= alpha;
#pragma unroll
    for (int j = 0; j < 8; ++j) { const float p = exp2f(s[j] - mn); l += p; const bf16_t* vp = Vb + (size_t)(k0 + j) * 64;
#pragma unroll
      for (int d = 0; d < 64; d += 2) { const unsigned w = *(const unsigned*)(vp + d); o[d] += p * __uint_as_float(w << 16); o[d + 1] += p * __uint_as_float(w & 0xFFFF0000u); } }
  }
  const float il = 1.f / l;
  bf16_t* op = A + (size_t)(b * SEQ + t) * D + 512 + hh * 64;
#pragma unroll
  for (int d = 0; d < 64; d += 2) *(unsigned*)(op + d) = pack2(o[d] * il, o[d + 1] * il);
}

typedef short bf16x8 __attribute__((ext_vector_type(8)));
struct MP {
  const float* in[29];
  float* out; char* ws;
  int ph_lo, ph_hi;
};
constexpr int LDS_BYTES = 131072 + 1024;
constexpr int CNT_OFF = 16384;
typedef short s16x4 __attribute__((ext_vector_type(4)));
typedef float f32x16 __attribute__((ext_vector_type(16)));
typedef unsigned u32x4 __attribute__((ext_vector_type(4)));
constexpr float ATT_THR = 11.5f;
constexpr int NCHUNK = MROWS / 64;

struct MK {
  int wv;
  __device__ __forceinline__ int tidx() const { int l = (int)__lane_id(); asm volatile("" : "+v"(l)); return (wv << 6) | l; }
#define MFMA16(a, b, c) __builtin_amdgcn_mfma_f32_16x16x32_bf16(a, b, c, 0, 0, 0)


template <int MI, class Epi>
__device__ __forceinline__ void gemm_tile(const bf16_t* __restrict__ A, int lda, const int* __restrict__ gather, int gshift, int Mvalid,
                                          const bf16_t* __restrict__ Bt, int ldb, int K, int m0, int n0, char* lds, const Epi& epi) {
  constexpr int BM = 64 * MI, ABYTES = BM * 128, STAGE = ABYTES + 128 * 128;
  const int t = tidx(), lane = t & 63, w = t >> 6, wm = w >> 1, wn = w & 1, l15 = lane & 15, lq = lane >> 4;
  const int c = t & 7, r = t >> 3;
  const bf16_t* ap[MI];
#pragma unroll
  for (int i = 0; i < MI; ++i) { int m = m0 + r + 64 * i; m = m < Mvalid ? m : Mvalid - 1; const int row = gather ? (gather[m] >> gshift) : m; ap[i] = A + (size_t)row * lda + c * 8; }
  const bf16_t* bp0 = Bt + (size_t)(n0 + r) * ldb + c * 8; const bf16_t* bp1 = bp0 + (size_t)64 * ldb;
  const int wofs = r * 128 + ((c ^ ((r >> 1) & 7)) << 4);
  const int sw = (l15 >> 1) & 7, x0 = (lq ^ sw) << 4, x1 = x0 ^ 64;
  const int arow = (wm * 16 * MI + l15) * 128, brow = ABYTES + (wn * 64 + l15) * 128;
  f32x4 acc[MI][4];
#pragma unroll
  for (int i = 0; i < MI; ++i)
#pragma unroll
    for (int j = 0; j < 4; ++j) acc[i][j] = (f32x4){0.f, 0.f, 0.f, 0.f};
  uint4 ra[MI], rb0, rb1;
  const int KT = K >> 6;
#pragma unroll
  for (int i = 0; i < MI; ++i) ra[i] = *(const uint4*)(ap[i]);
  rb0 = *(const uint4*)bp0; rb1 = *(const uint4*)bp1;
#pragma unroll
  for (int i = 0; i < MI; ++i) *(uint4*)(lds + wofs + i * 8192) = ra[i];
  *(uint4*)(lds + ABYTES + wofs) = rb0; *(uint4*)(lds + ABYTES + wofs + 8192) = rb1;
  __syncthreads();
  for (int kt = 0; kt < KT; ++kt) {
    char* cur = lds + (kt & 1) * STAGE; char* nxt = lds + ((kt + 1) & 1) * STAGE;
    const bool more = kt + 1 < KT;
    if (more) {
      const int k0 = (kt + 1) << 6;
#pragma unroll
      for (int i = 0; i < MI; ++i) ra[i] = *(const uint4*)(ap[i] + k0);
      rb0 = *(const uint4*)(bp0 + k0); rb1 = *(const uint4*)(bp1 + k0);
    }
#pragma unroll
    for (int ks = 0; ks < 2; ++ks) {
      const int xo = ks ? x1 : x0;
      bf16x8 af[MI], bfv[4];
#pragma unroll
      for (int i = 0; i < MI; ++i) af[i] = *(const bf16x8*)(cur + arow + i * 2048 + xo);
#pragma unroll
      for (int j = 0; j < 4; ++j) bfv[j] = *(const bf16x8*)(cur + brow + j * 2048 + xo);
#pragma unroll
      for (int i = 0; i < MI; ++i)
#pragma unroll
        for (int j = 0; j < 4; ++j) acc[i][j] = MFMA16(bfv[j], af[i], acc[i][j]);
    }
    if (more) {
#pragma unroll
      for (int i = 0; i < MI; ++i) *(uint4*)(nxt + wofs + i * 8192) = ra[i];
      *(uint4*)(nxt + ABYTES + wofs) = rb0; *(uint4*)(nxt + ABYTES + wofs + 8192) = rb1;
    }
    __syncthreads();
  }
  epi.tile(acc, m0 + wm * 16 * MI + l15, n0 + wn * 64 + lq * 4, Mvalid);
}
template <class E> struct EpiEach {
  E e;
  template <int MI> __device__ __forceinline__ void tile(const f32x4 (&acc)[MI][4], int mb, int nb, int Mvalid) const {
#pragma unroll
    for (int i = 0; i < MI; ++i) { const int m = mb + i * 16; if (m < Mvalid) {
#pragma unroll
      for (int j = 0; j < 4; ++j) e.apply(m, nb + j * 16, acc[i][j]); } }
  }
};
template <int MI, class E>
__device__ __forceinline__ void gemm_phase(const bf16_t* A, int lda, const bf16_t* Bt, int ldb, int M, int N, int K, const E& e, char* lds) {
  constexpr int BM = 64 * MI; const int ntm = (M + BM - 1) / BM, ntn = N >> 7;
  EpiEach<E> ee; ee.e = e;
  for (int tile = blockIdx.x; tile < ntm * ntn; tile += gridDim.x) { const int mt = tile / ntn, nt = tile - mt * ntn; gemm_tile<MI>(A, lda, nullptr, 0, M, Bt, ldb, K, mt * BM, nt * 128, lds, ee); }
}

#define PG8_LAS __attribute__((address_space(3)))
static constexpr int BM = 256, BK = 64, HALF = 128, HTB = HALF * BK * 2, STAGE_BYTES = 8 * HTB, NXCD = 8, WGM = 8;
static __device__ __forceinline__ int lds_byte(int r, int c) { const int st = (r >> 4) * 2 + (c >> 5), rr = r & 15, cc = c & 31, ob = rr * 64 + cc * 2; return st * 1024 + (ob ^ (((ob >> 9) & 1) << 5)); }
static __device__ __forceinline__ void stage_rc(int b, int& R, int& C) { const int st = b / 1024, sb = b % 1024, swz = sb ^ (((sb >> 9) & 1) << 5); R = (st >> 1) * 16 + swz / 64; C = (st & 1) * 32 + (swz % 64) / 2; }
static __device__ __forceinline__ int perm32(int rho) { const int n = rho >> 4, i = rho & 15; return 8 * (i >> 2) + 4 * n + (i & 3); }

struct Unit { int pm, pn; };
struct Gemm { const bf16_t* A; const bf16_t* Bt; int M, N, K; };
struct StaticOrder {
    int nM, nN, nwg, G, c;
    __device__ void init(int M, int N, int G_, int c_) { nM = M / BM; nN = N / BM; nwg = nM * nN; G = G_; c = c_; }
    __device__ bool next(int i, Unit& u) const {
        const long L = (long)i * G + c; if (L >= nwg) return false;
        int wgid = (int)L; { const int q = nwg / NXCD, r = nwg % NXCD, xcd = wgid % NXCD, off = wgid / NXCD; wgid = (xcd < r ? xcd * (q + 1) : r * (q + 1) + (xcd - r) * q) + off; }
        const int nig = WGM * nN, gid = wgid / nig, fm = gid * WGM, gsz = (nM - fm) < WGM ? (nM - fm) : WGM;
        u.pm = fm + ((wgid % nig) % gsz); u.pn = (wgid % nig) / gsz; return true;
    }
    __device__ __forceinline__ void a_ready(const Unit&) const {}
    __device__ __forceinline__ void done(const Unit&) const {}
};
template <class Epi, class Sched>
__device__ __forceinline__ void pg8_phase(PG8_LAS unsigned char* lds, const Gemm g, const Sched& S, const Epi& E) {
    const int tid = tidx(), wid = __builtin_amdgcn_readfirstlane(tid >> 6), lane = tid & 63, wr = wid >> 2, wc = wid & 3, fr = lane & 15, fq = lane >> 4;
    const int K = g.K, nt = K / BK;
    unsigned voffA[2], voffB[2];
#pragma unroll
    for (int i = 0; i < 2; ++i) { int R, C; stage_rc(tid * 16 + i * 8192, R, C); const int Rb = Epi::PERM ? ((R & ~31) + perm32(R & 31)) : R;
        voffA[i] = (unsigned)(R * K + C) * 2u; voffB[i] = (unsigned)(Rb * K + C) * 2u; }
    const size_t kstep = (size_t)(BK * 2);
    const size_t hstep = (size_t)HALF * K * 2;
    const size_t tstep = 2 * hstep;
    const unsigned ldsw = (unsigned)wid * 1024u;
    const int aoff = lds_byte(wr * 64 + fr, fq * 8), boff = lds_byte(wc * 32 + fr, fq * 8);
#define PG8_SA(b, h) (((b) * 2 + (h)) * HTB)
#define PG8_SB(b, h) ((4 + (b) * 2 + (h)) * HTB)
#define PG8_STAGE(bufoff, gbase, voff) do { _Pragma("unroll") for (int _i = 0; _i < 2; ++_i) \
        __builtin_amdgcn_global_load_lds((const unsigned*)((const char*)(gbase) + (voff)[_i]), (PG8_LAS unsigned*)(lds + (bufoff) + ldsw + _i * 8192), 16, 0, 0); } while (0)
#define PG8_LDA(dst, b, h) do { _Pragma("unroll") for (int m = 0; m < 4; ++m) _Pragma("unroll") for (int k = 0; k < 2; ++k) dst[m][k] = *(const PG8_LAS bf16x8*)(lds + PG8_SA(b, h) + aoff + m * 2048 + k * 1024); } while (0)
#define PG8_LDB(dst, b, h) do { _Pragma("unroll") for (int n = 0; n < 2; ++n) _Pragma("unroll") for (int k = 0; k < 2; ++k) dst[n][k] = *(const PG8_LAS bf16x8*)(lds + PG8_SB(b, h) + boff + n * 2048 + k * 1024); } while (0)
#define PG8_MMA(ai, bj, At, Bt) do { __builtin_amdgcn_s_setprio(1); _Pragma("unroll") for (int m = 0; m < 4; ++m) _Pragma("unroll") for (int n = 0; n < 2; ++n) _Pragma("unroll") for (int k = 0; k < 2; ++k) \
        acc[ai][bj][m][n] = __builtin_amdgcn_mfma_f32_16x16x32_bf16(Bt[n][k], At[m][k], acc[ai][bj][m][n], 0, 0, 0); __builtin_amdgcn_s_setprio(0); } while (0)
#define PG8_WAIT_V(n) asm volatile("s_waitcnt vmcnt(" #n ")" ::: "memory")
#define PG8_WAIT_L(n) asm volatile("s_waitcnt lgkmcnt(" #n ")" ::: "memory")
#define PG8_BAR __builtin_amdgcn_s_barrier()
#define PG8_SCHED __builtin_amdgcn_sched_barrier(0)
    Unit cur, nxt; int ui = 0;
    if (!S.next(0, cur)) return;
    f32x4 acc[2][2][4][2];
#pragma unroll
    for (int a = 0; a < 2; ++a)
#pragma unroll
        for (int b = 0; b < 2; ++b)
#pragma unroll
            for (int m = 0; m < 4; ++m)
#pragma unroll
                for (int n = 0; n < 2; ++n) acc[a][b][m][n] = (f32x4){0.f, 0.f, 0.f, 0.f};
    bf16x8 At[4][2], B0[2][2], B1[2][2];
    const char* cA = (const char*)g.A + (size_t)cur.pm * tstep; const char* cB = (const char*)g.Bt + (size_t)cur.pn * tstep;
    S.a_ready(cur);
    PG8_STAGE(PG8_SB(0, 0), cB, voffB); PG8_STAGE(PG8_SA(0, 0), cA, voffA); PG8_STAGE(PG8_SB(0, 1), cB + hstep, voffB); PG8_STAGE(PG8_SA(0, 1), cA + hstep, voffA);
    if (wr == 1) PG8_BAR;
    PG8_WAIT_V(4); PG8_BAR;
    PG8_STAGE(PG8_SB(1, 0), cB + kstep, voffB); PG8_STAGE(PG8_SA(1, 0), cA + kstep, voffA); PG8_STAGE(PG8_SB(1, 1), cB + hstep + kstep, voffB);
    PG8_WAIT_V(6); PG8_BAR;
    for (;;) {
        const bool has_next = S.next(ui + 1, nxt);
        const char* nA = has_next ? (const char*)g.A + (size_t)nxt.pm * tstep : cA; const char* nB = has_next ? (const char*)g.Bt + (size_t)nxt.pn * tstep : cB;
        for (int t = 0; t < nt; t += 2) {
            const bool last = (t == nt - 2);
            const char* a1 = cA + (size_t)(t + 1) * kstep;
            const char* a2 = last ? nA : cA + (size_t)(t + 2) * kstep; const char* b2 = last ? nB : cB + (size_t)(t + 2) * kstep;
            const char* a3 = a2 + kstep; const char* b3 = b2 + kstep;
            if (last && has_next) S.a_ready(nxt);
            PG8_LDB(B0, 0, 0); PG8_SCHED; PG8_LDA(At, 0, 0); PG8_STAGE(PG8_SA(1, 1), a1 + hstep, voffA);
            PG8_WAIT_L(8); PG8_BAR; PG8_WAIT_L(0); PG8_MMA(0, 0, At, B0); PG8_BAR; PG8_SCHED;
            PG8_LDB(B1, 0, 1); PG8_STAGE(PG8_SB(0, 0), b2, voffB);
            PG8_BAR; PG8_WAIT_L(0); PG8_MMA(0, 1, At, B1); PG8_BAR;
            PG8_LDA(At, 0, 1); PG8_STAGE(PG8_SA(0, 0), a2, voffA);
            PG8_BAR; PG8_WAIT_L(0); PG8_MMA(1, 0, At, B0); PG8_BAR; PG8_SCHED;
            PG8_STAGE(PG8_SB(0, 1), b2 + hstep, voffB);
            PG8_WAIT_V(6); PG8_BAR; PG8_MMA(1, 1, At, B1); PG8_BAR;
            PG8_LDB(B0, 1, 0); PG8_SCHED; PG8_LDA(At, 1, 0); PG8_STAGE(PG8_SA(0, 1), a2 + hstep, voffA);
            PG8_WAIT_L(8); PG8_BAR; PG8_WAIT_L(0); PG8_MMA(0, 0, At, B0); PG8_BAR; PG8_SCHED;
            PG8_LDB(B1, 1, 1); PG8_STAGE(PG8_SB(1, 0), b3, voffB);
            PG8_BAR; PG8_WAIT_L(0); PG8_MMA(0, 1, At, B1); PG8_BAR;
            PG8_LDA(At, 1, 1); PG8_STAGE(PG8_SA(1, 0), a3, voffA);
            PG8_BAR; PG8_WAIT_L(0); PG8_MMA(1, 0, At, B0); PG8_BAR; PG8_SCHED;
            PG8_STAGE(PG8_SB(1, 1), b3 + hstep, voffB);
            PG8_WAIT_V(6); PG8_BAR; PG8_MMA(1, 1, At, B1); PG8_BAR;
        }
        if constexpr (!Epi::AFTER_DRAIN) { E(acc, cur, wr, wc, fr, fq); S.done(cur); }
        if (!has_next) break;
#pragma unroll
        for (int a = 0; a < 2; ++a)
#pragma unroll
            for (int b = 0; b < 2; ++b)
#pragma unroll
                for (int m = 0; m < 4; ++m)
#pragma unroll
                    for (int n = 0; n < 2; ++n) acc[a][b][m][n] = (f32x4){0.f, 0.f, 0.f, 0.f};
        cur = nxt; cA = nA; cB = nB; ++ui;
    }
    PG8_WAIT_V(0);
    if (wr == 0) PG8_BAR;
    PG8_BAR;
    if constexpr (Epi::AFTER_DRAIN) { E.fused(acc, cur, wr, wc, fr, fq, lds, wid, lane); S.done(cur); }
#undef PG8_SA
#undef PG8_SB
#undef PG8_STAGE
#undef PG8_LDA
#undef PG8_LDB
#undef PG8_MMA
#undef PG8_WAIT_V
#undef PG8_WAIT_L
#undef PG8_BAR
#undef PG8_SCHED
}

template <class E> struct Pg8Each {
  static constexpr bool PERM = false, AFTER_DRAIN = false; E e;
  __device__ __forceinline__ void operator()(const f32x4 (&acc)[2][2][4][2], const Unit& u, int wr, int wc, int fr, int fq) const {
#pragma unroll
    for (int ai = 0; ai < 2; ++ai)
#pragma unroll
      for (int m = 0; m < 4; ++m) { const int row = u.pm * BM + ai * HALF + wr * 64 + m * 16 + fr;
#pragma unroll
        for (int bj = 0; bj < 2; ++bj)
#pragma unroll
          for (int n = 0; n < 2; ++n) e.apply(row, u.pn * BM + bj * HALF + wc * 32 + n * 16 + fq * 4, acc[ai][bj][m][n]); }
  }
};
template <class E>
__device__ __forceinline__ void gemm_phase8(const bf16_t* A, const bf16_t* Bt, int Mbig, int M, int N, int K, const E& e, char* lds, int ctx_n0, int ctx_n1) {
  { Gemm g; g.A = A; g.Bt = Bt; g.M = Mbig; g.N = N; g.K = K; StaticOrder S; S.init(Mbig, N, (int)gridDim.x, (int)blockIdx.x); Pg8Each<E> pe; pe.e = e;
    pg8_phase((PG8_LAS unsigned char*)lds, g, S, pe); }
  if (M > Mbig) { EpiEach<E> ee; ee.e = e; const int ntm = (M - Mbig) >> 7, ntn = (ctx_n1 - ctx_n0) >> 7;
    for (int tile = (int)gridDim.x - 1 - (int)blockIdx.x; tile < ntm * ntn; tile += gridDim.x) { const int mt = tile / ntn, nt = tile - mt * ntn;
      gemm_tile<2>(A, K, nullptr, 0, M, Bt, K, K, Mbig + mt * 128, ctx_n0 + nt * 128, lds, ee); } }
}

template <int K>
static __device__ __forceinline__ float row_rstd4(const bf16_t* rowp, int lq) {
  constexpr int PER = K / 4; float ss = 0.f;
#pragma unroll
  for (int i = 0; i < PER / 8; ++i) { const uint4 v = *(const uint4*)(rowp + lq * PER + i * 8); const unsigned wv[4] = {v.x, v.y, v.z, v.w};
#pragma unroll
    for (int q = 0; q < 4; ++q) { const float a = __uint_as_float(wv[q] << 16), b = __uint_as_float(wv[q] & 0xFFFF0000u); ss += a * a + b * b; } }
  ss += __shfl_xor(ss, 16); ss += __shfl_xor(ss, 32);
  return 1.f / sqrtf(ss * (1.f / K) + EPS);
}
struct EpiMlaQ2 {
  bf16_t* dq; const bf16_t* cq;
  template <int MI> __device__ __forceinline__ void tile(const f32x4 (&acc)[MI][4], int mb, int nb, int Mvalid) const {
#pragma unroll
    for (int i = 0; i < MI; ++i) { const int m = mb + i * 16; const float rs = row_rstd4<256>(cq + (size_t)m * 256, (nb >> 2) & 3) * MLA_QSCALE;
#pragma unroll
      for (int j = 0; j < 4; ++j) { const int n = nb + j * 16; const int hh = n / 96, off = n - hh * 96; const f32x4 v = acc[i][j] * rs;
        uint2 wv; wv.x = pack2(v.x, v.y); wv.y = pack2(v.z, v.w);
        *(uint2*)(dq + (((size_t)((m >> 13) * 8 + hh) * SEQ + (m & 8191)) * 96 + off)) = wv; } }
  }
};
struct EpiMlaKV2 {
  bf16_t *dk, *dv; const bf16_t* ckv;
  template <int MI> __device__ __forceinline__ void tile(const f32x4 (&acc)[MI][4], int mb, int nb, int Mvalid) const {
#pragma unroll
    for (int i = 0; i < MI; ++i) { const int m = mb + i * 16; const float rs = row_rstd4<128>(ckv + (size_t)m * 128, (nb >> 2) & 3);
      int b, key; row_bkey(m, b, key);
#pragma unroll
      for (int j = 0; j < 4; ++j) { const int n = nb + j * 16; const int hh = n >> 7, off = n & 127; const f32x4 v = acc[i][j] * rs;
        uint2 wv; wv.x = pack2(v.x, v.y); wv.y = pack2(v.z, v.w);
        if (off < 64) *(uint2*)(dk + (((size_t)(b * 8 + hh) * NKEY + key) * 128 + off)) = wv;
        else *(uint2*)(dv + (((size_t)(b * 8 + hh) * NKEY + key) * 64 + (off - 64))) = wv; } }
  }
};
struct EpiMoe1 {
  bf16_t* amoe; const int* list; const float* rw; int off_e, nt;
  template <int MI> __device__ __forceinline__ void tile(const f32x4 (&acc)[MI][4], int mb, int nb, int Mvalid) const {
    const int wn = (nb >> 6) & 1, lq = (nb >> 2) & 3;
#pragma unroll
    for (int i = 0; i < MI; ++i) { const int m = mb + i * 16; if (m < Mvalid) { const float wgt = rw[list[m]];
#pragma unroll
      for (int i2 = 0; i2 < 2; ++i2) { const f32x4 g = acc[i][i2], u = acc[i][2 + i2];
        const float a0 = siluf_(g.x) * u.x * wgt, a1 = siluf_(g.y) * u.y * wgt, a2 = siluf_(g.z) * u.z * wgt, a3 = siluf_(g.w) * u.w * wgt;
        uint2 wv; wv.x = pack2(a0, a1); wv.y = pack2(a2, a3);
        *(uint2*)(amoe + (size_t)(off_e + m) * 256 + nt * 64 + wn * 32 + i2 * 16 + lq * 4) = wv; } } }
  }
};
struct EpiMoe2 {
  bf16_t* Y; const int* list; int m_base;
  __device__ __forceinline__ void apply(int m, int n, f32x4 v) const {
    uint2 wv; wv.x = pack2(v.x, v.y); wv.y = pack2(v.z, v.w);
    *(uint2*)(Y + (size_t)list[m - m_base] * D + n) = wv;
  }
};

__device__ __forceinline__ void ph_ada(const MP& p, char* lds) {
  float* sv = (float*)lds;
  float* red = sv + 3 * 1024;
  const float* c = p.in[1]; const float* cctx = p.in[3]; float* mods = (float*)(p.ws + WS_MODS);
  const int j = tidx() & 63, kg = tidx() >> 6;
  for (int i = tidx(); i < 1024; i += 512) { sv[i] = siluf_(c[i]); sv[1024 + i] = siluf_(c[1024 + i]); sv[2048 + i] = siluf_(cctx[i]); }
  __syncthreads();
  for (int item = blockIdx.x; item < 192; item += gridDim.x) {
    const int l = item / 96, n0 = (item % 96) * 64;
    const float* W = p.in[4] + (size_t)l * 1024 * 6144 + n0 + j;
    float a0 = 0.f, a1 = 0.f, a2 = 0.f;
#pragma unroll 8
    for (int k = kg * 128; k < kg * 128 + 128; ++k) { const float wv = W[(size_t)k * 6144]; a0 += sv[k] * wv; a1 += sv[1024 + k] * wv; a2 += sv[2048 + k] * wv; }
    red[(kg * 3 + 0) * 64 + j] = a0; red[(kg * 3 + 1) * 64 + j] = a1; red[(kg * 3 + 2) * 64 + j] = a2;
    __syncthreads();
    if (tidx() < 192) { const int v = tidx() >> 6, jj = tidx() & 63; float s = 0.f;
      for (int g = 0; g < 8; ++g) s += red[(g * 3 + v) * 64 + jj];
      mods[(size_t)(l * 3 + v) * 6144 + n0 + jj] = s + p.in[5][l * 6144 + n0 + jj]; }
    __syncthreads();
  }
  if (blockIdx.x == gridDim.x - 1) { float* lb = (float*)(p.ws + WS_LB);
    for (int i = tidx(); i < 1024; i += 512) { const int d = i >> 9, cc = i & 511; const float l0 = p.in[10][(d * 2) * 512 + cc], l1 = p.in[10][(d * 2 + 1) * 512 + cc]; lb[i] = 1.f / (1.f + expf(l1 - l0)); } }
}
__device__ __forceinline__ void conv_tiles(const float* src, bf16_t* dst, const float* kscale, int K, int N, int Npad, int mode, int batch, size_t sbs, size_t dbs, char* lds) {
  float* tile = (float*)lds;
  const int ntn = (Npad + 63) >> 6, ntk = K >> 6, per = ntn * ntk, tx = tidx() & 63, ty = tidx() >> 6;
  for (int item = blockIdx.x; item < per * batch; item += gridDim.x) {
    const int bz = item / per, rem = item - bz * per, kb = rem / ntn, nb = rem - kb * ntn, n0 = nb * 64, k0 = kb * 64;
    const float* s = src + bz * sbs; bf16_t* d = dst + bz * dbs;
#pragma unroll
    for (int i = 0; i < 8; ++i) { const int k = k0 + ty + 8 * i, n = n0 + tx; float v = 0.f;
      if (n < N) { v = s[(size_t)k * N + n]; if (kscale) v *= kscale[k]; }
      tile[(ty + 8 * i) * 65 + tx] = v; }
    __syncthreads();
#pragma unroll
    for (int i = 0; i < 8; ++i) { const int nl = ty + 8 * i, n = n0 + nl;
      if (n < Npad) { int row = n; if (mode == 1) row = moe_gu_row(0, n); else if (mode == 2) row = moe_gu_row(1, n);
        d[(size_t)row * K + k0 + tx] = f2bf(tile[tx * 65 + nl]); } }
    __syncthreads();
  }
}
__device__ __forceinline__ void ph_conv_small(const MP& p, char* lds) {
  char* ws = p.ws;
  conv_tiles(p.in[8], (bf16_t*)(ws + WS_WT_ABIN), nullptr, 1024, 3072, 3072, 0, 1, 0, 0, lds);
  conv_tiles(p.in[9], (bf16_t*)(ws + WS_WT_ABOUT), nullptr, 1024, 1024, 1024, 0, 1, 0, 0, lds);
  conv_tiles(p.in[14], (bf16_t*)(ws + WS_WT_CDIN), nullptr, 1024, 1952, 2048, 0, 1, 0, 0, lds);
  conv_tiles(p.in[15], (bf16_t*)(ws + WS_WT_CDOUT), nullptr, 1024, 1024, 1024, 0, 1, 0, 0, lds);
  conv_tiles(p.in[18], (bf16_t*)(ws + WS_WT_UQ), p.in[17], 256, 768, 768, 0, 1, 0, 0, lds);
  conv_tiles(p.in[20], (bf16_t*)(ws + WS_WT_UKV), p.in[19], 128, 1024, 1024, 0, 1, 0, 0, lds);
  conv_tiles(p.in[12], (bf16_t*)(ws + WS_WT_POOL), nullptr, 128, 128, 128, 0, 4, (size_t)128 * 128, (size_t)128 * 128, lds);
}
__device__ __forceinline__ void ph_conv_moe(const MP& p, int layer, char* lds) {
  bf16_t* wgu = (bf16_t*)(p.ws + WS_WMOE); bf16_t* wd = wgu + (size_t)32 * 512 * 1024;
  const size_t lo = (size_t)layer * 32 * 1024 * 256;
  conv_tiles(p.in[25] + lo, wgu, nullptr, 1024, 256, 256, 1, 32, (size_t)1024 * 256, (size_t)512 * 1024, lds);
  conv_tiles(p.in[26] + lo, wgu, nullptr, 1024, 256, 256, 2, 32, (size_t)1024 * 256, (size_t)512 * 1024, lds);
  conv_tiles(p.in[27] + lo, wd, nullptr, 256, 1024, 1024, 0, 32, (size_t)256 * 1024, (size_t)1024 * 256, lds);
}
__device__ __forceinline__ void ph_norm_mod(const float* lat, const float* ctxr, const float* gain, const float* modl, int sh_off, int sc_off, bf16_t* out, int nrows) {
  const int lane = tidx() & 63, gw = blockIdx.x * 8 + (tidx() >> 6);
  for (int row = gw; row < nrows; row += gridDim.x * 8) {
    const float* src = row < NLAT ? lat + (size_t)row * D : ctxr + (size_t)(row - NLAT) * D;
    const float* mv = modl + row_vec(row) * 6144;
    f32x4 x[4]; float ss = 0.f;
#pragma unroll
    for (int j = 0; j < 4; ++j) { x[j] = ((const f32x4*)src)[lane + 64 * j]; ss += x[j].x * x[j].x + x[j].y * x[j].y + x[j].z * x[j].z + x[j].w * x[j].w; }
    const float rstd = 1.f / sqrtf(wave_sum(ss) * (1.f / D) + EPS);
#pragma unroll
    for (int j = 0; j < 4; ++j) {
      const int n = (lane + 64 * j) * 4;
      const f32x4 g = *(const f32x4*)(gain + n), sc = *(const f32x4*)(mv + sc_off + n), sh = *(const f32x4*)(mv + sh_off + n);
      const f32x4 h = x[j] * rstd * g * (sc + 1.f) + sh;
      uint2 o; o.x = pack2(h.x, h.y); o.y = pack2(h.z, h.w);
      *(uint2*)(out + (size_t)row * D + n) = o;
    }
  }
}
template <int HALF>
__device__ __forceinline__ void pool_prep_col(const bf16_t* Up, bf16_t* pd, int r0, int seg_lo, int seg_hi, int c) {
  float a[80];
#pragma unroll
  for (int i = 0; i < 80; ++i) { const int r = r0 - 8 + i; const bool in = (r >= seg_lo) && (r < seg_hi); const int rc = in ? r : r0; const float v = bf2f(Up[(size_t)rc * 512 + c]); a[i] = in ? v : 0.f; }
  float sum = 0.f;
#pragma unroll
  for (int i = 8 - HALF; i < 8 + HALF; ++i) sum += a[i];
#pragma unroll
  for (int j = 0; j < 64; ++j) {
    const int t = r0 + j; int lo = t - HALF, hi = t + HALF; lo = lo < seg_lo ? seg_lo : lo; hi = hi > seg_hi ? seg_hi : hi;
    pd[(size_t)t * 512 + c] = f2bf(sum / (float)(hi - lo) - a[8 + j]);
    if (j < 63) sum += a[8 + j + HALF] - a[8 + j - HALF];
  }
}
__device__ __forceinline__ void ph_pool_prep(const bf16_t* Up, bf16_t* pd) {
  const int c = tidx(), gi = c >> 7;
  for (int cid = blockIdx.x; cid < NCHUNK; cid += gridDim.x) {
    const int r0 = cid * 64; int seg_lo, seg_hi;
    if (r0 < NLAT) { seg_lo = r0 & ~8191; seg_hi = seg_lo + SEQ; } else { seg_lo = NLAT + ((r0 - NLAT) & ~255); seg_hi = seg_lo + CT; }
    if (gi == 0) pool_prep_col<1>(Up, pd, r0, seg_lo, seg_hi, c);
    else if (gi == 1) pool_prep_col<2>(Up, pd, r0, seg_lo, seg_hi, c);
    else if (gi == 2) pool_prep_col<4>(Up, pd, r0, seg_lo, seg_hi, c);
    else pool_prep_col<8>(Up, pd, r0, seg_lo, seg_hi, c);
  }
}
__device__ __forceinline__ void ph_router(const MP& p, int layer, int nrows, char* lds) {
  float* hs = (float*)lds;
  float* part = (float*)(lds + 66048);
  float* lgs = (float*)(lds + 66048 + 24576);
  const float* lat = p.out; const float* ctxr = (const float*)(p.ws + WS_XC); const float* gain = p.in[7] + layer * 1024;
  const float* modl = (const float*)(p.ws + WS_MODS) + layer * 3 * 6144;
  const float* wrg = p.in[21] + layer * 1024 * 4; const float* brg = p.in[22] + layer * 4; const float* wre = p.in[23] + layer * 1024 * 32; const float* bre = p.in[24] + layer * 32;
  bf16_t* out = (bf16_t*)(p.ws + WS_H); float* rw = (float*)(p.ws + WS_ROUTE_W);
  int* cnt = (int*)(p.ws + WS_CTL + CNT_OFF) + layer * 32; int* list = (int*)(p.ws + WS_LIST);
  const int tid = tidx(), lane = tid & 63, w = tid >> 6, l15 = lane & 15, lq = lane >> 4;
  float Bq[8][4][3];
#pragma unroll
  for (int g = 0; g < 8; ++g)
#pragma unroll
    for (int u = 0; u < 4; ++u)
#pragma unroll
      for (int nt = 0; nt < 3; ++nt) { const int kk = w * 128 + 16 * g + 4 * lq + u, col = nt * 16 + l15;
        Bq[g][u][nt] = col < 4 ? wrg[kk * 4 + col] : (col < 36 ? wre[kk * 32 + (col - 4)] : 0.f); }
  const int ntiles = nrows >> 4;
  for (int tile = blockIdx.x; tile < ntiles; tile += gridDim.x) {
#pragma unroll
    for (int rr = 0; rr < 2; ++rr) {
      const int lr = 2 * w + rr, row = tile * 16 + lr;
      const float* src = row < NLAT ? lat + (size_t)row * D : ctxr + (size_t)(row - NLAT) * D;
      const float* mv = modl + row_vec(row) * 6144;
      f32x4 x[4]; float ss = 0.f;
#pragma unroll
      for (int j = 0; j < 4; ++j) { x[j] = ((const f32x4*)src)[lane + 64 * j]; ss += x[j].x * x[j].x + x[j].y * x[j].y + x[j].z * x[j].z + x[j].w * x[j].w; }
      const float rstd = 1.f / sqrtf(wave_sum(ss) * (1.f / D) + EPS);
#pragma unroll
      for (int j = 0; j < 4; ++j) {
        const int n = (lane + 64 * j) * 4;
        const f32x4 g = *(const f32x4*)(gain + n), sc = *(const f32x4*)(mv + 4096 + n), sh = *(const f32x4*)(mv + 3072 + n);
        const f32x4 h = x[j] * rstd * g * (sc + 1.f) + sh;
        uint2 o; o.x = pack2(h.x, h.y); o.y = pack2(h.z, h.w);
        *(uint2*)(out + (size_t)row * D + n) = o;
        *(f32x4*)&hs[lr * 1032 + n] = h;
      }
    }
    __syncthreads();
    f32x4 acc[3];
#pragma unroll
    for (int nt = 0; nt < 3; ++nt) acc[nt] = (f32x4){0.f, 0.f, 0.f, 0.f};
#pragma unroll
    for (int g = 0; g < 8; ++g) {
      const f32x4 a4 = *(const f32x4*)&hs[l15 * 1032 + w * 128 + 16 * g + 4 * lq];
      const float av[4] = {a4.x, a4.y, a4.z, a4.w};
#pragma unroll
      for (int u = 0; u < 4; ++u)
#pragma unroll
        for (int nt = 0; nt < 3; ++nt) acc[nt] = __builtin_amdgcn_mfma_f32_16x16x4f32(av[u], Bq[g][u][nt], acc[nt], 0, 0, 0);
    }
#pragma unroll
    for (int nt = 0; nt < 3; ++nt) { const float av[4] = {acc[nt].x, acc[nt].y, acc[nt].z, acc[nt].w};
#pragma unroll
      for (int r = 0; r < 4; ++r) part[(w * 16 + lq * 4 + r) * 48 + nt * 16 + l15] = av[r]; }
    __syncthreads();
    for (int i = tid; i < 16 * 36; i += 512) { const int row = i / 36, col = i - row * 36; float sacc = col < 4 ? brg[col] : bre[col - 4];
#pragma unroll
      for (int ww = 0; ww < 8; ++ww) sacc += part[(ww * 16 + row) * 48 + col];
      lgs[i] = sacc; }
    __syncthreads();
    if (tid < 16) {
      const int row = tile * 16 + tid; const float* lg = lgs + tid * 36;
      int gi = 0; float gm = lg[0];
#pragma unroll
      for (int i = 1; i < 4; ++i) if (lg[i] > gm) { gm = lg[i]; gi = i; }
      float gs = 0.f;
#pragma unroll
      for (int i = 0; i < 4; ++i) gs += expf(lg[i] - gm);
      const float gp = 1.f / gs;
      const float* el = lg + 4 + gi * 8;
      int e1 = 0; float m1 = el[0];
#pragma unroll
      for (int i = 1; i < 8; ++i) if (el[i] > m1) { m1 = el[i]; e1 = i; }
      int e2 = 0; float m2 = -3.0e38f;
#pragma unroll
      for (int i = 0; i < 8; ++i) if (i != e1 && el[i] > m2) { m2 = el[i]; e2 = i; }
      const float w1 = 1.f / (1.f + expf(m2 - m1)), w2 = 1.f - w1;
      const int ea = gi * 8 + e1, eb = gi * 8 + e2;
      rw[row * 2] = gp * w1; rw[row * 2 + 1] = gp * w2;
      const int pa = atomicAdd(&cnt[ea], 1); list[(size_t)ea * MROWS + pa] = row * 2;
      const int pb = atomicAdd(&cnt[eb], 1); list[(size_t)eb * MROWS + pb] = row * 2 + 1;
    }
  }
}
template <int BM>
__device__ __forceinline__ int moe_tables(const MP& p, int layer, int ntn, int* tb) {
  const int* cnt = (const int*)(p.ws + WS_CTL + CNT_OFF) + layer * 32;
  __syncthreads();
  if (tidx() == 0) { int off = 0, ts = 0;
    for (int e = 0; e < 32; ++e) { const int c = __hip_atomic_load(&cnt[e], __ATOMIC_RELAXED, __HIP_MEMORY_SCOPE_AGENT); tb[e] = c; tb[32 + e] = off; tb[64 + e] = ts; off += c; ts += ((c + BM - 1) / BM) * ntn; }
    tb[96] = ts; }
  __syncthreads();
  return tb[96];
}
template <int MI>
__device__ __forceinline__ void ph_moe1(const MP& p, int layer, char* lds) {
  constexpr int BM = 64 * MI; int* tb = (int*)(lds + LDS_BYTES - 1024);
  const int total = moe_tables<BM>(p, layer, 4, tb);
  const bf16_t* H = (const bf16_t*)(p.ws + WS_H); const bf16_t* wgu = (const bf16_t*)(p.ws + WS_WMOE);
  for (int tile = blockIdx.x; tile < total; tile += gridDim.x) {
    int e = 0;
#pragma unroll 1
    for (int q = 1; q < 32; ++q) if (tb[64 + q] <= tile) e = q;
    const int lt = tile - tb[64 + e], mt = lt >> 2, nt = lt & 3;
    EpiMoe1 ep; ep.amoe = (bf16_t*)(p.ws + WS_AMOE); ep.list = (const int*)(p.ws + WS_LIST) + (size_t)e * MROWS; ep.rw = (const float*)(p.ws + WS_ROUTE_W); ep.off_e = tb[32 + e]; ep.nt = nt;
    gemm_tile<MI>(H, D, ep.list, 1, tb[e], wgu + (size_t)e * 512 * 1024, 1024, 1024, mt * BM, nt * 128, lds, ep);
  }
}
template <int MI>
__device__ __forceinline__ void ph_moe2(const MP& p, int layer, char* lds) {
  constexpr int BM = 64 * MI; int* tb = (int*)(lds + LDS_BYTES - 1024);
  const int total = moe_tables<BM>(p, layer, 8, tb);
  const bf16_t* wd = (const bf16_t*)(p.ws + WS_WMOE) + (size_t)32 * 512 * 1024;
  for (int tile = blockIdx.x; tile < total; tile += gridDim.x) {
    int e = 0;
#pragma unroll 1
    for (int q = 1; q < 32; ++q) if (tb[64 + q] <= tile) e = q;
    const int lt = tile - tb[64 + e], mt = lt >> 3, nt = lt & 7;
    EpiEach<EpiMoe2> ep; ep.e.Y = (bf16_t*)(p.ws + WS_YBUF); ep.e.list = (const int*)(p.ws + WS_LIST) + (size_t)e * MROWS; ep.e.m_base = 0;
    const bf16_t* A = (const bf16_t*)(p.ws + WS_AMOE) + (size_t)tb[32 + e] * 256;
    gemm_tile<MI>(A, 256, nullptr, 0, tb[e], wd + (size_t)e * 1024 * 256, 256, 256, mt * BM, nt * 128, lds, ep);
  }
}
__device__ __forceinline__ void ph_combine(const MP& p, int layer, int nrows, int final_) {
  float* lat = p.out; float* ctxr = (float*)(p.ws + WS_XC); const bf16_t* Y = (const bf16_t*)(p.ws + WS_YBUF);
  const float* modl_cur = (const float*)(p.ws + WS_MODS) + layer * 3 * 6144; const float* modl_next = (const float*)(p.ws + WS_MODS) + 3 * 6144;
  const float* gain = final_ ? p.in[28] : p.in[6] + 1024; bf16_t* hout = (bf16_t*)(p.ws + WS_H);
  const int lane = tidx() & 63, gw = blockIdx.x * 8 + (tidx() >> 6);
  for (int row = gw; row < nrows; row += gridDim.x * 8) {
    float* src = row < NLAT ? lat + (size_t)row * D : ctxr + (size_t)(row - NLAT) * D;
    const int v = row_vec(row);
    f32x4 x[4]; float ss = 0.f;
#pragma unroll
    for (int j = 0; j < 4; ++j) {
      const int n = (lane + 64 * j) * 4;
      const f32x4 g2 = *(const f32x4*)(modl_cur + v * 6144 + 5120 + n);
      const uint2 y0 = *(const uint2*)(Y + ((size_t)row * 2) * D + n), y1 = *(const uint2*)(Y + ((size_t)row * 2 + 1) * D + n);
      f32x4 ys;
      ys.x = __uint_as_float(y0.x << 16) + __uint_as_float(y1.x << 16); ys.y = __uint_as_float(y0.x & 0xFFFF0000u) + __uint_as_float(y1.x & 0xFFFF0000u);
      ys.z = __uint_as_float(y0.y << 16) + __uint_as_float(y1.y << 16); ys.w = __uint_as_float(y0.y & 0xFFFF0000u) + __uint_as_float(y1.y & 0xFFFF0000u);
      x[j] = ((const f32x4*)src)[lane + 64 * j] + g2 * ys;
      ss += x[j].x * x[j].x + x[j].y * x[j].y + x[j].z * x[j].z + x[j].w * x[j].w;
    }
    const float rstd = 1.f / sqrtf(wave_sum(ss) * (1.f / D) + EPS);
#pragma unroll
    for (int j = 0; j < 4; ++j) {
      const int n = (lane + 64 * j) * 4;
      const f32x4 g = *(const f32x4*)(gain + n);
      if (final_) { ((f32x4*)src)[lane + 64 * j] = x[j] * rstd * g; }
      else {
        ((f32x4*)src)[lane + 64 * j] = x[j];
        const f32x4 sc = *(const f32x4*)(modl_next + v * 6144 + 1024 + n), sh = *(const f32x4*)(modl_next + v * 6144 + n);
        const f32x4 h = x[j] * rstd * g * (sc + 1.f) + sh;
        uint2 o; o.x = pack2(h.x, h.y); o.y = pack2(h.z, h.w);
        *(uint2*)(hout + (size_t)row * D + n) = o;
      }
    }
  }
}
__device__ __forceinline__ void ph_kr_rope(const float* kr, bf16_t* dk) {
  for (int idx = blockIdx.x * 512 + tidx(); idx < MROWS * 32; idx += gridDim.x * 512) {
    const int m = idx >> 5, j = idx & 31; int b, key; row_bkey(m, b, key);
    float val = kr[idx];
    if (m < NLAT) {
      const int t = m & 8191; const int half = j >> 4, jj = j & 15, i = jj & 7;
      const float pos = half ? (float)(t & 63) : (float)(t >> 6);
      float sn, cs; sincosf(pos * rope_inv(i), &sn, &cs);
      const float x1 = kr[(size_t)m * 32 + half * 16 + i], x2 = kr[(size_t)m * 32 + half * 16 + 8 + i];
      val = (jj < 8) ? (x1 * cs - x2 * sn) : (x1 * sn + x2 * cs);
    }
    const bf16_t o = f2bf(val);
#pragma unroll
    for (int hh = 0; hh < 8; ++hh) dk[((size_t)(b * 8 + hh) * NKEY + key) * 128 + 64 + j] = o;
  }
}

#define MFMA32(a, b, c) __builtin_amdgcn_mfma_f32_32x32x16_bf16(a, b, c, 0, 0, 0)
#define KSWZ(row, colB) ((row) * 256 + ((colB) ^ (((row) & 7) << 4)))
#define SBAR() __builtin_amdgcn_sched_barrier(0)
__device__ __forceinline__ int crow(int r, int hi) { return (r & 3) + 8 * (r >> 2) + 4 * hi; }
__device__ __forceinline__ unsigned cvtpk(float lo, float hi) { unsigned r; asm volatile("v_cvt_pk_bf16_f32 %0, %1, %2" : "=v"(r) : "v"(lo), "v"(hi)); return r; }

__device__ __forceinline__ void att_partialSM(f32x16& p0, f32x16& p1, float& m_reg, float& mn, float& alpha) {
  float pmax = p0[0];
#pragma unroll
  for (int r = 1; r < 16; ++r) pmax = fmaxf(pmax, p0[r]);
#pragma unroll
  for (int r = 0; r < 16; ++r) pmax = fmaxf(pmax, p1[r]);
  { auto rr = __builtin_amdgcn_permlane32_swap(__float_as_uint(pmax), __float_as_uint(pmax), false, false);
    pmax = fmaxf(__uint_as_float(rr[0]), __uint_as_float(rr[1])); }
  if (__builtin_expect(__all(pmax - m_reg <= ATT_THR), 1)) { mn = m_reg; alpha = 1.f; }
  else { mn = fmaxf(m_reg, pmax); alpha = __builtin_amdgcn_exp2f(m_reg - mn); m_reg = mn; }
#pragma unroll
  for (int r = 0; r < 16; ++r) p0[r] = __builtin_amdgcn_exp2f(p0[r] - mn);
#pragma unroll
  for (int r = 0; r < 16; ++r) p1[r] = p1[r] - mn;
}
__device__ __forceinline__ void att_finishSM(f32x16& p0, f32x16& p1, float alpha, float& l_reg, bf16x8& pa0, bf16x8& pa1, bf16x8& pa2, bf16x8& pa3) {
#pragma unroll
  for (int r = 0; r < 16; ++r) p1[r] = __builtin_amdgcn_exp2f(p1[r]);
  float ps = 0.f;
#pragma unroll
  for (int r = 0; r < 16; ++r) ps += p0[r];
#pragma unroll
  for (int r = 0; r < 16; ++r) ps += p1[r];
  { auto rr = __builtin_amdgcn_permlane32_swap(__float_as_uint(ps), __float_as_uint(ps), false, false);
    ps = __uint_as_float(rr[0]) + __uint_as_float(rr[1]); }
  l_reg = l_reg * alpha + ps;
#define PK4(P, BASE, OUT) do { unsigned a0 = cvtpk(P[BASE + 0], P[BASE + 1]), a1 = cvtpk(P[BASE + 2], P[BASE + 3]);   \
    unsigned b0 = cvtpk(P[BASE + 4], P[BASE + 5]), b1 = cvtpk(P[BASE + 6], P[BASE + 7]);                              \
    auto r0 = __builtin_amdgcn_permlane32_swap(a0, b0, false, false); auto r1 = __builtin_amdgcn_permlane32_swap(a1, b1, false, false); \
    u32x4 w = {r0[0], r1[0], r0[1], r1[1]}; OUT = *reinterpret_cast<bf16x8*>(&w); } while (0)
  PK4(p0, 0, pa0); PK4(p0, 8, pa1); PK4(p1, 0, pa2); PK4(p1, 8, pa3);
}
template <int ND0>
__device__ __forceinline__ void att_qkt(f32x16& p0, f32x16& p1, const char* Ks, const bf16x8* qr, int r32, int hi) {
#pragma unroll
  for (int r = 0; r < 16; ++r) { p0[r] = 0.f; p1[r] = 0.f; }
#pragma unroll
  for (int d0 = 0; d0 < ND0; ++d0) { const int cb = (d0 * 16 + hi * 8) * 2;
    const bf16x8 b0 = *reinterpret_cast<const bf16x8*>(Ks + KSWZ(r32, cb));
    const bf16x8 b1 = *reinterpret_cast<const bf16x8*>(Ks + KSWZ(32 + r32, cb));
    p0 = MFMA32(b0, qr[d0], p0);
    p1 = MFMA32(b1, qr[d0], p1); }
}
__device__ __forceinline__ int v_st64(int k, int c) { const int kk = (k & ~0xC) | ((k & 4) << 1) | ((k & 8) >> 1); return ((kk >> 3) * 2 + (c >> 5)) * 512 + ((kk & 7) * 32 + (c & 31)) * 2; }
__device__ __forceinline__ int v_rd_base(int lane) { return ((lane & 3) << 3) | (((lane >> 2) & 3) << 6) | (((lane >> 4) & 1) << 5) | (((lane >> 5) & 1) << 8); }
static constexpr int v_rd_off64(int d0, int ks, int half) { return d0 * 512 + ks * 2048 + half * 1024; }
template <int OFF> __device__ __forceinline__ s16x4 tr_read(int vb) {
  s16x4 r; asm volatile("ds_read_b64_tr_b16 %0, %1 offset:%2" : "=&v"(r) : "v"(vb), "i"(OFF) : "memory"); return r;
}
template <int D0> __device__ __forceinline__ void pv_one64(f32x16& od, int vb, bf16x8 pa0, bf16x8 pa1, bf16x8 pa2, bf16x8 pa3) {
  const s16x4 l0 = tr_read<v_rd_off64(D0, 0, 0)>(vb), h0 = tr_read<v_rd_off64(D0, 0, 1)>(vb), l1 = tr_read<v_rd_off64(D0, 1, 0)>(vb), h1 = tr_read<v_rd_off64(D0, 1, 1)>(vb);
  const s16x4 l2 = tr_read<v_rd_off64(D0, 2, 0)>(vb), h2 = tr_read<v_rd_off64(D0, 2, 1)>(vb), l3 = tr_read<v_rd_off64(D0, 3, 0)>(vb), h3 = tr_read<v_rd_off64(D0, 3, 1)>(vb);
  asm volatile("s_waitcnt lgkmcnt(0)" ::: "memory"); SBAR();
#define PKV(L, H) (bf16x8){L[0], L[1], L[2], L[3], H[0], H[1], H[2], H[3]}
  od = MFMA32(pa0, PKV(l0, h0), od);
  od = MFMA32(pa1, PKV(l1, h1), od);
  od = MFMA32(pa2, PKV(l2, h2), od);
  od = MFMA32(pa3, PKV(l3, h3), od);
}

__device__ __forceinline__ void mla_block(const bf16_t* __restrict__ Qb, const bf16_t* __restrict__ Kh, const bf16_t* __restrict__ Vh, bf16_t* __restrict__ Ob, int t0, char* lds) {
  constexpr int SHM_V = 64 * 64 * 2, SHM_K = 64 * 128 * 2, NT = NKEY / 64;
  const int tid = tidx(), wid = tid >> 6, lane = tid & 63, r32 = lane & 31, hi = lane >> 5;
  char* V_lds = lds; char* K_lds = lds + 2 * SHM_V;
  float* wsf = (float*)(lds + 2 * SHM_V + 2 * SHM_K) + wid * 64; float* li_l = wsf; float* al_l = wsf + 32;
  float m_reg = -1e30f, l_reg = 0.f; f32x16 o[2];
#pragma unroll
  for (int r = 0; r < 16; ++r) { o[0][r] = 0.f; o[1][r] = 0.f; }
  bf16x8 qr[6];
  { const bf16_t* Qw = Qb + (size_t)(wid * 32 + r32) * 96;
#pragma unroll
    for (int d0 = 0; d0 < 4; ++d0) qr[d0] = *(const bf16x8*)(Qw + d0 * 16 + hi * 8);
    const int t = t0 + wid * 32 + r32;
#pragma unroll
    for (int g = 0; g < 2; ++g) {
      const bf16x8 x1 = *(const bf16x8*)(Qw + 64 + g * 16), x2 = *(const bf16x8*)(Qw + 64 + g * 16 + 8);
      const float pos = g ? (float)(t & 63) : (float)(t >> 6);
      unsigned wv[4];
#pragma unroll
      for (int i = 0; i < 8; i += 2) {
        float o2[2];
#pragma unroll
        for (int q = 0; q < 2; ++q) { const float ang = pos * rope_inv(i + q); const float sn = __sinf(ang), cs = __cosf(ang);
          const float a = bf2f((bf16_t)x1[i + q]), b = bf2f((bf16_t)x2[i + q]);
          o2[q] = hi ? (a * sn + b * cs) : (a * cs - b * sn); }
        wv[i >> 1] = pack2(o2[0], o2[1]);
      }
      u32x4 w4 = {wv[0], wv[1], wv[2], wv[3]}; qr[4 + g] = *reinterpret_cast<bf16x8*>(&w4);
    }
  }
  const int kq0 = tid, kq1 = tid < 256 ? 512 + tid : tid;
  const int kr0 = kq0 / 12, kc0 = (kq0 - kr0 * 12) * 8, kr1 = kq1 / 12, kc1 = (kq1 - kr1 * 12) * 8; const bool k2 = tid < 256;
  const int kw0 = KSWZ(kr0, kc0 * 2), kw1 = KSWZ(kr1, kc1 * 2);
  const int vk = tid >> 3, vc = (tid & 7) * 8, vst = v_st64(vk, vc);
  const int vb0 = (int)(uintptr_t)V_lds + v_rd_base(lane);
  const int ko0 = kr0 * 128 + kc0, ko1 = kr1 * 128 + kc1, vo = vk * 64 + vc;
  uint4 sv_0, sk0_0, sk1_0, sv_1, sk0_1, sk1_1;
#define SLOAD(i, kk0) do { sv_##i = *(const uint4*)(Vh + ((kk0) * 64 + vo)); sk0_##i = *(const uint4*)(Kh + ((kk0) * 128 + ko0)); sk1_##i = *(const uint4*)(Kh + ((kk0) * 128 + ko1)); } while (0)
#define SWRITE(b, i) do { *(uint4*)(V_lds + (b) * SHM_V + vst) = sv_##i; *(uint4*)(K_lds + (b) * SHM_K + kw0) = sk0_##i; if (k2) *(uint4*)(K_lds + (b) * SHM_K + kw1) = sk1_##i; } while (0)
#define SWAIT() asm volatile("s_waitcnt vmcnt(3)" ::: "memory")
#define RESC(a) do { if (__any((a) < 1.f)) { if (hi == 0) al_l[r32] = (a); asm volatile("s_waitcnt lgkmcnt(0)" ::: "memory"); \
    _Pragma("unroll") for (int d = 0; d < 2; ++d) _Pragma("unroll") for (int r = 0; r < 16; ++r) o[d][r] *= al_l[crow(r, hi)]; } } while (0)
#define PV2(vb) do { pv_one64<0>(o[0], (vb), pa0, pa1, pa2, pa3); pv_one64<1>(o[1], (vb), pa0, pa1, pa2, pa3); } while (0)
  f32x16 pA0, pA1, pB0, pB1; float mnA, mnB, alA, alB; bf16x8 pa0, pa1, pa2, pa3;
  SLOAD(0, 0); asm volatile("s_waitcnt vmcnt(0)" ::: "memory"); SWRITE(0, 0); __syncthreads();
  att_qkt<6>(pA0, pA1, K_lds, qr, r32, hi); att_partialSM(pA0, pA1, m_reg, mnA, alA);
  SLOAD(1, 64); SLOAD(0, 128);
  SWAIT(); SWRITE(1, 1); __syncthreads();
  for (int j = 1; j + 1 < NT; j += 2) {
    SBAR(); att_qkt<6>(pB0, pB1, K_lds + SHM_K, qr, r32, hi);
    att_finishSM(pA0, pA1, alA, l_reg, pa0, pa1, pa2, pa3); SBAR();
    SLOAD(1, (j + 2) * 64); SBAR();
    PV2(vb0); att_partialSM(pB0, pB1, m_reg, mnB, alB);
    __syncthreads(); SWAIT(); SWRITE(0, 0);
    RESC(alB); __syncthreads();
    SBAR(); att_qkt<6>(pA0, pA1, K_lds, qr, r32, hi);
    att_finishSM(pB0, pB1, alB, l_reg, pa0, pa1, pa2, pa3); SBAR();
    if (j + 3 < NT) SLOAD(0, (j + 3) * 64); SBAR();
    PV2(vb0 + SHM_V); att_partialSM(pA0, pA1, m_reg, mnA, alA);
    __syncthreads(); SWAIT(); SWRITE(1, 1);
    RESC(alA); __syncthreads();
  }
  SBAR(); att_qkt<6>(pB0, pB1, K_lds + SHM_K, qr, r32, hi);
  att_finishSM(pA0, pA1, alA, l_reg, pa0, pa1, pa2, pa3); SBAR();
  PV2(vb0); att_partialSM(pB0, pB1, m_reg, mnB, alB);
  __syncthreads(); RESC(alB);
  att_finishSM(pB0, pB1, alB, l_reg, pa0, pa1, pa2, pa3); SBAR();
  PV2(vb0 + SHM_V);
  if (hi == 0) li_l[r32] = l_reg; asm volatile("s_waitcnt lgkmcnt(0)" ::: "memory");
  bf16_t* Ow = Ob + (size_t)(wid * 32) * D;
#pragma unroll
  for (int r = 0; r < 16; ++r) { const int orow = crow(r, hi); const float rl = __builtin_amdgcn_rcpf(li_l[orow]);
#pragma unroll
    for (int d0 = 0; d0 < 2; ++d0) Ow[(size_t)orow * D + d0 * 32 + r32] = f2bf(o[d0][r] * rl); }
  __syncthreads();
#undef SLOAD
#undef SWRITE
#undef SWAIT
}
__device__ __forceinline__ void ph_mla(const MP& p, char* lds) {
  const bf16_t* dq = (const bf16_t*)(p.ws + WS_DQ); const bf16_t* dk = (const bf16_t*)(p.ws + WS_DK); const bf16_t* dv = (const bf16_t*)(p.ws + WS_DV);
  bf16_t* abuf = (bf16_t*)(p.ws + WS_A);
  for (int item = blockIdx.x; item < 512; item += gridDim.x) {
    const int bh = (item & 7) + 8 * (item >> 8), qb = (item >> 3) & 31, b = bh >> 3, h = bh & 7;
    mla_block(dq + ((size_t)bh * SEQ + qb * 256) * 96, dk + (size_t)bh * NKEY * 128, dv + (size_t)bh * NKEY * 64,
              abuf + (size_t)(b * SEQ + qb * 256) * D + 512 + h * 64, qb * 256, lds);
  }
}

__device__ __forceinline__ int hgrn_step_cid(int b, int dir, int s) {
  if (s < 4) return 256 + b * 4 + (dir ? 3 - s : s);
  return b * 128 + (dir ? 131 - s : s - 4);
}
__device__ __forceinline__ void ph_hgrn_a(const MP& p, char* lds) {
  bf16_t* U = (bf16_t*)(p.ws + WS_U); float* LF = (float*)(p.ws + WS_LF); float* alast = (float*)(p.ws + WS_ALAST);
  bf16_t* KT = (bf16_t*)(p.ws + WS_A); bf16_t* VT = (bf16_t*)(p.ws + WS_H + USLOT);
  float* Ef = (float*)lds;
  bf16_t* Kn = (bf16_t*)(lds + 33792);
  bf16_t* Vn = (bf16_t*)(lds + 33792 + 17408);
  float* gsum = (float*)(lds + 33792 + 2 * 17408);
  const int t = tidx(), srow = t >> 3, scb = (t & 7) * 16, col = t & 127, grp = t >> 7;
  for (int item = blockIdx.x; item < NCHUNK * 8; item += gridDim.x) {
    const int cid = item >> 3, dir = (item >> 2) & 1, h = item & 3; const size_t row0 = (size_t)cid * 64;
    { const size_t go = (row0 + srow) * 512 + h * 128 + scb;
      const float* lp = LF + (size_t)dir * MROWS * 512 + go;
      const f32x4 e0 = *(const f32x4*)lp, e1 = *(const f32x4*)(lp + 4), e2 = *(const f32x4*)(lp + 8), e3 = *(const f32x4*)(lp + 12);
      const uint4 k0 = *(const uint4*)(U + (size_t)(1 + dir) * MROWS * 512 + go), k1 = *(const uint4*)(U + (size_t)(1 + dir) * MROWS * 512 + go + 8);
      float* ed = Ef + srow * 132 + scb; *(f32x4*)ed = e0; *(f32x4*)(ed + 4) = e1; *(f32x4*)(ed + 8) = e2; *(f32x4*)(ed + 12) = e3;
      *(uint4*)(Kn + srow * 136 + scb) = k0; *(uint4*)(Kn + srow * 136 + scb + 8) = k1;
      if (dir == 0) { const uint4 v0 = *(const uint4*)(U + (size_t)3 * MROWS * 512 + go), v1 = *(const uint4*)(U + (size_t)3 * MROWS * 512 + go + 8);
        *(uint4*)(Vn + srow * 136 + scb) = v0; *(uint4*)(Vn + srow * 136 + scb + 8) = v1; } }
    __syncthreads();
    float pre[16]; float run = 0.f;
#pragma unroll
    for (int i = 0; i < 16; ++i) { const int rr = grp * 16 + (dir ? 15 - i : i); run += Ef[rr * 132 + col]; pre[i] = run; }
    gsum[grp * 128 + col] = run;
    __syncthreads();
    const float g0 = gsum[col], g1 = gsum[128 + col], g2 = gsum[256 + col], g3 = gsum[384 + col];
    const float total = (g0 + g1) + (g2 + g3);
    float offs;
    if (dir == 0) offs = grp == 0 ? 0.f : (grp == 1 ? g0 : (grp == 2 ? g0 + g1 : g0 + g1 + g2));
    else offs = grp == 3 ? 0.f : (grp == 2 ? g3 : (grp == 1 ? g3 + g2 : g3 + g2 + g1));
    if (grp == 0) alast[((size_t)dir * NCHUNK + cid) * 512 + h * 128 + col] = __expf(total);
    unsigned kw[8];
    float* lfo = LF + ((size_t)dir * MROWS + row0 + grp * 16) * 512 + h * 128 + col;
    bf16_t* uko = U + (size_t)(1 + dir) * MROWS * 512 + (row0 + grp * 16) * 512 + h * 128 + col;
#pragma unroll
    for (int i = 0; i < 16; i += 2) {
      const float ea = total - (offs + pre[dir ? 15 - i : i]), eb = total - (offs + pre[dir ? 14 - i : i + 1]);
      lfo[(size_t)i * 512] = ea; lfo[(size_t)(i + 1) * 512] = eb;
      const bf16_t ka = f2bf(bf2f(Kn[(grp * 16 + i) * 136 + col]) * __expf(ea)), kb = f2bf(bf2f(Kn[(grp * 16 + i + 1) * 136 + col]) * __expf(eb));
      uko[(size_t)i * 512] = ka; uko[(size_t)(i + 1) * 512] = kb; kw[i >> 1] = (unsigned)ka | ((unsigned)kb << 16);
    }
    { bf16_t* kt = KT + ((((size_t)dir * NCHUNK + cid) * 4 + h) * 128 + col) * 64 + grp * 16;
      *(uint4*)kt = make_uint4(kw[0], kw[1], kw[2], kw[3]); *(uint4*)(kt + 8) = make_uint4(kw[4], kw[5], kw[6], kw[7]); }
    if (dir == 0) {
      unsigned vw[8];
#pragma unroll
      for (int i = 0; i < 16; i += 2) vw[i >> 1] = (unsigned)Vn[(grp * 16 + i) * 136 + col] | ((unsigned)Vn[(grp * 16 + i + 1) * 136 + col] << 16);
      bf16_t* vt = VT + (((size_t)cid * 4 + h) * 128 + col) * 64 + grp * 16;
      *(uint4*)vt = make_uint4(vw[0], vw[1], vw[2], vw[3]); *(uint4*)(vt + 8) = make_uint4(vw[4], vw[5], vw[6], vw[7]);
    }
    __syncthreads();
  }
}
__device__ __forceinline__ bf16_t* hgrn_sbuf(const MP& p, int bhd, int cid) {
  return cid < 256 ? (bf16_t*)p.out + ((size_t)bhd * 128 + (cid & 127)) * 16384 : (bf16_t*)(p.ws + WS_ODIR_CTX) + ((size_t)bhd * 4 + ((cid - 256) & 3)) * 16384;
}
__device__ __forceinline__ void ph_hgrn_b(const MP& p) {
  const int w = tidx() >> 6, lane = tidx() & 63, l15 = lane & 15, lq = lane >> 4;
  if (w < 4) {
    const bf16_t* KT = (const bf16_t*)(p.ws + WS_A); const bf16_t* VT = (const bf16_t*)(p.ws + WS_H + USLOT); const float* alast = (const float*)(p.ws + WS_ALAST);
    for (int item = blockIdx.x * 4 + w; item < 1024; item += gridDim.x * 4) {
      const int bhd = item >> 6, dkt = (item >> 3) & 7, dvt = item & 7, b = bhd >> 3, h = (bhd >> 1) & 3, dir = bhd & 1;
      f32x4 S = {0.f, 0.f, 0.f, 0.f};
      uint4 ka[4][2], vb[4][2]; float al[4];
#define HB_LOAD(s0) _Pragma("unroll") for (int u = 0; u < 4; ++u) { const int cid = hgrn_step_cid(b, dir, (s0) + u);                                   \
        const bf16_t* kt = KT + ((((size_t)dir * NCHUNK + cid) * 4 + h) * 128 + dkt * 16 + l15) * 64 + lq * 8;                                       \
        const bf16_t* vt = VT + (((size_t)cid * 4 + h) * 128 + dvt * 16 + l15) * 64 + lq * 8;                                                       \
        ka[u][0] = *(const uint4*)kt; ka[u][1] = *(const uint4*)(kt + 32); vb[u][0] = *(const uint4*)vt; vb[u][1] = *(const uint4*)(vt + 32);          \
        al[u] = alast[((size_t)dir * NCHUNK + cid) * 512 + h * 128 + dkt * 16 + l15]; }
      HB_LOAD(0);
      for (int s0 = 0; s0 < 132; s0 += 4) {
        uint4 kc[4][2], vc[4][2]; float ac[4];
#pragma unroll
        for (int u = 0; u < 4; ++u) { kc[u][0] = ka[u][0]; kc[u][1] = ka[u][1]; vc[u][0] = vb[u][0]; vc[u][1] = vb[u][1]; ac[u] = al[u]; }
        if (s0 + 4 < 132) { HB_LOAD(s0 + 4); }
#pragma unroll
        for (int u = 0; u < 4; ++u) {
          const int cid = hgrn_step_cid(b, dir, s0 + u);
          f32x4 T = {0.f, 0.f, 0.f, 0.f};
          T = MFMA16(*reinterpret_cast<bf16x8*>(&vc[u][0]), *reinterpret_cast<bf16x8*>(&kc[u][0]), T);
          T = MFMA16(*reinterpret_cast<bf16x8*>(&vc[u][1]), *reinterpret_cast<bf16x8*>(&kc[u][1]), T);
          const f32x4 Sp = S * ac[u];
          bf16_t* sb = hgrn_sbuf(p, bhd, cid) + (size_t)(dvt * 16 + lq * 4) * 128 + dkt * 16 + l15;
          sb[0] = f2bf(Sp.x); sb[128] = f2bf(Sp.y); sb[256] = f2bf(Sp.z); sb[384] = f2bf(Sp.w);
          S = Sp + T;
        }
      }
#undef HB_LOAD
    }
  }
}
__device__ __forceinline__ void ph_hgrn_c(const MP& p, char* lds) {
  const bf16_t* U = (const bf16_t*)(p.ws + WS_U); const float* LF = (const float*)(p.ws + WS_LF); const bf16_t* VT = (const bf16_t*)(p.ws + WS_H + USLOT);
  bf16_t* abuf = (bf16_t*)(p.ws + WS_A); const float* onorm = p.in[11];
  char* Qs = lds; char* Ks = lds + 16384; char* Ss = lds + 32768; char* Vs = lds + 65536; char* As = lds + 81920; float* red = (float*)(lds + 90112);
  const int t = tidx(), lane = t & 63, w = t >> 6, wm = w >> 1, wn = w & 1, l15 = lane & 15, lq = lane >> 4;
  const int srow = t >> 3, scb = (t & 7) * 16;
  for (int item = blockIdx.x; item < 8 * 132; item += gridDim.x) {
    const int bh = item / 132, cpos = item - bh * 132, b = bh >> 2, h = bh & 3;
    const int cid = cpos < 128 ? b * 128 + cpos : 256 + b * 4 + (cpos - 128); const size_t row0 = (size_t)cid * 64;
    f32x4 acc[4];
#pragma unroll
    for (int j = 0; j < 4; ++j) acc[j] = (f32x4){0.f, 0.f, 0.f, 0.f};
    for (int dir = 0; dir < 2; ++dir) {
      {
        const size_t go = (row0 + srow) * 512 + h * 128 + scb;
        const uint4 q0 = *(const uint4*)(U + go), q1 = *(const uint4*)(U + go + 8);
        const uint4 k0 = *(const uint4*)(U + (size_t)(1 + dir) * MROWS * 512 + go), k1 = *(const uint4*)(U + (size_t)(1 + dir) * MROWS * 512 + go + 8);
        const float* ep = LF + (size_t)dir * MROWS * 512 + go;
        const f32x4 e0 = *(const f32x4*)ep, e1 = *(const f32x4*)(ep + 4), e2 = *(const f32x4*)(ep + 8), e3 = *(const f32x4*)(ep + 12);
        const unsigned qw[8] = {q0.x, q0.y, q0.z, q0.w, q1.x, q1.y, q1.z, q1.w};
        const float ev[16] = {e0.x, e0.y, e0.z, e0.w, e1.x, e1.y, e1.z, e1.w, e2.x, e2.y, e2.z, e2.w, e3.x, e3.y, e3.z, e3.w};
        unsigned ow[8];
#pragma unroll
        for (int i = 0; i < 8; ++i) ow[i] = pack2(__uint_as_float(qw[i] << 16) * __expf(-ev[2 * i]), __uint_as_float(qw[i] & 0xFFFF0000u) * __expf(-ev[2 * i + 1]));
        const int c0 = scb >> 3, sw = srow & 15;
        *(uint4*)(Qs + srow * 256 + ((c0 ^ sw) << 4)) = make_uint4(ow[0], ow[1], ow[2], ow[3]);
        *(uint4*)(Qs + srow * 256 + (((c0 + 1) ^ sw) << 4)) = make_uint4(ow[4], ow[5], ow[6], ow[7]);
        *(uint4*)(Ks + srow * 256 + ((c0 ^ sw) << 4)) = k0;
        *(uint4*)(Ks + srow * 256 + (((c0 + 1) ^ sw) << 4)) = k1;
        const bf16_t* vt = VT + ((size_t)cid * 4 + h) * 8192;
#pragma unroll
        for (int i = 0; i < 2; ++i) { const int idx = t + 512 * i, r = idx >> 3, c = idx & 7; *(uint4*)(Vs + r * 128 + ((c ^ ((r >> 1) & 7)) << 4)) = *(const uint4*)(vt + (size_t)idx * 8); }
        const bf16_t* sb = hgrn_sbuf(p, bh * 2 + dir, cid);
#pragma unroll
        for (int i = 0; i < 4; ++i) { const int idx = t + 512 * i, r = idx >> 4, c = idx & 15; *(uint4*)(Ss + r * 256 + ((c ^ (r & 15)) << 4)) = *(const uint4*)(sb + (size_t)idx * 8); }
      }
      __syncthreads();
      bf16x8 af[4];
#pragma unroll
      for (int ks = 0; ks < 4; ++ks) af[ks] = *(const bf16x8*)(Qs + (wm * 16 + l15) * 256 + (((ks * 4 + lq) ^ l15) << 4));
      {
        f32x4 a2[2];
#pragma unroll
        for (int ni = 0; ni < 2; ++ni) { a2[ni] = (f32x4){0.f, 0.f, 0.f, 0.f};
#pragma unroll
          for (int ks = 0; ks < 4; ++ks) { const bf16x8 bf = *(const bf16x8*)(Ks + (wn * 32 + ni * 16 + l15) * 256 + (((ks * 4 + lq) ^ l15) << 4)); a2[ni] = MFMA16(bf, af[ks], a2[ni]); } }
        const int tt = wm * 16 + l15;
#pragma unroll
        for (int ni = 0; ni < 2; ++ni) { const int s0 = wn * 32 + ni * 16 + lq * 4; float v[4] = {a2[ni].x, a2[ni].y, a2[ni].z, a2[ni].w};
#pragma unroll
          for (int r = 0; r < 4; ++r) { const int s = s0 + r; const bool keep = dir ? (s >= tt) : (s <= tt); v[r] = keep ? v[r] : 0.f; }
          uint2 wv; wv.x = pack2(v[0], v[1]); wv.y = pack2(v[2], v[3]);
          *(uint2*)(As + tt * 128 + (((s0 >> 3) ^ ((tt >> 1) & 7)) << 4) + (s0 & 7) * 2) = wv; }
      }
#pragma unroll
      for (int ni = 0; ni < 4; ++ni) {
#pragma unroll
        for (int ks = 0; ks < 4; ++ks) { const bf16x8 bf = *(const bf16x8*)(Ss + (wn * 64 + ni * 16 + l15) * 256 + (((ks * 4 + lq) ^ l15) << 4)); acc[ni] = MFMA16(bf, af[ks], acc[ni]); } }
      __syncthreads();
      {
        const int tt = wm * 16 + l15; bf16x8 aa[2];
#pragma unroll
        for (int ks = 0; ks < 2; ++ks) aa[ks] = *(const bf16x8*)(As + tt * 128 + (((ks * 4 + lq) ^ ((tt >> 1) & 7)) << 4));
#pragma unroll
        for (int ni = 0; ni < 4; ++ni) { const int r = wn * 64 + ni * 16 + l15;
#pragma unroll
          for (int ks = 0; ks < 2; ++ks) { const bf16x8 bf = *(const bf16x8*)(Vs + r * 128 + (((ks * 4 + lq) ^ ((r >> 1) & 7)) << 4)); acc[ni] = MFMA16(bf, aa[ks], acc[ni]); } }
      }
      __syncthreads();
    }
    const int tt = wm * 16 + l15; float ss = 0.f;
#pragma unroll
    for (int ni = 0; ni < 4; ++ni) ss += acc[ni].x * acc[ni].x + acc[ni].y * acc[ni].y + acc[ni].z * acc[ni].z + acc[ni].w * acc[ni].w;
    ss += __shfl_xor(ss, 16); ss += __shfl_xor(ss, 32);
    if (lq == 0) red[tt * 2 + wn] = ss;
    __syncthreads();
    const float rstd = 1.f / sqrtf((red[tt * 2] + red[tt * 2 + 1]) * (1.f / 128.f) + EPS);
#pragma unroll
    for (int ni = 0; ni < 4; ++ni) {
      const int dv = wn * 64 + ni * 16 + lq * 4; const size_t go = (row0 + tt) * 512 + h * 128 + dv;
      const uint2 gw = *(const uint2*)(U + (size_t)4 * MROWS * 512 + go); const f32x4 on = *(const f32x4*)(onorm + dv);
      uint2 wv;
      wv.x = pack2(acc[ni].x * rstd * on.x * __uint_as_float(gw.x << 16), acc[ni].y * rstd * on.y * __uint_as_float(gw.x & 0xFFFF0000u));
      wv.y = pack2(acc[ni].z * rstd * on.z * __uint_as_float(gw.y << 16), acc[ni].w * rstd * on.w * __uint_as_float(gw.y & 0xFFFF0000u));
      *(uint2*)(abuf + (row0 + tt) * D + h * 128 + dv) = wv;
    }
    __syncthreads();
  }
}

#define XB_TMO      128
#define XB_XCNT(j)  (256  + 64 * (j))
#define XB_XSUB(j)  (1280 + 64 * (j))
#define XB_XGEN(j)  (2304 + 64 * (j))
#define XB_TOP      3328
#define XB_TOPGEN   3392
#define XCD_BAR_WORDS 3456
#define XB_SPIN_CAP (1u << 20)
#define LAS __attribute__((address_space(3)))
__device__ __forceinline__ unsigned xb_ld(unsigned* p)              { return __hip_atomic_load(p, __ATOMIC_RELAXED, __HIP_MEMORY_SCOPE_AGENT); }
__device__ __forceinline__ unsigned xb_add(unsigned* p, unsigned v) { return __hip_atomic_fetch_add(p, v, __ATOMIC_RELAXED, __HIP_MEMORY_SCOPE_AGENT); }
__device__ __forceinline__ unsigned xb_xcc_id() { return (unsigned)__builtin_amdgcn_s_getreg((3 << 11) | 20) & 0xFu; }
#define XB_SPIN(cond, bar) do { unsigned _sp = 0; while (cond) { __builtin_amdgcn_s_sleep(1); \
    if ((++_sp & 255u) == 0u) { if (xb_ld(&(bar)[XB_TMO])) break; if (_sp > XB_SPIN_CAP) { atomicAdd(&(bar)[XB_TMO], 1u); break; } } } } while (0)
struct XcdBarrier { unsigned* bar; unsigned x; volatile LAS unsigned* st; };
__device__ __forceinline__ XcdBarrier xcd_barrier_post(unsigned* bar, volatile LAS unsigned* st) {
  XcdBarrier b; b.bar = bar; b.x = xb_xcc_id(); b.st = st;
  if (tidx() == 0) (void)xb_add(&bar[XB_XCNT(b.x)], 1u);
  return b;
}
__device__ __forceinline__ void xcd_barrier_complete(unsigned* bar, unsigned x, unsigned& nloc, unsigned& nx) {
  const unsigned G = gridDim.x * gridDim.y * gridDim.z;
  unsigned sum, cnt, mine, sp = 0u;
  for (;;) {
    sum = 0u; cnt = 0u; mine = 0u;
#pragma unroll
    for (unsigned j = 0; j < 16; ++j) { const unsigned c = xb_ld(&bar[XB_XCNT(j)]); sum += c; cnt += (c > 0u) ? 1u : 0u; mine = (j == x) ? c : mine; }
    if (sum == G) break;
    __builtin_amdgcn_s_sleep(1);
    if ((++sp & 255u) == 0u) { if (xb_ld(&bar[XB_TMO])) break; if (sp > XB_SPIN_CAP) { atomicAdd(&bar[XB_TMO], 1u); break; } }
  }
  nloc = mine > 0u ? mine : 1u; nx = cnt > 0u ? cnt : 1u;
}
__device__ __forceinline__ void xcd_barrier(const XcdBarrier& b) {
  asm volatile("s_waitcnt vmcnt(0)" ::: "memory");
  __syncthreads();
  if (tidx() == 0) {
    unsigned* bar = b.bar;
    __builtin_amdgcn_s_waitcnt(0);
    unsigned nloc = b.st[0], nx = b.st[1];
    if (nloc == 0u) { xcd_barrier_complete(bar, b.x, nloc, nx); b.st[0] = nloc; b.st[1] = nx; }
    const unsigned old = xb_add(&bar[XB_XSUB(b.x)], 1u);
    const unsigned gen = old / nloc;
    if (old + 1u == (gen + 1u) * nloc) {
      __builtin_amdgcn_fence(__ATOMIC_RELEASE, "agent");
      asm volatile("s_waitcnt vmcnt(0)" ::: "memory");
      const unsigned og = xb_add(&bar[XB_TOP], 1u);
      const unsigned tg = og / nx;
      if (og + 1u == (tg + 1u) * nx) xb_add(&bar[XB_TOPGEN], 1u);
      else XB_SPIN(xb_ld(&bar[XB_TOPGEN]) == tg, bar);
      __builtin_amdgcn_fence(__ATOMIC_ACQUIRE, "agent");
      xb_add(&bar[XB_XGEN(b.x)], 1u);
      asm volatile("s_waitcnt vmcnt(0)" ::: "memory");
    } else {
      XB_SPIN(xb_ld(&bar[XB_XGEN(b.x)]) == gen, bar);
      __builtin_amdgcn_fence(__ATOMIC_ACQUIRE, "agent");
      asm volatile("s_waitcnt vmcnt(0)" ::: "memory");
    }
  }
  __syncthreads();
}

  template <int D0> __device__ __forceinline__ void pv_one32(f32x16& od, int vb, bf16x8 pa0, bf16x8 pa1) {
    const s16x4 l0 = tr_read<v_rd_off64(D0, 0, 0)>(vb), h0 = tr_read<v_rd_off64(D0, 0, 1)>(vb), l1 = tr_read<v_rd_off64(D0, 1, 0)>(vb), h1 = tr_read<v_rd_off64(D0, 1, 1)>(vb);
    asm volatile("s_waitcnt lgkmcnt(0)" ::: "memory"); SBAR();
    od = MFMA32(pa0, PKV(l0, h0), od);
    od = MFMA32(pa1, PKV(l1, h1), od);
  }
  __device__ __forceinline__ void ph_na(const MP& p, char* lds) {
    const bf16_t* nq = (const bf16_t*)(p.ws + WS_NQ); const bf16_t* nk = (const bf16_t*)(p.ws + WS_NK); const bf16_t* nv = (const bf16_t*)(p.ws + WS_NV);
    bf16_t* A = (bf16_t*)(p.ws + WS_A);
    const int tid = tidx(), w = tid >> 6, lane = tid & 63, j = lane & 31, hi = lane >> 5;
    char* Kw = lds + w * 8192; char* Vw = Kw + 4096;
    float* rpbs = (float*)(lds + 65536);
    float* al_l = (float*)(lds + 65536 + 4096) + w * 64; float* li_l = al_l + 32;
    const int vb0 = (int)(uintptr_t)Vw + v_rd_base(lane);
    for (int item = blockIdx.x; item < 512; item += gridDim.x) {
      const int bh = (item & 7) + 8 * (item >> 8), patch = (item >> 3) & 31, b = bh >> 3, h = bh & 7, r0 = (patch >> 2) * 16, c0 = (patch & 3) * 16;
      for (int i = tid; i < 15 * 64; i += 512) { const int dr = i >> 6, dc = (i & 63) - 16; rpbs[i] = (dc >= 0 && dc < 31) ? p.in[16][(h * 15 + dr) * 31 + dc] * LOG2E : 0.f; }
      __syncthreads();
      const int ra = r0 + 2 * w, qrow = ra + (j >> 4), qc = c0 + (j & 15);
      int rs_q = qrow - 4; rs_q = rs_q < 0 ? 0 : (rs_q > 120 ? 120 : rs_q);
      int cs_q = qc - 8; cs_q = cs_q < 0 ? 0 : (cs_q > 48 ? 48 : cs_q);
      int rs0 = ra - 4; rs0 = rs0 < 0 ? 0 : (rs0 > 120 ? 120 : rs0);
      int rs1 = ra - 3; rs1 = rs1 < 0 ? 0 : (rs1 > 120 ? 120 : rs1);
      int cw = c0 - 8; cw = cw < 0 ? 0 : (cw > 32 ? 32 : cw);
      const int ntiles = 8 + (rs1 - rs0) + 8;
      const bf16_t* Kb = nk + (size_t)bh * NKEY * 64; const bf16_t* Vb = nv + (size_t)bh * NKEY * 64;
      bf16x8 qr[4];
      { const bf16_t* qp = nq + ((size_t)bh * SEQ + qrow * 64 + qc) * 64 + hi * 8;
#pragma unroll
        for (int d0 = 0; d0 < 4; ++d0) qr[d0] = *(const bf16x8*)(qp + d0 * 16); }
      f32x16 o[2];
#pragma unroll
      for (int r = 0; r < 16; ++r) { o[0][r] = 0.f; o[1][r] = 0.f; }
      float m_reg = -1e30f, l_reg = 0.f;
      int kwo[4], vwo[4];
#pragma unroll
      for (int i = 0; i < 4; ++i) { const int q = lane + 64 * i, row = q >> 3, c = q & 7; kwo[i] = row * 128 + ((c ^ ((row >> 1) & 7)) << 4); vwo[i] = v_st64(row, c * 8); }
      uint4 sk0, sk1, sk2, sk3, sv0, sv1, sv2, sv3;
#define NA_KBASE(tl) ((tl) < 8 ? (tl) * 32 : CT + (rs0 + (tl) - 8) * 64 + cw)
#define NA_L1(i) sk##i = *(const uint4*)(Kb + kb_ + (i) * 512); sv##i = *(const uint4*)(Vb + kb_ + (i) * 512);
#define NA_LOAD(tl) do { const size_t kb_ = (size_t)NA_KBASE(tl) * 64 + lane * 8; NA_L1(0) NA_L1(1) NA_L1(2) NA_L1(3) } while (0)
#define NA_W1(i) *(uint4*)(Kw + kwo[i]) = sk##i; *(uint4*)(Vw + vwo[i]) = sv##i;
#define NA_WRITE() do { NA_W1(0) NA_W1(1) NA_W1(2) NA_W1(3) } while (0)
      NA_LOAD(0); NA_WRITE();
      for (int tl = 0; tl < ntiles; ++tl) {
        if (tl + 1 < ntiles) NA_LOAD(tl + 1);
        f32x16 pt;
#pragma unroll
        for (int r = 0; r < 16; ++r) pt[r] = 0.f;
#pragma unroll
        for (int d0 = 0; d0 < 4; ++d0) { const bf16x8 kf = *(const bf16x8*)(Kw + j * 128 + (((d0 * 2 + hi) ^ ((j >> 1) & 7)) << 4)); pt = MFMA32(kf, qr[d0], pt); }
        if (tl >= 8) {
          const int kr = rs0 + tl - 8; const bool rowok = (kr >= rs_q) && (kr < rs_q + 8);
          int dr = kr - qrow + 7; dr = dr < 0 ? 0 : (dr > 14 ? 14 : dr);
          const float* bp = rpbs + dr * 64 + (cw - qc + 15 + 16) + 4 * hi; const int kc0 = cw + 4 * hi;
#pragma unroll
          for (int r = 0; r < 16; ++r) { const int cr = (r & 3) + 8 * (r >> 2); const int kc = kc0 + cr;
            const bool ok = rowok && (kc >= cs_q) && (kc < cs_q + 16); pt[r] = ok ? pt[r] + bp[cr] : -1e30f; }
        }
        float pmax = pt[0];
#pragma unroll
        for (int r = 1; r < 16; ++r) pmax = fmaxf(pmax, pt[r]);
        { auto rr = __builtin_amdgcn_permlane32_swap(__float_as_uint(pmax), __float_as_uint(pmax), false, false); pmax = fmaxf(__uint_as_float(rr[0]), __uint_as_float(rr[1])); }
        float mn, alpha;
        if (__all(pmax - m_reg <= ATT_THR)) { mn = m_reg; alpha = 1.f; }
        else { mn = fmaxf(m_reg, pmax); alpha = __builtin_amdgcn_exp2f(m_reg - mn); m_reg = mn; }
        float ps = 0.f;
#pragma unroll
        for (int r = 0; r < 16; ++r) { pt[r] = __builtin_amdgcn_exp2f(pt[r] - mn); ps += pt[r]; }
        { auto rr = __builtin_amdgcn_permlane32_swap(__float_as_uint(ps), __float_as_uint(ps), false, false); ps = __uint_as_float(rr[0]) + __uint_as_float(rr[1]); }
        l_reg = l_reg * alpha + ps;
        bf16x8 pa0, pa1; PK4(pt, 0, pa0); PK4(pt, 8, pa1);
        if (__any(alpha < 1.f)) { if (hi == 0) al_l[j] = alpha; asm volatile("s_waitcnt lgkmcnt(0)" ::: "memory");
#pragma unroll
          for (int d = 0; d < 2; ++d)
#pragma unroll
            for (int r = 0; r < 16; ++r) o[d][r] *= al_l[crow(r, hi)]; }
        pv_one32<0>(o[0], vb0, pa0, pa1); pv_one32<1>(o[1], vb0, pa0, pa1);
        if (tl + 1 < ntiles) NA_WRITE();
      }
#undef NA_LOAD
#undef NA_WRITE
#undef NA_KBASE
      if (hi == 0) li_l[j] = l_reg; asm volatile("s_waitcnt lgkmcnt(0)" ::: "memory");
#pragma unroll
      for (int r = 0; r < 16; ++r) { const int qq = crow(r, hi); const float rl = __builtin_amdgcn_rcpf(li_l[qq]);
        bf16_t* op = A + ((size_t)b * SEQ + (ra + (qq >> 4)) * 64 + c0 + (qq & 15)) * D + h * 64 + j;
        op[0] = f2bf(o[0][r] * rl); op[32] = f2bf(o[1][r] * rl); }
      __syncthreads();
    }
  }

__device__ __forceinline__ void ph_na_simple(const MP& p) {
  const bf16_t* nq = (const bf16_t*)(p.ws + WS_NQ); const bf16_t* nk = (const bf16_t*)(p.ws + WS_NK); const bf16_t* nv = (const bf16_t*)(p.ws + WS_NV);
  const float* rpb = p.in[16]; bf16_t* A = (bf16_t*)(p.ws + WS_A);
  for (int item = blockIdx.x; item < 256; item += gridDim.x) {
    const int bh = item >> 4, t = (item & 15) * 512 + tidx(), b = bh >> 3, hh = bh & 7;
    const int r = t >> 6, c = t & 63;
    int rs = r - 4; rs = rs < 0 ? 0 : (rs > 120 ? 120 : rs);
    int cs = c - 8; cs = cs < 0 ? 0 : (cs > 48 ? 48 : cs);
    float q[64], o[64];
    const bf16_t* qp = nq + ((size_t)bh * SEQ + t) * 64;
#pragma unroll
    for (int d = 0; d < 64; ++d) { q[d] = bf2f(qp[d]); o[d] = 0.f; }
    const bf16_t* Kb = nk + (size_t)bh * NKEY * 64; const bf16_t* Vb = nv + (size_t)bh * NKEY * 64;
    float mx = -3.0e38f, l = 0.f;
    for (int kk = 0; kk < 128 + CT; ++kk) {
      int key; float bias = 0.f;
      if (kk < 128) { const int kr_ = rs + (kk >> 4), kc = cs + (kk & 15); key = CT + kr_ * 64 + kc; bias = rpb[(hh * 15 + (kr_ - r + 7)) * 31 + (kc - c + 15)] * LOG2E; }
      else key = kk - 128;
      const bf16_t* kp = Kb + (size_t)key * 64; float s = bias;
#pragma unroll
      for (int d = 0; d < 64; d += 2) { const unsigned w = *(const unsigned*)(kp + d); s += q[d] * __uint_as_float(w << 16) + q[d + 1] * __uint_as_float(w & 0xFFFF0000u); }
      const float mn = fmaxf(mx, s), alpha = exp2f(mx - mn), pe = exp2f(s - mn);
      l = l * alpha + pe; mx = mn;
      const bf16_t* vp = Vb + (size_t)key * 64;
#pragma unroll
      for (int d = 0; d < 64; d += 2) { const unsigned w = *(const unsigned*)(vp + d); o[d] = o[d] * alpha + pe * __uint_as_float(w << 16); o[d + 1] = o[d + 1] * alpha + pe * __uint_as_float(w & 0xFFFF0000u); }
    }
    const float il = 1.f / l;
    bf16_t* op = A + (size_t)(b * SEQ + t) * D + hh * 64;
#pragma unroll
    for (int d = 0; d < 64; d += 2) *(unsigned*)(op + d) = pack2(o[d] * il, o[d + 1] * il);
  }
}

};

enum { PH_PRE = 0, PH_N1_0, PH_G1_0, PH_HA, PH_HB, PH_HC, PH_G2_0, PH_ROUTE_0, PH_MOE1_0, PH_MOE2_0, PH_COMB_0, PH_G1_1, PH_MLAUP, PH_MLA, PH_G2_1, PH_ROUTE_1, PH_MOE1_1, PH_MOE2_1, PH_FINAL, PH_COUNT };

#ifndef PROBE_PHASE
#define PROBE_PHASE (-1)
#endif
__global__ __launch_bounds__(512) void mega(MP p) {
  unsigned long long pt0 = 0, pt1 = 0;
  extern __shared__ __attribute__((aligned(16))) char smem[];
  char* ws = p.ws;
  MK k; k.wv = __builtin_amdgcn_readfirstlane((int)(threadIdx.x >> 6));
  volatile LAS unsigned* xbw = (volatile LAS unsigned*)(smem + LDS_BYTES - 16);
  if (k.tidx() == 0) { xbw[0] = 0u; xbw[1] = 0u; }
  __syncthreads();
  MK::XcdBarrier bar; bar.bar = (unsigned*)(ws + WS_CTL); bar.x = 0; bar.st = xbw;
  if (p.ph_hi - p.ph_lo > 1) bar = k.xcd_barrier_post((unsigned*)(ws + WS_CTL), xbw);
  const float* mods0 = (const float*)(ws + WS_MODS); const float* mods1 = mods0 + 3 * 6144;
  bf16_t* hbuf = (bf16_t*)(ws + WS_H); bf16_t* abuf = (bf16_t*)(ws + WS_A); bf16_t* U = (bf16_t*)(ws + WS_U); float* xc = (float*)(ws + WS_XC);
  if (p.ph_lo <= PH_PRE && PH_PRE < p.ph_hi) { if (PROBE_PHASE == PH_PRE) pt0 = __builtin_amdgcn_s_memrealtime(); k.ph_ada(p, smem); k.ph_conv_small(p, smem); k.ph_conv_moe(p, 0, smem);
    if (PH_PRE + 1 < p.ph_hi) k.xcd_barrier(bar);
    if (PROBE_PHASE == PH_PRE) pt1 = __builtin_amdgcn_s_memrealtime();
  }
  if (p.ph_lo <= PH_N1_0 && PH_N1_0 < p.ph_hi) { if (PROBE_PHASE == PH_N1_0) pt0 = __builtin_amdgcn_s_memrealtime(); k.ph_norm_mod(p.in[0], p.in[2], p.in[6], mods0, 0, 1024, hbuf, MROWS);
    if (PH_N1_0 + 1 < p.ph_hi) k.xcd_barrier(bar);
    if (PROBE_PHASE == PH_N1_0) pt1 = __builtin_amdgcn_s_memrealtime();
  }
  if (p.ph_lo <= PH_G1_0 && PH_G1_0 < p.ph_hi) { if (PROBE_PHASE == PH_G1_0) pt0 = __builtin_amdgcn_s_memrealtime(); { EpiABIn e; e.U = U; e.LF = (float*)(ws + WS_LF); e.lb = (const float*)(ws + WS_LB);
        k.gemm_phase8(hbuf, (const bf16_t*)(ws + WS_WT_ABIN), NLAT, MROWS, 3072, 1024, e, smem, 0, 3072); }
    if (PH_G1_0 + 1 < p.ph_hi) k.xcd_barrier(bar);
    if (PROBE_PHASE == PH_G1_0) pt1 = __builtin_amdgcn_s_memrealtime();
  }
  if (p.ph_lo <= PH_HA && PH_HA < p.ph_hi) { if (PROBE_PHASE == PH_HA) pt0 = __builtin_amdgcn_s_memrealtime(); k.ph_hgrn_a(p, smem); k.ph_pool_prep(U + 5 * (size_t)MROWS * 512, hbuf);
    if (PH_HA + 1 < p.ph_hi) k.xcd_barrier(bar);
    if (PROBE_PHASE == PH_HA) pt1 = __builtin_amdgcn_s_memrealtime();
  }
  if (p.ph_lo <= PH_HB && PH_HB < p.ph_hi) { if (PROBE_PHASE == PH_HB) pt0 = __builtin_amdgcn_s_memrealtime(); k.ph_hgrn_b(p);
    if (PH_HB + 1 < p.ph_hi) k.xcd_barrier(bar);
    if (PROBE_PHASE == PH_HB) pt1 = __builtin_amdgcn_s_memrealtime();
  }
  if (p.ph_lo <= PH_HC && PH_HC < p.ph_hi) { if (PROBE_PHASE == PH_HC) pt0 = __builtin_amdgcn_s_memrealtime(); k.ph_hgrn_c(p, smem);
    for (int gi = 0; gi < 4; ++gi) { EpiPool e; e.A = abuf; e.scale = p.in[13]; e.gi = gi; e.pad = 0;
      k.template gemm_phase<4>(hbuf + gi * 128, 512, (const bf16_t*)(ws + WS_WT_POOL) + (size_t)gi * 128 * 128, 128, MROWS, 128, 128, e, smem); }
    if (PH_HC + 1 < p.ph_hi) k.xcd_barrier(bar);
    if (PROBE_PHASE == PH_HC) pt1 = __builtin_amdgcn_s_memrealtime();
  }
  if (p.ph_lo <= PH_G2_0 && PH_G2_0 < p.ph_hi) { if (PROBE_PHASE == PH_G2_0) pt0 = __builtin_amdgcn_s_memrealtime(); { EpiOutRes e; e.base_lat = p.in[0]; e.base_ctx = p.in[2]; e.out_lat = p.out; e.out_ctx = xc; e.modl = mods0; e.g_off = 2048; e.pad = 0;
        k.gemm_phase8(abuf, (const bf16_t*)(ws + WS_WT_ABOUT), NLAT, MROWS, 1024, 1024, e, smem, 0, 1024); }
    if (PH_G2_0 + 1 < p.ph_hi) k.xcd_barrier(bar);
    if (PROBE_PHASE == PH_G2_0) pt1 = __builtin_amdgcn_s_memrealtime();
  }
  if (p.ph_lo <= PH_ROUTE_0 && PH_ROUTE_0 < p.ph_hi) { if (PROBE_PHASE == PH_ROUTE_0) pt0 = __builtin_amdgcn_s_memrealtime(); k.ph_router(p, 0, MROWS, smem);
    if (PH_ROUTE_0 + 1 < p.ph_hi) k.xcd_barrier(bar);
    if (PROBE_PHASE == PH_ROUTE_0) pt1 = __builtin_amdgcn_s_memrealtime();
  }
  if (p.ph_lo <= PH_MOE1_0 && PH_MOE1_0 < p.ph_hi) { if (PROBE_PHASE == PH_MOE1_0) pt0 = __builtin_amdgcn_s_memrealtime(); k.template ph_moe1<4>(p, 0, smem);
    if (PH_MOE1_0 + 1 < p.ph_hi) k.xcd_barrier(bar);
    if (PROBE_PHASE == PH_MOE1_0) pt1 = __builtin_amdgcn_s_memrealtime();
  }
  if (p.ph_lo <= PH_MOE2_0 && PH_MOE2_0 < p.ph_hi) { if (PROBE_PHASE == PH_MOE2_0) pt0 = __builtin_amdgcn_s_memrealtime(); k.template ph_moe2<4>(p, 0, smem);
    if (PH_MOE2_0 + 1 < p.ph_hi) k.xcd_barrier(bar);
    if (PROBE_PHASE == PH_MOE2_0) pt1 = __builtin_amdgcn_s_memrealtime();
  }
  if (p.ph_lo <= PH_COMB_0 && PH_COMB_0 < p.ph_hi) { if (PROBE_PHASE == PH_COMB_0) pt0 = __builtin_amdgcn_s_memrealtime(); k.ph_combine(p, 0, MROWS, 0); k.ph_conv_moe(p, 1, smem);
    if (PH_COMB_0 + 1 < p.ph_hi) k.xcd_barrier(bar);
    if (PROBE_PHASE == PH_COMB_0) pt1 = __builtin_amdgcn_s_memrealtime();
  }
  if (p.ph_lo <= PH_G1_1 && PH_G1_1 < p.ph_hi) { if (PROBE_PHASE == PH_G1_1) pt0 = __builtin_amdgcn_s_memrealtime(); { EpiCDIn e; e.nq = (bf16_t*)(ws + WS_NQ); e.nk = (bf16_t*)(ws + WS_NK); e.nv = (bf16_t*)(ws + WS_NV); e.cq = (bf16_t*)(ws + WS_CQ); e.ckv = (bf16_t*)(ws + WS_CKV); e.kr = (float*)(ws + WS_KR);
        k.gemm_phase8(hbuf, (const bf16_t*)(ws + WS_WT_CDIN), NLAT, MROWS, 2048, 1024, e, smem, 512, 2048); }
    if (PH_G1_1 + 1 < p.ph_hi) k.xcd_barrier(bar);
    if (PROBE_PHASE == PH_G1_1) pt1 = __builtin_amdgcn_s_memrealtime();
  }
  if (p.ph_lo <= PH_MLAUP && PH_MLAUP < p.ph_hi) { if (PROBE_PHASE == PH_MLAUP) pt0 = __builtin_amdgcn_s_memrealtime(); {
        { MK::EpiMlaQ2 e; e.dq = (bf16_t*)(ws + WS_DQ); e.cq = (const bf16_t*)(ws + WS_CQ); const int ntn = 6;
          for (int tile = blockIdx.x; tile < (NLAT / 256) * ntn; tile += gridDim.x) { const int mt = tile / ntn, nt = tile - mt * ntn;
            k.template gemm_tile<4>(e.cq, 256, nullptr, 0, NLAT, (const bf16_t*)(ws + WS_WT_UQ), 256, 256, mt * 256, nt * 128, smem, e); } }
        { MK::EpiMlaKV2 e; e.dk = (bf16_t*)(ws + WS_DK); e.dv = (bf16_t*)(ws + WS_DV); e.ckv = (const bf16_t*)(ws + WS_CKV); const int ntn = 8;
          for (int tile = blockIdx.x; tile < (MROWS / 256) * ntn; tile += gridDim.x) { const int mt = tile / ntn, nt = tile - mt * ntn;
            k.template gemm_tile<4>(e.ckv, 128, nullptr, 0, MROWS, (const bf16_t*)(ws + WS_WT_UKV), 128, 128, mt * 256, nt * 128, smem, e); } }
        k.ph_kr_rope((const float*)(ws + WS_KR), (bf16_t*)(ws + WS_DK));
      }
    if (PH_MLAUP + 1 < p.ph_hi) k.xcd_barrier(bar);
    if (PROBE_PHASE == PH_MLAUP) pt1 = __builtin_amdgcn_s_memrealtime();
  }
  if (p.ph_lo <= PH_MLA && PH_MLA < p.ph_hi) { if (PROBE_PHASE == PH_MLA) pt0 = __builtin_amdgcn_s_memrealtime(); k.ph_mla(p, smem); k.ph_na(p, smem);
    if (PH_MLA + 1 < p.ph_hi) k.xcd_barrier(bar);
    if (PROBE_PHASE == PH_MLA) pt1 = __builtin_amdgcn_s_memrealtime();
  }
  if (p.ph_lo <= PH_G2_1 && PH_G2_1 < p.ph_hi) { if (PROBE_PHASE == PH_G2_1) pt0 = __builtin_amdgcn_s_memrealtime(); { EpiOutRes e; e.base_lat = p.out; e.base_ctx = xc; e.out_lat = p.out; e.out_ctx = xc; e.modl = mods1; e.g_off = 2048; e.pad = 0;
        k.gemm_phase8(abuf, (const bf16_t*)(ws + WS_WT_CDOUT), NLAT, NLAT, 1024, 1024, e, smem, 0, 1024); }
    if (PH_G2_1 + 1 < p.ph_hi) k.xcd_barrier(bar);
    if (PROBE_PHASE == PH_G2_1) pt1 = __builtin_amdgcn_s_memrealtime();
  }
  if (p.ph_lo <= PH_ROUTE_1 && PH_ROUTE_1 < p.ph_hi) { if (PROBE_PHASE == PH_ROUTE_1) pt0 = __builtin_amdgcn_s_memrealtime(); k.ph_router(p, 1, NLAT, smem);
    if (PH_ROUTE_1 + 1 < p.ph_hi) k.xcd_barrier(bar);
    if (PROBE_PHASE == PH_ROUTE_1) pt1 = __builtin_amdgcn_s_memrealtime();
  }
  if (p.ph_lo <= PH_MOE1_1 && PH_MOE1_1 < p.ph_hi) { if (PROBE_PHASE == PH_MOE1_1) pt0 = __builtin_amdgcn_s_memrealtime(); k.template ph_moe1<4>(p, 1, smem);
    if (PH_MOE1_1 + 1 < p.ph_hi) k.xcd_barrier(bar);
    if (PROBE_PHASE == PH_MOE1_1) pt1 = __builtin_amdgcn_s_memrealtime();
  }
  if (p.ph_lo <= PH_MOE2_1 && PH_MOE2_1 < p.ph_hi) { if (PROBE_PHASE == PH_MOE2_1) pt0 = __builtin_amdgcn_s_memrealtime(); k.template ph_moe2<4>(p, 1, smem);
    if (PH_MOE2_1 + 1 < p.ph_hi) k.xcd_barrier(bar);
    if (PROBE_PHASE == PH_MOE2_1) pt1 = __builtin_amdgcn_s_memrealtime();
  }
  if (p.ph_lo <= PH_FINAL && PH_FINAL < p.ph_hi) { if (PROBE_PHASE == PH_FINAL) pt0 = __builtin_amdgcn_s_memrealtime(); k.ph_combine(p, 1, NLAT, 1);
    if (PH_FINAL + 1 < p.ph_hi) k.xcd_barrier(bar);
    if (PROBE_PHASE == PH_FINAL) pt1 = __builtin_amdgcn_s_memrealtime();
  }
  if (PROBE_PHASE >= 0 && blockIdx.x == 0) { const unsigned long long te = __builtin_amdgcn_s_memrealtime(), span = (pt1 - pt0) * 8ull; while (__builtin_amdgcn_s_memrealtime() - te < span) __builtin_amdgcn_s_sleep(32); }
}

static void run_phases(hipStream_t st, MP p, int lo, int hi) {
  for (int ph = lo; ph < hi; ++ph) { p.ph_lo = ph; p.ph_hi = ph + 1; hipLaunchKernelGGL(mega, dim3(256), dim3(512), LDS_BYTES, st, p); }
}

extern "C" void kernel_launch(void* const* d_in, const int* in_sizes, int n_in, void* d_out, int out_size, void* d_ws, size_t ws_size, hipStream_t stream) {
  static int ok = 0;
  if (!ok) {
    if (n_in != 29 || in_sizes[0] != NLAT * D || out_size != NLAT * D || ws_size < WS_END) {
      fprintf(stderr, "kernel_launch: unexpected shapes (n_in %d, in0 %d, out %d, ws %zu, need %zu)\n", n_in, n_in > 0 ? in_sizes[0] : -1, out_size, ws_size, (size_t)WS_END);
      return; }
    if (hipFuncSetAttribute((const void*)mega, hipFuncAttributeMaxDynamicSharedMemorySize, LDS_BYTES) != hipSuccess) { fprintf(stderr, "kernel_launch: hipFuncSetAttribute failed\n"); return; }
    ok = 1;
  }
  char* ws = (char*)d_ws; float* out = (float*)d_out;
  MP p; memset(&p, 0, sizeof(p));
  for (int i = 0; i < 29; ++i) p.in[i] = (const float*)d_in[i];
  p.out = out; p.ws = ws;
  hipMemsetAsync(ws + WS_CTL, 0, 65536, stream);
  float* odir_ctx = (float*)(ws + WS_ODIR_CTX);
  bf16_t* abuf = (bf16_t*)(ws + WS_A); bf16_t* U = (bf16_t*)(ws + WS_U); float* LF = (float*)(ws + WS_LF);
  bf16_t* nq = (bf16_t*)(ws + WS_NQ); bf16_t* nk = (bf16_t*)(ws + WS_NK); bf16_t* nv = (bf16_t*)(ws + WS_NV);
  bf16_t* dq = (bf16_t*)(ws + WS_DQ); bf16_t* dk = (bf16_t*)(ws + WS_DK); bf16_t* dv = (bf16_t*)(ws + WS_DV);

  p.ph_lo = 0; p.ph_hi = PH_COUNT;
  void* args[] = {&p};
  const hipError_t le = hipLaunchCooperativeKernel((const void*)mega, dim3(256), dim3(512), args, LDS_BYTES, stream);
  if (le != hipSuccess) fprintf(stderr, "kernel_launch: cooperative launch failed: %s\n", hipGetErrorString(le));
}
```

```cpp
#include <hip/hip_runtime.h>
#include <stdint.h>
#include <cstdio>
#include <cstring>

typedef unsigned short bf16_t;
typedef float f32x4 __attribute__((ext_vector_type(4)));

constexpr int D = 1024, NB = 2, SEQ = 8192, CT = 256;
constexpr int NLAT = NB * SEQ;
constexpr int NCTX = NB * CT;
constexpr int MROWS = NLAT + NCTX;
constexpr int NKEY = CT + SEQ;
constexpr float EPS = 1e-6f;
constexpr float LOG2E = 1.4426950408889634f;
constexpr float NA_QSCALE = 0.125f * LOG2E;
constexpr float MLA_QSCALE = 0.10206207261596577f * LOG2E;

constexpr size_t alignup(size_t x) { return (x + 255) & ~(size_t)255; }
constexpr size_t WS_CTL      = 0;
constexpr size_t WS_MODS     = 65536;
constexpr size_t WS_LB       = WS_MODS + alignup(2 * 3 * 6144 * 4);
constexpr size_t WS_XC       = WS_LB + 4096;
constexpr size_t WS_ROUTE_E  = WS_XC + (size_t)NCTX * D * 4;
constexpr size_t WS_ROUTE_W  = WS_ROUTE_E + alignup((size_t)MROWS * 2 * 4);
constexpr size_t WS_RSTD_Q   = WS_ROUTE_W + alignup((size_t)MROWS * 2 * 4);
constexpr size_t WS_RSTD_KV  = WS_RSTD_Q + alignup((size_t)NLAT * 4);
constexpr size_t WS_ODIR_CTX = WS_RSTD_KV + alignup((size_t)MROWS * 4);
constexpr size_t WS_LIST     = WS_ODIR_CTX + (size_t)2 * NCTX * 512 * 4;
constexpr size_t WS_ALAST    = WS_LIST + (size_t)32 * MROWS * 4;
constexpr size_t WS_WT_ABIN  = WS_ALAST + (size_t)2 * (MROWS / 64) * 512 * 4;
constexpr size_t WS_WT_ABOUT = WS_WT_ABIN + (size_t)3072 * 1024 * 2;
constexpr size_t WS_WT_CDIN  = WS_WT_ABOUT + (size_t)1024 * 1024 * 2;
constexpr size_t WS_WT_CDOUT = WS_WT_CDIN + (size_t)2048 * 1024 * 2;
constexpr size_t WS_WT_UQ    = WS_WT_CDOUT + (size_t)1024 * 1024 * 2;
constexpr size_t WS_WT_UKV   = WS_WT_UQ + (size_t)768 * 256 * 2;
constexpr size_t WS_WT_POOL  = WS_WT_UKV + (size_t)1024 * 128 * 2;
constexpr size_t WS_WMOE     = WS_WT_POOL + (size_t)4 * 128 * 128 * 2;
constexpr size_t WS_H        = WS_WMOE + (size_t)32 * 512 * 1024 * 2 + (size_t)32 * 1024 * 256 * 2;
constexpr size_t WS_A        = WS_H + (size_t)MROWS * D * 2;
constexpr size_t WS_U        = WS_A + (size_t)MROWS * D * 2;
constexpr size_t USLOT       = (size_t)MROWS * 512 * 2;
constexpr size_t WS_LF       = WS_U + 6 * USLOT;
constexpr size_t WS_END      = WS_LF + (size_t)2 * MROWS * 512 * 4;
constexpr size_t WS_NQ   = WS_U;
constexpr size_t WS_NK   = WS_NQ + (size_t)NLAT * 512 * 2;
constexpr size_t WS_NV   = WS_NK + USLOT;
constexpr size_t WS_CQ   = WS_NV + USLOT;
constexpr size_t WS_CKV  = WS_CQ + (size_t)NLAT * 256 * 2;
constexpr size_t WS_KR   = WS_CKV + (size_t)MROWS * 128 * 2;
constexpr size_t WS_DQ   = WS_KR + (size_t)MROWS * 32 * 4;
constexpr size_t WS_L1END = WS_DQ + (size_t)NLAT * 768 * 2;
static_assert(WS_L1END <= WS_LF, "layer-1 overlay too big");
constexpr size_t WS_DK   = WS_LF;
constexpr size_t WS_DV   = WS_DK + (size_t)MROWS * 1024 * 2;
static_assert(WS_DV + (size_t)MROWS * 512 * 2 <= WS_END, "dk/dv overlay too big");
constexpr size_t WS_YBUF = WS_LF;
constexpr size_t WS_AMOE = WS_U;

__device__ __forceinline__ float bf2f(bf16_t h) { return __uint_as_float(((unsigned)h) << 16); }
__device__ __forceinline__ unsigned pack2(float a, float b) { unsigned r; asm("v_cvt_pk_bf16_f32 %0, %1, %2" : "=v"(r) : "v"(a), "v"(b)); return r; }
__device__ __forceinline__ bf16_t f2bf(float f) { return (bf16_t)(pack2(f, 0.f) & 0xFFFFu); }
__device__ __forceinline__ float sigmoidf_(float x) { return __builtin_amdgcn_rcpf(1.f + __expf(-x)); }
__device__ __forceinline__ float siluf_(float x) { return x * __builtin_amdgcn_rcpf(1.f + __expf(-x)); }
__device__ __forceinline__ float wave_sum(float v) {
#pragma unroll
  for (int o = 1; o < 64; o <<= 1) v += __shfl_xor(v, o);
  return v;
}
__device__ __forceinline__ int row_vec(int m) { return m < NLAT ? (m >> 13) : 2; }
__device__ __forceinline__ void row_bkey(int m, int& b, int& key) {
  if (m < NLAT) { b = m >> 13; key = CT + (m & 8191); } else { const int mm = m - NLAT; b = mm >> 8; key = mm & 255; }
}

__global__ __launch_bounds__(512) void k_ada(const float* __restrict__ c, const float* __restrict__ cctx, const float* __restrict__ ada_w,
                                             const float* __restrict__ ada_b, float* __restrict__ mods) {
  const int l = blockIdx.y, n0 = blockIdx.x * 64, j = threadIdx.x & 63, kg = threadIdx.x >> 6;
  __shared__ float sv[3][1024];
  __shared__ float red[8][3][64];
  for (int i = threadIdx.x; i < 1024; i += 512) { sv[0][i] = siluf_(c[i]); sv[1][i] = siluf_(c[1024 + i]); sv[2][i] = siluf_(cctx[i]); }
  __syncthreads();
  const float* W = ada_w + (size_t)l * 1024 * 6144 + n0 + j;
  float a0 = 0.f, a1 = 0.f, a2 = 0.f;
  for (int k = kg * 128; k < kg * 128 + 128; ++k) { const float w = W[(size_t)k * 6144]; a0 += sv[0][k] * w; a1 += sv[1][k] * w; a2 += sv[2][k] * w; }
  red[kg][0][j] = a0; red[kg][1][j] = a1; red[kg][2][j] = a2;
  __syncthreads();
  if (threadIdx.x < 192) {
    const int v = threadIdx.x >> 6, jj = threadIdx.x & 63; float s = 0.f;
    for (int g = 0; g < 8; ++g) s += red[g][v][jj];
    mods[(size_t)(l * 3 + v) * 6144 + n0 + jj] = s + ada_b[l * 6144 + n0 + jj];
  }
}
__global__ void k_lb(const float* __restrict__ logits, float* __restrict__ lb) {
  const int i = blockIdx.x * blockDim.x + threadIdx.x;
  if (i < 1024) { const int d = i >> 9, cc = i & 511; const float l0 = logits[(d * 2 + 0) * 512 + cc], l1 = logits[(d * 2 + 1) * 512 + cc]; lb[i] = 1.f / (1.f + expf(l1 - l0)); }
}

struct ConvArgs { const float* src; bf16_t* dst; const float* kscale; int K, N, Npad, mode; size_t sbs, dbs; };
__device__ __forceinline__ int moe_gu_row(int sel, int hidden) {
  return (hidden >> 4) * 32 + sel * 16 + (hidden & 15);
}
__global__ __launch_bounds__(512) void k_convT(ConvArgs a) {
  __shared__ float tile[64][65];
  const float* src = a.src + blockIdx.z * a.sbs; bf16_t* dst = a.dst + blockIdx.z * a.dbs;
  const int n0 = blockIdx.x * 64, k0 = blockIdx.y * 64, tx = threadIdx.x & 63, ty = threadIdx.x >> 6;
#pragma unroll
  for (int i = 0; i < 8; ++i) {
    const int k = k0 + ty + 8 * i, n = n0 + tx; float v = 0.f;
    if (n < a.N) { v = src[(size_t)k * a.N + n]; if (a.kscale) v *= a.kscale[k]; }
    tile[ty + 8 * i][tx] = v;
  }
  __syncthreads();
#pragma unroll
  for (int i = 0; i < 8; ++i) {
    const int nl = ty + 8 * i, n = n0 + nl;
    if (n < a.Npad) { int row = n; if (a.mode == 1) row = moe_gu_row(0, n); else if (a.mode == 2) row = moe_gu_row(1, n);
      dst[(size_t)row * a.K + k0 + tx] = f2bf(tile[tx][nl]); }
  }
}

__global__ __launch_bounds__(512) void k_norm_mod(const float* __restrict__ lat, const float* __restrict__ ctxr, const float* __restrict__ gain,
                                                  const float* __restrict__ modl, int sh_off, int sc_off, bf16_t* __restrict__ out, int nrows) {
  const int lane = threadIdx.x & 63, gw = blockIdx.x * 8 + (threadIdx.x >> 6);
  for (int row = gw; row < nrows; row += gridDim.x * 8) {
    const float* src = row < NLAT ? lat + (size_t)row * D : ctxr + (size_t)(row - NLAT) * D;
    const float* mv = modl + row_vec(row) * 6144;
    f32x4 x[4]; float ss = 0.f;
#pragma unroll
    for (int j = 0; j < 4; ++j) { x[j] = ((const f32x4*)src)[lane + 64 * j]; ss += x[j].x * x[j].x + x[j].y * x[j].y + x[j].z * x[j].z + x[j].w * x[j].w; }
    const float rstd = 1.f / sqrtf(wave_sum(ss) * (1.f / D) + EPS);
#pragma unroll
    for (int j = 0; j < 4; ++j) {
      const int n = (lane + 64 * j) * 4;
      const f32x4 g = *(const f32x4*)(gain + n), sc = *(const f32x4*)(mv + sc_off + n), sh = *(const f32x4*)(mv + sh_off + n);
      const f32x4 h = x[j] * rstd * g * (sc + 1.f) + sh;
      uint2 o; o.x = pack2(h.x, h.y); o.y = pack2(h.z, h.w);
      *(uint2*)(out + (size_t)row * D + n) = o;
    }
  }
}

struct EpiABIn {
  bf16_t* U; float* LF; const float* lb;
  __device__ __forceinline__ void apply(int m, int n, f32x4 v) const {
    const int seg = n >> 9, cn = n & 511; float o[4] = {v.x, v.y, v.z, v.w};
    bf16_t* dst;
    if (seg == 0) { dst = U; for (int i = 0; i < 4; ++i) o[i] = siluf_(o[i]); }
    else if (seg == 1 || seg == 2) { const int d = seg - 1; dst = U + (size_t)(1 + d) * MROWS * 512;
      f32x4 lg;
#pragma unroll
      for (int i = 0; i < 4; ++i) { const float l = lb[d * 512 + cn + i]; const float k = (1.f - l) * sigmoidf_(-o[i]); o[i] = k; lg[i] = __logf(1.f - k); }
      *(f32x4*)(LF + ((size_t)d * MROWS + m) * 512 + cn) = lg; }
    else if (seg == 3) dst = U + (size_t)3 * MROWS * 512;
    else if (seg == 4) { dst = U + (size_t)4 * MROWS * 512; for (int i = 0; i < 4; ++i) o[i] = siluf_(o[i]); }
    else dst = U + (size_t)5 * MROWS * 512;
    uint2 w; w.x = pack2(o[0], o[1]); w.y = pack2(o[2], o[3]);
    *(uint2*)(dst + (size_t)m * 512 + cn) = w;
  }
};
struct EpiPool {
  bf16_t* A; const float* scale; int gi; int pad;
  __device__ __forceinline__ void apply(int m, int n, f32x4 v) const {
    const int cn = gi * 128 + n; const f32x4 s = *(const f32x4*)(scale + cn); v = v * s;
    uint2 w; w.x = pack2(v.x, v.y); w.y = pack2(v.z, v.w);
    *(uint2*)(A + (size_t)m * D + 512 + cn) = w;
  }
};
struct EpiOutRes {
  const float* base_lat; const float* base_ctx; float* out_lat; float* out_ctx; const float* modl; int g_off; int pad;
  __device__ __forceinline__ void apply(int m, int n, f32x4 v) const {
    const f32x4 g = *(const f32x4*)(modl + row_vec(m) * 6144 + g_off + n);
    if (m < NLAT) { const f32x4 b = *(const f32x4*)(base_lat + (size_t)m * D + n); *(f32x4*)(out_lat + (size_t)m * D + n) = b + g * v; }
    else { const size_t o = (size_t)(m - NLAT) * D + n; const f32x4 b = *(const f32x4*)(base_ctx + o); *(f32x4*)(out_ctx + o) = b + g * v; }
  }
};
struct EpiCDIn {
  bf16_t *nq, *nk, *nv, *cq, *ckv; float* kr;
  __device__ __forceinline__ void apply(int m, int n, f32x4 v) const {
    int b, key; row_bkey(m, b, key);
    if (n < 1536) {
      const int which = n >> 9, hh = (n & 511) >> 6, dd = n & 63;
      if (which == 0) { if (m >= NLAT) return; v = v * NA_QSCALE;
        uint2 w; w.x = pack2(v.x, v.y); w.y = pack2(v.z, v.w);
        *(uint2*)(nq + (((size_t)(b * 8 + hh) * SEQ + (m & 8191)) * 64 + dd)) = w; }
      else { bf16_t* dst = which == 1 ? nk : nv; uint2 w; w.x = pack2(v.x, v.y); w.y = pack2(v.z, v.w);
        *(uint2*)(dst + (((size_t)(b * 8 + hh) * NKEY + key) * 64 + dd)) = w; }
    } else if (n < 1792) { if (m >= NLAT) return; uint2 w; w.x = pack2(v.x, v.y); w.y = pack2(v.z, v.w); *(uint2*)(cq + (size_t)m * 256 + (n - 1536)) = w; }
    else if (n < 1920) { uint2 w; w.x = pack2(v.x, v.y); w.y = pack2(v.z, v.w); *(uint2*)(ckv + (size_t)m * 128 + (n - 1792)) = w; }
    else if (n < 1952) { *(f32x4*)(kr + (size_t)m * 32 + (n - 1920)) = v; }
  }
};
struct EpiMlaQ {
  bf16_t* dq; const float* rstd;
  __device__ __forceinline__ void apply(int m, int n, f32x4 v) const {
    const int hh = n / 96, off = n - hh * 96; v = v * (rstd[m] * MLA_QSCALE);
    uint2 w; w.x = pack2(v.x, v.y); w.y = pack2(v.z, v.w);
    *(uint2*)(dq + (((size_t)((m >> 13) * 8 + hh) * SEQ + (m & 8191)) * 96 + off)) = w;
  }
};
struct EpiMlaKV {
  bf16_t *dk, *dv; const float* rstd;
  __device__ __forceinline__ void apply(int m, int n, f32x4 v) const {
    int b, key; row_bkey(m, b, key);
    const int hh = n >> 7, off = n & 127; v = v * rstd[m];
    uint2 w; w.x = pack2(v.x, v.y); w.y = pack2(v.z, v.w);
    if (off < 64) *(uint2*)(dk + (((size_t)(b * 8 + hh) * NKEY + key) * 128 + off)) = w;
    else *(uint2*)(dv + (((size_t)(b * 8 + hh) * NKEY + key) * 64 + (off - 64))) = w;
  }
};

template <class Epi>
__global__ __launch_bounds__(256) void k_gemm_naive(const bf16_t* __restrict__ A, int lda, const bf16_t* __restrict__ Bt, int ldb, int M, int N, int K, Epi epi) {
  __shared__ float As[32][68];
  __shared__ float Bs[32][68];
  const int m0 = blockIdx.y * 64, n0 = blockIdx.x * 64, t = threadIdx.x, tx = t & 15, ty = t >> 4;
  float acc[4][4];
#pragma unroll
  for (int i = 0; i < 4; ++i)
#pragma unroll
    for (int j = 0; j < 4; ++j) acc[i][j] = 0.f;
  const int lr = t >> 2, lk = (t & 3) * 8;
  for (int k0 = 0; k0 < K; k0 += 32) {
    uint4 ra = make_uint4(0, 0, 0, 0), rb = make_uint4(0, 0, 0, 0);
    if (m0 + lr < M) ra = *(const uint4*)(A + (size_t)(m0 + lr) * lda + k0 + lk);
    if (n0 + lr < N) rb = *(const uint4*)(Bt + (size_t)(n0 + lr) * ldb + k0 + lk);
    const unsigned wa[4] = {ra.x, ra.y, ra.z, ra.w}, wb[4] = {rb.x, rb.y, rb.z, rb.w};
#pragma unroll
    for (int i = 0; i < 4; ++i) {
      As[lk + 2 * i][lr] = __uint_as_float(wa[i] << 16); As[lk + 2 * i + 1][lr] = __uint_as_float(wa[i] & 0xFFFF0000u);
      Bs[lk + 2 * i][lr] = __uint_as_float(wb[i] << 16); Bs[lk + 2 * i + 1][lr] = __uint_as_float(wb[i] & 0xFFFF0000u);
    }
    __syncthreads();
#pragma unroll 8
    for (int kk = 0; kk < 32; ++kk) {
      const f32x4 a = *(const f32x4*)&As[kk][ty * 4], b = *(const f32x4*)&Bs[kk][tx * 4];
      const float av[4] = {a.x, a.y, a.z, a.w}, bv[4] = {b.x, b.y, b.z, b.w};
#pragma unroll
      for (int i = 0; i < 4; ++i)
#pragma unroll
        for (int j = 0; j < 4; ++j) acc[i][j] += av[i] * bv[j];
    }
    __syncthreads();
  }
#pragma unroll
  for (int i = 0; i < 4; ++i) {
    const int m = m0 + ty * 4 + i, n = n0 + tx * 4;
    if (m < M && n < N) { f32x4 v = {acc[i][0], acc[i][1], acc[i][2], acc[i][3]}; epi.apply(m, n, v); }
  }
}
template <class Epi>
static void launch_gemm_naive(hipStream_t st, const bf16_t* A, int lda, const bf16_t* Bt, int ldb, int M, int N, int K, Epi epi) {
  hipLaunchKernelGGL((k_gemm_naive<Epi>), dim3((N + 63) / 64, (M + 63) / 64), dim3(256), 0, st, A, lda, Bt, ldb, M, N, K, epi);
}

__device__ __forceinline__ int hgrn_step_row(int b, int dir, int s) {
  if (s < CT) return NLAT + b * CT + (dir ? (CT - 1 - s) : s);
  const int ls = s - CT; return b * SEQ + (dir ? (SEQ - 1 - ls) : ls);
}
__global__ __launch_bounds__(128) void k_hgrn_naive(const bf16_t* __restrict__ U, const float* __restrict__ LF, float* __restrict__ odir_lat, float* __restrict__ odir_ctx) {
  const int bid = blockIdx.x, dir = bid & 1, h = (bid >> 1) & 3, b = bid >> 3, e = threadIdx.x;
  __shared__ float sf[32][128];
  __shared__ float sk[32][128];
  __shared__ float sq[32][128];
  float Sreg[128];
#pragma unroll
  for (int d = 0; d < 128; ++d) Sreg[d] = 0.f;
  const bf16_t* Uq = U; const bf16_t* Uk = U + (size_t)(1 + dir) * MROWS * 512; const bf16_t* Uv = U + (size_t)3 * MROWS * 512;
  const float* lf = LF + (size_t)dir * MROWS * 512;
  for (int s0 = 0; s0 < NKEY; s0 += 32) {
    __syncthreads();
    for (int i = 0; i < 32; ++i) {
      const size_t off = (size_t)hgrn_step_row(b, dir, s0 + i) * 512 + h * 128 + e;
      sf[i][e] = expf(lf[off]); sk[i][e] = bf2f(Uk[off]); sq[i][e] = bf2f(Uq[off]);
    }
    __syncthreads();
    for (int i = 0; i < 32; ++i) {
      const int row = hgrn_step_row(b, dir, s0 + i);
      const float v = bf2f(Uv[(size_t)row * 512 + h * 128 + e]); float o = 0.f;
#pragma unroll
      for (int d = 0; d < 128; ++d) { Sreg[d] = sf[i][d] * Sreg[d] + sk[i][d] * v; o += Sreg[d] * sq[i][d]; }
      if (row < NLAT) odir_lat[((size_t)dir * NLAT + row) * 512 + h * 128 + e] = o;
      else odir_ctx[((size_t)dir * NCTX + (row - NLAT)) * 512 + h * 128 + e] = o;
    }
  }
}
__global__ __launch_bounds__(512) void k_hgrn_out(const float* __restrict__ odir_lat, const float* __restrict__ odir_ctx, const bf16_t* __restrict__ Ug,
                                                  const float* __restrict__ onorm_g, bf16_t* __restrict__ A) {
  const int lane = threadIdx.x & 63, gw = blockIdx.x * 8 + (threadIdx.x >> 6);
  for (int row = gw; row < MROWS; row += gridDim.x * 8) {
    const float* pf = row < NLAT ? odir_lat + (size_t)row * 512 : odir_ctx + (size_t)(row - NLAT) * 512;
    const float* pb = row < NLAT ? odir_lat + ((size_t)NLAT + row) * 512 : odir_ctx + ((size_t)NCTX + (row - NLAT)) * 512;
    const int c0 = lane * 8; float o[8]; float ss = 0.f;
#pragma unroll
    for (int i = 0; i < 8; ++i) { o[i] = pf[c0 + i] + pb[c0 + i]; ss += o[i] * o[i]; }
    ss += __shfl_xor(ss, 1); ss += __shfl_xor(ss, 2); ss += __shfl_xor(ss, 4); ss += __shfl_xor(ss, 8);
    const float rstd = 1.f / sqrtf(ss * (1.f / 128.f) + EPS);
    const uint4 gr = *(const uint4*)(Ug + (size_t)row * 512 + c0); const unsigned gw4[4] = {gr.x, gr.y, gr.z, gr.w};
    unsigned w[4];
#pragma unroll
    for (int i = 0; i < 4; ++i) {
      const float g0 = __uint_as_float(gw4[i] << 16), g1 = __uint_as_float(gw4[i] & 0xFFFF0000u);
      const int e0 = (c0 + 2 * i) & 127;
      w[i] = pack2(o[2 * i] * rstd * onorm_g[e0] * g0, o[2 * i + 1] * rstd * onorm_g[e0 + 1] * g1);
    }
    *(uint4*)(A + (size_t)row * D + c0) = make_uint4(w[0], w[1], w[2], w[3]);
  }
}
__global__ __launch_bounds__(512) void k_pool_prep(const bf16_t* __restrict__ Up, bf16_t* __restrict__ pd) {
  const int c = threadIdx.x;
  for (int row = blockIdx.x; row < MROWS; row += gridDim.x) {
    int base, t, n; if (row < NLAT) { base = row & ~8191; t = row & 8191; n = SEQ; } else { const int mm = row - NLAT; base = NLAT + (mm & ~255); t = mm & 255; n = CT; }
    const int gi = c >> 7, win = 2 << gi; int lo = t - win / 2, hi = t + win - win / 2; lo = lo < 0 ? 0 : lo; hi = hi > n ? n : hi;
    float s = 0.f; for (int r = lo; r < hi; ++r) s += bf2f(Up[(size_t)(base + r) * 512 + c]);
    pd[(size_t)row * 512 + c] = f2bf(s / (float)(hi - lo) - bf2f(Up[(size_t)row * 512 + c]));
  }
}

__global__ __launch_bounds__(512) void k_router(const float* __restrict__ lat, const float* __restrict__ ctxr, const float* __restrict__ gain, const float* __restrict__ modl,
                                                const float* __restrict__ wrg, const float* __restrict__ brg, const float* __restrict__ wre, const float* __restrict__ bre,
                                                bf16_t* __restrict__ out, int* __restrict__ re, float* __restrict__ rw, int nrows) {
  __shared__ float hs[8][1024];
  const int lane = threadIdx.x & 63, wv = threadIdx.x >> 6, gw = blockIdx.x * 8 + wv;
  const float* wp = lane < 4 ? wrg + lane : wre + ((lane - 4) & 31); const int wst = lane < 4 ? 4 : 32;
  const float bias = lane < 4 ? brg[lane] : bre[(lane - 4) & 31];
  for (int row = gw; row < nrows; row += gridDim.x * 8) {
    const float* src = row < NLAT ? lat + (size_t)row * D : ctxr + (size_t)(row - NLAT) * D;
    const float* mv = modl + row_vec(row) * 6144;
    f32x4 x[4]; float ss = 0.f;
#pragma unroll
    for (int j = 0; j < 4; ++j) { x[j] = ((const f32x4*)src)[lane + 64 * j]; ss += x[j].x * x[j].x + x[j].y * x[j].y + x[j].z * x[j].z + x[j].w * x[j].w; }
    const float rstd = 1.f / sqrtf(wave_sum(ss) * (1.f / D) + EPS);
#pragma unroll
    for (int j = 0; j < 4; ++j) {
      const int n = (lane + 64 * j) * 4;
      const f32x4 g = *(const f32x4*)(gain + n), sc = *(const f32x4*)(mv + 4096 + n), sh = *(const f32x4*)(mv + 3072 + n);
      const f32x4 h = x[j] * rstd * g * (sc + 1.f) + sh;
      uint2 o; o.x = pack2(h.x, h.y); o.y = pack2(h.z, h.w);
      *(uint2*)(out + (size_t)row * D + n) = o;
      *(f32x4*)&hs[wv][n] = h;
    }
    __builtin_amdgcn_wave_barrier();
    float acc = 0.f;
#pragma unroll 8
    for (int k = 0; k < 1024; ++k) acc += hs[wv][k] * wp[(size_t)k * wst];
    acc += bias;
    __builtin_amdgcn_wave_barrier();
    float gl[4];
#pragma unroll
    for (int i = 0; i < 4; ++i) gl[i] = __shfl(acc, i);
    int gi = 0; float gm = gl[0];
#pragma unroll
    for (int i = 1; i < 4; ++i) if (gl[i] > gm) { gm = gl[i]; gi = i; }
    float gs = 0.f;
#pragma unroll
    for (int i = 0; i < 4; ++i) gs += expf(gl[i] - gm);
    const float gp = 1.f / gs;
    float el[8];
#pragma unroll
    for (int i = 0; i < 8; ++i) el[i] = __shfl(acc, 4 + gi * 8 + i);
    int e1 = 0; float m1 = el[0];
#pragma unroll
    for (int i = 1; i < 8; ++i) if (el[i] > m1) { m1 = el[i]; e1 = i; }
    int e2 = 0; float m2 = -3.0e38f;
#pragma unroll
    for (int i = 0; i < 8; ++i) if (i != e1 && el[i] > m2) { m2 = el[i]; e2 = i; }
    const float w1 = 1.f / (1.f + expf(m2 - m1)), w2 = 1.f - w1;
    if (lane == 0) { re[row * 2] = gi * 8 + e1; re[row * 2 + 1] = gi * 8 + e2; rw[row * 2] = gp * w1; rw[row * 2 + 1] = gp * w2; }
  }
}

__global__ __launch_bounds__(256) void k_moe_naive(const bf16_t* __restrict__ H, const int* __restrict__ re, const float* __restrict__ rw,
                                                   const float* __restrict__ Wg, const float* __restrict__ Wu, const float* __restrict__ Wd, bf16_t* __restrict__ Y) {
  const int row = blockIdx.x, f = threadIdx.x;
  __shared__ float hs[1024];
  __shared__ float as_[256];
  for (int i = f; i < 1024; i += 256) hs[i] = bf2f(H[(size_t)row * D + i]);
  __syncthreads();
  for (int slot = 0; slot < 2; ++slot) {
    const int e = re[row * 2 + slot]; const float w = rw[row * 2 + slot];
    const float* wg = Wg + (size_t)e * 1024 * 256 + f; const float* wu = Wu + (size_t)e * 1024 * 256 + f;
    float g = 0.f, u = 0.f;
#pragma unroll 8
    for (int k = 0; k < 1024; ++k) { g += hs[k] * wg[(size_t)k * 256]; u += hs[k] * wu[(size_t)k * 256]; }
    as_[f] = siluf_(g) * u * w;
    __syncthreads();
    const float* wd = Wd + (size_t)e * 256 * 1024;
    float y[4] = {0.f, 0.f, 0.f, 0.f};
#pragma unroll 4
    for (int k = 0; k < 256; ++k) { const float a = as_[k];
#pragma unroll
      for (int i = 0; i < 4; ++i) y[i] += a * wd[(size_t)k * 1024 + f + 256 * i]; }
#pragma unroll
    for (int i = 0; i < 4; ++i) Y[((size_t)row * 2 + slot) * D + f + 256 * i] = f2bf(y[i]);
    __syncthreads();
  }
}

__global__ __launch_bounds__(512) void k_combine_norm(float* __restrict__ lat, float* __restrict__ ctxr, const bf16_t* __restrict__ Y, const float* __restrict__ modl_cur,
                                                      const float* __restrict__ gain, const float* __restrict__ modl_next, bf16_t* __restrict__ hout, int nrows, int final_) {
  const int lane = threadIdx.x & 63, gw = blockIdx.x * 8 + (threadIdx.x >> 6);
  for (int row = gw; row < nrows; row += gridDim.x * 8) {
    float* src = row < NLAT ? lat + (size_t)row * D : ctxr + (size_t)(row - NLAT) * D;
    const int v = row_vec(row);
    f32x4 x[4]; float ss = 0.f;
#pragma unroll
    for (int j = 0; j < 4; ++j) {
      const int n = (lane + 64 * j) * 4;
      const f32x4 g2 = *(const f32x4*)(modl_cur + v * 6144 + 5120 + n);
      const uint2 y0 = *(const uint2*)(Y + ((size_t)row * 2) * D + n), y1 = *(const uint2*)(Y + ((size_t)row * 2 + 1) * D + n);
      f32x4 ys;
      ys.x = __uint_as_float(y0.x << 16) + __uint_as_float(y1.x << 16); ys.y = __uint_as_float(y0.x & 0xFFFF0000u) + __uint_as_float(y1.x & 0xFFFF0000u);
      ys.z = __uint_as_float(y0.y << 16) + __uint_as_float(y1.y << 16); ys.w = __uint_as_float(y0.y & 0xFFFF0000u) + __uint_as_float(y1.y & 0xFFFF0000u);
      x[j] = ((const f32x4*)src)[lane + 64 * j] + g2 * ys;
      ss += x[j].x * x[j].x + x[j].y * x[j].y + x[j].z * x[j].z + x[j].w * x[j].w;
    }
    const float rstd = 1.f / sqrtf(wave_sum(ss) * (1.f / D) + EPS);
#pragma unroll
    for (int j = 0; j < 4; ++j) {
      const int n = (lane + 64 * j) * 4;
      const f32x4 g = *(const f32x4*)(gain + n);
      if (final_) { ((f32x4*)src)[lane + 64 * j] = x[j] * rstd * g; }
      else {
        ((f32x4*)src)[lane + 64 * j] = x[j];
        const f32x4 sc = *(const f32x4*)(modl_next + v * 6144 + 1024 + n), sh = *(const f32x4*)(modl_next + v * 6144 + n);
        const f32x4 h = x[j] * rstd * g * (sc + 1.f) + sh;
        uint2 o; o.x = pack2(h.x, h.y); o.y = pack2(h.z, h.w);
        *(uint2*)(hout + (size_t)row * D + n) = o;
      }
    }
  }
}

__global__ __launch_bounds__(512) void k_rowssq(const bf16_t* __restrict__ cq, const bf16_t* __restrict__ ckv, float* __restrict__ rq, float* __restrict__ rkv) {
  const int lane = threadIdx.x & 63, gw = blockIdx.x * 8 + (threadIdx.x >> 6);
  for (int row = gw; row < MROWS; row += gridDim.x * 8) {
    { const unsigned w = *(const unsigned*)(ckv + (size_t)row * 128 + lane * 2); const float a = __uint_as_float(w << 16), b = __uint_as_float(w & 0xFFFF0000u);
      const float ss = wave_sum(a * a + b * b); if (lane == 0) rkv[row] = 1.f / sqrtf(ss * (1.f / 128.f) + EPS); }
    if (row < NLAT) { const uint2 w = *(const uint2*)(cq + (size_t)row * 256 + lane * 4);
      const float a = __uint_as_float(w.x << 16), b = __uint_as_float(w.x & 0xFFFF0000u), c = __uint_as_float(w.y << 16), d = __uint_as_float(w.y & 0xFFFF0000u);
      const float ss = wave_sum(a * a + b * b + c * c + d * d); if (lane == 0) rq[row] = 1.f / sqrtf(ss * (1.f / 256.f) + EPS); }
  }
}
__device__ __forceinline__ float rope_inv(int i) { return exp2f(-(float)i * (13.287712379549449f / 8.f)); }
__global__ __launch_bounds__(256) void k_kr_rope(const float* __restrict__ kr, bf16_t* __restrict__ dk) {
  const int idx = blockIdx.x * 256 + threadIdx.x; if (idx >= MROWS * 32) return;
  const int m = idx >> 5, j = idx & 31; int b, key; row_bkey(m, b, key);
  float val = kr[idx];
  if (m < NLAT) {
    const int t = m & 8191; const int half = j >> 4, jj = j & 15, i = jj & 7;
    const float pos = half ? (float)(t & 63) : (float)(t >> 6);
    const float ang = pos * rope_inv(i); float sn, cs; sincosf(ang, &sn, &cs);
    const float x1 = kr[(size_t)m * 32 + half * 16 + i], x2 = kr[(size_t)m * 32 + half * 16 + 8 + i];
    val = (jj < 8) ? (x1 * cs - x2 * sn) : (x1 * sn + x2 * cs);
  }
  const bf16_t o = f2bf(val);
#pragma unroll
  for (int hh = 0; hh < 8; ++hh) dk[((size_t)(b * 8 + hh) * NKEY + key) * 128 + 64 + j] = o;
}

__global__ __launch_bounds__(64) void k_na_naive(const bf16_t* __restrict__ nq, const bf16_t* __restrict__ nk, const bf16_t* __restrict__ nv, const float* __restrict__ rpb,
                                                 bf16_t* __restrict__ A) {
  const int t = blockIdx.x * 64 + threadIdx.x, hh = blockIdx.y, b = blockIdx.z;
  const int r = t >> 6, c = t & 63;
  int rs = r - 4; rs = rs < 0 ? 0 : (rs > 120 ? 120 : rs);
  int cs = c - 8; cs = cs < 0 ? 0 : (cs > 48 ? 48 : cs);
  float q[64], o[64];
  const bf16_t* qp = nq + ((size_t)(b * 8 + hh) * SEQ + t) * 64;
#pragma unroll
  for (int d = 0; d < 64; ++d) { q[d] = bf2f(qp[d]); o[d] = 0.f; }
  const bf16_t* Kb = nk + (size_t)(b * 8 + hh) * NKEY * 64; const bf16_t* Vb = nv + (size_t)(b * 8 + hh) * NKEY * 64;
  float mx = -3.0e38f, l = 0.f;
  for (int kk = 0; kk < 128 + CT; ++kk) {
    int key; float bias = 0.f;
    if (kk < 128) { const int kr_ = rs + (kk >> 4), kc = cs + (kk & 15); key = CT + kr_ * 64 + kc; bias = rpb[(hh * 15 + (kr_ - r + 7)) * 31 + (kc - c + 15)] * LOG2E; }
    else key = kk - 128;
    const bf16_t* kp = Kb + (size_t)key * 64; float s = bias;
#pragma unroll
    for (int d = 0; d < 64; d += 2) { const unsigned w = *(const unsigned*)(kp + d); s += q[d] * __uint_as_float(w << 16) + q[d + 1] * __uint_as_float(w & 0xFFFF0000u); }
    const float mn = fmaxf(mx, s), alpha = exp2f(mx - mn), p = exp2f(s - mn);
    l = l * alpha + p; mx = mn;
    const bf16_t* vp = Vb + (size_t)key * 64;
#pragma unroll
    for (int d = 0; d < 64; d += 2) { const unsigned w = *(const unsigned*)(vp + d); o[d] = o[d] * alpha + p * __uint_as_float(w << 16); o[d + 1] = o[d + 1] * alpha + p * __uint_as_float(w & 0xFFFF0000u); }
  }
  const float il = 1.f / l;
  bf16_t* op = A + (size_t)(b * SEQ + t) * D + hh * 64;
#pragma unroll
  for (int d = 0; d < 64; d += 2) *(unsigned*)(op + d) = pack2(o[d] * il, o[d + 1] * il);
}
__global__ __launch_bounds__(64) void k_mla_naive(const bf16_t* __restrict__ dq, const bf16_t* __restrict__ dk, const bf16_t* __restrict__ dv, bf16_t* __restrict__ A) {
  const int t = blockIdx.x * 64 + threadIdx.x, hh = blockIdx.y, b = blockIdx.z;
  float q[96], o[64];
  const bf16_t* qp = dq + ((size_t)(b * 8 + hh) * SEQ + t) * 96;
#pragma unroll
  for (int d = 0; d < 96; ++d) q[d] = bf2f(qp[d]);
#pragma unroll
  for (int half = 0; half < 2; ++half) {
    const float pos = half ? (float)(t & 63) : (float)(t >> 6);
#pragma unroll
    for (int i = 0; i < 8; ++i) { float sn, cs; sincosf(pos * rope_inv(i), &sn, &cs);
      const float x1 = q[64 + half * 16 + i], x2 = q[64 + half * 16 + 8 + i];
      q[64 + half * 16 + i] = x1 * cs - x2 * sn; q[64 + half * 16 + 8 + i] = x1 * sn + x2 * cs; }
  }
#pragma unroll
  for (int d = 0; d < 64; ++d) o[d] = 0.f;
  const bf16_t* Kb = dk + (size_t)(b * 8 + hh) * NKEY * 128; const bf16_t* Vb = dv + (size_t)(b * 8 + hh) * NKEY * 64;
  float mx = -3.0e38f, l = 0.f;
  for (int k0 = 0; k0 < NKEY; k0 += 8) {
    float s[8]; float bm = -3.0e38f;
#pragma unroll
    for (int j = 0; j < 8; ++j) { const bf16_t* kp = Kb + (size_t)(k0 + j) * 128; float a = 0.f;
#pragma unroll
      for (int d = 0; d < 96; d += 2) { const unsigned w = *(const unsigned*)(kp + d); a += q[d] * __uint_as_float(w << 16) + q[d + 1] * __uint_as_float(w & 0xFFFF0000u); }
      s[j] = a; bm = fmaxf(bm, a); }
    const float mn = fmaxf(mx, bm), alpha = exp2f(mx - mn); mx = mn; l *= alpha;
#pragma unroll
    for (int d = 0; d < 64; ++d) o[d] *= alpha;
#pragma unroll
    for (int j = 0; j < 8; ++j) { const float p = exp2f(s[j] - mn); l += p; const bf16_t* vp = Vb + (size_t)(k0 + j) * 64;
#pragma unroll
      for (int d = 0; d < 64; d += 2) { const unsigned w = *(const unsigned*)(vp + d); o[d] += p * __uint_as_float(w << 16); o[d + 1] += p * __uint_as_float(w & 0xFFFF0000u); } }
  }
  const float il = 1.f / l;
  bf16_t* op = A + (size_t)(b * SEQ + t) * D + 512 + hh * 64;
#pragma unroll
  for (int d = 0; d < 64; d += 2) *(unsigned*)(op + d) = pack2(o[d] * il, o[d + 1] * il);
}

typedef short bf16x8 __attribute__((ext_vector_type(8)));
struct MP {
  const float* in[29];
  float* out; char* ws;
  int ph_lo, ph_hi;
};
constexpr int LDS_BYTES = 131072 + 1024;
constexpr int CNT_OFF = 16384;
typedef short s16x4 __attribute__((ext_vector_type(4)));
typedef float f32x16 __attribute__((ext_vector_type(16)));
typedef unsigned u32x4 __attribute__((ext_vector_type(4)));
constexpr float ATT_THR = 11.5f;
constexpr int NCHUNK = MROWS / 64;

struct MK {
  int wv;
  __device__ __forceinline__ int tidx() const { int l = (int)__lane_id(); asm volatile("" : "+v"(l)); return (wv << 6) | l; }
#define MFMA16(a, b, c) __builtin_amdgcn_mfma_f32_16x16x32_bf16(a, b, c, 0, 0, 0)


template <int MI, class Epi>
__device__ __forceinline__ void gemm_tile(const bf16_t* __restrict__ A, int lda, const int* __restrict__ gather, int gshift, int Mvalid,
                                          const bf16_t* __restrict__ Bt, int ldb, int K, int m0, int n0, char* lds, const Epi& epi) {
  constexpr int BM = 64 * MI, ABYTES = BM * 128, STAGE = ABYTES + 128 * 128;
  const int t = tidx(), lane = t & 63, w = t >> 6, wm = w >> 1, wn = w & 1, l15 = lane & 15, lq = lane >> 4;
  const int c = t & 7, r = t >> 3;
  const bf16_t* ap[MI];
#pragma unroll
  for (int i = 0; i < MI; ++i) { int m = m0 + r + 64 * i; m = m < Mvalid ? m : Mvalid - 1; const int row = gather ? (gather[m] >> gshift) : m; ap[i] = A + (size_t)row * lda + c * 8; }
  const bf16_t* bp0 = Bt + (size_t)(n0 + r) * ldb + c * 8; const bf16_t* bp1 = bp0 + (size_t)64 * ldb;
  const int wofs = r * 128 + ((c ^ ((r >> 1) & 7)) << 4);
  const int sw = (l15 >> 1) & 7, x0 = (lq ^ sw) << 4, x1 = x0 ^ 64;
  const int arow = (wm * 16 * MI + l15) * 128, brow = ABYTES + (wn * 64 + l15) * 128;
  f32x4 acc[MI][4];
#pragma unroll
  for (int i = 0; i < MI; ++i)
#pragma unroll
    for (int j = 0; j < 4; ++j) acc[i][j] = (f32x4){0.f, 0.f, 0.f, 0.f};
  uint4 ra[MI], rb0, rb1;
  const int KT = K >> 6;
#pragma unroll
  for (int i = 0; i < MI; ++i) ra[i] = *(const uint4*)(ap[i]);
  rb0 = *(const uint4*)bp0; rb1 = *(const uint4*)bp1;
#pragma unroll
  for (int i = 0; i < MI; ++i) *(uint4*)(lds + wofs + i * 8192) = ra[i];
  *(uint4*)(lds + ABYTES + wofs) = rb0; *(uint4*)(lds + ABYTES + wofs + 8192) = rb1;
  __syncthreads();
  for (int kt = 0; kt < KT; ++kt) {
    char* cur = lds + (kt & 1) * STAGE; char* nxt = lds + ((kt + 1) & 1) * STAGE;
    const bool more = kt + 1 < KT;
    if (more) {
      const int k0 = (kt + 1) << 6;
#pragma unroll
      for (int i = 0; i < MI; ++i) ra[i] = *(const uint4*)(ap[i] + k0);
      rb0 = *(const uint4*)(bp0 + k0); rb1 = *(const uint4*)(bp1 + k0);
    }
#pragma unroll
    for (int ks = 0; ks < 2; ++ks) {
      const int xo = ks ? x1 : x0;
      bf16x8 af[MI], bfv[4];
#pragma unroll
      for (int i = 0; i < MI; ++i) af[i] = *(const bf16x8*)(cur + arow + i * 2048 + xo);
#pragma unroll
      for (int j = 0; j < 4; ++j) bfv[j] = *(const bf16x8*)(cur + brow + j * 2048 + xo);
#pragma unroll
      for (int i = 0; i < MI; ++i)
#pragma unroll
        for (int j = 0; j < 4; ++j) acc[i][j] = MFMA16(bfv[j], af[i], acc[i][j]);
    }
    if (more) {
#pragma unroll
      for (int i = 0; i < MI; ++i) *(uint4*)(nxt + wofs + i * 8192) = ra[i];
      *(uint4*)(nxt + ABYTES + wofs) = rb0; *(uint4*)(nxt + ABYTES + wofs + 8192) = rb1;
    }
    __syncthreads();
  }
  epi.tile(acc, m0 + wm * 16 * MI + l15, n0 + wn * 64 + lq * 4, Mvalid);
}
template <class E> struct EpiEach {
  E e;
  template <int MI> __device__ __forceinline__ void tile(const f32x4 (&acc)[MI][4], int mb, int nb, int Mvalid) const {
#pragma unroll
    for (int i = 0; i < MI; ++i) { const int m = mb + i * 16; if (m < Mvalid) {
#pragma unroll
      for (int j = 0; j < 4; ++j) e.apply(m, nb + j * 16, acc[i][j]); } }
  }
};
template <int MI, class E>
__device__ __forceinline__ void gemm_phase(const bf16_t* A, int lda, const bf16_t* Bt, int ldb, int M, int N, int K, const E& e, char* lds) {
  constexpr int BM = 64 * MI; const int ntm = (M + BM - 1) / BM, ntn = N >> 7;
  EpiEach<E> ee; ee.e = e;
  for (int tile = blockIdx.x; tile < ntm * ntn; tile += gridDim.x) { const int mt = tile / ntn, nt = tile - mt * ntn; gemm_tile<MI>(A, lda, nullptr, 0, M, Bt, ldb, K, mt * BM, nt * 128, lds, ee); }
}

#define PG8_LAS __attribute__((address_space(3)))
static constexpr int BM = 256, BK = 64, HALF = 128, HTB = HALF * BK * 2, STAGE_BYTES = 8 * HTB, NXCD = 8, WGM = 8;
static __device__ __forceinline__ int lds_byte(int r, int c) { const int st = (r >> 4) * 2 + (c >> 5), rr = r & 15, cc = c & 31, ob = rr * 64 + cc * 2; return st * 1024 + (ob ^ (((ob >> 9) & 1) << 5)); }
static __device__ __forceinline__ void stage_rc(int b, int& R, int& C) { const int st = b / 1024, sb = b % 1024, swz = sb ^ (((sb >> 9) & 1) << 5); R = (st >> 1) * 16 + swz / 64; C = (st & 1) * 32 + (swz % 64) / 2; }
static __device__ __forceinline__ int perm32(int rho) { const int n = rho >> 4, i = rho & 15; return 8 * (i >> 2) + 4 * n + (i & 3); }

struct Unit { int pm, pn; };
struct Gemm { const bf16_t* A; const bf16_t* Bt; int M, N, K; };
struct StaticOrder {
    int nM, nN, nwg, G, c;
    __device__ void init(int M, int N, int G_, int c_) { nM = M / BM; nN = N / BM; nwg = nM * nN; G = G_; c = c_; }
    __device__ bool next(int i, Unit& u) const {
        const long L = (long)i * G + c; if (L >= nwg) return false;
        int wgid = (int)L; { const int q = nwg / NXCD, r = nwg % NXCD, xcd = wgid % NXCD, off = wgid / NXCD; wgid = (xcd < r ? xcd * (q + 1) : r * (q + 1) + (xcd - r) * q) + off; }
        const int nig = WGM * nN, gid = wgid / nig, fm = gid * WGM, gsz = (nM - fm) < WGM ? (nM - fm) : WGM;
        u.pm = fm + ((wgid % nig) % gsz); u.pn = (wgid % nig) / gsz; return true;
    }
    __device__ __forceinline__ void a_ready(const Unit&) const {}
    __device__ __forceinline__ void done(const Unit&) const {}
};
template <class Epi, class Sched>
__device__ __forceinline__ void pg8_phase(PG8_LAS unsigned char* lds, const Gemm g, const Sched& S, const Epi& E) {
    const int tid = tidx(), wid = __builtin_amdgcn_readfirstlane(tid >> 6), lane = tid & 63, wr = wid >> 2, wc = wid & 3, fr = lane & 15, fq = lane >> 4;
    const int K = g.K, nt = K / BK;
    unsigned voffA[2], voffB[2];
#pragma unroll
    for (int i = 0; i < 2; ++i) { int R, C; stage_rc(tid * 16 + i * 8192, R, C); const int Rb = Epi::PERM ? ((R & ~31) + perm32(R & 31)) : R;
        voffA[i] = (unsigned)(R * K + C) * 2u; voffB[i] = (unsigned)(Rb * K + C) * 2u; }
    const size_t kstep = (size_t)(BK * 2);
    const size_t hstep = (size_t)HALF * K * 2;
    const size_t tstep = 2 * hstep;
    const unsigned ldsw = (unsigned)wid * 1024u;
    const int aoff = lds_byte(wr * 64 + fr, fq * 8), boff = lds_byte(wc * 32 + fr, fq * 8);
#define PG8_SA(b, h) (((b) * 2 + (h)) * HTB)
#define PG8_SB(b, h) ((4 + (b) * 2 + (h)) * HTB)
#define PG8_STAGE(bufoff, gbase, voff) do { _Pragma("unroll") for (int _i = 0; _i < 2; ++_i) \
        __builtin_amdgcn_global_load_lds((const unsigned*)((const char*)(gbase) + (voff)[_i]), (PG8_LAS unsigned*)(lds + (bufoff) + ldsw + _i * 8192), 16, 0, 0); } while (0)
#define PG8_LDA(dst, b, h) do { _Pragma("unroll") for (int m = 0; m < 4; ++m) _Pragma("unroll") for (int k = 0; k < 2; ++k) dst[m][k] = *(const PG8_LAS bf16x8*)(lds + PG8_SA(b, h) + aoff + m * 2048 + k * 1024); } while (0)
#define PG8_LDB(dst, b, h) do { _Pragma("unroll") for (int n = 0; n < 2; ++n) _Pragma("unroll") for (int k = 0; k < 2; ++k) dst[n][k] = *(const PG8_LAS bf16x8*)(lds + PG8_SB(b, h) + boff + n * 2048 + k * 1024); } while (0)
#define PG8_MMA(ai, bj, At, Bt) do { __builtin_amdgcn_s_setprio(1); _Pragma("unroll") for (int m = 0; m < 4; ++m) _Pragma("unroll") for (int n = 0; n < 2; ++n) _Pragma("unroll") for (int k = 0; k < 2; ++k) \
        acc[ai][bj][m][n] = __builtin_amdgcn_mfma_f32_16x16x32_bf16(Bt[n][k], At[m][k], acc[ai][bj][m][n], 0, 0, 0); __builtin_amdgcn_s_setprio(0); } while (0)
#define PG8_WAIT_V(n) asm volatile("s_waitcnt vmcnt(" #n ")" ::: "memory")
#define PG8_WAIT_L(n) asm volatile("s_waitcnt lgkmcnt(" #n ")" ::: "memory")
#define PG8_BAR __builtin_amdgcn_s_barrier()
#define PG8_SCHED __builtin_amdgcn_sched_barrier(0)
    Unit cur, nxt; int ui = 0;
    if (!S.next(0, cur)) return;
    f32x4 acc[2][2][4][2];
#pragma unroll
    for (int a = 0; a < 2; ++a)
#pragma unroll
        for (int b = 0; b < 2; ++b)
#pragma unroll
            for (int m = 0; m < 4; ++m)
#pragma unroll
                for (int n = 0; n < 2; ++n) acc[a][b][m][n] = (f32x4){0.f, 0.f, 0.f, 0.f};
    bf16x8 At[4][2], B0[2][2], B1[2][2];
    const char* cA = (const char*)g.A + (size_t)cur.pm * tstep; const char* cB = (const char*)g.Bt + (size_t)cur.pn * tstep;
    S.a_ready(cur);
    PG8_STAGE(PG8_SB(0, 0), cB, voffB); PG8_STAGE(PG8_SA(0, 0), cA, voffA); PG8_STAGE(PG8_SB(0, 1), cB + hstep, voffB); PG8_STAGE(PG8_SA(0, 1), cA + hstep, voffA);
    if (wr == 1) PG8_BAR;
    PG8_WAIT_V(4); PG8_BAR;
    PG8_STAGE(PG8_SB(1, 0), cB + kstep, voffB); PG8_STAGE(PG8_SA(1, 0), cA + kstep, voffA); PG8_STAGE(PG8_SB(1, 1), cB + hstep + kstep, voffB);
    PG8_WAIT_V(6); PG8_BAR;
    for (;;) {
        const bool has_next = S.next(ui + 1, nxt);
        const char* nA = has_next ? (const char*)g.A + (size_t)nxt.pm * tstep : cA; const char* nB = has_next ? (const char*)g.Bt + (size_t)nxt.pn * tstep : cB;
        for (int t = 0; t < nt; t += 2) {
            const bool last = (t == nt - 2);
            const char* a1 = cA + (size_t)(t + 1) * kstep;
            const char* a2 = last ? nA : cA + (size_t)(t + 2) * kstep; const char* b2 = last ? nB : cB + (size_t)(t + 2) * kstep;
            const char* a3 = a2 + kstep; const char* b3 = b2 + kstep;
            if (last && has_next) S.a_ready(nxt);
            PG8_LDB(B0, 0, 0); PG8_SCHED; PG8_LDA(At, 0, 0); PG8_STAGE(PG8_SA(1, 1), a1 + hstep, voffA);
            PG8_WAIT_L(8); PG8_BAR; PG8_WAIT_L(0); PG8_MMA(0, 0, At, B0); PG8_BAR; PG8_SCHED;
            PG8_LDB(B1, 0, 1); PG8_STAGE(PG8_SB(0, 0), b2, voffB);
            PG8_BAR; PG8_WAIT_L(0); PG8_MMA(0, 1, At, B1); PG8_BAR;
            PG8_LDA(At, 0, 1); PG8_STAGE(PG8_SA(0, 0), a2, voffA);
            PG8_BAR; PG8_WAIT_L(0); PG8_MMA(1, 0, At, B0); PG8_BAR; PG8_SCHED;
            PG8_STAGE(PG8_SB(0, 1), b2 + hstep, voffB);
            PG8_WAIT_V(6); PG8_BAR; PG8_MMA(1, 1, At, B1); PG8_BAR;
            PG8_LDB(B0, 1, 0); PG8_SCHED; PG8_LDA(At, 1, 0); PG8_STAGE(PG8_SA(0, 1), a2 + hstep, voffA);
            PG8_WAIT_L(8); PG8_BAR; PG8_WAIT_L(0); PG8_MMA(0, 0, At, B0); PG8_BAR; PG8_SCHED;
            PG8_LDB(B1, 1, 1); PG8_STAGE(PG8_SB(1, 0), b3, voffB);
            PG8_BAR; PG8_WAIT_L(0); PG8_MMA(0, 1, At, B1); PG8_BAR;
            PG8_LDA(At, 1, 1); PG8_STAGE(PG8_SA(1, 0), a3, voffA);
            PG8_BAR; PG8_WAIT_L(0); PG8_MMA(1, 0, At, B0); PG8_BAR; PG8_SCHED;
            PG8_STAGE(PG8_SB(1, 1), b3 + hstep, voffB);
            PG8_WAIT_V(6); PG8_BAR; PG8_MMA(1, 1, At, B1); PG8_BAR;
        }
        if constexpr (!Epi::AFTER_DRAIN) { E(acc, cur, wr, wc, fr, fq); S.done(cur); }
        if (!has_next) break;
#pragma unroll
        for (int a = 0; a < 2; ++a)
#pragma unroll
            for (int b = 0; b < 2; ++b)
#pragma unroll
                for (int m = 0; m < 4; ++m)
#pragma unroll
                    for (int n = 0; n < 2; ++n) acc[a][b][m][n] = (f32x4){0.f, 0.f, 0.f, 0.f};
        cur = nxt; cA = nA; cB = nB; ++ui;
    }
    PG8_WAIT_V(0);
    if (wr == 0) PG8_BAR;
    PG8_BAR;
    if constexpr (Epi::AFTER_DRAIN) { E.fused(acc, cur, wr, wc, fr, fq, lds, wid, lane); S.done(cur); }
#undef PG8_SA
#undef PG8_SB
#undef PG8_STAGE
#undef PG8_LDA
#undef PG8_LDB
#undef PG8_MMA
#undef PG8_WAIT_V
#undef PG8_WAIT_L
#undef PG8_BAR
#undef PG8_SCHED
}

template <class E> struct Pg8Each {
  static constexpr bool PERM = false, AFTER_DRAIN = false; E e;
  __device__ __forceinline__ void operator()(const f32x4 (&acc)[2][2][4][2], const Unit& u, int wr, int wc, int fr, int fq) const {
#pragma unroll
    for (int ai = 0; ai < 2; ++ai)
#pragma unroll
      for (int m = 0; m < 4; ++m) { const int row = u.pm * BM + ai * HALF + wr * 64 + m * 16 + fr;
#pragma unroll
        for (int bj = 0; bj < 2; ++bj)
#pragma unroll
          for (int n = 0; n < 2; ++n) e.apply(row, u.pn * BM + bj * HALF + wc * 32 + n * 16 + fq * 4, acc[ai][bj][m][n]); }
  }
};
template <class E>
__device__ __forceinline__ void gemm_phase8(const bf16_t* A, const bf16_t* Bt, int Mbig, int M, int N, int K, const E& e, char* lds, int ctx_n0, int ctx_n1) {
  { Gemm g; g.A = A; g.Bt = Bt; g.M = Mbig; g.N = N; g.K = K; StaticOrder S; S.init(Mbig, N, (int)gridDim.x, (int)blockIdx.x); Pg8Each<E> pe; pe.e = e;
    pg8_phase((PG8_LAS unsigned char*)lds, g, S, pe); }
  if (M > Mbig) { EpiEach<E> ee; ee.e = e; const int ntm = (M - Mbig) >> 7, ntn = (ctx_n1 - ctx_n0) >> 7;
    for (int tile = (int)gridDim.x - 1 - (int)blockIdx.x; tile < ntm * ntn; tile += gridDim.x) { const int mt = tile / ntn, nt = tile - mt * ntn;
      gemm_tile<2>(A, K, nullptr, 0, M, Bt, K, K, Mbig + mt * 128, ctx_n0 + nt * 128, lds, ee); } }
}

template <int K>
static __device__ __forceinline__ float row_rstd4(const bf16_t* rowp, int lq) {
  constexpr int PER = K / 4; float ss = 0.f;
#pragma unroll
  for (int i = 0; i < PER / 8; ++i) { const uint4 v = *(const uint4*)(rowp + lq * PER + i * 8); const unsigned wv[4] = {v.x, v.y, v.z, v.w};
#pragma unroll
    for (int q = 0; q < 4; ++q) { const float a = __uint_as_float(wv[q] << 16), b = __uint_as_float(wv[q] & 0xFFFF0000u); ss += a * a + b * b; } }
  ss += __shfl_xor(ss, 16); ss += __shfl_xor(ss, 32);
  return 1.f / sqrtf(ss * (1.f / K) + EPS);
}
struct EpiMlaQ2 {
  bf16_t* dq; const bf16_t* cq;
  template <int MI> __device__ __forceinline__ void tile(const f32x4 (&acc)[MI][4], int mb, int nb, int Mvalid) const {
#pragma unroll
    for (int i = 0; i < MI; ++i) { const int m = mb + i * 16; const float rs = row_rstd4<256>(cq + (size_t)m * 256, (nb >> 2) & 3) * MLA_QSCALE;
#pragma unroll
      for (int j = 0; j < 4; ++j) { const int n = nb + j * 16; const int hh = n / 96, off = n - hh * 96; const f32x4 v = acc[i][j] * rs;
        uint2 wv; wv.x = pack2(v.x, v.y); wv.y = pack2(v.z, v.w);
        *(uint2*)(dq + (((size_t)((m >> 13) * 8 + hh) * SEQ + (m & 8191)) * 96 + off)) = wv; } }
  }
};
struct EpiMlaKV2 {
  bf16_t *dk, *dv; const bf16_t* ckv;
  template <int MI> __device__ __forceinline__ void tile(const f32x4 (&acc)[MI][4], int mb, int nb, int Mvalid) const {
#pragma unroll
    for (int i = 0; i < MI; ++i) { const int m = mb + i * 16; const float rs = row_rstd4<128>(ckv + (size_t)m * 128, (nb >> 2) & 3);
      int b, key; row_bkey(m, b, key);
#pragma unroll
      for (int j = 0; j < 4; ++j) { const int n = nb + j * 16; const int hh = n >> 7, off = n & 127; const f32x4 v = acc[i][j] * rs;
        uint2 wv; wv.x = pack2(v.x, v.y); wv.y = pack2(v.z, v.w);
        if (off < 64) *(uint2*)(dk + (((size_t)(b * 8 + hh) * NKEY + key) * 128 + off)) = wv;
        else *(uint2*)(dv + (((size_t)(b * 8 + hh) * NKEY + key) * 64 + (off - 64))) = wv; } }
  }
};
struct EpiMoe1 {
  bf16_t* amoe; const int* list; const float* rw; int off_e, nt;
  template <int MI> __device__ __forceinline__ void tile(const f32x4 (&acc)[MI][4], int mb, int nb, int Mvalid) const {
    const int wn = (nb >> 6) & 1, lq = (nb >> 2) & 3;
#pragma unroll
    for (int i = 0; i < MI; ++i) { const int m = mb + i * 16; if (m < Mvalid) { const float wgt = rw[list[m]];
#pragma unroll
      for (int i2 = 0; i2 < 2; ++i2) { const f32x4 g = acc[i][i2], u = acc[i][2 + i2];
        const float a0 = siluf_(g.x) * u.x * wgt, a1 = siluf_(g.y) * u.y * wgt, a2 = siluf_(g.z) * u.z * wgt, a3 = siluf_(g.w) * u.w * wgt;
        uint2 wv; wv.x = pack2(a0, a1); wv.y = pack2(a2, a3);
        *(uint2*)(amoe + (size_t)(off_e + m) * 256 + nt * 64 + wn * 32 + i2 * 16 + lq * 4) = wv; } } }
  }
};
struct EpiMoe2 {
  bf16_t* Y; const int* list; int m_base;
  __device__ __forceinline__ void apply(int m, int n, f32x4 v) const {
    uint2 wv; wv.x = pack2(v.x, v.y); wv.y = pack2(v.z, v.w);
    *(uint2*)(Y + (size_t)list[m - m_base] * D + n) = wv;
  }
};

__device__ __forceinline__ void ph_ada(const MP& p, char* lds) {
  float* sv = (float*)lds;
  const float* c = p.in[1]; const float* cctx = p.in[3]; float* mods = (float*)(p.ws + WS_MODS);
  const int t = tidx();
  for (int i = t; i < 1024; i += 512) { sv[i] = siluf_(c[i]); sv[1024 + i] = siluf_(c[1024 + i]); sv[2048 + i] = siluf_(cctx[i]); }
  __syncthreads();
  for (int item = blockIdx.x; item < 256; item += gridDim.x) {
    const int l = item >> 7, kg = (item >> 4) & 7, cg = item & 15;
    if (t < 384) {
      const int col = cg * 384 + t;
      const float* W = p.in[4] + ((size_t)l * 1024 + kg * 128) * 6144 + col;
      float a0 = 0.f, a1 = 0.f, a2 = 0.f;
#pragma unroll 16
      for (int k = 0; k < 128; ++k) { const float wv = W[(size_t)k * 6144]; const int kk = kg * 128 + k; a0 += sv[kk] * wv; a1 += sv[1024 + kk] * wv; a2 += sv[2048 + kk] * wv; }
      if (kg == 0) { const float bb = p.in[5][l * 6144 + col]; a0 += bb; a1 += bb; a2 += bb; }
      atomicAdd(&mods[(size_t)(l * 3 + 0) * 6144 + col], a0); atomicAdd(&mods[(size_t)(l * 3 + 1) * 6144 + col], a1); atomicAdd(&mods[(size_t)(l * 3 + 2) * 6144 + col], a2);
    }
  }
  if (blockIdx.x == gridDim.x - 1) { float* lb = (float*)(p.ws + WS_LB);
    for (int i = t; i < 1024; i += 512) { const int d = i >> 9, cc = i & 511; const float l0 = p.in[10][(d * 2) * 512 + cc], l1 = p.in[10][(d * 2 + 1) * 512 + cc]; lb[i] = 1.f / (1.f + expf(l1 - l0)); } }
  __syncthreads();
}
__device__ __forceinline__ void conv_tiles(const float* src, bf16_t* dst, const float* kscale, int K, int N, int Npad, int mode, int batch, size_t sbs, size_t dbs, char* lds) {
  float* tile = (float*)lds;
  const int ntn = (Npad + 63) >> 6, ntk = K >> 7, per = ntn * ntk, t = tidx();
  for (int item = blockIdx.x; item < per * batch; item += gridDim.x) {
    const int bz = item / per, rem = item - bz * per, kb = rem / ntn, nb = rem - kb * ntn, n0 = nb * 64, k0 = kb * 128;
    const float* s = src + bz * sbs; bf16_t* d = dst + bz * dbs;
#pragma unroll
    for (int i = 0; i < 4; ++i) { const int idx = t + 512 * i, k = idx >> 4, n4 = (idx & 15) * 4; f32x4 v = {0.f, 0.f, 0.f, 0.f};
      if (n0 + n4 < N) { v = *(const f32x4*)(s + (size_t)(k0 + k) * N + n0 + n4); if (kscale) v = v * kscale[k0 + k]; }
      float* tp = tile + k * 65 + n4; tp[0] = v.x; tp[1] = v.y; tp[2] = v.z; tp[3] = v.w; }
    __syncthreads();
#pragma unroll
    for (int i = 0; i < 2; ++i) { const int idx = t + 512 * i, nl = idx >> 4, k8 = (idx & 15) * 8, n = n0 + nl;
      if (n < Npad) { int row = n; if (mode == 1) row = moe_gu_row(0, n); else if (mode == 2) row = moe_gu_row(1, n);
        const float* tp = tile + k8 * 65 + nl;
        uint4 o; o.x = pack2(tp[0], tp[65]); o.y = pack2(tp[130], tp[195]); o.z = pack2(tp[260], tp[325]); o.w = pack2(tp[390], tp[455]);
        *(uint4*)(d + (size_t)row * K + k0 + k8) = o; } }
    __syncthreads();
  }
}
__device__ __forceinline__ void ph_conv_small(const MP& p, char* lds) {
  char* ws = p.ws;
  conv_tiles(p.in[8], (bf16_t*)(ws + WS_WT_ABIN), nullptr, 1024, 3072, 3072, 0, 1, 0, 0, lds);
  conv_tiles(p.in[9], (bf16_t*)(ws + WS_WT_ABOUT), nullptr, 1024, 1024, 1024, 0, 1, 0, 0, lds);
  conv_tiles(p.in[14], (bf16_t*)(ws + WS_WT_CDIN), nullptr, 1024, 1952, 2048, 0, 1, 0, 0, lds);
  conv_tiles(p.in[15], (bf16_t*)(ws + WS_WT_CDOUT), nullptr, 1024, 1024, 1024, 0, 1, 0, 0, lds);
  conv_tiles(p.in[18], (bf16_t*)(ws + WS_WT_UQ), p.in[17], 256, 768, 768, 0, 1, 0, 0, lds);
  conv_tiles(p.in[20], (bf16_t*)(ws + WS_WT_UKV), p.in[19], 128, 1024, 1024, 0, 1, 0, 0, lds);
  conv_tiles(p.in[12], (bf16_t*)(ws + WS_WT_POOL), nullptr, 128, 128, 128, 0, 4, (size_t)128 * 128, (size_t)128 * 128, lds);
}
__device__ __forceinline__ void ph_conv_moe(const MP& p, int layer, char* lds) {
  bf16_t* wgu = (bf16_t*)(p.ws + WS_WMOE); bf16_t* wd = wgu + (size_t)32 * 512 * 1024;
  const size_t lo = (size_t)layer * 32 * 1024 * 256;
  conv_tiles(p.in[25] + lo, wgu, nullptr, 1024, 256, 256, 1, 32, (size_t)1024 * 256, (size_t)512 * 1024, lds);
  conv_tiles(p.in[26] + lo, wgu, nullptr, 1024, 256, 256, 2, 32, (size_t)1024 * 256, (size_t)512 * 1024, lds);
  conv_tiles(p.in[27] + lo, wd, nullptr, 256, 1024, 1024, 0, 32, (size_t)256 * 1024, (size_t)1024 * 256, lds);
}
__device__ __forceinline__ void ph_norm_mod(const float* lat, const float* ctxr, const float* gain, const float* modl, int sh_off, int sc_off, bf16_t* out, int nrows) {
  const int lane = tidx() & 63, gw = blockIdx.x * 8 + (tidx() >> 6);
  for (int row = gw; row < nrows; row += gridDim.x * 8) {
    const float* src = row < NLAT ? lat + (size_t)row * D : ctxr + (size_t)(row - NLAT) * D;
    const float* mv = modl + row_vec(row) * 6144;
    f32x4 x[4]; float ss = 0.f;
#pragma unroll
    for (int j = 0; j < 4; ++j) { x[j] = ((const f32x4*)src)[lane + 64 * j]; ss += x[j].x * x[j].x + x[j].y * x[j].y + x[j].z * x[j].z + x[j].w * x[j].w; }
    const float rstd = 1.f / sqrtf(wave_sum(ss) * (1.f / D) + EPS);
#pragma unroll
    for (int j = 0; j < 4; ++j) {
      const int n = (lane + 64 * j) * 4;
      const f32x4 g = *(const f32x4*)(gain + n), sc = *(const f32x4*)(mv + sc_off + n), sh = *(const f32x4*)(mv + sh_off + n);
      const f32x4 h = x[j] * rstd * g * (sc + 1.f) + sh;
      uint2 o; o.x = pack2(h.x, h.y); o.y = pack2(h.z, h.w);
      *(uint2*)(out + (size_t)row * D + n) = o;
    }
  }
}
template <int HALF>
__device__ __forceinline__ void pool_prep_col(const bf16_t* Up, bf16_t* pd, int r0, int seg_lo, int seg_hi, int c) {
  float a[80];
#pragma unroll
  for (int i = 0; i < 80; ++i) { const int r = r0 - 8 + i; const bool in = (r >= seg_lo) && (r < seg_hi); const int rc = in ? r : r0; const float v = bf2f(Up[(size_t)rc * 512 + c]); a[i] = in ? v : 0.f; }
  float sum = 0.f;
#pragma unroll
  for (int i = 8 - HALF; i < 8 + HALF; ++i) sum += a[i];
#pragma unroll
  for (int j = 0; j < 64; ++j) {
    const int t = r0 + j; int lo = t - HALF, hi = t + HALF; lo = lo < seg_lo ? seg_lo : lo; hi = hi > seg_hi ? seg_hi : hi;
    pd[(size_t)t * 512 + c] = f2bf(sum / (float)(hi - lo) - a[8 + j]);
    if (j < 63) sum += a[8 + j + HALF] - a[8 + j - HALF];
  }
}
__device__ __forceinline__ void ph_pool_prep(const bf16_t* Up, bf16_t* pd) {
  const int c = tidx(), gi = c >> 7;
  for (int cid = blockIdx.x; cid < NCHUNK; cid += gridDim.x) {
    const int r0 = cid * 64; int seg_lo, seg_hi;
    if (r0 < NLAT) { seg_lo = r0 & ~8191; seg_hi = seg_lo + SEQ; } else { seg_lo = NLAT + ((r0 - NLAT) & ~255); seg_hi = seg_lo + CT; }
    if (gi == 0) pool_prep_col<1>(Up, pd, r0, seg_lo, seg_hi, c);
    else if (gi == 1) pool_prep_col<2>(Up, pd, r0, seg_lo, seg_hi, c);
    else if (gi == 2) pool_prep_col<4>(Up, pd, r0, seg_lo, seg_hi, c);
    else pool_prep_col<8>(Up, pd, r0, seg_lo, seg_hi, c);
  }
}
__device__ __forceinline__ void ph_router(const MP& p, int layer, int nrows, char* lds) {
  float* hs = (float*)lds;
  float* part = (float*)(lds + 66048);
  float* lgs = (float*)(lds + 66048 + 24576);
  const float* lat = p.out; const float* ctxr = (const float*)(p.ws + WS_XC); const float* gain = p.in[7] + layer * 1024;
  const float* modl = (const float*)(p.ws + WS_MODS) + layer * 3 * 6144;
  const float* wrg = p.in[21] + layer * 1024 * 4; const float* brg = p.in[22] + layer * 4; const float* wre = p.in[23] + layer * 1024 * 32; const float* bre = p.in[24] + layer * 32;
  bf16_t* out = (bf16_t*)(p.ws + WS_H); float* rw = (float*)(p.ws + WS_ROUTE_W);
  int* cnt = (int*)(p.ws + WS_CTL + CNT_OFF) + layer * 32; int* list = (int*)(p.ws + WS_LIST);
  const int tid = tidx(), lane = tid & 63, w = tid >> 6, l15 = lane & 15, lq = lane >> 4;
  float Bq[8][4][3];
#pragma unroll
  for (int g = 0; g < 8; ++g)
#pragma unroll
    for (int u = 0; u < 4; ++u)
#pragma unroll
      for (int nt = 0; nt < 3; ++nt) { const int kk = w * 128 + 16 * g + 4 * lq + u, col = nt * 16 + l15;
        Bq[g][u][nt] = col < 4 ? wrg[kk * 4 + col] : (col < 36 ? wre[kk * 32 + (col - 4)] : 0.f); }
  const int ntiles = nrows >> 4;
  f32x4 xa[2][4];
#define RT_LOAD(tile_) do { _Pragma("unroll") for (int rr = 0; rr < 2; ++rr) { const int row_ = (tile_) * 16 + 2 * w + rr; \
      const float* src_ = row_ < NLAT ? lat + (size_t)row_ * D : ctxr + (size_t)(row_ - NLAT) * D; \
      _Pragma("unroll") for (int j = 0; j < 4; ++j) xa[rr][j] = ((const f32x4*)src_)[lane + 64 * j]; } } while (0)
  if ((int)blockIdx.x < ntiles) RT_LOAD((int)blockIdx.x);
  for (int tile = blockIdx.x; tile < ntiles; tile += gridDim.x) {
#pragma unroll
    for (int rr = 0; rr < 2; ++rr) {
      const int lr = 2 * w + rr, row = tile * 16 + lr;
      const float* mv = modl + row_vec(row) * 6144;
      float ss = 0.f;
#pragma unroll
      for (int j = 0; j < 4; ++j) { const f32x4 x = xa[rr][j]; ss += x.x * x.x + x.y * x.y + x.z * x.z + x.w * x.w; }
      const float rstd = 1.f / sqrtf(wave_sum(ss) * (1.f / D) + EPS);
#pragma unroll
      for (int j = 0; j < 4; ++j) {
        const int n = (lane + 64 * j) * 4;
        const f32x4 g = *(const f32x4*)(gain + n), sc = *(const f32x4*)(mv + 4096 + n), sh = *(const f32x4*)(mv + 3072 + n);
        const f32x4 h = xa[rr][j] * rstd * g * (sc + 1.f) + sh;
        uint2 o; o.x = pack2(h.x, h.y); o.y = pack2(h.z, h.w);
        *(uint2*)(out + (size_t)row * D + n) = o;
        *(f32x4*)&hs[lr * 1032 + n] = h;
      }
    }
    __syncthreads();
    if (tile + (int)gridDim.x < ntiles) RT_LOAD(tile + (int)gridDim.x);
    f32x4 acc[3];
#pragma unroll
    for (int nt = 0; nt < 3; ++nt) acc[nt] = (f32x4){0.f, 0.f, 0.f, 0.f};
#pragma unroll
    for (int g = 0; g < 8; ++g) {
      const f32x4 a4 = *(const f32x4*)&hs[l15 * 1032 + w * 128 + 16 * g + 4 * lq];
      const float av[4] = {a4.x, a4.y, a4.z, a4.w};
#pragma unroll
      for (int u = 0; u < 4; ++u)
#pragma unroll
        for (int nt = 0; nt < 3; ++nt) acc[nt] = __builtin_amdgcn_mfma_f32_16x16x4f32(av[u], Bq[g][u][nt], acc[nt], 0, 0, 0);
    }
#pragma unroll
    for (int nt = 0; nt < 3; ++nt) { const float av[4] = {acc[nt].x, acc[nt].y, acc[nt].z, acc[nt].w};
#pragma unroll
      for (int r = 0; r < 4; ++r) part[(w * 16 + lq * 4 + r) * 48 + nt * 16 + l15] = av[r]; }
    __syncthreads();
    for (int i = tid; i < 16 * 36; i += 512) { const int row = i / 36, col = i - row * 36; float sacc = col < 4 ? brg[col] : bre[col - 4];
#pragma unroll
      for (int ww = 0; ww < 8; ++ww) sacc += part[(ww * 16 + row) * 48 + col];
      lgs[i] = sacc; }
    __syncthreads();
    if (tid < 32) {
      const int lr = tid >> 1, slot = tid & 1, row = tile * 16 + lr; const float* lg = lgs + lr * 36;
      int gi = 0; float gm = lg[0];
#pragma unroll
      for (int i = 1; i < 4; ++i) if (lg[i] > gm) { gm = lg[i]; gi = i; }
      float gs = 0.f;
#pragma unroll
      for (int i = 0; i < 4; ++i) gs += __expf(lg[i] - gm);
      const float gp = 1.f / gs;
      const float* el = lg + 4 + gi * 8;
      int e1 = 0; float m1 = el[0];
#pragma unroll
      for (int i = 1; i < 8; ++i) if (el[i] > m1) { m1 = el[i]; e1 = i; }
      int e2 = 0; float m2 = -3.0e38f;
#pragma unroll
      for (int i = 0; i < 8; ++i) if (i != e1 && el[i] > m2) { m2 = el[i]; e2 = i; }
      const float w1 = 1.f / (1.f + __expf(m2 - m1));
      const int ee = gi * 8 + (slot ? e2 : e1);
      rw[row * 2 + slot] = gp * (slot ? 1.f - w1 : w1);
      const int pos = atomicAdd(&cnt[ee], 1); list[(size_t)ee * MROWS + pos] = row * 2 + slot;
    }
  }
#undef RT_LOAD
}
template <int BM>
__device__ __forceinline__ int moe_tables(const MP& p, int layer, int ntn, int* tb) {
  const int* cnt = (const int*)(p.ws + WS_CTL + CNT_OFF) + layer * 32;
  __syncthreads();
  if (tidx() == 0) { int off = 0, ts = 0;
    for (int e = 0; e < 32; ++e) { const int c = __hip_atomic_load(&cnt[e], __ATOMIC_RELAXED, __HIP_MEMORY_SCOPE_AGENT); tb[e] = c; tb[32 + e] = off; tb[64 + e] = ts; off += c; ts += ((c + BM - 1) / BM) * ntn; }
    tb[96] = ts; }
  __syncthreads();
  return tb[96];
}
template <int MI>
__device__ __forceinline__ void ph_moe1(const MP& p, int layer, char* lds) {
  constexpr int BM = 64 * MI; int* tb = (int*)(lds + LDS_BYTES - 1024);
  const int total = moe_tables<BM>(p, layer, 4, tb);
  const bf16_t* H = (const bf16_t*)(p.ws + WS_H); const bf16_t* wgu = (const bf16_t*)(p.ws + WS_WMOE);
  for (int tile = blockIdx.x; tile < total; tile += gridDim.x) {
    int e = 0;
#pragma unroll 1
    for (int q = 1; q < 32; ++q) if (tb[64 + q] <= tile) e = q;
    const int lt = tile - tb[64 + e], mt = lt >> 2, nt = lt & 3;
    EpiMoe1 ep; ep.amoe = (bf16_t*)(p.ws + WS_AMOE); ep.list = (const int*)(p.ws + WS_LIST) + (size_t)e * MROWS; ep.rw = (const float*)(p.ws + WS_ROUTE_W); ep.off_e = tb[32 + e]; ep.nt = nt;
    gemm_tile<MI>(H, D, ep.list, 1, tb[e], wgu + (size_t)e * 512 * 1024, 1024, 1024, mt * BM, nt * 128, lds, ep);
  }
}
template <int MI>
__device__ __forceinline__ void ph_moe2(const MP& p, int layer, char* lds) {
  constexpr int BM = 64 * MI; int* tb = (int*)(lds + LDS_BYTES - 1024);
  const int total = moe_tables<BM>(p, layer, 8, tb);
  const bf16_t* wd = (const bf16_t*)(p.ws + WS_WMOE) + (size_t)32 * 512 * 1024;
  for (int tile = blockIdx.x; tile < total; tile += gridDim.x) {
    int e = 0;
#pragma unroll 1
    for (int q = 1; q < 32; ++q) if (tb[64 + q] <= tile) e = q;
    const int lt = tile - tb[64 + e], mt = lt >> 3, nt = lt & 7;
    EpiEach<EpiMoe2> ep; ep.e.Y = (bf16_t*)(p.ws + WS_YBUF); ep.e.list = (const int*)(p.ws + WS_LIST) + (size_t)e * MROWS; ep.e.m_base = 0;
    const bf16_t* A = (const bf16_t*)(p.ws + WS_AMOE) + (size_t)tb[32 + e] * 256;
    gemm_tile<MI>(A, 256, nullptr, 0, tb[e], wd + (size_t)e * 1024 * 256, 256, 256, mt * BM, nt * 128, lds, ep);
  }
}

struct GUnit { unsigned a, b; int m0, n0, mvalid, e; };
struct MoeSched {
  const PG8_LAS int* tb; const char* wsb; unsigned Abase, Bbase, b_estride; int ntn, G, c, K, gather;
  __device__ __forceinline__ bool next(int i, GUnit& u) const {
    const int L = i * G + c; if (L >= tb[96]) return false;
    int e = 0;
#pragma unroll 1
    for (int q = 1; q < 32; ++q) if (tb[64 + q] <= L) e = q;
    const int lt = L - tb[64 + e], mt = lt / ntn, nt = lt - mt * ntn;
    u.e = e; u.m0 = mt * 256; u.n0 = nt * 256; u.mvalid = tb[e];
    u.b = Bbase + (unsigned)e * b_estride + (unsigned)(nt * 256 * K * 2);
    u.a = gather ? Abase : Abase + (unsigned)((tb[32 + e] + mt * 256) * K * 2);
    return true;
  }
  __device__ __forceinline__ void done(const GUnit&) const {}
  __device__ __forceinline__ void a_offsets(const GUnit& u, int tid, unsigned (&ao)[2][2]) const {
    const int* list = (const int*)(wsb + WS_LIST) + (size_t)u.e * MROWS;
#pragma unroll
    for (int i = 0; i < 2; ++i) { int R, C; stage_rc(tid * 16 + i * 8192, R, C);
#pragma unroll
      for (int h = 0; h < 2; ++h) {
        if (gather) { int r = u.m0 + h * 128 + R; r = r < u.mvalid ? r : u.mvalid - 1; const int tok = list[r] >> 1; ao[h][i] = (unsigned)(tok * K + C) * 2u; }
        else ao[h][i] = (unsigned)((h * 128 + R) * K + C) * 2u;
      } }
  }
};
template <class Epi, class Sched>
__device__ __forceinline__ void pg8g_phase(PG8_LAS unsigned char* lds, const char* wsb, const int K, const Sched& S, const Epi& E) {
    const int tid = tidx(), wid = __builtin_amdgcn_readfirstlane(tid >> 6), lane = tid & 63, wr = wid >> 2, wc = wid & 3, fr = lane & 15, fq = lane >> 4;
    const int nt = K / BK;
    unsigned voffB[2];
#pragma unroll
    for (int i = 0; i < 2; ++i) { int R, C; stage_rc(tid * 16 + i * 8192, R, C); const int Rb = Epi::PERM ? ((R & ~31) + perm32(R & 31)) : R;
        voffB[i] = (unsigned)(Rb * K + C) * 2u; }
    const unsigned kstep = (unsigned)(BK * 2);
    const unsigned hstep = (unsigned)(HALF * K * 2);
    const unsigned ldsw = (unsigned)wid * 1024u;
    const int aoff = lds_byte(wr * 64 + fr, fq * 8), boff = lds_byte(wc * 32 + fr, fq * 8);
#define PG8_SA(b, h) (((b) * 2 + (h)) * HTB)
#define PG8_SB(b, h) ((4 + (b) * 2 + (h)) * HTB)
#define PG8_STAGE(bufoff, gbase, voff) do { _Pragma("unroll") for (int _i = 0; _i < 2; ++_i) \
        __builtin_amdgcn_global_load_lds((const unsigned*)(wsb + (size_t)(gbase) + (voff)[_i]), (PG8_LAS unsigned*)(lds + (bufoff) + ldsw + _i * 8192), 16, 0, 0); } while (0)
#define PG8_STAGE_A(bufoff, gbase, o0, o1) do { \
        __builtin_amdgcn_global_load_lds((const unsigned*)(wsb + (size_t)(gbase) + (o0)), (PG8_LAS unsigned*)(lds + (bufoff) + ldsw), 16, 0, 0); \
        __builtin_amdgcn_global_load_lds((const unsigned*)(wsb + (size_t)(gbase) + (o1)), (PG8_LAS unsigned*)(lds + (bufoff) + ldsw + 8192), 16, 0, 0); } while (0)
#define PG8_LDA(dst, b, h) do { _Pragma("unroll") for (int m = 0; m < 4; ++m) _Pragma("unroll") for (int k = 0; k < 2; ++k) dst[m][k] = *(const PG8_LAS bf16x8*)(lds + PG8_SA(b, h) + aoff + m * 2048 + k * 1024); } while (0)
#define PG8_LDB(dst, b, h) do { _Pragma("unroll") for (int n = 0; n < 2; ++n) _Pragma("unroll") for (int k = 0; k < 2; ++k) dst[n][k] = *(const PG8_LAS bf16x8*)(lds + PG8_SB(b, h) + boff + n * 2048 + k * 1024); } while (0)
#define PG8_MMA(ai, bj, At, Bt) do { __builtin_amdgcn_s_setprio(1); _Pragma("unroll") for (int m = 0; m < 4; ++m) _Pragma("unroll") for (int n = 0; n < 2; ++n) _Pragma("unroll") for (int k = 0; k < 2; ++k) \
        acc[ai][bj][m][n] = __builtin_amdgcn_mfma_f32_16x16x32_bf16(Bt[n][k], At[m][k], acc[ai][bj][m][n], 0, 0, 0); __builtin_amdgcn_s_setprio(0); } while (0)
#define PG8_WAIT_V(n) asm volatile("s_waitcnt vmcnt(" #n ")" ::: "memory")
#define PG8_WAIT_L(n) asm volatile("s_waitcnt lgkmcnt(" #n ")" ::: "memory")
#define PG8_BAR __builtin_amdgcn_s_barrier()
#define PG8_SCHED __builtin_amdgcn_sched_barrier(0)
    GUnit cur, nxt; int ui = 0;
    if (!S.next(0, cur)) return;
    f32x4 acc[2][2][4][2];
#pragma unroll
    for (int a = 0; a < 2; ++a)
#pragma unroll
        for (int b = 0; b < 2; ++b)
#pragma unroll
            for (int m = 0; m < 4; ++m)
#pragma unroll
                for (int n = 0; n < 2; ++n) acc[a][b][m][n] = (f32x4){0.f, 0.f, 0.f, 0.f};
    bf16x8 At[4][2], B0[2][2], B1[2][2];
    unsigned cA = cur.a, cB = cur.b;
    unsigned aoc[2][2];
    S.a_offsets(cur, tid, aoc);
    PG8_STAGE(PG8_SB(0, 0), cB, voffB); PG8_STAGE_A(PG8_SA(0, 0), cA, aoc[0][0], aoc[0][1]); PG8_STAGE(PG8_SB(0, 1), cB + hstep, voffB); PG8_STAGE_A(PG8_SA(0, 1), cA, aoc[1][0], aoc[1][1]);
    if (wr == 1) PG8_BAR;
    PG8_WAIT_V(4); PG8_BAR;
    PG8_STAGE(PG8_SB(1, 0), cB + kstep, voffB); PG8_STAGE_A(PG8_SA(1, 0), cA + kstep, aoc[0][0], aoc[0][1]); PG8_STAGE(PG8_SB(1, 1), cB + hstep + kstep, voffB);
    PG8_WAIT_V(6); PG8_BAR;
    for (;;) {
        const bool has_next = S.next(ui + 1, nxt);
        const unsigned nA = has_next ? nxt.a : cA, nB = has_next ? nxt.b : cB;
        for (int t = 0; t < nt; t += 2) {
            const bool last = (t == nt - 2);
            const unsigned a1 = cA + (unsigned)(t + 1) * kstep;
            const unsigned a2 = last ? nA : cA + (unsigned)(t + 2) * kstep, b2 = last ? nB : cB + (unsigned)(t + 2) * kstep;
            const unsigned a3 = a2 + kstep, b3 = b2 + kstep;
            if (last && has_next) {
              PG8_STAGE_A(PG8_SA(1, 1), a1, aoc[1][0], aoc[1][1]); S.a_offsets(nxt, tidx(), aoc); PG8_SCHED;
              PG8_LDB(B0, 0, 0); PG8_SCHED; PG8_LDA(At, 0, 0);
            } else { PG8_LDB(B0, 0, 0); PG8_SCHED; PG8_LDA(At, 0, 0); PG8_STAGE_A(PG8_SA(1, 1), a1, aoc[1][0], aoc[1][1]); }
            PG8_WAIT_L(8); PG8_BAR; PG8_WAIT_L(0); PG8_MMA(0, 0, At, B0); PG8_BAR; PG8_SCHED;
            PG8_LDB(B1, 0, 1); PG8_STAGE(PG8_SB(0, 0), b2, voffB);
            PG8_BAR; PG8_WAIT_L(0); PG8_MMA(0, 1, At, B1); PG8_BAR;
            PG8_LDA(At, 0, 1); PG8_STAGE_A(PG8_SA(0, 0), a2, aoc[0][0], aoc[0][1]);
            PG8_BAR; PG8_WAIT_L(0); PG8_MMA(1, 0, At, B0); PG8_BAR; PG8_SCHED;
            PG8_STAGE(PG8_SB(0, 1), b2 + hstep, voffB);
            PG8_WAIT_V(6); PG8_BAR; PG8_MMA(1, 1, At, B1); PG8_BAR;
            PG8_LDB(B0, 1, 0); PG8_SCHED; PG8_LDA(At, 1, 0); PG8_STAGE_A(PG8_SA(0, 1), a2, aoc[1][0], aoc[1][1]);
            PG8_WAIT_L(8); PG8_BAR; PG8_WAIT_L(0); PG8_MMA(0, 0, At, B0); PG8_BAR; PG8_SCHED;
            PG8_LDB(B1, 1, 1); PG8_STAGE(PG8_SB(1, 0), b3, voffB);
            PG8_BAR; PG8_WAIT_L(0); PG8_MMA(0, 1, At, B1); PG8_BAR;
            PG8_LDA(At, 1, 1); PG8_STAGE_A(PG8_SA(1, 0), a3, aoc[0][0], aoc[0][1]);
            PG8_BAR; PG8_WAIT_L(0); PG8_MMA(1, 0, At, B0); PG8_BAR; PG8_SCHED;
            PG8_STAGE(PG8_SB(1, 1), b3 + hstep, voffB);
            PG8_WAIT_V(6); PG8_BAR; PG8_MMA(1, 1, At, B1); PG8_BAR;
        }
        if constexpr (!Epi::AFTER_DRAIN) { const int l2 = tidx() & 63; E(acc, cur, wr, wc, l2 & 15, l2 >> 4); S.done(cur); }
        if (!has_next) break;
#pragma unroll
        for (int a = 0; a < 2; ++a)
#pragma unroll
            for (int b = 0; b < 2; ++b)
#pragma unroll
                for (int m = 0; m < 4; ++m)
#pragma unroll
                    for (int n = 0; n < 2; ++n) acc[a][b][m][n] = (f32x4){0.f, 0.f, 0.f, 0.f};
        cur = nxt; cA = nA; cB = nB; ++ui;
    }
    PG8_WAIT_V(0);
    if (wr == 0) PG8_BAR;
    PG8_BAR;
    if constexpr (Epi::AFTER_DRAIN) { E.fused(acc, cur, wr, wc, fr, fq, lds, wid, lane); S.done(cur); }
#undef PG8_SA
#undef PG8_SB
#undef PG8_STAGE
#undef PG8_STAGE_A
#undef PG8_LDA
#undef PG8_LDB
#undef PG8_MMA
#undef PG8_WAIT_V
#undef PG8_WAIT_L
#undef PG8_BAR
#undef PG8_SCHED

#undef PG8_MMA
#undef PG8_WAIT_V
#undef PG8_WAIT_L
#undef PG8_BAR
#undef PG8_SCHED
}

struct EpiMoe1G {
  static constexpr bool PERM = false, AFTER_DRAIN = false;
  char* wsb; const PG8_LAS int* tb;
  __device__ __forceinline__ void operator()(const f32x4 (&acc)[2][2][4][2], const GUnit& u, int wr, int wc, int fr, int fq) const {
    const int* list = (const int*)(wsb + WS_LIST) + (size_t)u.e * MROWS; const int off_e = tb[32 + u.e]; const float* rw = (const float*)(wsb + WS_ROUTE_W); bf16_t* amoe = (bf16_t*)(wsb + WS_AMOE);
    const int rbase = u.m0 + wr * 64 + fr;
    int ent[2][4]; float wg[2][4];
#pragma unroll
    for (int ai = 0; ai < 2; ++ai)
#pragma unroll
      for (int m = 0; m < 4; ++m) { int r = rbase + ai * HALF + m * 16; r = r < u.mvalid ? r : u.mvalid - 1; ent[ai][m] = list[r]; }
#pragma unroll
    for (int ai = 0; ai < 2; ++ai)
#pragma unroll
      for (int m = 0; m < 4; ++m) wg[ai][m] = rw[ent[ai][m]];
#pragma unroll
    for (int ai = 0; ai < 2; ++ai)
#pragma unroll
      for (int m = 0; m < 4; ++m) { const int r = rbase + ai * HALF + m * 16;
        if (r < u.mvalid) { const float wgt = wg[ai][m];
#pragma unroll
          for (int bj = 0; bj < 2; ++bj) { const f32x4 g = acc[ai][bj][m][0], uu = acc[ai][bj][m][1];
            const int hidden = ((u.n0 + bj * HALF + wc * 32) >> 1) + fq * 4;
            uint2 wv; wv.x = pack2(siluf_(g.x) * uu.x * wgt, siluf_(g.y) * uu.y * wgt); wv.y = pack2(siluf_(g.z) * uu.z * wgt, siluf_(g.w) * uu.w * wgt);
            *(uint2*)(amoe + (size_t)(off_e + r) * 256 + hidden) = wv; } } }
  }
};
struct EpiMoe2G {
  static constexpr bool PERM = false, AFTER_DRAIN = false;
  char* wsb;
  __device__ __forceinline__ void operator()(const f32x4 (&acc)[2][2][4][2], const GUnit& u, int wr, int wc, int fr, int fq) const {
    const int* list = (const int*)(wsb + WS_LIST) + (size_t)u.e * MROWS; bf16_t* Y = (bf16_t*)(wsb + WS_YBUF);
    const int rbase = u.m0 + wr * 64 + fr;
    int ent[2][4];
#pragma unroll
    for (int ai = 0; ai < 2; ++ai)
#pragma unroll
      for (int m = 0; m < 4; ++m) { int r = rbase + ai * HALF + m * 16; r = r < u.mvalid ? r : u.mvalid - 1; ent[ai][m] = list[r]; }
#pragma unroll
    for (int ai = 0; ai < 2; ++ai)
#pragma unroll
      for (int m = 0; m < 4; ++m) { const int r = rbase + ai * HALF + m * 16;
        if (r < u.mvalid) { bf16_t* yp = Y + (size_t)ent[ai][m] * D + u.n0 + wc * 32 + fq * 4;
#pragma unroll
          for (int bj = 0; bj < 2; ++bj)
#pragma unroll
            for (int n = 0; n < 2; ++n) { const f32x4 v = acc[ai][bj][m][n]; uint2 wv; wv.x = pack2(v.x, v.y); wv.y = pack2(v.z, v.w); *(uint2*)(yp + bj * HALF + n * 16) = wv; } } }
  }
};
__device__ __forceinline__ void ph_moe1g(const MP& p, int layer, char* lds) {
  int* tb = (int*)(lds + 131072);
  moe_tables<256>(p, layer, 2, tb);
  MoeSched S; S.tb = (const PG8_LAS int*)tb; S.wsb = p.ws; S.Abase = (unsigned)WS_H; S.Bbase = (unsigned)WS_WMOE; S.b_estride = 512u * 1024u * 2u;
  S.ntn = 2; S.G = (int)gridDim.x; S.c = (int)blockIdx.x; S.K = 1024; S.gather = 1;
  EpiMoe1G E; E.wsb = p.ws; E.tb = S.tb;
  pg8g_phase((PG8_LAS unsigned char*)lds, p.ws, 1024, S, E);
}
__device__ __forceinline__ void ph_moe2g(const MP& p, int layer, char* lds) {
  int* tb = (int*)(lds + 131072);
  moe_tables<256>(p, layer, 4, tb);
  MoeSched S; S.tb = (const PG8_LAS int*)tb; S.wsb = p.ws; S.Abase = (unsigned)WS_AMOE; S.Bbase = (unsigned)(WS_WMOE + (size_t)32 * 512 * 1024 * 2); S.b_estride = 1024u * 256u * 2u;
  S.ntn = 4; S.G = (int)gridDim.x; S.c = (int)blockIdx.x; S.K = 256; S.gather = 0;
  EpiMoe2G E; E.wsb = p.ws;
  pg8g_phase((PG8_LAS unsigned char*)lds, p.ws, 256, S, E);
}
__device__ __forceinline__ void ph_combine(const MP& p, int layer, int nrows, int final_) {
  float* lat = p.out; float* ctxr = (float*)(p.ws + WS_XC); const bf16_t* Y = (const bf16_t*)(p.ws + WS_YBUF);
  const float* modl_cur = (const float*)(p.ws + WS_MODS) + layer * 3 * 6144; const float* modl_next = (const float*)(p.ws + WS_MODS) + 3 * 6144;
  const float* gain = final_ ? p.in[28] : p.in[6] + 1024; bf16_t* hout = (bf16_t*)(p.ws + WS_H);
  const int lane = tidx() & 63, gw = blockIdx.x * 8 + (tidx() >> 6);
  for (int row = gw; row < nrows; row += gridDim.x * 8) {
    float* src = row < NLAT ? lat + (size_t)row * D : ctxr + (size_t)(row - NLAT) * D;
    const int v = row_vec(row);
    f32x4 x[4]; float ss = 0.f;
#pragma unroll
    for (int j = 0; j < 4; ++j) {
      const int n = (lane + 64 * j) * 4;
      const f32x4 g2 = *(const f32x4*)(modl_cur + v * 6144 + 5120 + n);
      const uint2 y0 = *(const uint2*)(Y + ((size_t)row * 2) * D + n), y1 = *(const uint2*)(Y + ((size_t)row * 2 + 1) * D + n);
      f32x4 ys;
      ys.x = __uint_as_float(y0.x << 16) + __uint_as_float(y1.x << 16); ys.y = __uint_as_float(y0.x & 0xFFFF0000u) + __uint_as_float(y1.x & 0xFFFF0000u);
      ys.z = __uint_as_float(y0.y << 16) + __uint_as_float(y1.y << 16); ys.w = __uint_as_float(y0.y & 0xFFFF0000u) + __uint_as_float(y1.y & 0xFFFF0000u);
      x[j] = ((const f32x4*)src)[lane + 64 * j] + g2 * ys;
      ss += x[j].x * x[j].x + x[j].y * x[j].y + x[j].z * x[j].z + x[j].w * x[j].w;
    }
    const float rstd = 1.f / sqrtf(wave_sum(ss) * (1.f / D) + EPS);
#pragma unroll
    for (int j = 0; j < 4; ++j) {
      const int n = (lane + 64 * j) * 4;
      const f32x4 g = *(const f32x4*)(gain + n);
      if (final_) { ((f32x4*)src)[lane + 64 * j] = x[j] * rstd * g; }
      else {
        ((f32x4*)src)[lane + 64 * j] = x[j];
        const f32x4 sc = *(const f32x4*)(modl_next + v * 6144 + 1024 + n), sh = *(const f32x4*)(modl_next + v * 6144 + n);
        const f32x4 h = x[j] * rstd * g * (sc + 1.f) + sh;
        uint2 o; o.x = pack2(h.x, h.y); o.y = pack2(h.z, h.w);
        *(uint2*)(hout + (size_t)row * D + n) = o;
      }
    }
  }
}
__device__ __forceinline__ void ph_kr_rope(const float* kr, bf16_t* dk) {
  for (int idx = blockIdx.x * 512 + tidx(); idx < MROWS * 32; idx += gridDim.x * 512) {
    const int m = idx >> 5, j = idx & 31; int b, key; row_bkey(m, b, key);
    float val = kr[idx];
    if (m < NLAT) {
      const int t = m & 8191; const int half = j >> 4, jj = j & 15, i = jj & 7;
      const float pos = half ? (float)(t & 63) : (float)(t >> 6);
      float sn, cs; sincosf(pos * rope_inv(i), &sn, &cs);
      const float x1 = kr[(size_t)m * 32 + half * 16 + i], x2 = kr[(size_t)m * 32 + half * 16 + 8 + i];
      val = (jj < 8) ? (x1 * cs - x2 * sn) : (x1 * sn + x2 * cs);
    }
    const bf16_t o = f2bf(val);
#pragma unroll
    for (int hh = 0; hh < 8; ++hh) dk[((size_t)(b * 8 + hh) * NKEY + key) * 128 + 64 + j] = o;
  }
}

#define MFMA32(a, b, c) __builtin_amdgcn_mfma_f32_32x32x16_bf16(a, b, c, 0, 0, 0)
#define KSWZ(row, colB) ((row) * 256 + ((colB) ^ (((row) & 7) << 4)))
#define SBAR() __builtin_amdgcn_sched_barrier(0)
__device__ __forceinline__ int crow(int r, int hi) { return (r & 3) + 8 * (r >> 2) + 4 * hi; }
__device__ __forceinline__ unsigned cvtpk(float lo, float hi) { unsigned r; asm volatile("v_cvt_pk_bf16_f32 %0, %1, %2" : "=v"(r) : "v"(lo), "v"(hi)); return r; }

__device__ __forceinline__ void att_partialSM(f32x16& p0, f32x16& p1, float& m_reg, float& mn, float& alpha) {
  float pmax = p0[0];
#pragma unroll
  for (int r = 1; r < 16; ++r) pmax = fmaxf(pmax, p0[r]);
#pragma unroll
  for (int r = 0; r < 16; ++r) pmax = fmaxf(pmax, p1[r]);
  { auto rr = __builtin_amdgcn_permlane32_swap(__float_as_uint(pmax), __float_as_uint(pmax), false, false);
    pmax = fmaxf(__uint_as_float(rr[0]), __uint_as_float(rr[1])); }
  if (__builtin_expect(__all(pmax - m_reg <= ATT_THR), 1)) { mn = m_reg; alpha = 1.f; }
  else { mn = fmaxf(m_reg, pmax); alpha = __builtin_amdgcn_exp2f(m_reg - mn); m_reg = mn; }
#pragma unroll
  for (int r = 0; r < 16; ++r) p0[r] = __builtin_amdgcn_exp2f(p0[r] - mn);
#pragma unroll
  for (int r = 0; r < 16; ++r) p1[r] = p1[r] - mn;
}
__device__ __forceinline__ void att_finishSM(f32x16& p0, f32x16& p1, float alpha, float& l_reg, bf16x8& pa0, bf16x8& pa1, bf16x8& pa2, bf16x8& pa3) {
#pragma unroll
  for (int r = 0; r < 16; ++r) p1[r] = __builtin_amdgcn_exp2f(p1[r]);
  float ps = 0.f;
#pragma unroll
  for (int r = 0; r < 16; ++r) ps += p0[r];
#pragma unroll
  for (int r = 0; r < 16; ++r) ps += p1[r];
  { auto rr = __builtin_amdgcn_permlane32_swap(__float_as_uint(ps), __float_as_uint(ps), false, false);
    ps = __uint_as_float(rr[0]) + __uint_as_float(rr[1]); }
  l_reg = l_reg * alpha + ps;
#define PK4(P, BASE, OUT) do { unsigned a0 = cvtpk(P[BASE + 0], P[BASE + 1]), a1 = cvtpk(P[BASE + 2], P[BASE + 3]);   \
    unsigned b0 = cvtpk(P[BASE + 4], P[BASE + 5]), b1 = cvtpk(P[BASE + 6], P[BASE + 7]);                              \
    auto r0 = __builtin_amdgcn_permlane32_swap(a0, b0, false, false); auto r1 = __builtin_amdgcn_permlane32_swap(a1, b1, false, false); \
    u32x4 w = {r0[0], r1[0], r0[1], r1[1]}; OUT = *reinterpret_cast<bf16x8*>(&w); } while (0)
  PK4(p0, 0, pa0); PK4(p0, 8, pa1); PK4(p1, 0, pa2); PK4(p1, 8, pa3);
}
template <int ND0>
__device__ __forceinline__ void att_qkt(f32x16& p0, f32x16& p1, const char* Ks, const bf16x8* qr, int r32, int hi) {
#pragma unroll
  for (int r = 0; r < 16; ++r) { p0[r] = 0.f; p1[r] = 0.f; }
#pragma unroll
  for (int d0 = 0; d0 < ND0; ++d0) { const int cb = (d0 * 16 + hi * 8) * 2;
    const bf16x8 b0 = *reinterpret_cast<const bf16x8*>(Ks + KSWZ(r32, cb));
    const bf16x8 b1 = *reinterpret_cast<const bf16x8*>(Ks + KSWZ(32 + r32, cb));
    p0 = MFMA32(b0, qr[d0], p0);
    p1 = MFMA32(b1, qr[d0], p1); }
}
__device__ __forceinline__ int v_st64(int k, int c) { const int kk = (k & ~0xC) | ((k & 4) << 1) | ((k & 8) >> 1); return ((kk >> 3) * 2 + (c >> 5)) * 512 + ((kk & 7) * 32 + (c & 31)) * 2; }
__device__ __forceinline__ int v_rd_base(int lane) { return ((lane & 3) << 3) | (((lane >> 2) & 3) << 6) | (((lane >> 4) & 1) << 5) | (((lane >> 5) & 1) << 8); }
static constexpr int v_rd_off64(int d0, int ks, int half) { return d0 * 512 + ks * 2048 + half * 1024; }
template <int OFF> __device__ __forceinline__ s16x4 tr_read(int vb) {
  s16x4 r; asm volatile("ds_read_b64_tr_b16 %0, %1 offset:%2" : "=&v"(r) : "v"(vb), "i"(OFF) : "memory"); return r;
}
template <int D0> __device__ __forceinline__ void pv_one64(f32x16& od, int vb, bf16x8 pa0, bf16x8 pa1, bf16x8 pa2, bf16x8 pa3) {
  const s16x4 l0 = tr_read<v_rd_off64(D0, 0, 0)>(vb), h0 = tr_read<v_rd_off64(D0, 0, 1)>(vb), l1 = tr_read<v_rd_off64(D0, 1, 0)>(vb), h1 = tr_read<v_rd_off64(D0, 1, 1)>(vb);
  const s16x4 l2 = tr_read<v_rd_off64(D0, 2, 0)>(vb), h2 = tr_read<v_rd_off64(D0, 2, 1)>(vb), l3 = tr_read<v_rd_off64(D0, 3, 0)>(vb), h3 = tr_read<v_rd_off64(D0, 3, 1)>(vb);
  asm volatile("s_waitcnt lgkmcnt(0)" ::: "memory"); SBAR();
#define PKV(L, H) (bf16x8){L[0], L[1], L[2], L[3], H[0], H[1], H[2], H[3]}
  od = MFMA32(pa0, PKV(l0, h0), od);
  od = MFMA32(pa1, PKV(l1, h1), od);
  od = MFMA32(pa2, PKV(l2, h2), od);
  od = MFMA32(pa3, PKV(l3, h3), od);
}

__device__ __forceinline__ void mla_block(const bf16_t* __restrict__ Qb, const bf16_t* __restrict__ Kh, const bf16_t* __restrict__ Vh, bf16_t* __restrict__ Ob, int t0, char* lds) {
  constexpr int SHM_V = 64 * 64 * 2, SHM_K = 64 * 128 * 2, NT = NKEY / 64;
  const int tid = tidx(), wid = tid >> 6, lane = tid & 63, r32 = lane & 31, hi = lane >> 5;
  char* V_lds = lds; char* K_lds = lds + 2 * SHM_V;
  float* wsf = (float*)(lds + 2 * SHM_V + 2 * SHM_K) + wid * 64; float* li_l = wsf; float* al_l = wsf + 32;
  float m_reg = -1e30f, l_reg = 0.f; f32x16 o[2];
#pragma unroll
  for (int r = 0; r < 16; ++r) { o[0][r] = 0.f; o[1][r] = 0.f; }
  bf16x8 qr[6];
  { const bf16_t* Qw = Qb + (size_t)(wid * 32 + r32) * 96;
#pragma unroll
    for (int d0 = 0; d0 < 4; ++d0) qr[d0] = *(const bf16x8*)(Qw + d0 * 16 + hi * 8);
    const int t = t0 + wid * 32 + r32;
#pragma unroll
    for (int g = 0; g < 2; ++g) {
      const bf16x8 x1 = *(const bf16x8*)(Qw + 64 + g * 16), x2 = *(const bf16x8*)(Qw + 64 + g * 16 + 8);
      const float pos = g ? (float)(t & 63) : (float)(t >> 6);
      unsigned wv[4];
#pragma unroll
      for (int i = 0; i < 8; i += 2) {
        float o2[2];
#pragma unroll
        for (int q = 0; q < 2; ++q) { const float ang = pos * rope_inv(i + q); const float sn = __sinf(ang), cs = __cosf(ang);
          const float a = bf2f((bf16_t)x1[i + q]), b = bf2f((bf16_t)x2[i + q]);
          o2[q] = hi ? (a * sn + b * cs) : (a * cs - b * sn); }
        wv[i >> 1] = pack2(o2[0], o2[1]);
      }
      u32x4 w4 = {wv[0], wv[1], wv[2], wv[3]}; qr[4 + g] = *reinterpret_cast<bf16x8*>(&w4);
    }
  }
  const int kq0 = tid, kq1 = tid < 256 ? 512 + tid : tid;
  const int kr0 = kq0 / 12, kc0 = (kq0 - kr0 * 12) * 8, kr1 = kq1 / 12, kc1 = (kq1 - kr1 * 12) * 8; const bool k2 = tid < 256;
  const int kw0 = KSWZ(kr0, kc0 * 2), kw1 = KSWZ(kr1, kc1 * 2);
  const int vk = tid >> 3, vc = (tid & 7) * 8, vst = v_st64(vk, vc);
  const int vb0 = (int)(uintptr_t)V_lds + v_rd_base(lane);
  const int ko0 = kr0 * 128 + kc0, ko1 = kr1 * 128 + kc1, vo = vk * 64 + vc;
  uint4 sv_0, sk0_0, sk1_0, sv_1, sk0_1, sk1_1;
#define SLOAD(i, kk0) do { sv_##i = *(const uint4*)(Vh + ((kk0) * 64 + vo)); sk0_##i = *(const uint4*)(Kh + ((kk0) * 128 + ko0)); sk1_##i = *(const uint4*)(Kh + ((kk0) * 128 + ko1)); } while (0)
#define SWRITE(b, i) do { *(uint4*)(V_lds + (b) * SHM_V + vst) = sv_##i; *(uint4*)(K_lds + (b) * SHM_K + kw0) = sk0_##i; if (k2) *(uint4*)(K_lds + (b) * SHM_K + kw1) = sk1_##i; } while (0)
#define SWAIT() asm volatile("s_waitcnt vmcnt(3)" ::: "memory")
#define RESC(a) do { if (__any((a) < 1.f)) { if (hi == 0) al_l[r32] = (a); asm volatile("s_waitcnt lgkmcnt(0)" ::: "memory"); \
    _Pragma("unroll") for (int d = 0; d < 2; ++d) _Pragma("unroll") for (int r = 0; r < 16; ++r) o[d][r] *= al_l[crow(r, hi)]; } } while (0)
#define PV2(vb) do { pv_one64<0>(o[0], (vb), pa0, pa1, pa2, pa3); pv_one64<1>(o[1], (vb), pa0, pa1, pa2, pa3); } while (0)
  f32x16 pA0, pA1, pB0, pB1; float mnA, mnB, alA, alB; bf16x8 pa0, pa1, pa2, pa3;
  SLOAD(0, 0); asm volatile("s_waitcnt vmcnt(0)" ::: "memory"); SWRITE(0, 0); __syncthreads();
  att_qkt<6>(pA0, pA1, K_lds, qr, r32, hi); att_partialSM(pA0, pA1, m_reg, mnA, alA);
  SLOAD(1, 64); SLOAD(0, 128);
  SWAIT(); SWRITE(1, 1); __syncthreads();
  for (int j = 1; j + 1 < NT; j += 2) {
    SBAR(); att_qkt<6>(pB0, pB1, K_lds + SHM_K, qr, r32, hi);
    att_finishSM(pA0, pA1, alA, l_reg, pa0, pa1, pa2, pa3); SBAR();
    SLOAD(1, (j + 2) * 64); SBAR();
    PV2(vb0); att_partialSM(pB0, pB1, m_reg, mnB, alB);
    __syncthreads(); SWAIT(); SWRITE(0, 0);
    RESC(alB); __syncthreads();
    SBAR(); att_qkt<6>(pA0, pA1, K_lds, qr, r32, hi);
    att_finishSM(pB0, pB1, alB, l_reg, pa0, pa1, pa2, pa3); SBAR();
    if (j + 3 < NT) SLOAD(0, (j + 3) * 64); SBAR();
    PV2(vb0 + SHM_V); att_partialSM(pA0, pA1, m_reg, mnA, alA);
    __syncthreads(); SWAIT(); SWRITE(1, 1);
    RESC(alA); __syncthreads();
  }
  SBAR(); att_qkt<6>(pB0, pB1, K_lds + SHM_K, qr, r32, hi);
  att_finishSM(pA0, pA1, alA, l_reg, pa0, pa1, pa2, pa3); SBAR();
  PV2(vb0); att_partialSM(pB0, pB1, m_reg, mnB, alB);
  __syncthreads(); RESC(alB);
  att_finishSM(pB0, pB1, alB, l_reg, pa0, pa1, pa2, pa3); SBAR();
  PV2(vb0 + SHM_V);
  if (hi == 0) li_l[r32] = l_reg; asm volatile("s_waitcnt lgkmcnt(0)" ::: "memory");
  bf16_t* Ow = Ob + (size_t)(wid * 32) * D;
#pragma unroll
  for (int r = 0; r < 16; ++r) { const int orow = crow(r, hi); const float rl = __builtin_amdgcn_rcpf(li_l[orow]);
#pragma unroll
    for (int d0 = 0; d0 < 2; ++d0) Ow[(size_t)orow * D + d0 * 32 + r32] = f2bf(o[d0][r] * rl); }
  __syncthreads();
#undef SLOAD
#undef SWRITE
#undef SWAIT
}
__device__ __forceinline__ void ph_mla(const MP& p, char* lds) {
  const bf16_t* dq = (const bf16_t*)(p.ws + WS_DQ); const bf16_t* dk = (const bf16_t*)(p.ws + WS_DK); const bf16_t* dv = (const bf16_t*)(p.ws + WS_DV);
  bf16_t* abuf = (bf16_t*)(p.ws + WS_A);
  for (int item = blockIdx.x; item < 512; item += gridDim.x) {
    const int bh = (item & 7) + 8 * (item >> 8), qb = (item >> 3) & 31, b = bh >> 3, h = bh & 7;
    mla_block(dq + ((size_t)bh * SEQ + qb * 256) * 96, dk + (size_t)bh * NKEY * 128, dv + (size_t)bh * NKEY * 64,
              abuf + (size_t)(b * SEQ + qb * 256) * D + 512 + h * 64, qb * 256, lds);
  }
}

__device__ __forceinline__ int hgrn_step_cid(int b, int dir, int s) {
  if (s < 4) return 256 + b * 4 + (dir ? 3 - s : s);
  return b * 128 + (dir ? 131 - s : s - 4);
}
__device__ __forceinline__ void ph_hgrn_a(const MP& p, char* lds) {
  bf16_t* U = (bf16_t*)(p.ws + WS_U); float* LF = (float*)(p.ws + WS_LF); float* alast = (float*)(p.ws + WS_ALAST);
  bf16_t* KT = (bf16_t*)(p.ws + WS_A); bf16_t* VT = (bf16_t*)(p.ws + WS_H + USLOT);
  float* Ef = (float*)lds;
  bf16_t* Kn = (bf16_t*)(lds + 33792);
  bf16_t* Vn = (bf16_t*)(lds + 33792 + 17408);
  float* gsum = (float*)(lds + 33792 + 2 * 17408);
  const int t = tidx(), srow = t >> 3, scb = (t & 7) * 16, col = t & 127, grp = t >> 7;
  for (int item = blockIdx.x; item < NCHUNK * 8; item += gridDim.x) {
    const int cid = item >> 3, dir = (item >> 2) & 1, h = item & 3; const size_t row0 = (size_t)cid * 64;
    { const size_t go = (row0 + srow) * 512 + h * 128 + scb;
      const float* lp = LF + (size_t)dir * MROWS * 512 + go;
      const f32x4 e0 = *(const f32x4*)lp, e1 = *(const f32x4*)(lp + 4), e2 = *(const f32x4*)(lp + 8), e3 = *(const f32x4*)(lp + 12);
      const uint4 k0 = *(const uint4*)(U + (size_t)(1 + dir) * MROWS * 512 + go), k1 = *(const uint4*)(U + (size_t)(1 + dir) * MROWS * 512 + go + 8);
      float* ed = Ef + srow * 132 + scb; *(f32x4*)ed = e0; *(f32x4*)(ed + 4) = e1; *(f32x4*)(ed + 8) = e2; *(f32x4*)(ed + 12) = e3;
      *(uint4*)(Kn + srow * 136 + scb) = k0; *(uint4*)(Kn + srow * 136 + scb + 8) = k1;
      if (dir == 0) { const uint4 v0 = *(const uint4*)(U + (size_t)3 * MROWS * 512 + go), v1 = *(const uint4*)(U + (size_t)3 * MROWS * 512 + go + 8);
        *(uint4*)(Vn + srow * 136 + scb) = v0; *(uint4*)(Vn + srow * 136 + scb + 8) = v1; } }
    __syncthreads();
    float pre[16]; float run = 0.f;
#pragma unroll
    for (int i = 0; i < 16; ++i) { const int rr = grp * 16 + (dir ? 15 - i : i); run += Ef[rr * 132 + col]; pre[i] = run; }
    gsum[grp * 128 + col] = run;
    __syncthreads();
    const float g0 = gsum[col], g1 = gsum[128 + col], g2 = gsum[256 + col], g3 = gsum[384 + col];
    const float total = (g0 + g1) + (g2 + g3);
    float offs;
    if (dir == 0) offs = grp == 0 ? 0.f : (grp == 1 ? g0 : (grp == 2 ? g0 + g1 : g0 + g1 + g2));
    else offs = grp == 3 ? 0.f : (grp == 2 ? g3 : (grp == 1 ? g3 + g2 : g3 + g2 + g1));
    if (grp == 0) alast[((size_t)dir * NCHUNK + cid) * 512 + h * 128 + col] = __expf(total);
    unsigned kw[8];
    float* lfo = LF + ((size_t)dir * MROWS + row0 + grp * 16) * 512 + h * 128 + col;
    bf16_t* uko = U + (size_t)(1 + dir) * MROWS * 512 + (row0 + grp * 16) * 512 + h * 128 + col;
#pragma unroll
    for (int i = 0; i < 16; i += 2) {
      const float ea = total - (offs + pre[dir ? 15 - i : i]), eb = total - (offs + pre[dir ? 14 - i : i + 1]);
      lfo[(size_t)i * 512] = ea; lfo[(size_t)(i + 1) * 512] = eb;
      const bf16_t ka = f2bf(bf2f(Kn[(grp * 16 + i) * 136 + col]) * __expf(ea)), kb = f2bf(bf2f(Kn[(grp * 16 + i + 1) * 136 + col]) * __expf(eb));
      uko[(size_t)i * 512] = ka; uko[(size_t)(i + 1) * 512] = kb; kw[i >> 1] = (unsigned)ka | ((unsigned)kb << 16);
    }
    { bf16_t* kt = KT + ((((size_t)dir * NCHUNK + cid) * 4 + h) * 128 + col) * 64 + grp * 16;
      *(uint4*)kt = make_uint4(kw[0], kw[1], kw[2], kw[3]); *(uint4*)(kt + 8) = make_uint4(kw[4], kw[5], kw[6], kw[7]); }
    if (dir == 0) {
      unsigned vw[8];
#pragma unroll
      for (int i = 0; i < 16; i += 2) vw[i >> 1] = (unsigned)Vn[(grp * 16 + i) * 136 + col] | ((unsigned)Vn[(grp * 16 + i + 1) * 136 + col] << 16);
      bf16_t* vt = VT + (((size_t)cid * 4 + h) * 128 + col) * 64 + grp * 16;
      *(uint4*)vt = make_uint4(vw[0], vw[1], vw[2], vw[3]); *(uint4*)(vt + 8) = make_uint4(vw[4], vw[5], vw[6], vw[7]);
    }
    __syncthreads();
  }
}
__device__ __forceinline__ bf16_t* hgrn_sbuf(const MP& p, int bhd, int cid) {
  return cid < 256 ? (bf16_t*)p.out + ((size_t)bhd * 128 + (cid & 127)) * 16384 : (bf16_t*)(p.ws + WS_ODIR_CTX) + ((size_t)bhd * 4 + ((cid - 256) & 3)) * 16384;
}
__device__ __forceinline__ void ph_hgrn_b(const MP& p) {
  const int w = tidx() >> 6, lane = tidx() & 63, l15 = lane & 15, lq = lane >> 4;
  if (w < 4) {
    const bf16_t* KT = (const bf16_t*)(p.ws + WS_A); const bf16_t* VT = (const bf16_t*)(p.ws + WS_H + USLOT); const float* alast = (const float*)(p.ws + WS_ALAST);
    for (int item = blockIdx.x * 4 + w; item < 1024; item += gridDim.x * 4) {
      const int bhd = item >> 6, dkt = (item >> 3) & 7, dvt = item & 7, b = bhd >> 3, h = (bhd >> 1) & 3, dir = bhd & 1;
      f32x4 S = {0.f, 0.f, 0.f, 0.f};
      uint4 ka[4][2], vb[4][2]; float al[4];
#define HB_LOAD(s0) _Pragma("unroll") for (int u = 0; u < 4; ++u) { const int cid = hgrn_step_cid(b, dir, (s0) + u);                                   \
        const bf16_t* kt = KT + ((((size_t)dir * NCHUNK + cid) * 4 + h) * 128 + dkt * 16 + l15) * 64 + lq * 8;                                       \
        const bf16_t* vt = VT + (((size_t)cid * 4 + h) * 128 + dvt * 16 + l15) * 64 + lq * 8;                                                       \
        ka[u][0] = *(const uint4*)kt; ka[u][1] = *(const uint4*)(kt + 32); vb[u][0] = *(const uint4*)vt; vb[u][1] = *(const uint4*)(vt + 32);          \
        al[u] = alast[((size_t)dir * NCHUNK + cid) * 512 + h * 128 + dkt * 16 + l15]; }
      HB_LOAD(0);
      for (int s0 = 0; s0 < 132; s0 += 4) {
        uint4 kc[4][2], vc[4][2]; float ac[4];
#pragma unroll
        for (int u = 0; u < 4; ++u) { kc[u][0] = ka[u][0]; kc[u][1] = ka[u][1]; vc[u][0] = vb[u][0]; vc[u][1] = vb[u][1]; ac[u] = al[u]; }
        if (s0 + 4 < 132) { HB_LOAD(s0 + 4); }
#pragma unroll
        for (int u = 0; u < 4; ++u) {
          const int cid = hgrn_step_cid(b, dir, s0 + u);
          f32x4 T = {0.f, 0.f, 0.f, 0.f};
          T = MFMA16(*reinterpret_cast<bf16x8*>(&vc[u][0]), *reinterpret_cast<bf16x8*>(&kc[u][0]), T);
          T = MFMA16(*reinterpret_cast<bf16x8*>(&vc[u][1]), *reinterpret_cast<bf16x8*>(&kc[u][1]), T);
          const f32x4 Sp = S * ac[u];
          bf16_t* sb = hgrn_sbuf(p, bhd, cid) + (size_t)(dvt * 16 + lq * 4) * 128 + dkt * 16 + l15;
          sb[0] = f2bf(Sp.x); sb[128] = f2bf(Sp.y); sb[256] = f2bf(Sp.z); sb[384] = f2bf(Sp.w);
          S = Sp + T;
        }
      }
#undef HB_LOAD
    }
  }
}
__device__ __forceinline__ void ph_hgrn_c(const MP& p, char* lds) {
  const bf16_t* U = (const bf16_t*)(p.ws + WS_U); const float* LF = (const float*)(p.ws + WS_LF); const bf16_t* VT = (const bf16_t*)(p.ws + WS_H + USLOT);
  bf16_t* abuf = (bf16_t*)(p.ws + WS_A); const float* onorm = p.in[11];
  char* Qs = lds; char* Ks = lds + 16384; char* Ss = lds + 32768; char* Vs = lds + 65536; char* As = lds + 81920; float* red = (float*)(lds + 90112);
  const int t = tidx(), lane = t & 63, w = t >> 6, wm = w >> 1, wn = w & 1, l15 = lane & 15, lq = lane >> 4;
  const int srow = t >> 3, scb = (t & 7) * 16;
  for (int item = blockIdx.x; item < 8 * 132; item += gridDim.x) {
    const int bh = item / 132, cpos = item - bh * 132, b = bh >> 2, h = bh & 3;
    const int cid = cpos < 128 ? b * 128 + cpos : 256 + b * 4 + (cpos - 128); const size_t row0 = (size_t)cid * 64;
    f32x4 acc[4];
#pragma unroll
    for (int j = 0; j < 4; ++j) acc[j] = (f32x4){0.f, 0.f, 0.f, 0.f};
    for (int dir = 0; dir < 2; ++dir) {
      {
        const size_t go = (row0 + srow) * 512 + h * 128 + scb;
        const uint4 q0 = *(const uint4*)(U + go), q1 = *(const uint4*)(U + go + 8);
        const uint4 k0 = *(const uint4*)(U + (size_t)(1 + dir) * MROWS * 512 + go), k1 = *(const uint4*)(U + (size_t)(1 + dir) * MROWS * 512 + go + 8);
        const float* ep = LF + (size_t)dir * MROWS * 512 + go;
        const f32x4 e0 = *(const f32x4*)ep, e1 = *(const f32x4*)(ep + 4), e2 = *(const f32x4*)(ep + 8), e3 = *(const f32x4*)(ep + 12);
        const unsigned qw[8] = {q0.x, q0.y, q0.z, q0.w, q1.x, q1.y, q1.z, q1.w};
        const float ev[16] = {e0.x, e0.y, e0.z, e0.w, e1.x, e1.y, e1.z, e1.w, e2.x, e2.y, e2.z, e2.w, e3.x, e3.y, e3.z, e3.w};
        unsigned ow[8];
#pragma unroll
        for (int i = 0; i < 8; ++i) ow[i] = pack2(__uint_as_float(qw[i] << 16) * __expf(-ev[2 * i]), __uint_as_float(qw[i] & 0xFFFF0000u) * __expf(-ev[2 * i + 1]));
        const int c0 = scb >> 3, sw = srow & 15;
        *(uint4*)(Qs + srow * 256 + ((c0 ^ sw) << 4)) = make_uint4(ow[0], ow[1], ow[2], ow[3]);
        *(uint4*)(Qs + srow * 256 + (((c0 + 1) ^ sw) << 4)) = make_uint4(ow[4], ow[5], ow[6], ow[7]);
        *(uint4*)(Ks + srow * 256 + ((c0 ^ sw) << 4)) = k0;
        *(uint4*)(Ks + srow * 256 + (((c0 + 1) ^ sw) << 4)) = k1;
        const bf16_t* vt = VT + ((size_t)cid * 4 + h) * 8192;
#pragma unroll
        for (int i = 0; i < 2; ++i) { const int idx = t + 512 * i, r = idx >> 3, c = idx & 7; *(uint4*)(Vs + r * 128 + ((c ^ ((r >> 1) & 7)) << 4)) = *(const uint4*)(vt + (size_t)idx * 8); }
        const bf16_t* sb = hgrn_sbuf(p, bh * 2 + dir, cid);
#pragma unroll
        for (int i = 0; i < 4; ++i) { const int idx = t + 512 * i, r = idx >> 4, c = idx & 15; *(uint4*)(Ss + r * 256 + ((c ^ (r & 15)) << 4)) = *(const uint4*)(sb + (size_t)idx * 8); }
      }
      __syncthreads();
      bf16x8 af[4];
#pragma unroll
      for (int ks = 0; ks < 4; ++ks) af[ks] = *(const bf16x8*)(Qs + (wm * 16 + l15) * 256 + (((ks * 4 + lq) ^ l15) << 4));
      {
        f32x4 a2[2];
#pragma unroll
        for (int ni = 0; ni < 2; ++ni) { a2[ni] = (f32x4){0.f, 0.f, 0.f, 0.f};
#pragma unroll
          for (int ks = 0; ks < 4; ++ks) { const bf16x8 bf = *(const bf16x8*)(Ks + (wn * 32 + ni * 16 + l15) * 256 + (((ks * 4 + lq) ^ l15) << 4)); a2[ni] = MFMA16(bf, af[ks], a2[ni]); } }
        const int tt = wm * 16 + l15;
#pragma unroll
        for (int ni = 0; ni < 2; ++ni) { const int s0 = wn * 32 + ni * 16 + lq * 4; float v[4] = {a2[ni].x, a2[ni].y, a2[ni].z, a2[ni].w};
#pragma unroll
          for (int r = 0; r < 4; ++r) { const int s = s0 + r; const bool keep = dir ? (s >= tt) : (s <= tt); v[r] = keep ? v[r] : 0.f; }
          uint2 wv; wv.x = pack2(v[0], v[1]); wv.y = pack2(v[2], v[3]);
          *(uint2*)(As + tt * 128 + (((s0 >> 3) ^ ((tt >> 1) & 7)) << 4) + (s0 & 7) * 2) = wv; }
      }
#pragma unroll
      for (int ni = 0; ni < 4; ++ni) {
#pragma unroll
        for (int ks = 0; ks < 4; ++ks) { const bf16x8 bf = *(const bf16x8*)(Ss + (wn * 64 + ni * 16 + l15) * 256 + (((ks * 4 + lq) ^ l15) << 4)); acc[ni] = MFMA16(bf, af[ks], acc[ni]); } }
      __syncthreads();
      {
        const int tt = wm * 16 + l15; bf16x8 aa[2];
#pragma unroll
        for (int ks = 0; ks < 2; ++ks) aa[ks] = *(const bf16x8*)(As + tt * 128 + (((ks * 4 + lq) ^ ((tt >> 1) & 7)) << 4));
#pragma unroll
        for (int ni = 0; ni < 4; ++ni) { const int r = wn * 64 + ni * 16 + l15;
#pragma unroll
          for (int ks = 0; ks < 2; ++ks) { const bf16x8 bf = *(const bf16x8*)(Vs + r * 128 + (((ks * 4 + lq) ^ ((r >> 1) & 7)) << 4)); acc[ni] = MFMA16(bf, aa[ks], acc[ni]); } }
      }
      __syncthreads();
    }
    const int tt = wm * 16 + l15; float ss = 0.f;
#pragma unroll
    for (int ni = 0; ni < 4; ++ni) ss += acc[ni].x * acc[ni].x + acc[ni].y * acc[ni].y + acc[ni].z * acc[ni].z + acc[ni].w * acc[ni].w;
    ss += __shfl_xor(ss, 16); ss += __shfl_xor(ss, 32);
    if (lq == 0) red[tt * 2 + wn] = ss;
    __syncthreads();
    const float rstd = 1.f / sqrtf((red[tt * 2] + red[tt * 2 + 1]) * (1.f / 128.f) + EPS);
#pragma unroll
    for (int ni = 0; ni < 4; ++ni) {
      const int dv = wn * 64 + ni * 16 + lq * 4; const size_t go = (row0 + tt) * 512 + h * 128 + dv;
      const uint2 gw = *(const uint2*)(U + (size_t)4 * MROWS * 512 + go); const f32x4 on = *(const f32x4*)(onorm + dv);
      uint2 wv;
      wv.x = pack2(acc[ni].x * rstd * on.x * __uint_as_float(gw.x << 16), acc[ni].y * rstd * on.y * __uint_as_float(gw.x & 0xFFFF0000u));
      wv.y = pack2(acc[ni].z * rstd * on.z * __uint_as_float(gw.y << 16), acc[ni].w * rstd * on.w * __uint_as_float(gw.y & 0xFFFF0000u));
      *(uint2*)(abuf + (row0 + tt) * D + h * 128 + dv) = wv;
    }
    __syncthreads();
  }
}

#define XB_TMO      128
#define XB_XCNT(j)  (256  + 64 * (j))
#define XB_XSUB(j)  (1280 + 64 * (j))
#define XB_XGEN(j)  (2304 + 64 * (j))
#define XB_TOP      3328
#define XB_TOPGEN   3392
#define XCD_BAR_WORDS 3456
#define XB_SPIN_CAP (1u << 20)
#define LAS __attribute__((address_space(3)))
__device__ __forceinline__ unsigned xb_ld(unsigned* p)              { return __hip_atomic_load(p, __ATOMIC_RELAXED, __HIP_MEMORY_SCOPE_AGENT); }
__device__ __forceinline__ unsigned xb_add(unsigned* p, unsigned v) { return __hip_atomic_fetch_add(p, v, __ATOMIC_RELAXED, __HIP_MEMORY_SCOPE_AGENT); }
__device__ __forceinline__ unsigned xb_xcc_id() { return (unsigned)__builtin_amdgcn_s_getreg((3 << 11) | 20) & 0xFu; }
#define XB_SPIN(cond, bar) do { unsigned _sp = 0; while (cond) { __builtin_amdgcn_s_sleep(1); \
    if ((++_sp & 255u) == 0u) { if (xb_ld(&(bar)[XB_TMO])) break; if (_sp > XB_SPIN_CAP) { atomicAdd(&(bar)[XB_TMO], 1u); break; } } } } while (0)
struct XcdBarrier { unsigned* bar; unsigned x; volatile LAS unsigned* st; };
__device__ __forceinline__ XcdBarrier xcd_barrier_post(unsigned* bar, volatile LAS unsigned* st) {
  XcdBarrier b; b.bar = bar; b.x = xb_xcc_id(); b.st = st;
  if (tidx() == 0) (void)xb_add(&bar[XB_XCNT(b.x)], 1u);
  return b;
}
__device__ __forceinline__ void xcd_barrier_complete(unsigned* bar, unsigned x, unsigned& nloc, unsigned& nx) {
  const unsigned G = gridDim.x * gridDim.y * gridDim.z;
  unsigned sum, cnt, mine, sp = 0u;
  for (;;) {
    sum = 0u; cnt = 0u; mine = 0u;
#pragma unroll
    for (unsigned j = 0; j < 16; ++j) { const unsigned c = xb_ld(&bar[XB_XCNT(j)]); sum += c; cnt += (c > 0u) ? 1u : 0u; mine = (j == x) ? c : mine; }
    if (sum == G) break;
    __builtin_amdgcn_s_sleep(1);
    if ((++sp & 255u) == 0u) { if (xb_ld(&bar[XB_TMO])) break; if (sp > XB_SPIN_CAP) { atomicAdd(&bar[XB_TMO], 1u); break; } }
  }
  nloc = mine > 0u ? mine : 1u; nx = cnt > 0u ? cnt : 1u;
}
__device__ __forceinline__ void xcd_barrier(const XcdBarrier& b) {
  asm volatile("s_waitcnt vmcnt(0)" ::: "memory");
  __syncthreads();
  if (tidx() == 0) {
    unsigned* bar = b.bar;
    __builtin_amdgcn_s_waitcnt(0);
    unsigned nloc = b.st[0], nx = b.st[1];
    if (nloc == 0u) { xcd_barrier_complete(bar, b.x, nloc, nx); b.st[0] = nloc; b.st[1] = nx; }
    const unsigned old = xb_add(&bar[XB_XSUB(b.x)], 1u);
    const unsigned gen = old / nloc;
    if (old + 1u == (gen + 1u) * nloc) {
      __builtin_amdgcn_fence(__ATOMIC_RELEASE, "agent");
      asm volatile("s_waitcnt vmcnt(0)" ::: "memory");
      const unsigned og = xb_add(&bar[XB_TOP], 1u);
      const unsigned tg = og / nx;
      if (og + 1u == (tg + 1u) * nx) xb_add(&bar[XB_TOPGEN], 1u);
      else XB_SPIN(xb_ld(&bar[XB_TOPGEN]) == tg, bar);
      __builtin_amdgcn_fence(__ATOMIC_ACQUIRE, "agent");
      xb_add(&bar[XB_XGEN(b.x)], 1u);
      asm volatile("s_waitcnt vmcnt(0)" ::: "memory");
    } else {
      XB_SPIN(xb_ld(&bar[XB_XGEN(b.x)]) == gen, bar);
      __builtin_amdgcn_fence(__ATOMIC_ACQUIRE, "agent");
      asm volatile("s_waitcnt vmcnt(0)" ::: "memory");
    }
  }
  __syncthreads();
}

  template <int D0> __device__ __forceinline__ void pv_one32(f32x16& od, int vb, bf16x8 pa0, bf16x8 pa1) {
    const s16x4 l0 = tr_read<v_rd_off64(D0, 0, 0)>(vb), h0 = tr_read<v_rd_off64(D0, 0, 1)>(vb), l1 = tr_read<v_rd_off64(D0, 1, 0)>(vb), h1 = tr_read<v_rd_off64(D0, 1, 1)>(vb);
    asm volatile("s_waitcnt lgkmcnt(0)" ::: "memory"); SBAR();
    od = MFMA32(pa0, PKV(l0, h0), od);
    od = MFMA32(pa1, PKV(l1, h1), od);
  }
  __device__ __forceinline__ void ph_na(const MP& p, char* lds) {
    const bf16_t* nq = (const bf16_t*)(p.ws + WS_NQ); const bf16_t* nk = (const bf16_t*)(p.ws + WS_NK); const bf16_t* nv = (const bf16_t*)(p.ws + WS_NV);
    bf16_t* A = (bf16_t*)(p.ws + WS_A);
    const int tid = tidx(), w = tid >> 6, lane = tid & 63, j = lane & 31, hi = lane >> 5;
    char* Kw = lds + w * 8192; char* Vw = Kw + 4096;
    float* rpbs = (float*)(lds + 65536);
    float* al_l = (float*)(lds + 65536 + 4096) + w * 64; float* li_l = al_l + 32;
    const int vb0 = (int)(uintptr_t)Vw + v_rd_base(lane);
    for (int item = blockIdx.x; item < 512; item += gridDim.x) {
      const int bh = (item & 7) + 8 * (item >> 8), patch = (item >> 3) & 31, b = bh >> 3, h = bh & 7, r0 = (patch >> 2) * 16, c0 = (patch & 3) * 16;
      for (int i = tid; i < 15 * 64; i += 512) { const int dr = i >> 6, dc = (i & 63) - 16; rpbs[i] = (dc >= 0 && dc < 31) ? p.in[16][(h * 15 + dr) * 31 + dc] * LOG2E : 0.f; }
      __syncthreads();
      const int ra = r0 + 2 * w, qrow = ra + (j >> 4), qc = c0 + (j & 15);
      int rs_q = qrow - 4; rs_q = rs_q < 0 ? 0 : (rs_q > 120 ? 120 : rs_q);
      int cs_q = qc - 8; cs_q = cs_q < 0 ? 0 : (cs_q > 48 ? 48 : cs_q);
      int rs0 = ra - 4; rs0 = rs0 < 0 ? 0 : (rs0 > 120 ? 120 : rs0);
      int rs1 = ra - 3; rs1 = rs1 < 0 ? 0 : (rs1 > 120 ? 120 : rs1);
      int cw = c0 - 8; cw = cw < 0 ? 0 : (cw > 32 ? 32 : cw);
      const int ntiles = 8 + (rs1 - rs0) + 8;
      const bf16_t* Kb = nk + (size_t)bh * NKEY * 64; const bf16_t* Vb = nv + (size_t)bh * NKEY * 64;
      bf16x8 qr[4];
      { const bf16_t* qp = nq + ((size_t)bh * SEQ + qrow * 64 + qc) * 64 + hi * 8;
#pragma unroll
        for (int d0 = 0; d0 < 4; ++d0) qr[d0] = *(const bf16x8*)(qp + d0 * 16); }
      f32x16 o[2];
#pragma unroll
      for (int r = 0; r < 16; ++r) { o[0][r] = 0.f; o[1][r] = 0.f; }
      float m_reg = -1e30f, l_reg = 0.f;
      int kwo[4], vwo[4];
#pragma unroll
      for (int i = 0; i < 4; ++i) { const int q = lane + 64 * i, row = q >> 3, c = q & 7; kwo[i] = row * 128 + ((c ^ ((row >> 1) & 7)) << 4); vwo[i] = v_st64(row, c * 8); }
      uint4 sk0, sk1, sk2, sk3, sv0, sv1, sv2, sv3;
#define NA_KBASE(tl) ((tl) < 8 ? (tl) * 32 : CT + (rs0 + (tl) - 8) * 64 + cw)
#define NA_L1(i) sk##i = *(const uint4*)(Kb + kb_ + (i) * 512); sv##i = *(const uint4*)(Vb + kb_ + (i) * 512);
#define NA_LOAD(tl) do { const size_t kb_ = (size_t)NA_KBASE(tl) * 64 + lane * 8; NA_L1(0) NA_L1(1) NA_L1(2) NA_L1(3) } while (0)
#define NA_W1(i) *(uint4*)(Kw + kwo[i]) = sk##i; *(uint4*)(Vw + vwo[i]) = sv##i;
#define NA_WRITE() do { NA_W1(0) NA_W1(1) NA_W1(2) NA_W1(3) } while (0)
      NA_LOAD(0); NA_WRITE();
      for (int tl = 0; tl < ntiles; ++tl) {
        if (tl + 1 < ntiles) NA_LOAD(tl + 1);
        f32x16 pt;
#pragma unroll
        for (int r = 0; r < 16; ++r) pt[r] = 0.f;
#pragma unroll
        for (int d0 = 0; d0 < 4; ++d0) { const bf16x8 kf = *(const bf16x8*)(Kw + j * 128 + (((d0 * 2 + hi) ^ ((j >> 1) & 7)) << 4)); pt = MFMA32(kf, qr[d0], pt); }
        if (tl >= 8) {
          const int kr = rs0 + tl - 8; const bool rowok = (kr >= rs_q) && (kr < rs_q + 8);
          int dr = kr - qrow + 7; dr = dr < 0 ? 0 : (dr > 14 ? 14 : dr);
          const float* bp = rpbs + dr * 64 + (cw - qc + 15 + 16) + 4 * hi; const int kc0 = cw + 4 * hi;
#pragma unroll
          for (int r = 0; r < 16; ++r) { const int cr = (r & 3) + 8 * (r >> 2); const int kc = kc0 + cr;
            const bool ok = rowok && (kc >= cs_q) && (kc < cs_q + 16); pt[r] = ok ? pt[r] + bp[cr] : -1e30f; }
        }
        float pmax = pt[0];
#pragma unroll
        for (int r = 1; r < 16; ++r) pmax = fmaxf(pmax, pt[r]);
        { auto rr = __builtin_amdgcn_permlane32_swap(__float_as_uint(pmax), __float_as_uint(pmax), false, false); pmax = fmaxf(__uint_as_float(rr[0]), __uint_as_float(rr[1])); }
        float mn, alpha;
        if (__all(pmax - m_reg <= ATT_THR)) { mn = m_reg; alpha = 1.f; }
        else { mn = fmaxf(m_reg, pmax); alpha = __builtin_amdgcn_exp2f(m_reg - mn); m_reg = mn; }
        float ps = 0.f;
#pragma unroll
        for (int r = 0; r < 16; ++r) { pt[r] = __builtin_amdgcn_exp2f(pt[r] - mn); ps += pt[r]; }
        { auto rr = __builtin_amdgcn_permlane32_swap(__float_as_uint(ps), __float_as_uint(ps), false, false); ps = __uint_as_float(rr[0]) + __uint_as_float(rr[1]); }
        l_reg = l_reg * alpha + ps;
        bf16x8 pa0, pa1; PK4(pt, 0, pa0); PK4(pt, 8, pa1);
        if (__any(alpha < 1.f)) { if (hi == 0) al_l[j] = alpha; asm volatile("s_waitcnt lgkmcnt(0)" ::: "memory");
#pragma unroll
          for (int d = 0; d < 2; ++d)
#pragma unroll
            for (int r = 0; r < 16; ++r) o[d][r] *= al_l[crow(r, hi)]; }
        pv_one32<0>(o[0], vb0, pa0, pa1); pv_one32<1>(o[1], vb0, pa0, pa1);
        if (tl + 1 < ntiles) NA_WRITE();
      }
#undef NA_LOAD
#undef NA_WRITE
#undef NA_KBASE
      if (hi == 0) li_l[j] = l_reg; asm volatile("s_waitcnt lgkmcnt(0)" ::: "memory");
#pragma unroll
      for (int r = 0; r < 16; ++r) { const int qq = crow(r, hi); const float rl = __builtin_amdgcn_rcpf(li_l[qq]);
        bf16_t* op = A + ((size_t)b * SEQ + (ra + (qq >> 4)) * 64 + c0 + (qq & 15)) * D + h * 64 + j;
        op[0] = f2bf(o[0][r] * rl); op[32] = f2bf(o[1][r] * rl); }
      __syncthreads();
    }
  }

__device__ __forceinline__ void ph_na_simple(const MP& p) {
  const bf16_t* nq = (const bf16_t*)(p.ws + WS_NQ); const bf16_t* nk = (const bf16_t*)(p.ws + WS_NK); const bf16_t* nv = (const bf16_t*)(p.ws + WS_NV);
  const float* rpb = p.in[16]; bf16_t* A = (bf16_t*)(p.ws + WS_A);
  for (int item = blockIdx.x; item < 256; item += gridDim.x) {
    const int bh = item >> 4, t = (item & 15) * 512 + tidx(), b = bh >> 3, hh = bh & 7;
    const int r = t >> 6, c = t & 63;
    int rs = r - 4; rs = rs < 0 ? 0 : (rs > 120 ? 120 : rs);
    int cs = c - 8; cs = cs < 0 ? 0 : (cs > 48 ? 48 : cs);
    float q[64], o[64];
    const bf16_t* qp = nq + ((size_t)bh * SEQ + t) * 64;
#pragma unroll
    for (int d = 0; d < 64; ++d) { q[d] = bf2f(qp[d]); o[d] = 0.f; }
    const bf16_t* Kb = nk + (size_t)bh * NKEY * 64; const bf16_t* Vb = nv + (size_t)bh * NKEY * 64;
    float mx = -3.0e38f, l = 0.f;
    for (int kk = 0; kk < 128 + CT; ++kk) {
      int key; float bias = 0.f;
      if (kk < 128) { const int kr_ = rs + (kk >> 4), kc = cs + (kk & 15); key = CT + kr_ * 64 + kc; bias = rpb[(hh * 15 + (kr_ - r + 7)) * 31 + (kc - c + 15)] * LOG2E; }
      else key = kk - 128;
      const bf16_t* kp = Kb + (size_t)key * 64; float s = bias;
#pragma unroll
      for (int d = 0; d < 64; d += 2) { const unsigned w = *(const unsigned*)(kp + d); s += q[d] * __uint_as_float(w << 16) + q[d + 1] * __uint_as_float(w & 0xFFFF0000u); }
      const float mn = fmaxf(mx, s), alpha = exp2f(mx - mn), pe = exp2f(s - mn);
      l = l * alpha + pe; mx = mn;
      const bf16_t* vp = Vb + (size_t)key * 64;
#pragma unroll
      for (int d = 0; d < 64; d += 2) { const unsigned w = *(const unsigned*)(vp + d); o[d] = o[d] * alpha + pe * __uint_as_float(w << 16); o[d + 1] = o[d + 1] * alpha + pe * __uint_as_float(w & 0xFFFF0000u); }
    }
    const float il = 1.f / l;
    bf16_t* op = A + (size_t)(b * SEQ + t) * D + hh * 64;
#pragma unroll
    for (int d = 0; d < 64; d += 2) *(unsigned*)(op + d) = pack2(o[d] * il, o[d + 1] * il);
  }
}

};

enum { PH_PRE = 0, PH_N1_0, PH_G1_0, PH_HA, PH_HB, PH_HC, PH_G2_0, PH_ROUTE_0, PH_MOE1_0, PH_MOE2_0, PH_COMB_0, PH_G1_1, PH_MLAUP, PH_MLA, PH_G2_1, PH_ROUTE_1, PH_MOE1_1, PH_MOE2_1, PH_FINAL, PH_COUNT };

#ifndef PROBE_PHASE
#define PROBE_PHASE (-1)
#endif
__global__ __launch_bounds__(512) void mega(MP p) {
  unsigned long long pt0 = 0, pt1 = 0;
  extern __shared__ __attribute__((aligned(16))) char smem[];
  char* ws = p.ws;
  MK k; k.wv = __builtin_amdgcn_readfirstlane((int)(threadIdx.x >> 6));
  volatile LAS unsigned* xbw = (volatile LAS unsigned*)(smem + LDS_BYTES - 16);
  if (k.tidx() == 0) { xbw[0] = 0u; xbw[1] = 0u; }
  __syncthreads();
  MK::XcdBarrier bar; bar.bar = (unsigned*)(ws + WS_CTL); bar.x = 0; bar.st = xbw;
  if (p.ph_hi - p.ph_lo > 1) bar = k.xcd_barrier_post((unsigned*)(ws + WS_CTL), xbw);
  const float* mods0 = (const float*)(ws + WS_MODS); const float* mods1 = mods0 + 3 * 6144;
  bf16_t* hbuf = (bf16_t*)(ws + WS_H); bf16_t* abuf = (bf16_t*)(ws + WS_A); bf16_t* U = (bf16_t*)(ws + WS_U); float* xc = (float*)(ws + WS_XC);
  if (p.ph_lo <= PH_PRE && PH_PRE < p.ph_hi) { if (PROBE_PHASE == PH_PRE) pt0 = __builtin_amdgcn_s_memrealtime(); k.ph_ada(p, smem); k.ph_conv_small(p, smem); k.ph_conv_moe(p, 0, smem);
    if (PH_PRE + 1 < p.ph_hi) k.xcd_barrier(bar);
    if (PROBE_PHASE == PH_PRE) pt1 = __builtin_amdgcn_s_memrealtime();
  }
  if (p.ph_lo <= PH_N1_0 && PH_N1_0 < p.ph_hi) { if (PROBE_PHASE == PH_N1_0) pt0 = __builtin_amdgcn_s_memrealtime(); k.ph_norm_mod(p.in[0], p.in[2], p.in[6], mods0, 0, 1024, hbuf, MROWS);
    if (PH_N1_0 + 1 < p.ph_hi) k.xcd_barrier(bar);
    if (PROBE_PHASE == PH_N1_0) pt1 = __builtin_amdgcn_s_memrealtime();
  }
  if (p.ph_lo <= PH_G1_0 && PH_G1_0 < p.ph_hi) { if (PROBE_PHASE == PH_G1_0) pt0 = __builtin_amdgcn_s_memrealtime(); { EpiABIn e; e.U = U; e.LF = (float*)(ws + WS_LF); e.lb = (const float*)(ws + WS_LB);
        k.gemm_phase8(hbuf, (const bf16_t*)(ws + WS_WT_ABIN), NLAT, MROWS, 3072, 1024, e, smem, 0, 3072); }
    if (PH_G1_0 + 1 < p.ph_hi) k.xcd_barrier(bar);
    if (PROBE_PHASE == PH_G1_0) pt1 = __builtin_amdgcn_s_memrealtime();
  }
  if (p.ph_lo <= PH_HA && PH_HA < p.ph_hi) { if (PROBE_PHASE == PH_HA) pt0 = __builtin_amdgcn_s_memrealtime(); k.ph_hgrn_a(p, smem); k.ph_pool_prep(U + 5 * (size_t)MROWS * 512, hbuf);
    if (PH_HA + 1 < p.ph_hi) k.xcd_barrier(bar);
    if (PROBE_PHASE == PH_HA) pt1 = __builtin_amdgcn_s_memrealtime();
  }
  if (p.ph_lo <= PH_HB && PH_HB < p.ph_hi) { if (PROBE_PHASE == PH_HB) pt0 = __builtin_amdgcn_s_memrealtime(); k.ph_hgrn_b(p);
    if (PH_HB + 1 < p.ph_hi) k.xcd_barrier(bar);
    if (PROBE_PHASE == PH_HB) pt1 = __builtin_amdgcn_s_memrealtime();
  }
  if (p.ph_lo <= PH_HC && PH_HC < p.ph_hi) { if (PROBE_PHASE == PH_HC) pt0 = __builtin_amdgcn_s_memrealtime(); k.ph_hgrn_c(p, smem);
    for (int gi = 0; gi < 4; ++gi) { EpiPool e; e.A = abuf; e.scale = p.in[13]; e.gi = gi; e.pad = 0;
      k.template gemm_phase<4>(hbuf + gi * 128, 512, (const bf16_t*)(ws + WS_WT_POOL) + (size_t)gi * 128 * 128, 128, MROWS, 128, 128, e, smem); }
    if (PH_HC + 1 < p.ph_hi) k.xcd_barrier(bar);
    if (PROBE_PHASE == PH_HC) pt1 = __builtin_amdgcn_s_memrealtime();
  }
  if (p.ph_lo <= PH_G2_0 && PH_G2_0 < p.ph_hi) { if (PROBE_PHASE == PH_G2_0) pt0 = __builtin_amdgcn_s_memrealtime(); { EpiOutRes e; e.base_lat = p.in[0]; e.base_ctx = p.in[2]; e.out_lat = p.out; e.out_ctx = xc; e.modl = mods0; e.g_off = 2048; e.pad = 0;
        k.gemm_phase8(abuf, (const bf16_t*)(ws + WS_WT_ABOUT), NLAT, MROWS, 1024, 1024, e, smem, 0, 1024); }
    if (PH_G2_0 + 1 < p.ph_hi) k.xcd_barrier(bar);
    if (PROBE_PHASE == PH_G2_0) pt1 = __builtin_amdgcn_s_memrealtime();
  }
  if (p.ph_lo <= PH_ROUTE_0 && PH_ROUTE_0 < p.ph_hi) { if (PROBE_PHASE == PH_ROUTE_0) pt0 = __builtin_amdgcn_s_memrealtime(); k.ph_router(p, 0, MROWS, smem);
    if (PH_ROUTE_0 + 1 < p.ph_hi) k.xcd_barrier(bar);
    if (PROBE_PHASE == PH_ROUTE_0) pt1 = __builtin_amdgcn_s_memrealtime();
  }
  if (p.ph_lo <= PH_MOE1_0 && PH_MOE1_0 < p.ph_hi) { if (PROBE_PHASE == PH_MOE1_0) pt0 = __builtin_amdgcn_s_memrealtime(); k.ph_moe1g(p, 0, smem);
    if (PH_MOE1_0 + 1 < p.ph_hi) k.xcd_barrier(bar);
    if (PROBE_PHASE == PH_MOE1_0) pt1 = __builtin_amdgcn_s_memrealtime();
  }
  if (p.ph_lo <= PH_MOE2_0 && PH_MOE2_0 < p.ph_hi) { if (PROBE_PHASE == PH_MOE2_0) pt0 = __builtin_amdgcn_s_memrealtime(); k.ph_moe2g(p, 0, smem);
    if (PH_MOE2_0 + 1 < p.ph_hi) k.xcd_barrier(bar);
    if (PROBE_PHASE == PH_MOE2_0) pt1 = __builtin_amdgcn_s_memrealtime();
  }
  if (p.ph_lo <= PH_COMB_0 && PH_COMB_0 < p.ph_hi) { if (PROBE_PHASE == PH_COMB_0) pt0 = __builtin_amdgcn_s_memrealtime(); k.ph_combine(p, 0, MROWS, 0); k.ph_conv_moe(p, 1, smem);
    if (PH_COMB_0 + 1 < p.ph_hi) k.xcd_barrier(bar);
    if (PROBE_PHASE == PH_COMB_0) pt1 = __builtin_amdgcn_s_memrealtime();
  }
  if (p.ph_lo <= PH_G1_1 && PH_G1_1 < p.ph_hi) { if (PROBE_PHASE == PH_G1_1) pt0 = __builtin_amdgcn_s_memrealtime(); { EpiCDIn e; e.nq = (bf16_t*)(ws + WS_NQ); e.nk = (bf16_t*)(ws + WS_NK); e.nv = (bf16_t*)(ws + WS_NV); e.cq = (bf16_t*)(ws + WS_CQ); e.ckv = (bf16_t*)(ws + WS_CKV); e.kr = (float*)(ws + WS_KR);
        k.gemm_phase8(hbuf, (const bf16_t*)(ws + WS_WT_CDIN), NLAT, MROWS, 2048, 1024, e, smem, 512, 2048); }
    if (PH_G1_1 + 1 < p.ph_hi) k.xcd_barrier(bar);
    if (PROBE_PHASE == PH_G1_1) pt1 = __builtin_amdgcn_s_memrealtime();
  }
  if (p.ph_lo <= PH_MLAUP && PH_MLAUP < p.ph_hi) { if (PROBE_PHASE == PH_MLAUP) pt0 = __builtin_amdgcn_s_memrealtime(); {
        { MK::EpiMlaQ2 e; e.dq = (bf16_t*)(ws + WS_DQ); e.cq = (const bf16_t*)(ws + WS_CQ); const int ntn = 6;
          for (int tile = blockIdx.x; tile < (NLAT / 256) * ntn; tile += gridDim.x) { const int mt = tile / ntn, nt = tile - mt * ntn;
            k.template gemm_tile<4>(e.cq, 256, nullptr, 0, NLAT, (const bf16_t*)(ws + WS_WT_UQ), 256, 256, mt * 256, nt * 128, smem, e); } }
        { MK::EpiMlaKV2 e; e.dk = (bf16_t*)(ws + WS_DK); e.dv = (bf16_t*)(ws + WS_DV); e.ckv = (const bf16_t*)(ws + WS_CKV); const int ntn = 8;
          for (int tile = blockIdx.x; tile < (MROWS / 256) * ntn; tile += gridDim.x) { const int mt = tile / ntn, nt = tile - mt * ntn;
            k.template gemm_tile<4>(e.ckv, 128, nullptr, 0, MROWS, (const bf16_t*)(ws + WS_WT_UKV), 128, 128, mt * 256, nt * 128, smem, e); } }
        k.ph_kr_rope((const float*)(ws + WS_KR), (bf16_t*)(ws + WS_DK));
      }
    if (PH_MLAUP + 1 < p.ph_hi) k.xcd_barrier(bar);
    if (PROBE_PHASE == PH_MLAUP) pt1 = __builtin_amdgcn_s_memrealtime();
  }
  if (p.ph_lo <= PH_MLA && PH_MLA < p.ph_hi) { if (PROBE_PHASE == PH_MLA) pt0 = __builtin_amdgcn_s_memrealtime(); k.ph_mla(p, smem); k.ph_na(p, smem);
    if (PH_MLA + 1 < p.ph_hi) k.xcd_barrier(bar);
    if (PROBE_PHASE == PH_MLA) pt1 = __builtin_amdgcn_s_memrealtime();
  }
  if (p.ph_lo <= PH_G2_1 && PH_G2_1 < p.ph_hi) { if (PROBE_PHASE == PH_G2_1) pt0 = __builtin_amdgcn_s_memrealtime(); { EpiOutRes e; e.base_lat = p.out; e.base_ctx = xc; e.out_lat = p.out; e.out_ctx = xc; e.modl = mods1; e.g_off = 2048; e.pad = 0;
        k.gemm_phase8(abuf, (const bf16_t*)(ws + WS_WT_CDOUT), NLAT, NLAT, 1024, 1024, e, smem, 0, 1024); }
    if (PH_G2_1 + 1 < p.ph_hi) k.xcd_barrier(bar);
    if (PROBE_PHASE == PH_G2_1) pt1 = __builtin_amdgcn_s_memrealtime();
  }
  if (p.ph_lo <= PH_ROUTE_1 && PH_ROUTE_1 < p.ph_hi) { if (PROBE_PHASE == PH_ROUTE_1) pt0 = __builtin_amdgcn_s_memrealtime(); k.ph_router(p, 1, NLAT, smem);
    if (PH_ROUTE_1 + 1 < p.ph_hi) k.xcd_barrier(bar);
    if (PROBE_PHASE == PH_ROUTE_1) pt1 = __builtin_amdgcn_s_memrealtime();
  }
  if (p.ph_lo <= PH_MOE1_1 && PH_MOE1_1 < p.ph_hi) { if (PROBE_PHASE == PH_MOE1_1) pt0 = __builtin_amdgcn_s_memrealtime(); k.ph_moe1g(p, 1, smem);
    if (PH_MOE1_1 + 1 < p.ph_hi) k.xcd_barrier(bar);
    if (PROBE_PHASE == PH_MOE1_1) pt1 = __builtin_amdgcn_s_memrealtime();
  }
  if (p.ph_lo <= PH_MOE2_1 && PH_MOE2_1 < p.ph_hi) { if (PROBE_PHASE == PH_MOE2_1) pt0 = __builtin_amdgcn_s_memrealtime(); k.ph_moe2g(p, 1, smem);
    if (PH_MOE2_1 + 1 < p.ph_hi) k.xcd_barrier(bar);
    if (PROBE_PHASE == PH_MOE2_1) pt1 = __builtin_amdgcn_s_memrealtime();
  }
  if (p.ph_lo <= PH_FINAL && PH_FINAL < p.ph_hi) { if (PROBE_PHASE == PH_FINAL) pt0 = __builtin_amdgcn_s_memrealtime(); k.ph_combine(p, 1, NLAT, 1);
    if (PH_FINAL + 1 < p.ph_hi) k.xcd_barrier(bar);
    if (PROBE_PHASE == PH_FINAL) pt1 = __builtin_amdgcn_s_memrealtime();
  }
  if (PROBE_PHASE >= 0 && blockIdx.x == 0) { const unsigned long long te = __builtin_amdgcn_s_memrealtime(), span = (pt1 - pt0) * 8ull; while (__builtin_amdgcn_s_memrealtime() - te < span) __builtin_amdgcn_s_sleep(32); }
}

static void run_phases(hipStream_t st, MP p, int lo, int hi) {
  for (int ph = lo; ph < hi; ++ph) { p.ph_lo = ph; p.ph_hi = ph + 1; hipLaunchKernelGGL(mega, dim3(256), dim3(512), LDS_BYTES, st, p); }
}

extern "C" void kernel_launch(void* const* d_in, const int* in_sizes, int n_in, void* d_out, int out_size, void* d_ws, size_t ws_size, hipStream_t stream) {
  static int ok = 0;
  if (!ok) {
    if (n_in != 29 || in_sizes[0] != NLAT * D || out_size != NLAT * D || ws_size < WS_END) {
      fprintf(stderr, "kernel_launch: unexpected shapes (n_in %d, in0 %d, out %d, ws %zu, need %zu)\n", n_in, n_in > 0 ? in_sizes[0] : -1, out_size, ws_size, (size_t)WS_END);
      return; }
    if (hipFuncSetAttribute((const void*)mega, hipFuncAttributeMaxDynamicSharedMemorySize, LDS_BYTES) != hipSuccess) { fprintf(stderr, "kernel_launch: hipFuncSetAttribute failed\n"); return; }
    ok = 1;
  }
  char* ws = (char*)d_ws; float* out = (float*)d_out;
  MP p; memset(&p, 0, sizeof(p));
  for (int i = 0; i < 29; ++i) p.in[i] = (const float*)d_in[i];
  p.out = out; p.ws = ws;
  hipMemsetAsync(ws + WS_CTL, 0, WS_MODS + 2 * 3 * 6144 * 4, stream);
  float* odir_ctx = (float*)(ws + WS_ODIR_CTX);
  bf16_t* abuf = (bf16_t*)(ws + WS_A); bf16_t* U = (bf16_t*)(ws + WS_U); float* LF = (float*)(ws + WS_LF);
  bf16_t* nq = (bf16_t*)(ws + WS_NQ); bf16_t* nk = (bf16_t*)(ws + WS_NK); bf16_t* nv = (bf16_t*)(ws + WS_NV);
  bf16_t* dq = (bf16_t*)(ws + WS_DQ); bf16_t* dk = (bf16_t*)(ws + WS_DK); bf16_t* dv = (bf16_t*)(ws + WS_DV);

  p.ph_lo = 0; p.ph_hi = PH_COUNT;
  void* args[] = {&p};
  const hipError_t le = hipLaunchCooperativeKernel((const void*)mega, dim3(256), dim3(512), args, LDS_BYTES, stream);
  if (le != hipSuccess) fprintf(stderr, "kernel_launch: cooperative launch failed: %s\n", hipGetErrorString(le));
}
```

```cpp
#include <hip/hip_runtime.h>
#include <stdint.h>
#include <cstdio>
#include <cstring>

typedef unsigned short bf16_t;
typedef float f32x4 __attribute__((ext_vector_type(4)));

constexpr int D = 1024, NB = 2, SEQ = 8192, CT = 256;
constexpr int NLAT = NB * SEQ;
constexpr int NCTX = NB * CT;
constexpr int MROWS = NLAT + NCTX;
constexpr int NKEY = CT + SEQ;
constexpr float EPS = 1e-6f;
constexpr float LOG2E = 1.4426950408889634f;
constexpr float NA_QSCALE = 0.125f * LOG2E;
constexpr float MLA_QSCALE = 0.10206207261596577f * LOG2E;

constexpr size_t alignup(size_t x) { return (x + 255) & ~(size_t)255; }
constexpr size_t WS_CTL      = 0;
constexpr size_t WS_MODS     = 65536;
constexpr size_t WS_LB       = WS_MODS + alignup(2 * 3 * 6144 * 4);
constexpr size_t WS_XC       = WS_LB + 4096;
constexpr size_t WS_ROUTE_E  = WS_XC + (size_t)NCTX * D * 4;
constexpr size_t WS_ROUTE_W  = WS_ROUTE_E + alignup((size_t)MROWS * 2 * 4);
constexpr size_t WS_RSTD_Q   = WS_ROUTE_W + alignup((size_t)MROWS * 2 * 4);
constexpr size_t WS_RSTD_KV  = WS_RSTD_Q + alignup((size_t)NLAT * 4);
constexpr size_t WS_ODIR_CTX = WS_RSTD_KV + alignup((size_t)MROWS * 4);
constexpr size_t WS_LIST     = WS_ODIR_CTX + (size_t)2 * NCTX * 512 * 4;
constexpr size_t WS_ALAST    = WS_LIST + (size_t)32 * MROWS * 4;
constexpr size_t WS_WT_ABIN  = WS_ALAST + (size_t)2 * (MROWS / 64) * 512 * 4;
constexpr size_t WS_WT_ABOUT = WS_WT_ABIN + (size_t)3072 * 1024 * 2;
constexpr size_t WS_WT_CDIN  = WS_WT_ABOUT + (size_t)1024 * 1024 * 2;
constexpr size_t WS_WT_CDOUT = WS_WT_CDIN + (size_t)2048 * 1024 * 2;
constexpr size_t WS_WT_UQ    = WS_WT_CDOUT + (size_t)1024 * 1024 * 2;
constexpr size_t WS_WT_UKV   = WS_WT_UQ + (size_t)768 * 256 * 2;
constexpr size_t WS_WT_POOL  = WS_WT_UKV + (size_t)1024 * 128 * 2;
constexpr size_t WS_WMOE     = WS_WT_POOL + (size_t)4 * 128 * 128 * 2;
constexpr size_t WS_H        = WS_WMOE + (size_t)32 * 512 * 1024 * 2 + (size_t)32 * 1024 * 256 * 2;
constexpr size_t WS_A        = WS_H + (size_t)MROWS * D * 2;
constexpr size_t WS_U        = WS_A + (size_t)MROWS * D * 2;
constexpr size_t USLOT       = (size_t)MROWS * 512 * 2;
constexpr size_t WS_LF       = WS_U + 6 * USLOT;
constexpr size_t WS_END      = WS_LF + (size_t)2 * MROWS * 512 * 4;
constexpr size_t WS_NQ   = WS_U;
constexpr size_t WS_NK   = WS_NQ + (size_t)NLAT * 512 * 2;
constexpr size_t WS_NV   = WS_NK + USLOT;
constexpr size_t WS_CQ   = WS_NV + USLOT;
constexpr size_t WS_CKV  = WS_CQ + (size_t)NLAT * 256 * 2;
constexpr size_t WS_KR   = WS_CKV + (size_t)MROWS * 128 * 2;
constexpr size_t WS_DQ   = WS_KR + (size_t)MROWS * 32 * 4;
constexpr size_t WS_L1END = WS_DQ + (size_t)NLAT * 768 * 2;
static_assert(WS_L1END <= WS_LF, "layer-1 overlay too big");
constexpr size_t WS_DK   = WS_LF;
constexpr size_t WS_DV   = WS_DK + (size_t)MROWS * 1024 * 2;
static_assert(WS_DV + (size_t)MROWS * 512 * 2 <= WS_END, "dk/dv overlay too big");
constexpr size_t WS_YBUF = WS_LF;
constexpr size_t WS_AMOE = WS_U;

__device__ __forceinline__ float bf2f(bf16_t h) { return __uint_as_float(((unsigned)h) << 16); }
__device__ __forceinline__ unsigned pack2(float a, float b) { unsigned r; asm("v_cvt_pk_bf16_f32 %0, %1, %2" : "=v"(r) : "v"(a), "v"(b)); return r; }
__device__ __forceinline__ bf16_t f2bf(float f) { return (bf16_t)(pack2(f, 0.f) & 0xFFFFu); }
__device__ __forceinline__ float sigmoidf_(float x) { return __builtin_amdgcn_rcpf(1.f + __expf(-x)); }
__device__ __forceinline__ float siluf_(float x) { return x * __builtin_amdgcn_rcpf(1.f + __expf(-x)); }
__device__ __forceinline__ float wave_sum(float v) {
#pragma unroll
  for (int o = 1; o < 64; o <<= 1) v += __shfl_xor(v, o);
  return v;
}
__device__ __forceinline__ int row_vec(int m) { return m < NLAT ? (m >> 13) : 2; }
__device__ __forceinline__ void row_bkey(int m, int& b, int& key) {
  if (m < NLAT) { b = m >> 13; key = CT + (m & 8191); } else { const int mm = m - NLAT; b = mm >> 8; key = mm & 255; }
}

__global__ __launch_bounds__(512) void k_ada(const float* __restrict__ c, const float* __restrict__ cctx, const float* __restrict__ ada_w,
                                             const float* __restrict__ ada_b, float* __restrict__ mods) {
  const int l = blockIdx.y, n0 = blockIdx.x * 64, j = threadIdx.x & 63, kg = threadIdx.x >> 6;
  __shared__ float sv[3][1024];
  __shared__ float red[8][3][64];
  for (int i = threadIdx.x; i < 1024; i += 512) { sv[0][i] = siluf_(c[i]); sv[1][i] = siluf_(c[1024 + i]); sv[2][i] = siluf_(cctx[i]); }
  __syncthreads();
  const float* W = ada_w + (size_t)l * 1024 * 6144 + n0 + j;
  float a0 = 0.f, a1 = 0.f, a2 = 0.f;
  for (int k = kg * 128; k < kg * 128 + 128; ++k) { const float w = W[(size_t)k * 6144]; a0 += sv[0][k] * w; a1 += sv[1][k] * w; a2 += sv[2][k] * w; }
  red[kg][0][j] = a0; red[kg][1][j] = a1; red[kg][2][j] = a2;
  __syncthreads();
  if (threadIdx.x < 192) {
    const int v = threadIdx.x >> 6, jj = threadIdx.x & 63; float s = 0.f;
    for (int g = 0; g < 8; ++g) s += red[g][v][jj];
    mods[(size_t)(l * 3 + v) * 6144 + n0 + jj] = s + ada_b[l * 6144 + n0 + jj];
  }
}
__global__ void k_lb(const float* __restrict__ logits, float* __restrict__ lb) {
  const int i = blockIdx.x * blockDim.x + threadIdx.x;
  if (i < 1024) { const int d = i >> 9, cc = i & 511; const float l0 = logits[(d * 2 + 0) * 512 + cc], l1 = logits[(d * 2 + 1) * 512 + cc]; lb[i] = 1.f / (1.f + expf(l1 - l0)); }
}

struct ConvArgs { const float* src; bf16_t* dst; const float* kscale; int K, N, Npad, mode; size_t sbs, dbs; };
__device__ __forceinline__ int moe_gu_row(int sel, int hidden) {
  return (hidden >> 4) * 32 + sel * 16 + (hidden & 15);
}
__global__ __launch_bounds__(512) void k_convT(ConvArgs a) {
  __shared__ float tile[64][65];
  const float* src = a.src + blockIdx.z * a.sbs; bf16_t* dst = a.dst + blockIdx.z * a.dbs;
  const int n0 = blockIdx.x * 64, k0 = blockIdx.y * 64, tx = threadIdx.x & 63, ty = threadIdx.x >> 6;
#pragma unroll
  for (int i = 0; i < 8; ++i) {
    const int k = k0 + ty + 8 * i, n = n0 + tx; float v = 0.f;
    if (n < a.N) { v = src[(size_t)k * a.N + n]; if (a.kscale) v *= a.kscale[k]; }
    tile[ty + 8 * i][tx] = v;
  }
  __syncthreads();
#pragma unroll
  for (int i = 0; i < 8; ++i) {
    const int nl = ty + 8 * i, n = n0 + nl;
    if (n < a.Npad) { int row = n; if (a.mode == 1) row = moe_gu_row(0, n); else if (a.mode == 2) row = moe_gu_row(1, n);
      dst[(size_t)row * a.K + k0 + tx] = f2bf(tile[tx][nl]); }
  }
}

__global__ __launch_bounds__(512) void k_norm_mod(const float* __restrict__ lat, const float* __restrict__ ctxr, const float* __restrict__ gain,
                                                  const float* __restrict__ modl, int sh_off, int sc_off, bf16_t* __restrict__ out, int nrows) {
  const int lane = threadIdx.x & 63, gw = blockIdx.x * 8 + (threadIdx.x >> 6);
  for (int row = gw; row < nrows; row += gridDim.x * 8) {
    const float* src = row < NLAT ? lat + (size_t)row * D : ctxr + (size_t)(row - NLAT) * D;
    const float* mv = modl + row_vec(row) * 6144;
    f32x4 x[4]; float ss = 0.f;
#pragma unroll
    for (int j = 0; j < 4; ++j) { x[j] = ((const f32x4*)src)[lane + 64 * j]; ss += x[j].x * x[j].x + x[j].y * x[j].y + x[j].z * x[j].z + x[j].w * x[j].w; }
    const float rstd = 1.f / sqrtf(wave_sum(ss) * (1.f / D) + EPS);
#pragma unroll
    for (int j = 0; j < 4; ++j) {
      const int n = (lane + 64 * j) * 4;
      const f32x4 g = *(const f32x4*)(gain + n), sc = *(const f32x4*)(mv + sc_off + n), sh = *(const f32x4*)(mv + sh_off + n);
      const f32x4 h = x[j] * rstd * g * (sc + 1.f) + sh;
      uint2 o; o.x = pack2(h.x, h.y); o.y = pack2(h.z, h.w);
      *(uint2*)(out + (size_t)row * D + n) = o;
    }
  }
}

struct EpiABIn {
  bf16_t* U; float* LF; const float* lb;
  __device__ __forceinline__ void apply(int m, int n, f32x4 v) const {
    const int seg = n >> 9, cn = n & 511; float o[4] = {v.x, v.y, v.z, v.w};
    bf16_t* dst;
    if (seg == 0) { dst = U; for (int i = 0; i < 4; ++i) o[i] = siluf_(o[i]); }
    else if (seg == 1 || seg == 2) { const int d = seg - 1; dst = U + (size_t)(1 + d) * MROWS * 512;
      f32x4 lg;
#pragma unroll
      for (int i = 0; i < 4; ++i) { const float l = lb[d * 512 + cn + i]; const float k = (1.f - l) * sigmoidf_(-o[i]); o[i] = k; lg[i] = __logf(1.f - k); }
      *(f32x4*)(LF + ((size_t)d * MROWS + m) * 512 + cn) = lg; }
    else if (seg == 3) dst = U + (size_t)3 * MROWS * 512;
    else if (seg == 4) { dst = U + (size_t)4 * MROWS * 512; for (int i = 0; i < 4; ++i) o[i] = siluf_(o[i]); }
    else dst = U + (size_t)5 * MROWS * 512;
    uint2 w; w.x = pack2(o[0], o[1]); w.y = pack2(o[2], o[3]);
    *(uint2*)(dst + (size_t)m * 512 + cn) = w;
  }
};
struct EpiPool {
  bf16_t* A; const float* scale; int gi; int pad;
  __device__ __forceinline__ void apply(int m, int n, f32x4 v) const {
    const int cn = gi * 128 + n; const f32x4 s = *(const f32x4*)(scale + cn); v = v * s;
    uint2 w; w.x = pack2(v.x, v.y); w.y = pack2(v.z, v.w);
    *(uint2*)(A + (size_t)m * D + 512 + cn) = w;
  }
};
struct EpiOutRes {
  const float* base_lat; const float* base_ctx; float* out_lat; float* out_ctx; const float* modl; int g_off; int pad;
  __device__ __forceinline__ void apply(int m, int n, f32x4 v) const {
    const f32x4 g = *(const f32x4*)(modl + row_vec(m) * 6144 + g_off + n);
    if (m < NLAT) { const f32x4 b = *(const f32x4*)(base_lat + (size_t)m * D + n); *(f32x4*)(out_lat + (size_t)m * D + n) = b + g * v; }
    else { const size_t o = (size_t)(m - NLAT) * D + n; const f32x4 b = *(const f32x4*)(base_ctx + o); *(f32x4*)(out_ctx + o) = b + g * v; }
  }
};
struct EpiCDIn {
  bf16_t *nq, *nk, *nv, *cq, *ckv; float* kr;
  __device__ __forceinline__ void apply(int m, int n, f32x4 v) const {
    int b, key; row_bkey(m, b, key);
    if (n < 1536) {
      const int which = n >> 9, hh = (n & 511) >> 6, dd = n & 63;
      if (which == 0) { if (m >= NLAT) return; v = v * NA_QSCALE;
        uint2 w; w.x = pack2(v.x, v.y); w.y = pack2(v.z, v.w);
        *(uint2*)(nq + (((size_t)(b * 8 + hh) * SEQ + (m & 8191)) * 64 + dd)) = w; }
      else { bf16_t* dst = which == 1 ? nk : nv; uint2 w; w.x = pack2(v.x, v.y); w.y = pack2(v.z, v.w);
        *(uint2*)(dst + (((size_t)(b * 8 + hh) * NKEY + key) * 64 + dd)) = w; }
    } else if (n < 1792) { if (m >= NLAT) return; uint2 w; w.x = pack2(v.x, v.y); w.y = pack2(v.z, v.w); *(uint2*)(cq + (size_t)m * 256 + (n - 1536)) = w; }
    else if (n < 1920) { uint2 w; w.x = pack2(v.x, v.y); w.y = pack2(v.z, v.w); *(uint2*)(ckv + (size_t)m * 128 + (n - 1792)) = w; }
    else if (n < 1952) { *(f32x4*)(kr + (size_t)m * 32 + (n - 1920)) = v; }
  }
};
struct EpiMlaQ {
  bf16_t* dq; const float* rstd;
  __device__ __forceinline__ void apply(int m, int n, f32x4 v) const {
    const int hh = n / 96, off = n - hh * 96; v = v * (rstd[m] * MLA_QSCALE);
    uint2 w; w.x = pack2(v.x, v.y); w.y = pack2(v.z, v.w);
    *(uint2*)(dq + (((size_t)((m >> 13) * 8 + hh) * SEQ + (m & 8191)) * 96 + off)) = w;
  }
};
struct EpiMlaKV {
  bf16_t *dk, *dv; const float* rstd;
  __device__ __forceinline__ void apply(int m, int n, f32x4 v) const {
    int b, key; row_bkey(m, b, key);
    const int hh = n >> 7, off = n & 127; v = v * rstd[m];
    uint2 w; w.x = pack2(v.x, v.y); w.y = pack2(v.z, v.w);
    if (off < 64) *(uint2*)(dk + (((size_t)(b * 8 + hh) * NKEY + key) * 128 + off)) = w;
    else *(uint2*)(dv + (((size_t)(b * 8 + hh) * NKEY + key) * 64 + (off - 64))) = w;
  }
};

template <class Epi>
__global__ __launch_bounds__(256) void k_gemm_naive(const bf16_t* __restrict__ A, int lda, const bf16_t* __restrict__ Bt, int ldb, int M, int N, int K, Epi epi) {
  __shared__ float As[32][68];
  __shared__ float Bs[32][68];
  const int m0 = blockIdx.y * 64, n0 = blockIdx.x * 64, t = threadIdx.x, tx = t & 15, ty = t >> 4;
  float acc[4][4];
#pragma unroll
  for (int i = 0; i < 4; ++i)
#pragma unroll
    for (int j = 0; j < 4; ++j) acc[i][j] = 0.f;
  const int lr = t >> 2, lk = (t & 3) * 8;
  for (int k0 = 0; k0 < K; k0 += 32) {
    uint4 ra = make_uint4(0, 0, 0, 0), rb = make_uint4(0, 0, 0, 0);
    if (m0 + lr < M) ra = *(const uint4*)(A + (size_t)(m0 + lr) * lda + k0 + lk);
    if (n0 + lr < N) rb = *(const uint4*)(Bt + (size_t)(n0 + lr) * ldb + k0 + lk);
    const unsigned wa[4] = {ra.x, ra.y, ra.z, ra.w}, wb[4] = {rb.x, rb.y, rb.z, rb.w};
#pragma unroll
    for (int i = 0; i < 4; ++i) {
      As[lk + 2 * i][lr] = __uint_as_float(wa[i] << 16); As[lk + 2 * i + 1][lr] = __uint_as_float(wa[i] & 0xFFFF0000u);
      Bs[lk + 2 * i][lr] = __uint_as_float(wb[i] << 16); Bs[lk + 2 * i + 1][lr] = __uint_as_float(wb[i] & 0xFFFF0000u);
    }
    __syncthreads();
#pragma unroll 8
    for (int kk = 0; kk < 32; ++kk) {
      const f32x4 a = *(const f32x4*)&As[kk][ty * 4], b = *(const f32x4*)&Bs[kk][tx * 4];
      const float av[4] = {a.x, a.y, a.z, a.w}, bv[4] = {b.x, b.y, b.z, b.w};
#pragma unroll
      for (int i = 0; i < 4; ++i)
#pragma unroll
        for (int j = 0; j < 4; ++j) acc[i][j] += av[i] * bv[j];
    }
    __syncthreads();
  }
#pragma unroll
  for (int i = 0; i < 4; ++i) {
    const int m = m0 + ty * 4 + i, n = n0 + tx * 4;
    if (m < M && n < N) { f32x4 v = {acc[i][0], acc[i][1], acc[i][2], acc[i][3]}; epi.apply(m, n, v); }
  }
}
template <class Epi>
static void launch_gemm_naive(hipStream_t st, const bf16_t* A, int lda, const bf16_t* Bt, int ldb, int M, int N, int K, Epi epi) {
  hipLaunchKernelGGL((k_gemm_naive<Epi>), dim3((N + 63) / 64, (M + 63) / 64), dim3(256), 0, st, A, lda, Bt, ldb, M, N, K, epi);
}

__device__ __forceinline__ int hgrn_step_row(int b, int dir, int s) {
  if (s < CT) return NLAT + b * CT + (dir ? (CT - 1 - s) : s);
  const int ls = s - CT; return b * SEQ + (dir ? (SEQ - 1 - ls) : ls);
}
__global__ __launch_bounds__(128) void k_hgrn_naive(const bf16_t* __restrict__ U, const float* __restrict__ LF, float* __restrict__ odir_lat, float* __restrict__ odir_ctx) {
  const int bid = blockIdx.x, dir = bid & 1, h = (bid >> 1) & 3, b = bid >> 3, e = threadIdx.x;
  __shared__ float sf[32][128];
  __shared__ float sk[32][128];
  __shared__ float sq[32][128];
  float Sreg[128];
#pragma unroll
  for (int d = 0; d < 128; ++d) Sreg[d] = 0.f;
  const bf16_t* Uq = U; const bf16_t* Uk = U + (size_t)(1 + dir) * MROWS * 512; const bf16_t* Uv = U + (size_t)3 * MROWS * 512;
  const float* lf = LF + (size_t)dir * MROWS * 512;
  for (int s0 = 0; s0 < NKEY; s0 += 32) {
    __syncthreads();
    for (int i = 0; i < 32; ++i) {
      const size_t off = (size_t)hgrn_step_row(b, dir, s0 + i) * 512 + h * 128 + e;
      sf[i][e] = expf(lf[off]); sk[i][e] = bf2f(Uk[off]); sq[i][e] = bf2f(Uq[off]);
    }
    __syncthreads();
    for (int i = 0; i < 32; ++i) {
      const int row = hgrn_step_row(b, dir, s0 + i);
      const float v = bf2f(Uv[(size_t)row * 512 + h * 128 + e]); float o = 0.f;
#pragma unroll
      for (int d = 0; d < 128; ++d) { Sreg[d] = sf[i][d] * Sreg[d] + sk[i][d] * v; o += Sreg[d] * sq[i][d]; }
      if (row < NLAT) odir_lat[((size_t)dir * NLAT + row) * 512 + h * 128 + e] = o;
      else odir_ctx[((size_t)dir * NCTX + (row - NLAT)) * 512 + h * 128 + e] = o;
    }
  }
}
__global__ __launch_bounds__(512) void k_hgrn_out(const float* __restrict__ odir_lat, const float* __restrict__ odir_ctx, const bf16_t* __restrict__ Ug,
                                                  const float* __restrict__ onorm_g, bf16_t* __restrict__ A) {
  const int lane = threadIdx.x & 63, gw = blockIdx.x * 8 + (threadIdx.x >> 6);
  for (int row = gw; row < MROWS; row += gridDim.x * 8) {
    const float* pf = row < NLAT ? odir_lat + (size_t)row * 512 : odir_ctx + (size_t)(row - NLAT) * 512;
    const float* pb = row < NLAT ? odir_lat + ((size_t)NLAT + row) * 512 : odir_ctx + ((size_t)NCTX + (row - NLAT)) * 512;
    const int c0 = lane * 8; float o[8]; float ss = 0.f;
#pragma unroll
    for (int i = 0; i < 8; ++i) { o[i] = pf[c0 + i] + pb[c0 + i]; ss += o[i] * o[i]; }
    ss += __shfl_xor(ss, 1); ss += __shfl_xor(ss, 2); ss += __shfl_xor(ss, 4); ss += __shfl_xor(ss, 8);
    const float rstd = 1.f / sqrtf(ss * (1.f / 128.f) + EPS);
    const uint4 gr = *(const uint4*)(Ug + (size_t)row * 512 + c0); const unsigned gw4[4] = {gr.x, gr.y, gr.z, gr.w};
    unsigned w[4];
#pragma unroll
    for (int i = 0; i < 4; ++i) {
      const float g0 = __uint_as_float(gw4[i] << 16), g1 = __uint_as_float(gw4[i] & 0xFFFF0000u);
      const int e0 = (c0 + 2 * i) & 127;
      w[i] = pack2(o[2 * i] * rstd * onorm_g[e0] * g0, o[2 * i + 1] * rstd * onorm_g[e0 + 1] * g1);
    }
    *(uint4*)(A + (size_t)row * D + c0) = make_uint4(w[0], w[1], w[2], w[3]);
  }
}
__global__ __launch_bounds__(512) void k_pool_prep(const bf16_t* __restrict__ Up, bf16_t* __restrict__ pd) {
  const int c = threadIdx.x;
  for (int row = blockIdx.x; row < MROWS; row += gridDim.x) {
    int base, t, n; if (row < NLAT) { base = row & ~8191; t = row & 8191; n = SEQ; } else { const int mm = row - NLAT; base = NLAT + (mm & ~255); t = mm & 255; n = CT; }
    const int gi = c >> 7, win = 2 << gi; int lo = t - win / 2, hi = t + win - win / 2; lo = lo < 0 ? 0 : lo; hi = hi > n ? n : hi;
    float s = 0.f; for (int r = lo; r < hi; ++r) s += bf2f(Up[(size_t)(base + r) * 512 + c]);
    pd[(size_t)row * 512 + c] = f2bf(s / (float)(hi - lo) - bf2f(Up[(size_t)row * 512 + c]));
  }
}

__global__ __launch_bounds__(512) void k_router(const float* __restrict__ lat, const float* __restrict__ ctxr, const float* __restrict__ gain, const float* __restrict__ modl,
                                                const float* __restrict__ wrg, const float* __restrict__ brg, const float* __restrict__ wre, const float* __restrict__ bre,
                                                bf16_t* __restrict__ out, int* __restrict__ re, float* __restrict__ rw, int nrows) {
  __shared__ float hs[8][1024];
  const int lane = threadIdx.x & 63, wv = threadIdx.x >> 6, gw = blockIdx.x * 8 + wv;
  const float* wp = lane < 4 ? wrg + lane : wre + ((lane - 4) & 31); const int wst = lane < 4 ? 4 : 32;
  const float bias = lane < 4 ? brg[lane] : bre[(lane - 4) & 31];
  for (int row = gw; row < nrows; row += gridDim.x * 8) {
    const float* src = row < NLAT ? lat + (size_t)row * D : ctxr + (size_t)(row - NLAT) * D;
    const float* mv = modl + row_vec(row) * 6144;
    f32x4 x[4]; float ss = 0.f;
#pragma unroll
    for (int j = 0; j < 4; ++j) { x[j] = ((const f32x4*)src)[lane + 64 * j]; ss += x[j].x * x[j].x + x[j].y * x[j].y + x[j].z * x[j].z + x[j].w * x[j].w; }
    const float rstd = 1.f / sqrtf(wave_sum(ss) * (1.f / D) + EPS);
#pragma unroll
    for (int j = 0; j < 4; ++j) {
      const int n = (lane + 64 * j) * 4;
      const f32x4 g = *(const f32x4*)(gain + n), sc = *(const f32x4*)(mv + 4096 + n), sh = *(const f32x4*)(mv + 3072 + n);
      const f32x4 h = x[j] * rstd * g * (sc + 1.f) + sh;
      uint2 o; o.x = pack2(h.x, h.y); o.y = pack2(h.z, h.w);
      *(uint2*)(out + (size_t)row * D + n) = o;
      *(f32x4*)&hs[wv][n] = h;
    }
    __builtin_amdgcn_wave_barrier();
    float acc = 0.f;
#pragma unroll 8
    for (int k = 0; k < 1024; ++k) acc += hs[wv][k] * wp[(size_t)k * wst];
    acc += bias;
    __builtin_amdgcn_wave_barrier();
    float gl[4];
#pragma unroll
    for (int i = 0; i < 4; ++i) gl[i] = __shfl(acc, i);
    int gi = 0; float gm = gl[0];
#pragma unroll
    for (int i = 1; i < 4; ++i) if (gl[i] > gm) { gm = gl[i]; gi = i; }
    float gs = 0.f;
#pragma unroll
    for (int i = 0; i < 4; ++i) gs += expf(gl[i] - gm);
    const float gp = 1.f / gs;
    float el[8];
#pragma unroll
    for (int i = 0; i < 8; ++i) el[i] = __shfl(acc, 4 + gi * 8 + i);
    int e1 = 0; float m1 = el[0];
#pragma unroll
    for (int i = 1; i < 8; ++i) if (el[i] > m1) { m1 = el[i]; e1 = i; }
    int e2 = 0; float m2 = -3.0e38f;
#pragma unroll
    for (int i = 0; i < 8; ++i) if (i != e1 && el[i] > m2) { m2 = el[i]; e2 = i; }
    const float w1 = 1.f / (1.f + expf(m2 - m1)), w2 = 1.f - w1;
    if (lane == 0) { re[row * 2] = gi * 8 + e1; re[row * 2 + 1] = gi * 8 + e2; rw[row * 2] = gp * w1; rw[row * 2 + 1] = gp * w2; }
  }
}

__global__ __launch_bounds__(256) void k_moe_naive(const bf16_t* __restrict__ H, const int* __restrict__ re, const float* __restrict__ rw,
                                                   const float* __restrict__ Wg, const float* __restrict__ Wu, const float* __restrict__ Wd, bf16_t* __restrict__ Y) {
  const int row = blockIdx.x, f = threadIdx.x;
  __shared__ float hs[1024];
  __shared__ float as_[256];
  for (int i = f; i < 1024; i += 256) hs[i] = bf2f(H[(size_t)row * D + i]);
  __syncthreads();
  for (int slot = 0; slot < 2; ++slot) {
    const int e = re[row * 2 + slot]; const float w = rw[row * 2 + slot];
    const float* wg = Wg + (size_t)e * 1024 * 256 + f; const float* wu = Wu + (size_t)e * 1024 * 256 + f;
    float g = 0.f, u = 0.f;
#pragma unroll 8
    for (int k = 0; k < 1024; ++k) { g += hs[k] * wg[(size_t)k * 256]; u += hs[k] * wu[(size_t)k * 256]; }
    as_[f] = siluf_(g) * u * w;
    __syncthreads();
    const float* wd = Wd + (size_t)e * 256 * 1024;
    float y[4] = {0.f, 0.f, 0.f, 0.f};
#pragma unroll 4
    for (int k = 0; k < 256; ++k) { const float a = as_[k];
#pragma unroll
      for (int i = 0; i < 4; ++i) y[i] += a * wd[(size_t)k * 1024 + f + 256 * i]; }
#pragma unroll
    for (int i = 0; i < 4; ++i) Y[((size_t)row * 2 + slot) * D + f + 256 * i] = f2bf(y[i]);
    __syncthreads();
  }
}

__global__ __launch_bounds__(512) void k_combine_norm(float* __restrict__ lat, float* __restrict__ ctxr, const bf16_t* __restrict__ Y, const float* __restrict__ modl_cur,
                                                      const float* __restrict__ gain, const float* __restrict__ modl_next, bf16_t* __restrict__ hout, int nrows, int final_) {
  const int lane = threadIdx.x & 63, gw = blockIdx.x * 8 + (threadIdx.x >> 6);
  for (int row = gw; row < nrows; row += gridDim.x * 8) {
    float* src = row < NLAT ? lat + (size_t)row * D : ctxr + (size_t)(row - NLAT) * D;
    const int v = row_vec(row);
    f32x4 x[4]; float ss = 0.f;
#pragma unroll
    for (int j = 0; j < 4; ++j) {
      const int n = (lane + 64 * j) * 4;
      const f32x4 g2 = *(const f32x4*)(modl_cur + v * 6144 + 5120 + n);
      const uint2 y0 = *(const uint2*)(Y + ((size_t)row * 2) * D + n), y1 = *(const uint2*)(Y + ((size_t)row * 2 + 1) * D + n);
      f32x4 ys;
      ys.x = __uint_as_float(y0.x << 16) + __uint_as_float(y1.x << 16); ys.y = __uint_as_float(y0.x & 0xFFFF0000u) + __uint_as_float(y1.x & 0xFFFF0000u);
      ys.z = __uint_as_float(y0.y << 16) + __uint_as_float(y1.y << 16); ys.w = __uint_as_float(y0.y & 0xFFFF0000u) + __uint_as_float(y1.y & 0xFFFF0000u);
      x[j] = ((const f32x4*)src)[lane + 64 * j] + g2 * ys;
      ss += x[j].x * x[j].x + x[j].y * x[j].y + x[j].z * x[j].z + x[j].w * x[j].w;
    }
    const float rstd = 1.f / sqrtf(wave_sum(ss) * (1.f / D) + EPS);
#pragma unroll
    for (int j = 0; j < 4; ++j) {
      const int n = (lane + 64 * j) * 4;
      const f32x4 g = *(const f32x4*)(gain + n);
      if (final_) { ((f32x4*)src)[lane + 64 * j] = x[j] * rstd * g; }
      else {
        ((f32x4*)src)[lane + 64 * j] = x[j];
        const f32x4 sc = *(const f32x4*)(modl_next + v * 6144 + 1024 + n), sh = *(const f32x4*)(modl_next + v * 6144 + n);
        const f32x4 h = x[j] * rstd * g * (sc + 1.f) + sh;
        uint2 o; o.x = pack2(h.x, h.y); o.y = pack2(h.z, h.w);
        *(uint2*)(hout + (size_t)row * D + n) = o;
      }
    }
  }
}

__global__ __launch_bounds__(512) void k_rowssq(const bf16_t* __restrict__ cq, const bf16_t* __restrict__ ckv, float* __restrict__ rq, float* __restrict__ rkv) {
  const int lane = threadIdx.x & 63, gw = blockIdx.x * 8 + (threadIdx.x >> 6);
  for (int row = gw; row < MROWS; row += gridDim.x * 8) {
    { const unsigned w = *(const unsigned*)(ckv + (size_t)row * 128 + lane * 2); const float a = __uint_as_float(w << 16), b = __uint_as_float(w & 0xFFFF0000u);
      const float ss = wave_sum(a * a + b * b); if (lane == 0) rkv[row] = 1.f / sqrtf(ss * (1.f / 128.f) + EPS); }
    if (row < NLAT) { const uint2 w = *(const uint2*)(cq + (size_t)row * 256 + lane * 4);
      const float a = __uint_as_float(w.x << 16), b = __uint_as_float(w.x & 0xFFFF0000u), c = __uint_as_float(w.y << 16), d = __uint_as_float(w.y & 0xFFFF0000u);
      const float ss = wave_sum(a * a + b * b + c * c + d * d); if (lane == 0) rq[row] = 1.f / sqrtf(ss * (1.f / 256.f) + EPS); }
  }
}
__device__ __forceinline__ float rope_inv(int i) { return exp2f(-(float)i * (13.287712379549449f / 8.f)); }
__global__ __launch_bounds__(256) void k_kr_rope(const float* __restrict__ kr, bf16_t* __restrict__ dk) {
  const int idx = blockIdx.x * 256 + threadIdx.x; if (idx >= MROWS * 32) return;
  const int m = idx >> 5, j = idx & 31; int b, key; row_bkey(m, b, key);
  float val = kr[idx];
  if (m < NLAT) {
    const int t = m & 8191; const int half = j >> 4, jj = j & 15, i = jj & 7;
    const float pos = half ? (float)(t & 63) : (float)(t >> 6);
    const float ang = pos * rope_inv(i); float sn, cs; sincosf(ang, &sn, &cs);
    const float x1 = kr[(size_t)m * 32 + half * 16 + i], x2 = kr[(size_t)m * 32 + half * 16 + 8 + i];
    val = (jj < 8) ? (x1 * cs - x2 * sn) : (x1 * sn + x2 * cs);
  }
  const bf16_t o = f2bf(val);
#pragma unroll
  for (int hh = 0; hh < 8; ++hh) dk[((size_t)(b * 8 + hh) * NKEY + key) * 128 + 64 + j] = o;
}

__global__ __launch_bounds__(64) void k_na_naive(const bf16_t* __restrict__ nq, const bf16_t* __restrict__ nk, const bf16_t* __restrict__ nv, const float* __restrict__ rpb,
                                                 bf16_t* __restrict__ A) {
  const int t = blockIdx.x * 64 + threadIdx.x, hh = blockIdx.y, b = blockIdx.z;
  const int r = t >> 6, c = t & 63;
  int rs = r - 4; rs = rs < 0 ? 0 : (rs > 120 ? 120 : rs);
  int cs = c - 8; cs = cs < 0 ? 0 : (cs > 48 ? 48 : cs);
  float q[64], o[64];
  const bf16_t* qp = nq + ((size_t)(b * 8 + hh) * SEQ + t) * 64;
#pragma unroll
  for (int d = 0; d < 64; ++d) { q[d] = bf2f(qp[d]); o[d] = 0.f; }
  const bf16_t* Kb = nk + (size_t)(b * 8 + hh) * NKEY * 64; const bf16_t* Vb = nv + (size_t)(b * 8 + hh) * NKEY * 64;
  float mx = -3.0e38f, l = 0.f;
  for (int kk = 0; kk < 128 + CT; ++kk) {
    int key; float bias = 0.f;
    if (kk < 128) { const int kr_ = rs + (kk >> 4), kc = cs + (kk & 15); key = CT + kr_ * 64 + kc; bias = rpb[(hh * 15 + (kr_ - r + 7)) * 31 + (kc - c + 15)] * LOG2E; }
    else key = kk - 128;
    const bf16_t* kp = Kb + (size_t)key * 64; float s = bias;
#pragma unroll
    for (int d = 0; d < 64; d += 2) { const unsigned w = *(const unsigned*)(kp + d); s += q[d] * __uint_as_float(w << 16) + q[d + 1] * __uint_as_float(w & 0xFFFF0000u); }
    const float mn = fmaxf(mx, s), alpha = exp2f(mx - mn), p = exp2f(s - mn);
    l = l * alpha + p; mx = mn;
    const bf16_t* vp = Vb + (size_t)key * 64;
#pragma unroll
    for (int d = 0; d < 64; d += 2) { const unsigned w = *(const unsigned*)(vp + d); o[d] = o[d] * alpha + p * __uint_as_float(w << 16); o[d + 1] = o[d + 1] * alpha + p * __uint_as_float(w & 0xFFFF0000u); }
  }
  const float il = 1.f / l;
  bf16_t* op = A + (size_t)(b * SEQ + t) * D + hh * 64;
#pragma unroll
  for (int d = 0; d < 64; d += 2) *(unsigned*)(op + d) = pack2(o[d] * il, o[d + 1] * il);
}
__global__ __launch_bounds__(64) void k_mla_naive(const bf16_t* __restrict__ dq, const bf16_t* __restrict__ dk, const bf16_t* __restrict__ dv, bf16_t* __restrict__ A) {
  const int t = blockIdx.x * 64 + threadIdx.x, hh = blockIdx.y, b = blockIdx.z;
  float q[96], o[64];
  const bf16_t* qp = dq + ((size_t)(b * 8 + hh) * SEQ + t) * 96;
#pragma unroll
  for (int d = 0; d < 96; ++d) q[d] = bf2f(qp[d]);
#pragma unroll
  for (int half = 0; half < 2; ++half) {
    const float pos = half ? (float)(t & 63) : (float)(t >> 6);
#pragma unroll
    for (int i = 0; i < 8; ++i) { float sn, cs; sincosf(pos * rope_inv(i), &sn, &cs);
      const float x1 = q[64 + half * 16 + i], x2 = q[64 + half * 16 + 8 + i];
      q[64 + half * 16 + i] = x1 * cs - x2 * sn; q[64 + half * 16 + 8 + i] = x1 * sn + x2 * cs; }
  }
#pragma unroll
  for (int d = 0; d < 64; ++d) o[d] = 0.f;
  const bf16_t* Kb = dk + (size_t)(b * 8 + hh) * NKEY * 128; const bf16_t* Vb = dv + (size_t)(b * 8 + hh) * NKEY * 64;
  float mx = -3.0e38f, l = 0.f;
  for (int k0 = 0; k0 < NKEY; k0 += 8) {
    float s[8]; float bm = -3.0e38f;
#pragma unroll
    for (int j = 0; j < 8; ++j) { const bf16_t* kp = Kb + (size_t)(k0 + j) * 128; float a = 0.f;
#pragma unroll
      for (int d = 0; d < 96; d += 2) { const unsigned w = *(const unsigned*)(kp + d); a += q[d] * __uint_as_float(w << 16) + q[d + 1] * __uint_as_float(w & 0xFFFF0000u); }
      s[j] = a; bm = fmaxf(bm, a); }
    const float mn = fmaxf(mx, bm), alpha = exp2f(mx - mn); mx = mn; l *= alpha;
#pragma unroll
    for (int d = 0; d < 64; ++d) o[d] *= alpha;
#pragma unroll
    for (int j = 0; j < 8; ++j) { const float p = exp2f(s[j] - mn); l += p; const bf16_t* vp = Vb + (size_t)(k0 + j) * 64;
#pragma unroll
      for (int d = 0; d < 64; d += 2) { const unsigned w = *(const unsigned*)(vp + d); o[d] += p * __uint_as_float(w << 16); o[d + 1] += p * __uint_as_float(w & 0xFFFF0000u); } }
  }
  const float il = 1.f / l;
  bf16_t* op = A + (size_t)(b * SEQ + t) * D + 512 + hh * 64;
#pragma unroll
  for (int d = 0; d < 64; d += 2) *(unsigned*)(op + d) = pack2(o[d] * il, o[d + 1] * il);
}

typedef short bf16x8 __attribute__((ext_vector_type(8)));
struct MP {
  const float* in[29];
  float* out; char* ws;
  int ph_lo, ph_hi;
};
constexpr int LDS_BYTES = 131072 + 1024;
constexpr int CNT_OFF = 16384;
typedef short s16x4 __attribute__((ext_vector_type(4)));
typedef float f32x16 __attribute__((ext_vector_type(16)));
typedef unsigned u32x4 __attribute__((ext_vector_type(4)));
constexpr float ATT_THR = 11.5f;
constexpr int NCHUNK = MROWS / 64;

struct MK {
  int wv;
  __device__ __forceinline__ int tidx() const { int l = (int)__lane_id(); asm volatile("" : "+v"(l)); return (wv << 6) | l; }
#define MFMA16(a, b, c) __builtin_amdgcn_mfma_f32_16x16x32_bf16(a, b, c, 0, 0, 0)


template <int MI, class Epi>
__device__ __forceinline__ void gemm_tile(const bf16_t* __restrict__ A, int lda, const int* __restrict__ gather, int gshift, int Mvalid,
                                          const bf16_t* __restrict__ Bt, int ldb, int K, int m0, int n0, char* lds, const Epi& epi) {
  constexpr int BM = 64 * MI, ABYTES = BM * 128, STAGE = ABYTES + 128 * 128;
  const int t = tidx(), lane = t & 63, w = t >> 6, wm = w >> 1, wn = w & 1, l15 = lane & 15, lq = lane >> 4;
  const int c = t & 7, r = t >> 3;
  const bf16_t* ap[MI];
#pragma unroll
  for (int i = 0; i < MI; ++i) { int m = m0 + r + 64 * i; m = m < Mvalid ? m : Mvalid - 1; const int row = gather ? (gather[m] >> gshift) : m; ap[i] = A + (size_t)row * lda + c * 8; }
  const bf16_t* bp0 = Bt + (size_t)(n0 + r) * ldb + c * 8; const bf16_t* bp1 = bp0 + (size_t)64 * ldb;
  const int wofs = r * 128 + ((c ^ ((r >> 1) & 7)) << 4);
  const int sw = (l15 >> 1) & 7, x0 = (lq ^ sw) << 4, x1 = x0 ^ 64;
  const int arow = (wm * 16 * MI + l15) * 128, brow = ABYTES + (wn * 64 + l15) * 128;
  f32x4 acc[MI][4];
#pragma unroll
  for (int i = 0; i < MI; ++i)
#pragma unroll
    for (int j = 0; j < 4; ++j) acc[i][j] = (f32x4){0.f, 0.f, 0.f, 0.f};
  uint4 ra[MI], rb0, rb1;
  const int KT = K >> 6;
#pragma unroll
  for (int i = 0; i < MI; ++i) ra[i] = *(const uint4*)(ap[i]);
  rb0 = *(const uint4*)bp0; rb1 = *(const uint4*)bp1;
#pragma unroll
  for (int i = 0; i < MI; ++i) *(uint4*)(lds + wofs + i * 8192) = ra[i];
  *(uint4*)(lds + ABYTES + wofs) = rb0; *(uint4*)(lds + ABYTES + wofs + 8192) = rb1;
  __syncthreads();
  for (int kt = 0; kt < KT; ++kt) {
    char* cur = lds + (kt & 1) * STAGE; char* nxt = lds + ((kt + 1) & 1) * STAGE;
    const bool more = kt + 1 < KT;
    if (more) {
      const int k0 = (kt + 1) << 6;
#pragma unroll
      for (int i = 0; i < MI; ++i) ra[i] = *(const uint4*)(ap[i] + k0);
      rb0 = *(const uint4*)(bp0 + k0); rb1 = *(const uint4*)(bp1 + k0);
    }
#pragma unroll
    for (int ks = 0; ks < 2; ++ks) {
      const int xo = ks ? x1 : x0;
      bf16x8 af[MI], bfv[4];
#pragma unroll
      for (int i = 0; i < MI; ++i) af[i] = *(const bf16x8*)(cur + arow + i * 2048 + xo);
#pragma unroll
      for (int j = 0; j < 4; ++j) bfv[j] = *(const bf16x8*)(cur + brow + j * 2048 + xo);
#pragma unroll
      for (int i = 0; i < MI; ++i)
#pragma unroll
        for (int j = 0; j < 4; ++j) acc[i][j] = MFMA16(bfv[j], af[i], acc[i][j]);
    }
    if (more) {
#pragma unroll
      for (int i = 0; i < MI; ++i) *(uint4*)(nxt + wofs + i * 8192) = ra[i];
      *(uint4*)(nxt + ABYTES + wofs) = rb0; *(uint4*)(nxt + ABYTES + wofs + 8192) = rb1;
    }
    __syncthreads();
  }
  epi.tile(acc, m0 + wm * 16 * MI + l15, n0 + wn * 64 + lq * 4, Mvalid);
}
template <class E> struct EpiEach {
  E e;
  template <int MI> __device__ __forceinline__ void tile(const f32x4 (&acc)[MI][4], int mb, int nb, int Mvalid) const {
#pragma unroll
    for (int i = 0; i < MI; ++i) { const int m = mb + i * 16; if (m < Mvalid) {
#pragma unroll
      for (int j = 0; j < 4; ++j) e.apply(m, nb + j * 16, acc[i][j]); } }
  }
};
template <int MI, class E>
__device__ __forceinline__ void gemm_phase(const bf16_t* A, int lda, const bf16_t* Bt, int ldb, int M, int N, int K, const E& e, char* lds) {
  constexpr int BM = 64 * MI; const int ntm = (M + BM - 1) / BM, ntn = N >> 7;
  EpiEach<E> ee; ee.e = e;
  for (int tile = blockIdx.x; tile < ntm * ntn; tile += gridDim.x) { const int mt = tile / ntn, nt = tile - mt * ntn; gemm_tile<MI>(A, lda, nullptr, 0, M, Bt, ldb, K, mt * BM, nt * 128, lds, ee); }
}

#define PG8_LAS __attribute__((address_space(3)))
static constexpr int BM = 256, BK = 64, HALF = 128, HTB = HALF * BK * 2, STAGE_BYTES = 8 * HTB, NXCD = 8, WGM = 8;
static __device__ __forceinline__ int lds_byte(int r, int c) { const int st = (r >> 4) * 2 + (c >> 5), rr = r & 15, cc = c & 31, ob = rr * 64 + cc * 2; return st * 1024 + (ob ^ (((ob >> 9) & 1) << 5)); }
static __device__ __forceinline__ void stage_rc(int b, int& R, int& C) { const int st = b / 1024, sb = b % 1024, swz = sb ^ (((sb >> 9) & 1) << 5); R = (st >> 1) * 16 + swz / 64; C = (st & 1) * 32 + (swz % 64) / 2; }
static __device__ __forceinline__ int perm32(int rho) { const int n = rho >> 4, i = rho & 15; return 8 * (i >> 2) + 4 * n + (i & 3); }

struct Unit { int pm, pn; };
struct Gemm { const bf16_t* A; const bf16_t* Bt; int M, N, K; };
struct StaticOrder {
    int nM, nN, nwg, G, c;
    __device__ void init(int M, int N, int G_, int c_) { nM = M / BM; nN = N / BM; nwg = nM * nN; G = G_; c = c_; }
    __device__ bool next(int i, Unit& u) const {
        const long L = (long)i * G + c; if (L >= nwg) return false;
        int wgid = (int)L; { const int q = nwg / NXCD, r = nwg % NXCD, xcd = wgid % NXCD, off = wgid / NXCD; wgid = (xcd < r ? xcd * (q + 1) : r * (q + 1) + (xcd - r) * q) + off; }
        const int nig = WGM * nN, gid = wgid / nig, fm = gid * WGM, gsz = (nM - fm) < WGM ? (nM - fm) : WGM;
        u.pm = fm + ((wgid % nig) % gsz); u.pn = (wgid % nig) / gsz; return true;
    }
    __device__ __forceinline__ void a_ready(const Unit&) const {}
    __device__ __forceinline__ void done(const Unit&) const {}
};
template <class Epi, class Sched>
__device__ __forceinline__ void pg8_phase(PG8_LAS unsigned char* lds, const Gemm g, const Sched& S, const Epi& E) {
    const int tid = tidx(), wid = __builtin_amdgcn_readfirstlane(tid >> 6), lane = tid & 63, wr = wid >> 2, wc = wid & 3, fr = lane & 15, fq = lane >> 4;
    const int K = g.K, nt = K / BK;
    unsigned voffA[2], voffB[2];
#pragma unroll
    for (int i = 0; i < 2; ++i) { int R, C; stage_rc(tid * 16 + i * 8192, R, C); const int Rb = Epi::PERM ? ((R & ~31) + perm32(R & 31)) : R;
        voffA[i] = (unsigned)(R * K + C) * 2u; voffB[i] = (unsigned)(Rb * K + C) * 2u; }
    const size_t kstep = (size_t)(BK * 2);
    const size_t hstep = (size_t)HALF * K * 2;
    const size_t tstep = 2 * hstep;
    const unsigned ldsw = (unsigned)wid * 1024u;
    const int aoff = lds_byte(wr * 64 + fr, fq * 8), boff = lds_byte(wc * 32 + fr, fq * 8);
#define PG8_SA(b, h) (((b) * 2 + (h)) * HTB)
#define PG8_SB(b, h) ((4 + (b) * 2 + (h)) * HTB)
#define PG8_STAGE(bufoff, gbase, voff) do { _Pragma("unroll") for (int _i = 0; _i < 2; ++_i) \
        __builtin_amdgcn_global_load_lds((const unsigned*)((const char*)(gbase) + (voff)[_i]), (PG8_LAS unsigned*)(lds + (bufoff) + ldsw + _i * 8192), 16, 0, 0); } while (0)
#define PG8_LDA(dst, b, h) do { _Pragma("unroll") for (int m = 0; m < 4; ++m) _Pragma("unroll") for (int k = 0; k < 2; ++k) dst[m][k] = *(const PG8_LAS bf16x8*)(lds + PG8_SA(b, h) + aoff + m * 2048 + k * 1024); } while (0)
#define PG8_LDB(dst, b, h) do { _Pragma("unroll") for (int n = 0; n < 2; ++n) _Pragma("unroll") for (int k = 0; k < 2; ++k) dst[n][k] = *(const PG8_LAS bf16x8*)(lds + PG8_SB(b, h) + boff + n * 2048 + k * 1024); } while (0)
#define PG8_MMA(ai, bj, At, Bt) do { __builtin_amdgcn_s_setprio(1); _Pragma("unroll") for (int m = 0; m < 4; ++m) _Pragma("unroll") for (int n = 0; n < 2; ++n) _Pragma("unroll") for (int k = 0; k < 2; ++k) \
        acc[ai][bj][m][n] = __builtin_amdgcn_mfma_f32_16x16x32_bf16(Bt[n][k], At[m][k], acc[ai][bj][m][n], 0, 0, 0); __builtin_amdgcn_s_setprio(0); } while (0)
#define PG8_WAIT_V(n) asm volatile("s_waitcnt vmcnt(" #n ")" ::: "memory")
#define PG8_WAIT_L(n) asm volatile("s_waitcnt lgkmcnt(" #n ")" ::: "memory")
#define PG8_BAR __builtin_amdgcn_s_barrier()
#define PG8_SCHED __builtin_amdgcn_sched_barrier(0)
    Unit cur, nxt; int ui = 0;
    if (!S.next(0, cur)) return;
    f32x4 acc[2][2][4][2];
#pragma unroll
    for (int a = 0; a < 2; ++a)
#pragma unroll
        for (int b = 0; b < 2; ++b)
#pragma unroll
            for (int m = 0; m < 4; ++m)
#pragma unroll
                for (int n = 0; n < 2; ++n) acc[a][b][m][n] = (f32x4){0.f, 0.f, 0.f, 0.f};
    bf16x8 At[4][2], B0[2][2], B1[2][2];
    const char* cA = (const char*)g.A + (size_t)cur.pm * tstep; const char* cB = (const char*)g.Bt + (size_t)cur.pn * tstep;
    S.a_ready(cur);
    PG8_STAGE(PG8_SB(0, 0), cB, voffB); PG8_STAGE(PG8_SA(0, 0), cA, voffA); PG8_STAGE(PG8_SB(0, 1), cB + hstep, voffB); PG8_STAGE(PG8_SA(0, 1), cA + hstep, voffA);
    if (wr == 1) PG8_BAR;
    PG8_WAIT_V(4); PG8_BAR;
    PG8_STAGE(PG8_SB(1, 0), cB + kstep, voffB); PG8_STAGE(PG8_SA(1, 0), cA + kstep, voffA); PG8_STAGE(PG8_SB(1, 1), cB + hstep + kstep, voffB);
    PG8_WAIT_V(6); PG8_BAR;
    for (;;) {
        const bool has_next = S.next(ui + 1, nxt);
        const char* nA = has_next ? (const char*)g.A + (size_t)nxt.pm * tstep : cA; const char* nB = has_next ? (const char*)g.Bt + (size_t)nxt.pn * tstep : cB;
        for (int t = 0; t < nt; t += 2) {
            const bool last = (t == nt - 2);
            const char* a1 = cA + (size_t)(t + 1) * kstep;
            const char* a2 = last ? nA : cA + (size_t)(t + 2) * kstep; const char* b2 = last ? nB : cB + (size_t)(t + 2) * kstep;
            const char* a3 = a2 + kstep; const char* b3 = b2 + kstep;
            if (last && has_next) S.a_ready(nxt);
            PG8_LDB(B0, 0, 0); PG8_SCHED; PG8_LDA(At, 0, 0); PG8_STAGE(PG8_SA(1, 1), a1 + hstep, voffA);
            PG8_WAIT_L(8); PG8_BAR; PG8_WAIT_L(0); PG8_MMA(0, 0, At, B0); PG8_BAR; PG8_SCHED;
            PG8_LDB(B1, 0, 1); PG8_STAGE(PG8_SB(0, 0), b2, voffB);
            PG8_BAR; PG8_WAIT_L(0); PG8_MMA(0, 1, At, B1); PG8_BAR;
            PG8_LDA(At, 0, 1); PG8_STAGE(PG8_SA(0, 0), a2, voffA);
            PG8_BAR; PG8_WAIT_L(0); PG8_MMA(1, 0, At, B0); PG8_BAR; PG8_SCHED;
            PG8_STAGE(PG8_SB(0, 1), b2 + hstep, voffB);
            PG8_WAIT_V(6); PG8_BAR; PG8_MMA(1, 1, At, B1); PG8_BAR;
            PG8_LDB(B0, 1, 0); PG8_SCHED; PG8_LDA(At, 1, 0); PG8_STAGE(PG8_SA(0, 1), a2 + hstep, voffA);
            PG8_WAIT_L(8); PG8_BAR; PG8_WAIT_L(0); PG8_MMA(0, 0, At, B0); PG8_BAR; PG8_SCHED;
            PG8_LDB(B1, 1, 1); PG8_STAGE(PG8_SB(1, 0), b3, voffB);
            PG8_BAR; PG8_WAIT_L(0); PG8_MMA(0, 1, At, B1); PG8_BAR;
            PG8_LDA(At, 1, 1); PG8_STAGE(PG8_SA(1, 0), a3, voffA);
            PG8_BAR; PG8_WAIT_L(0); PG8_MMA(1, 0, At, B0); PG8_BAR; PG8_SCHED;
            PG8_STAGE(PG8_SB(1, 1), b3 + hstep, voffB);
            PG8_WAIT_V(6); PG8_BAR; PG8_MMA(1, 1, At, B1); PG8_BAR;
        }
        if constexpr (!Epi::AFTER_DRAIN) { E(acc, cur, wr, wc, fr, fq); S.done(cur); }
        if (!has_next) break;
#pragma unroll
        for (int a = 0; a < 2; ++a)
#pragma unroll
            for (int b = 0; b < 2; ++b)
#pragma unroll
                for (int m = 0; m < 4; ++m)
#pragma unroll
                    for (int n = 0; n < 2; ++n) acc[a][b][m][n] = (f32x4){0.f, 0.f, 0.f, 0.f};
        cur = nxt; cA = nA; cB = nB; ++ui;
    }
    PG8_WAIT_V(0);
    if (wr == 0) PG8_BAR;
    PG8_BAR;
    if constexpr (Epi::AFTER_DRAIN) { E.fused(acc, cur, wr, wc, fr, fq, lds, wid, lane); S.done(cur); }
#undef PG8_SA
#undef PG8_SB
#undef PG8_STAGE
#undef PG8_LDA
#undef PG8_LDB
#undef PG8_MMA
#undef PG8_WAIT_V
#undef PG8_WAIT_L
#undef PG8_BAR
#undef PG8_SCHED
}

template <class E> struct Pg8Each {
  static constexpr bool PERM = false, AFTER_DRAIN = false; E e;
  __device__ __forceinline__ void operator()(const f32x4 (&acc)[2][2][4][2], const Unit& u, int wr, int wc, int fr, int fq) const {
#pragma unroll
    for (int ai = 0; ai < 2; ++ai)
#pragma unroll
      for (int m = 0; m < 4; ++m) { const int row = u.pm * BM + ai * HALF + wr * 64 + m * 16 + fr;
#pragma unroll
        for (int bj = 0; bj < 2; ++bj)
#pragma unroll
          for (int n = 0; n < 2; ++n) e.apply(row, u.pn * BM + bj * HALF + wc * 32 + n * 16 + fq * 4, acc[ai][bj][m][n]); }
  }
};
template <class E>
__device__ __forceinline__ void gemm_phase8(const bf16_t* A, const bf16_t* Bt, int Mbig, int M, int N, int K, const E& e, char* lds, int ctx_n0, int ctx_n1) {
  { Gemm g; g.A = A; g.Bt = Bt; g.M = Mbig; g.N = N; g.K = K; StaticOrder S; S.init(Mbig, N, (int)gridDim.x, (int)blockIdx.x); Pg8Each<E> pe; pe.e = e;
    pg8_phase((PG8_LAS unsigned char*)lds, g, S, pe); }
  if (M > Mbig) { EpiEach<E> ee; ee.e = e; const int ntm = (M - Mbig) >> 6, ntn = (ctx_n1 - ctx_n0) >> 7;
    for (int tile = (int)gridDim.x - 1 - (int)blockIdx.x; tile < ntm * ntn; tile += gridDim.x) { const int mt = tile / ntn, nt = tile - mt * ntn;
      gemm_tile<1>(A, K, nullptr, 0, M, Bt, K, K, Mbig + mt * 64, ctx_n0 + nt * 128, lds, ee); } }
}

template <int K>
static __device__ __forceinline__ float row_rstd4(const bf16_t* rowp, int lq) {
  constexpr int PER = K / 4; float ss = 0.f;
#pragma unroll
  for (int i = 0; i < PER / 8; ++i) { const uint4 v = *(const uint4*)(rowp + lq * PER + i * 8); const unsigned wv[4] = {v.x, v.y, v.z, v.w};
#pragma unroll
    for (int q = 0; q < 4; ++q) { const float a = __uint_as_float(wv[q] << 16), b = __uint_as_float(wv[q] & 0xFFFF0000u); ss += a * a + b * b; } }
  ss += __shfl_xor(ss, 16); ss += __shfl_xor(ss, 32);
  return 1.f / sqrtf(ss * (1.f / K) + EPS);
}
struct EpiMlaQ2 {
  bf16_t* dq; const bf16_t* cq;
  template <int MI> __device__ __forceinline__ void tile(const f32x4 (&acc)[MI][4], int mb, int nb, int Mvalid) const {
#pragma unroll
    for (int i = 0; i < MI; ++i) { const int m = mb + i * 16; const float rs = row_rstd4<256>(cq + (size_t)m * 256, (nb >> 2) & 3) * MLA_QSCALE;
#pragma unroll
      for (int j = 0; j < 4; ++j) { const int n = nb + j * 16; const int hh = n / 96, off = n - hh * 96; const f32x4 v = acc[i][j] * rs;
        uint2 wv; wv.x = pack2(v.x, v.y); wv.y = pack2(v.z, v.w);
        *(uint2*)(dq + (((size_t)((m >> 13) * 8 + hh) * SEQ + (m & 8191)) * 96 + off)) = wv; } }
  }
};
struct EpiMlaKV2 {
  bf16_t *dk, *dv; const bf16_t* ckv;
  template <int MI> __device__ __forceinline__ void tile(const f32x4 (&acc)[MI][4], int mb, int nb, int Mvalid) const {
#pragma unroll
    for (int i = 0; i < MI; ++i) { const int m = mb + i * 16; const float rs = row_rstd4<128>(ckv + (size_t)m * 128, (nb >> 2) & 3);
      int b, key; row_bkey(m, b, key);
#pragma unroll
      for (int j = 0; j < 4; ++j) { const int n = nb + j * 16; const int hh = n >> 7, off = n & 127; const f32x4 v = acc[i][j] * rs;
        uint2 wv; wv.x = pack2(v.x, v.y); wv.y = pack2(v.z, v.w);
        if (off < 64) *(uint2*)(dk + (((size_t)(b * 8 + hh) * NKEY + key) * 128 + off)) = wv;
        else *(uint2*)(dv + (((size_t)(b * 8 + hh) * NKEY + key) * 64 + (off - 64))) = wv; } }
  }
};
struct EpiMoe1 {
  bf16_t* amoe; const int* list; const float* rw; int off_e, nt;
  template <int MI> __device__ __forceinline__ void tile(const f32x4 (&acc)[MI][4], int mb, int nb, int Mvalid) const {
    const int wn = (nb >> 6) & 1, lq = (nb >> 2) & 3;
#pragma unroll
    for (int i = 0; i < MI; ++i) { const int m = mb + i * 16; if (m < Mvalid) { const float wgt = rw[list[m]];
#pragma unroll
      for (int i2 = 0; i2 < 2; ++i2) { const f32x4 g = acc[i][i2], u = acc[i][2 + i2];
        const float a0 = siluf_(g.x) * u.x * wgt, a1 = siluf_(g.y) * u.y * wgt, a2 = siluf_(g.z) * u.z * wgt, a3 = siluf_(g.w) * u.w * wgt;
        uint2 wv; wv.x = pack2(a0, a1); wv.y = pack2(a2, a3);
        *(uint2*)(amoe + (size_t)(off_e + m) * 256 + nt * 64 + wn * 32 + i2 * 16 + lq * 4) = wv; } } }
  }
};
struct EpiMoe2 {
  bf16_t* Y; const int* list; int m_base;
  __device__ __forceinline__ void apply(int m, int n, f32x4 v) const {
    uint2 wv; wv.x = pack2(v.x, v.y); wv.y = pack2(v.z, v.w);
    *(uint2*)(Y + (size_t)list[m - m_base] * D + n) = wv;
  }
};

__device__ __forceinline__ void ph_ada(const MP& p, char* lds) {
  float* sv = (float*)lds;
  const float* c = p.in[1]; const float* cctx = p.in[3]; float* mods = (float*)(p.ws + WS_MODS);
  const int t = tidx();
  for (int i = t; i < 1024; i += 512) { sv[i] = siluf_(c[i]); sv[1024 + i] = siluf_(c[1024 + i]); sv[2048 + i] = siluf_(cctx[i]); }
  __syncthreads();
  for (int item = blockIdx.x; item < 256; item += gridDim.x) {
    const int l = item >> 7, kg = (item >> 4) & 7, cg = item & 15;
    if (t < 384) {
      const int col = cg * 384 + t;
      const float* W = p.in[4] + ((size_t)l * 1024 + kg * 128) * 6144 + col;
      float a0 = 0.f, a1 = 0.f, a2 = 0.f;
#pragma unroll 16
      for (int k = 0; k < 128; ++k) { const float wv = W[(size_t)k * 6144]; const int kk = kg * 128 + k; a0 += sv[kk] * wv; a1 += sv[1024 + kk] * wv; a2 += sv[2048 + kk] * wv; }
      if (kg == 0) { const float bb = p.in[5][l * 6144 + col]; a0 += bb; a1 += bb; a2 += bb; }
      atomicAdd(&mods[(size_t)(l * 3 + 0) * 6144 + col], a0); atomicAdd(&mods[(size_t)(l * 3 + 1) * 6144 + col], a1); atomicAdd(&mods[(size_t)(l * 3 + 2) * 6144 + col], a2);
    }
  }
  if (blockIdx.x == gridDim.x - 1) { float* lb = (float*)(p.ws + WS_LB);
    for (int i = t; i < 1024; i += 512) { const int d = i >> 9, cc = i & 511; const float l0 = p.in[10][(d * 2) * 512 + cc], l1 = p.in[10][(d * 2 + 1) * 512 + cc]; lb[i] = 1.f / (1.f + expf(l1 - l0)); } }
  __syncthreads();
}
__device__ __forceinline__ void conv_tiles(const float* src, bf16_t* dst, const float* kscale, int K, int N, int Npad, int mode, int batch, size_t sbs, size_t dbs, char* lds) {
  float* tile = (float*)lds;
  const int ntn = (Npad + 63) >> 6, ntk = K >> 7, per = ntn * ntk, t = tidx();
  for (int item = blockIdx.x; item < per * batch; item += gridDim.x) {
    const int bz = item / per, rem = item - bz * per, kb = rem / ntn, nb = rem - kb * ntn, n0 = nb * 64, k0 = kb * 128;
    const float* s = src + bz * sbs; bf16_t* d = dst + bz * dbs;
#pragma unroll
    for (int i = 0; i < 4; ++i) { const int idx = t + 512 * i, k = idx >> 4, n4 = (idx & 15) * 4; f32x4 v = {0.f, 0.f, 0.f, 0.f};
      if (n0 + n4 < N) { v = *(const f32x4*)(s + (size_t)(k0 + k) * N + n0 + n4); if (kscale) v = v * kscale[k0 + k]; }
      float* tp = tile + k * 65 + n4; tp[0] = v.x; tp[1] = v.y; tp[2] = v.z; tp[3] = v.w; }
    __syncthreads();
#pragma unroll
    for (int i = 0; i < 2; ++i) { const int idx = t + 512 * i, nl = idx >> 4, k8 = (idx & 15) * 8, n = n0 + nl;
      if (n < Npad) { int row = n; if (mode == 1) row = moe_gu_row(0, n); else if (mode == 2) row = moe_gu_row(1, n);
        const float* tp = tile + k8 * 65 + nl;
        uint4 o; o.x = pack2(tp[0], tp[65]); o.y = pack2(tp[130], tp[195]); o.z = pack2(tp[260], tp[325]); o.w = pack2(tp[390], tp[455]);
        *(uint4*)(d + (size_t)row * K + k0 + k8) = o; } }
    __syncthreads();
  }
}
__device__ __forceinline__ void ph_conv_small(const MP& p, char* lds) {
  char* ws = p.ws;
  conv_tiles(p.in[8], (bf16_t*)(ws + WS_WT_ABIN), nullptr, 1024, 3072, 3072, 0, 1, 0, 0, lds);
  conv_tiles(p.in[9], (bf16_t*)(ws + WS_WT_ABOUT), nullptr, 1024, 1024, 1024, 0, 1, 0, 0, lds);
  conv_tiles(p.in[14], (bf16_t*)(ws + WS_WT_CDIN), nullptr, 1024, 1952, 2048, 0, 1, 0, 0, lds);
  conv_tiles(p.in[15], (bf16_t*)(ws + WS_WT_CDOUT), nullptr, 1024, 1024, 1024, 0, 1, 0, 0, lds);
  conv_tiles(p.in[18], (bf16_t*)(ws + WS_WT_UQ), p.in[17], 256, 768, 768, 0, 1, 0, 0, lds);
  conv_tiles(p.in[20], (bf16_t*)(ws + WS_WT_UKV), p.in[19], 128, 1024, 1024, 0, 1, 0, 0, lds);
  conv_tiles(p.in[12], (bf16_t*)(ws + WS_WT_POOL), nullptr, 128, 128, 128, 0, 4, (size_t)128 * 128, (size_t)128 * 128, lds);
}
__device__ __forceinline__ void ph_conv_moe(const MP& p, int layer, char* lds) {
  bf16_t* wgu = (bf16_t*)(p.ws + WS_WMOE); bf16_t* wd = wgu + (size_t)32 * 512 * 1024;
  const size_t lo = (size_t)layer * 32 * 1024 * 256;
  conv_tiles(p.in[25] + lo, wgu, nullptr, 1024, 256, 256, 1, 32, (size_t)1024 * 256, (size_t)512 * 1024, lds);
  conv_tiles(p.in[26] + lo, wgu, nullptr, 1024, 256, 256, 2, 32, (size_t)1024 * 256, (size_t)512 * 1024, lds);
  conv_tiles(p.in[27] + lo, wd, nullptr, 256, 1024, 1024, 0, 32, (size_t)256 * 1024, (size_t)1024 * 256, lds);
}
__device__ __forceinline__ void ph_norm_mod(const float* lat, const float* ctxr, const float* gain, const float* modl, int sh_off, int sc_off, bf16_t* out, int nrows) {
  const int lane = tidx() & 63, gw = blockIdx.x * 8 + (tidx() >> 6);
  for (int row = gw; row < nrows; row += gridDim.x * 8) {
    const float* src = row < NLAT ? lat + (size_t)row * D : ctxr + (size_t)(row - NLAT) * D;
    const float* mv = modl + row_vec(row) * 6144;
    f32x4 x[4]; float ss = 0.f;
#pragma unroll
    for (int j = 0; j < 4; ++j) { x[j] = ((const f32x4*)src)[lane + 64 * j]; ss += x[j].x * x[j].x + x[j].y * x[j].y + x[j].z * x[j].z + x[j].w * x[j].w; }
    const float rstd = 1.f / sqrtf(wave_sum(ss) * (1.f / D) + EPS);
#pragma unroll
    for (int j = 0; j < 4; ++j) {
      const int n = (lane + 64 * j) * 4;
      const f32x4 g = *(const f32x4*)(gain + n), sc = *(const f32x4*)(mv + sc_off + n), sh = *(const f32x4*)(mv + sh_off + n);
      const f32x4 h = x[j] * rstd * g * (sc + 1.f) + sh;
      uint2 o; o.x = pack2(h.x, h.y); o.y = pack2(h.z, h.w);
      *(uint2*)(out + (size_t)row * D + n) = o;
    }
  }
}
template <int HALF>
__device__ __forceinline__ void pool_prep_col(const bf16_t* Up, bf16_t* pd, int r0, int seg_lo, int seg_hi, int c) {
  float a[80];
#pragma unroll
  for (int i = 0; i < 80; ++i) { const int r = r0 - 8 + i; const bool in = (r >= seg_lo) && (r < seg_hi); const int rc = in ? r : r0; const float v = bf2f(Up[(size_t)rc * 512 + c]); a[i] = in ? v : 0.f; }
  float sum = 0.f;
#pragma unroll
  for (int i = 8 - HALF; i < 8 + HALF; ++i) sum += a[i];
#pragma unroll
  for (int j = 0; j < 64; ++j) {
    const int t = r0 + j; int lo = t - HALF, hi = t + HALF; lo = lo < seg_lo ? seg_lo : lo; hi = hi > seg_hi ? seg_hi : hi;
    pd[(size_t)t * 512 + c] = f2bf(sum / (float)(hi - lo) - a[8 + j]);
    if (j < 63) sum += a[8 + j + HALF] - a[8 + j - HALF];
  }
}
__device__ __forceinline__ void ph_pool_prep(const bf16_t* Up, bf16_t* pd) {
  const int c = tidx(), gi = c >> 7;
  for (int cid = blockIdx.x; cid < NCHUNK; cid += gridDim.x) {
    const int r0 = cid * 64; int seg_lo, seg_hi;
    if (r0 < NLAT) { seg_lo = r0 & ~8191; seg_hi = seg_lo + SEQ; } else { seg_lo = NLAT + ((r0 - NLAT) & ~255); seg_hi = seg_lo + CT; }
    if (gi == 0) pool_prep_col<1>(Up, pd, r0, seg_lo, seg_hi, c);
    else if (gi == 1) pool_prep_col<2>(Up, pd, r0, seg_lo, seg_hi, c);
    else if (gi == 2) pool_prep_col<4>(Up, pd, r0, seg_lo, seg_hi, c);
    else pool_prep_col<8>(Up, pd, r0, seg_lo, seg_hi, c);
  }
}
__device__ __forceinline__ void ph_router(const MP& p, int layer, int nrows, char* lds) {
  float* hs = (float*)lds;
  float* part = (float*)(lds + 66048);
  float* lgs = (float*)(lds + 66048 + 24576);
  const float* lat = p.out; const float* ctxr = (const float*)(p.ws + WS_XC); const float* gain = p.in[7] + layer * 1024;
  const float* modl = (const float*)(p.ws + WS_MODS) + layer * 3 * 6144;
  const float* wrg = p.in[21] + layer * 1024 * 4; const float* brg = p.in[22] + layer * 4; const float* wre = p.in[23] + layer * 1024 * 32; const float* bre = p.in[24] + layer * 32;
  bf16_t* out = (bf16_t*)(p.ws + WS_H); float* rw = (float*)(p.ws + WS_ROUTE_W);
  int* cnt = (int*)(p.ws + WS_CTL + CNT_OFF) + layer * 32; int* list = (int*)(p.ws + WS_LIST);
  const int tid = tidx(), lane = tid & 63, w = tid >> 6, l15 = lane & 15, lq = lane >> 4;
  float Bq[8][4][3];
#pragma unroll
  for (int g = 0; g < 8; ++g)
#pragma unroll
    for (int u = 0; u < 4; ++u)
#pragma unroll
      for (int nt = 0; nt < 3; ++nt) { const int kk = w * 128 + 16 * g + 4 * lq + u, col = nt * 16 + l15;
        Bq[g][u][nt] = col < 4 ? wrg[kk * 4 + col] : (col < 36 ? wre[kk * 32 + (col - 4)] : 0.f); }
  const int ntiles = nrows >> 4;
  int* lcnt = (int*)(lds + 66048 + 24576 + 2304);
  int* lbase = lcnt + 32;
  int* pend = lbase + 32;
  int nloc = 0;
  if (tid < 32) lcnt[tid] = 0;
  f32x4 xa[2][4];
#define RT_LOAD(tile_) do { _Pragma("unroll") for (int rr = 0; rr < 2; ++rr) { const int row_ = (tile_) * 16 + 2 * w + rr; \
      const float* src_ = row_ < NLAT ? lat + (size_t)row_ * D : ctxr + (size_t)(row_ - NLAT) * D; \
      _Pragma("unroll") for (int j = 0; j < 4; ++j) xa[rr][j] = ((const f32x4*)src_)[lane + 64 * j]; } } while (0)
  if ((int)blockIdx.x < ntiles) RT_LOAD((int)blockIdx.x);
  for (int tile = blockIdx.x; tile < ntiles; tile += gridDim.x) {
#pragma unroll
    for (int rr = 0; rr < 2; ++rr) {
      const int lr = 2 * w + rr, row = tile * 16 + lr;
      const float* mv = modl + row_vec(row) * 6144;
      float ss = 0.f;
#pragma unroll
      for (int j = 0; j < 4; ++j) { const f32x4 x = xa[rr][j]; ss += x.x * x.x + x.y * x.y + x.z * x.z + x.w * x.w; }
      const float rstd = 1.f / sqrtf(wave_sum(ss) * (1.f / D) + EPS);
#pragma unroll
      for (int j = 0; j < 4; ++j) {
        const int n = (lane + 64 * j) * 4;
        const f32x4 g = *(const f32x4*)(gain + n), sc = *(const f32x4*)(mv + 4096 + n), sh = *(const f32x4*)(mv + 3072 + n);
        const f32x4 h = xa[rr][j] * rstd * g * (sc + 1.f) + sh;
        uint2 o; o.x = pack2(h.x, h.y); o.y = pack2(h.z, h.w);
        *(uint2*)(out + (size_t)row * D + n) = o;
        *(f32x4*)&hs[lr * 1032 + n] = h;
      }
    }
    __syncthreads();
    if (tile + (int)gridDim.x < ntiles) RT_LOAD(tile + (int)gridDim.x);
    f32x4 acc[3];
#pragma unroll
    for (int nt = 0; nt < 3; ++nt) acc[nt] = (f32x4){0.f, 0.f, 0.f, 0.f};
#pragma unroll
    for (int g = 0; g < 8; ++g) {
      const f32x4 a4 = *(const f32x4*)&hs[l15 * 1032 + w * 128 + 16 * g + 4 * lq];
      const float av[4] = {a4.x, a4.y, a4.z, a4.w};
#pragma unroll
      for (int u = 0; u < 4; ++u)
#pragma unroll
        for (int nt = 0; nt < 3; ++nt) acc[nt] = __builtin_amdgcn_mfma_f32_16x16x4f32(av[u], Bq[g][u][nt], acc[nt], 0, 0, 0);
    }
#pragma unroll
    for (int nt = 0; nt < 3; ++nt) { const float av[4] = {acc[nt].x, acc[nt].y, acc[nt].z, acc[nt].w};
#pragma unroll
      for (int r = 0; r < 4; ++r) part[(w * 16 + lq * 4 + r) * 48 + nt * 16 + l15] = av[r]; }
    __syncthreads();
    for (int i = tid; i < 16 * 36; i += 512) { const int row = i / 36, col = i - row * 36; float sacc = col < 4 ? brg[col] : bre[col - 4];
#pragma unroll
      for (int ww = 0; ww < 8; ++ww) sacc += part[(ww * 16 + row) * 48 + col];
      lgs[i] = sacc; }
    __syncthreads();
    if (tid < 32) {
      const int lr = tid >> 1, slot = tid & 1, row = tile * 16 + lr; const float* lg = lgs + lr * 36;
      int gi = 0; float gm = lg[0];
#pragma unroll
      for (int i = 1; i < 4; ++i) if (lg[i] > gm) { gm = lg[i]; gi = i; }
      float gs = 0.f;
#pragma unroll
      for (int i = 0; i < 4; ++i) gs += __expf(lg[i] - gm);
      const float gp = 1.f / gs;
      const float* el = lg + 4 + gi * 8;
      int e1 = 0; float m1 = el[0];
#pragma unroll
      for (int i = 1; i < 8; ++i) if (el[i] > m1) { m1 = el[i]; e1 = i; }
      int e2 = 0; float m2 = -3.0e38f;
#pragma unroll
      for (int i = 0; i < 8; ++i) if (i != e1 && el[i] > m2) { m2 = el[i]; e2 = i; }
      const float w1 = 1.f / (1.f + __expf(m2 - m1));
      const int ee = gi * 8 + (slot ? e2 : e1);
      rw[row * 2 + slot] = gp * (slot ? 1.f - w1 : w1);
      const int rk = atomicAdd(&lcnt[ee], 1);
      pend[nloc * 32 + tid] = (ee << 24) | (rk << 16) | (row & 0xFFFF) | 0;
    }
    ++nloc;
  }
  __syncthreads();
  if (tid < 32) lbase[tid] = lcnt[tid] ? atomicAdd(&cnt[tid], lcnt[tid]) : 0;
  __syncthreads();
  for (int i = tid; i < nloc * 32; i += 512) { const int v = pend[i], ee = (v >> 24) & 31, rk = (v >> 16) & 255, row = v & 0xFFFF;
    list[(size_t)ee * MROWS + lbase[ee] + rk] = row * 2 + (i & 1); }
  __syncthreads();
#undef RT_LOAD
}
template <int BM>
__device__ __forceinline__ int moe_tables(const MP& p, int layer, int ntn, int* tb) {
  const int* cnt = (const int*)(p.ws + WS_CTL + CNT_OFF) + layer * 32;
  __syncthreads();
  if (tidx() == 0) { int off = 0, ts = 0;
    for (int e = 0; e < 32; ++e) { const int c = __hip_atomic_load(&cnt[e], __ATOMIC_RELAXED, __HIP_MEMORY_SCOPE_AGENT); tb[e] = c; tb[32 + e] = off; tb[64 + e] = ts; off += c; ts += ((c + BM - 1) / BM) * ntn; }
    tb[96] = ts; }
  __syncthreads();
  return tb[96];
}
template <int MI>
__device__ __forceinline__ void ph_moe1(const MP& p, int layer, char* lds) {
  constexpr int BM = 64 * MI; int* tb = (int*)(lds + LDS_BYTES - 1024);
  const int total = moe_tables<BM>(p, layer, 4, tb);
  const bf16_t* H = (const bf16_t*)(p.ws + WS_H); const bf16_t* wgu = (const bf16_t*)(p.ws + WS_WMOE);
  for (int tile = blockIdx.x; tile < total; tile += gridDim.x) {
    int e = 0;
#pragma unroll 1
    for (int q = 1; q < 32; ++q) if (tb[64 + q] <= tile) e = q;
    const int lt = tile - tb[64 + e], mt = lt >> 2, nt = lt & 3;
    EpiMoe1 ep; ep.amoe = (bf16_t*)(p.ws + WS_AMOE); ep.list = (const int*)(p.ws + WS_LIST) + (size_t)e * MROWS; ep.rw = (const float*)(p.ws + WS_ROUTE_W); ep.off_e = tb[32 + e]; ep.nt = nt;
    gemm_tile<MI>(H, D, ep.list, 1, tb[e], wgu + (size_t)e * 512 * 1024, 1024, 1024, mt * BM, nt * 128, lds, ep);
  }
}
template <int MI>
__device__ __forceinline__ void ph_moe2(const MP& p, int layer, char* lds) {
  constexpr int BM = 64 * MI; int* tb = (int*)(lds + LDS_BYTES - 1024);
  const int total = moe_tables<BM>(p, layer, 8, tb);
  const bf16_t* wd = (const bf16_t*)(p.ws + WS_WMOE) + (size_t)32 * 512 * 1024;
  for (int tile = blockIdx.x; tile < total; tile += gridDim.x) {
    int e = 0;
#pragma unroll 1
    for (int q = 1; q < 32; ++q) if (tb[64 + q] <= tile) e = q;
    const int lt = tile - tb[64 + e], mt = lt >> 3, nt = lt & 7;
    EpiEach<EpiMoe2> ep; ep.e.Y = (bf16_t*)(p.ws + WS_YBUF); ep.e.list = (const int*)(p.ws + WS_LIST) + (size_t)e * MROWS; ep.e.m_base = 0;
    const bf16_t* A = (const bf16_t*)(p.ws + WS_AMOE) + (size_t)tb[32 + e] * 256;
    gemm_tile<MI>(A, 256, nullptr, 0, tb[e], wd + (size_t)e * 1024 * 256, 256, 256, mt * BM, nt * 128, lds, ep);
  }
}

struct GUnit { unsigned a, b; int m0, n0, mvalid, e; };
struct MoeSched {
  const PG8_LAS int* tb; const char* wsb; unsigned Abase, Bbase, b_estride; int ntn, G, c, K, gather;
  __device__ __forceinline__ bool next(int i, GUnit& u) const {
    const int L = i * G + c; if (L >= tb[96]) return false;
    int e = 0;
#pragma unroll 1
    for (int q = 1; q < 32; ++q) if (tb[64 + q] <= L) e = q;
    const int lt = L - tb[64 + e], mt = lt / ntn, nt = lt - mt * ntn;
    u.e = e; u.m0 = mt * 256; u.n0 = nt * 256; u.mvalid = tb[e];
    u.b = Bbase + (unsigned)e * b_estride + (unsigned)(nt * 256 * K * 2);
    u.a = gather ? Abase : Abase + (unsigned)((tb[32 + e] + mt * 256) * K * 2);
    return true;
  }
  __device__ __forceinline__ void done(const GUnit&) const {}
  __device__ __forceinline__ void a_offsets(const GUnit& u, int tid, unsigned (&ao)[2][2]) const {
    const int* list = (const int*)(wsb + WS_LIST) + (size_t)u.e * MROWS;
#pragma unroll
    for (int i = 0; i < 2; ++i) { int R, C; stage_rc(tid * 16 + i * 8192, R, C);
#pragma unroll
      for (int h = 0; h < 2; ++h) {
        if (gather) { int r = u.m0 + h * 128 + R; r = r < u.mvalid ? r : u.mvalid - 1; const int tok = list[r] >> 1; ao[h][i] = (unsigned)(tok * K + C) * 2u; }
        else ao[h][i] = (unsigned)((h * 128 + R) * K + C) * 2u;
      } }
  }
};
template <class Epi, class Sched>
__device__ __forceinline__ void pg8g_phase(PG8_LAS unsigned char* lds, const char* wsb, const int K, const Sched& S, const Epi& E) {
    const int tid = tidx(), wid = __builtin_amdgcn_readfirstlane(tid >> 6), lane = tid & 63, wr = wid >> 2, wc = wid & 3, fr = lane & 15, fq = lane >> 4;
    const int nt = K / BK;
    unsigned voffB[2];
#pragma unroll
    for (int i = 0; i < 2; ++i) { int R, C; stage_rc(tid * 16 + i * 8192, R, C); const int Rb = Epi::PERM ? ((R & ~31) + perm32(R & 31)) : R;
        voffB[i] = (unsigned)(Rb * K + C) * 2u; }
    const unsigned kstep = (unsigned)(BK * 2);
    const unsigned hstep = (unsigned)(HALF * K * 2);
    const unsigned ldsw = (unsigned)wid * 1024u;
    const int aoff = lds_byte(wr * 64 + fr, fq * 8), boff = lds_byte(wc * 32 + fr, fq * 8);
#define PG8_SA(b, h) (((b) * 2 + (h)) * HTB)
#define PG8_SB(b, h) ((4 + (b) * 2 + (h)) * HTB)
#define PG8_STAGE(bufoff, gbase, voff) do { _Pragma("unroll") for (int _i = 0; _i < 2; ++_i) \
        __builtin_amdgcn_global_load_lds((const unsigned*)(wsb + (size_t)(gbase) + (voff)[_i]), (PG8_LAS unsigned*)(lds + (bufoff) + ldsw + _i * 8192), 16, 0, 0); } while (0)
#define PG8_STAGE_A(bufoff, gbase, o0, o1) do { \
        __builtin_amdgcn_global_load_lds((const unsigned*)(wsb + (size_t)(gbase) + (o0)), (PG8_LAS unsigned*)(lds + (bufoff) + ldsw), 16, 0, 0); \
        __builtin_amdgcn_global_load_lds((const unsigned*)(wsb + (size_t)(gbase) + (o1)), (PG8_LAS unsigned*)(lds + (bufoff) + ldsw + 8192), 16, 0, 0); } while (0)
#define PG8_LDA(dst, b, h) do { _Pragma("unroll") for (int m = 0; m < 4; ++m) _Pragma("unroll") for (int k = 0; k < 2; ++k) dst[m][k] = *(const PG8_LAS bf16x8*)(lds + PG8_SA(b, h) + aoff + m * 2048 + k * 1024); } while (0)
#define PG8_LDB(dst, b, h) do { _Pragma("unroll") for (int n = 0; n < 2; ++n) _Pragma("unroll") for (int k = 0; k < 2; ++k) dst[n][k] = *(const PG8_LAS bf16x8*)(lds + PG8_SB(b, h) + boff + n * 2048 + k * 1024); } while (0)
#define PG8_MMA(ai, bj, At, Bt) do { __builtin_amdgcn_s_setprio(1); _Pragma("unroll") for (int m = 0; m < 4; ++m) _Pragma("unroll") for (int n = 0; n < 2; ++n) _Pragma("unroll") for (int k = 0; k < 2; ++k) \
        acc[ai][bj][m][n] = __builtin_amdgcn_mfma_f32_16x16x32_bf16(Bt[n][k], At[m][k], acc[ai][bj][m][n], 0, 0, 0); __builtin_amdgcn_s_setprio(0); } while (0)
#define PG8_WAIT_V(n) asm volatile("s_waitcnt vmcnt(" #n ")" ::: "memory")
#define PG8_WAIT_L(n) asm volatile("s_waitcnt lgkmcnt(" #n ")" ::: "memory")
#define PG8_BAR __builtin_amdgcn_s_barrier()
#define PG8_SCHED __builtin_amdgcn_sched_barrier(0)
    GUnit cur, nxt; int ui = 0;
    if (!S.next(0, cur)) return;
    f32x4 acc[2][2][4][2];
#pragma unroll
    for (int a = 0; a < 2; ++a)
#pragma unroll
        for (int b = 0; b < 2; ++b)
#pragma unroll
            for (int m = 0; m < 4; ++m)
#pragma unroll
                for (int n = 0; n < 2; ++n) acc[a][b][m][n] = (f32x4){0.f, 0.f, 0.f, 0.f};
    bf16x8 At[4][2], B0[2][2], B1[2][2];
    unsigned cA = cur.a, cB = cur.b;
    unsigned aoc[2][2];
    S.a_offsets(cur, tid, aoc);
    PG8_STAGE(PG8_SB(0, 0), cB, voffB); PG8_STAGE_A(PG8_SA(0, 0), cA, aoc[0][0], aoc[0][1]); PG8_STAGE(PG8_SB(0, 1), cB + hstep, voffB); PG8_STAGE_A(PG8_SA(0, 1), cA, aoc[1][0], aoc[1][1]);
    if (wr == 1) PG8_BAR;
    PG8_WAIT_V(4); PG8_BAR;
    PG8_STAGE(PG8_SB(1, 0), cB + kstep, voffB); PG8_STAGE_A(PG8_SA(1, 0), cA + kstep, aoc[0][0], aoc[0][1]); PG8_STAGE(PG8_SB(1, 1), cB + hstep + kstep, voffB);
    PG8_WAIT_V(6); PG8_BAR;
    for (;;) {
        const bool has_next = S.next(ui + 1, nxt);
        const unsigned nA = has_next ? nxt.a : cA, nB = has_next ? nxt.b : cB;
        for (int t = 0; t < nt; t += 2) {
            const bool last = (t == nt - 2);
            const unsigned a1 = cA + (unsigned)(t + 1) * kstep;
            const unsigned a2 = last ? nA : cA + (unsigned)(t + 2) * kstep, b2 = last ? nB : cB + (unsigned)(t + 2) * kstep;
            const unsigned a3 = a2 + kstep, b3 = b2 + kstep;
            if (last && has_next) {
              PG8_STAGE_A(PG8_SA(1, 1), a1, aoc[1][0], aoc[1][1]); S.a_offsets(nxt, tidx(), aoc); PG8_SCHED;
              PG8_LDB(B0, 0, 0); PG8_SCHED; PG8_LDA(At, 0, 0);
            } else { PG8_LDB(B0, 0, 0); PG8_SCHED; PG8_LDA(At, 0, 0); PG8_STAGE_A(PG8_SA(1, 1), a1, aoc[1][0], aoc[1][1]); }
            PG8_WAIT_L(8); PG8_BAR; PG8_WAIT_L(0); PG8_MMA(0, 0, At, B0); PG8_BAR; PG8_SCHED;
            PG8_LDB(B1, 0, 1); PG8_STAGE(PG8_SB(0, 0), b2, voffB);
            PG8_BAR; PG8_WAIT_L(0); PG8_MMA(0, 1, At, B1); PG8_BAR;
            PG8_LDA(At, 0, 1); PG8_STAGE_A(PG8_SA(0, 0), a2, aoc[0][0], aoc[0][1]);
            PG8_BAR; PG8_WAIT_L(0); PG8_MMA(1, 0, At, B0); PG8_BAR; PG8_SCHED;
            PG8_STAGE(PG8_SB(0, 1), b2 + hstep, voffB);
            PG8_WAIT_V(6); PG8_BAR; PG8_MMA(1, 1, At, B1); PG8_BAR;
            PG8_LDB(B0, 1, 0); PG8_SCHED; PG8_LDA(At, 1, 0); PG8_STAGE_A(PG8_SA(0, 1), a2, aoc[1][0], aoc[1][1]);
            PG8_WAIT_L(8); PG8_BAR; PG8_WAIT_L(0); PG8_MMA(0, 0, At, B0); PG8_BAR; PG8_SCHED;
            PG8_LDB(B1, 1, 1); PG8_STAGE(PG8_SB(1, 0), b3, voffB);
            PG8_BAR; PG8_WAIT_L(0); PG8_MMA(0, 1, At, B1); PG8_BAR;
            PG8_LDA(At, 1, 1); PG8_STAGE_A(PG8_SA(1, 0), a3, aoc[0][0], aoc[0][1]);
            PG8_BAR; PG8_WAIT_L(0); PG8_MMA(1, 0, At, B0); PG8_BAR; PG8_SCHED;
            PG8_STAGE(PG8_SB(1, 1), b3 + hstep, voffB);
            PG8_WAIT_V(6); PG8_BAR; PG8_MMA(1, 1, At, B1); PG8_BAR;
        }
        if constexpr (!Epi::AFTER_DRAIN) { const int l2 = tidx() & 63; E(acc, cur, wr, wc, l2 & 15, l2 >> 4); S.done(cur); }
        if (!has_next) break;
#pragma unroll
        for (int a = 0; a < 2; ++a)
#pragma unroll
            for (int b = 0; b < 2; ++b)
#pragma unroll
                for (int m = 0; m < 4; ++m)
#pragma unroll
                    for (int n = 0; n < 2; ++n) acc[a][b][m][n] = (f32x4){0.f, 0.f, 0.f, 0.f};
        cur = nxt; cA = nA; cB = nB; ++ui;
    }
    PG8_WAIT_V(0);
    if (wr == 0) PG8_BAR;
    PG8_BAR;
    if constexpr (Epi::AFTER_DRAIN) { E.fused(acc, cur, wr, wc, fr, fq, lds, wid, lane); S.done(cur); }
#undef PG8_SA
#undef PG8_SB
#undef PG8_STAGE
#undef PG8_STAGE_A
#undef PG8_LDA
#undef PG8_LDB
#undef PG8_MMA
#undef PG8_WAIT_V
#undef PG8_WAIT_L
#undef PG8_BAR
#undef PG8_SCHED

#undef PG8_MMA
#undef PG8_WAIT_V
#undef PG8_WAIT_L
#undef PG8_BAR
#undef PG8_SCHED
}

struct EpiMoe1G {
  static constexpr bool PERM = false, AFTER_DRAIN = false;
  char* wsb; const PG8_LAS int* tb;
  __device__ __forceinline__ void operator()(const f32x4 (&acc)[2][2][4][2], const GUnit& u, int wr, int wc, int fr, int fq) const {
    const int* list = (const int*)(wsb + WS_LIST) + (size_t)u.e * MROWS; const int off_e = tb[32 + u.e]; const float* rw = (const float*)(wsb + WS_ROUTE_W); bf16_t* amoe = (bf16_t*)(wsb + WS_AMOE);
    const int rbase = u.m0 + wr * 64 + fr;
    int ent[2][4]; float wg[2][4];
#pragma unroll
    for (int ai = 0; ai < 2; ++ai)
#pragma unroll
      for (int m = 0; m < 4; ++m) { int r = rbase + ai * HALF + m * 16; r = r < u.mvalid ? r : u.mvalid - 1; ent[ai][m] = list[r]; }
#pragma unroll
    for (int ai = 0; ai < 2; ++ai)
#pragma unroll
      for (int m = 0; m < 4; ++m) wg[ai][m] = rw[ent[ai][m]];
#pragma unroll
    for (int ai = 0; ai < 2; ++ai)
#pragma unroll
      for (int m = 0; m < 4; ++m) { const int r = rbase + ai * HALF + m * 16;
        if (r < u.mvalid) { const float wgt = wg[ai][m];
#pragma unroll
          for (int bj = 0; bj < 2; ++bj) { const f32x4 g = acc[ai][bj][m][0], uu = acc[ai][bj][m][1];
            const int hidden = ((u.n0 + bj * HALF + wc * 32) >> 1) + fq * 4;
            uint2 wv; wv.x = pack2(siluf_(g.x) * uu.x * wgt, siluf_(g.y) * uu.y * wgt); wv.y = pack2(siluf_(g.z) * uu.z * wgt, siluf_(g.w) * uu.w * wgt);
            *(uint2*)(amoe + (size_t)(off_e + r) * 256 + hidden) = wv; } } }
  }
};
struct EpiMoe2G {
  static constexpr bool PERM = false, AFTER_DRAIN = false;
  char* wsb;
  __device__ __forceinline__ void operator()(const f32x4 (&acc)[2][2][4][2], const GUnit& u, int wr, int wc, int fr, int fq) const {
    const int* list = (const int*)(wsb + WS_LIST) + (size_t)u.e * MROWS; bf16_t* Y = (bf16_t*)(wsb + WS_YBUF);
    const int rbase = u.m0 + wr * 64 + fr;
    int ent[2][4];
#pragma unroll
    for (int ai = 0; ai < 2; ++ai)
#pragma unroll
      for (int m = 0; m < 4; ++m) { int r = rbase + ai * HALF + m * 16; r = r < u.mvalid ? r : u.mvalid - 1; ent[ai][m] = list[r]; }
#pragma unroll
    for (int ai = 0; ai < 2; ++ai)
#pragma unroll
      for (int m = 0; m < 4; ++m) { const int r = rbase + ai * HALF + m * 16;
        if (r < u.mvalid) { bf16_t* yp = Y + (size_t)ent[ai][m] * D + u.n0 + wc * 32 + fq * 4;
#pragma unroll
          for (int bj = 0; bj < 2; ++bj)
#pragma unroll
            for (int n = 0; n < 2; ++n) { const f32x4 v = acc[ai][bj][m][n]; uint2 wv; wv.x = pack2(v.x, v.y); wv.y = pack2(v.z, v.w); *(uint2*)(yp + bj * HALF + n * 16) = wv; } } }
  }
};
__device__ __forceinline__ void ph_moe1g(const MP& p, int layer, char* lds) {
  int* tb = (int*)(lds + 131072);
  moe_tables<256>(p, layer, 2, tb);
  MoeSched S; S.tb = (const PG8_LAS int*)tb; S.wsb = p.ws; S.Abase = (unsigned)WS_H; S.Bbase = (unsigned)WS_WMOE; S.b_estride = 512u * 1024u * 2u;
  S.ntn = 2; S.G = (int)gridDim.x; S.c = (int)blockIdx.x; S.K = 1024; S.gather = 1;
  EpiMoe1G E; E.wsb = p.ws; E.tb = S.tb;
  pg8g_phase((PG8_LAS unsigned char*)lds, p.ws, 1024, S, E);
}
__device__ __forceinline__ void ph_moe2g(const MP& p, int layer, char* lds) {
  int* tb = (int*)(lds + 131072);
  moe_tables<256>(p, layer, 4, tb);
  MoeSched S; S.tb = (const PG8_LAS int*)tb; S.wsb = p.ws; S.Abase = (unsigned)WS_AMOE; S.Bbase = (unsigned)(WS_WMOE + (size_t)32 * 512 * 1024 * 2); S.b_estride = 1024u * 256u * 2u;
  S.ntn = 4; S.G = (int)gridDim.x; S.c = (int)blockIdx.x; S.K = 256; S.gather = 0;
  EpiMoe2G E; E.wsb = p.ws;
  pg8g_phase((PG8_LAS unsigned char*)lds, p.ws, 256, S, E);
}
__device__ __forceinline__ void ph_combine(const MP& p, int layer, int nrows, int final_) {
  float* lat = p.out; float* ctxr = (float*)(p.ws + WS_XC); const bf16_t* Y = (const bf16_t*)(p.ws + WS_YBUF);
  const float* modl_cur = (const float*)(p.ws + WS_MODS) + layer * 3 * 6144; const float* modl_next = (const float*)(p.ws + WS_MODS) + 3 * 6144;
  const float* gain = final_ ? p.in[28] : p.in[6] + 1024; bf16_t* hout = (bf16_t*)(p.ws + WS_H);
  const int lane = tidx() & 63, gw = blockIdx.x * 8 + (tidx() >> 6);
  for (int row = gw; row < nrows; row += gridDim.x * 8) {
    float* src = row < NLAT ? lat + (size_t)row * D : ctxr + (size_t)(row - NLAT) * D;
    const int v = row_vec(row);
    f32x4 x[4]; float ss = 0.f;
#pragma unroll
    for (int j = 0; j < 4; ++j) {
      const int n = (lane + 64 * j) * 4;
      const f32x4 g2 = *(const f32x4*)(modl_cur + v * 6144 + 5120 + n);
      const uint2 y0 = *(const uint2*)(Y + ((size_t)row * 2) * D + n), y1 = *(const uint2*)(Y + ((size_t)row * 2 + 1) * D + n);
      f32x4 ys;
      ys.x = __uint_as_float(y0.x << 16) + __uint_as_float(y1.x << 16); ys.y = __uint_as_float(y0.x & 0xFFFF0000u) + __uint_as_float(y1.x & 0xFFFF0000u);
      ys.z = __uint_as_float(y0.y << 16) + __uint_as_float(y1.y << 16); ys.w = __uint_as_float(y0.y & 0xFFFF0000u) + __uint_as_float(y1.y & 0xFFFF0000u);
      x[j] = ((const f32x4*)src)[lane + 64 * j] + g2 * ys;
      ss += x[j].x * x[j].x + x[j].y * x[j].y + x[j].z * x[j].z + x[j].w * x[j].w;
    }
    const float rstd = 1.f / sqrtf(wave_sum(ss) * (1.f / D) + EPS);
#pragma unroll
    for (int j = 0; j < 4; ++j) {
      const int n = (lane + 64 * j) * 4;
      const f32x4 g = *(const f32x4*)(gain + n);
      if (final_) { ((f32x4*)src)[lane + 64 * j] = x[j] * rstd * g; }
      else {
        ((f32x4*)src)[lane + 64 * j] = x[j];
        const f32x4 sc = *(const f32x4*)(modl_next + v * 6144 + 1024 + n), sh = *(const f32x4*)(modl_next + v * 6144 + n);
        const f32x4 h = x[j] * rstd * g * (sc + 1.f) + sh;
        uint2 o; o.x = pack2(h.x, h.y); o.y = pack2(h.z, h.w);
        *(uint2*)(hout + (size_t)row * D + n) = o;
      }
    }
  }
}
__device__ __forceinline__ void ph_kr_rope(const float* kr, bf16_t* dk) {
  for (int idx = blockIdx.x * 512 + tidx(); idx < MROWS * 32; idx += gridDim.x * 512) {
    const int m = idx >> 5, j = idx & 31; int b, key; row_bkey(m, b, key);
    float val = kr[idx];
    if (m < NLAT) {
      const int t = m & 8191; const int half = j >> 4, jj = j & 15, i = jj & 7;
      const float pos = half ? (float)(t & 63) : (float)(t >> 6);
      float sn, cs; sincosf(pos * rope_inv(i), &sn, &cs);
      const float x1 = kr[(size_t)m * 32 + half * 16 + i], x2 = kr[(size_t)m * 32 + half * 16 + 8 + i];
      val = (jj < 8) ? (x1 * cs - x2 * sn) : (x1 * sn + x2 * cs);
    }
    const bf16_t o = f2bf(val);
#pragma unroll
    for (int hh = 0; hh < 8; ++hh) dk[((size_t)(b * 8 + hh) * NKEY + key) * 128 + 64 + j] = o;
  }
}

#define MFMA32(a, b, c) __builtin_amdgcn_mfma_f32_32x32x16_bf16(a, b, c, 0, 0, 0)
#define KSWZ(row, colB) ((row) * 256 + ((colB) ^ (((row) & 7) << 4)))
#define SBAR() __builtin_amdgcn_sched_barrier(0)
__device__ __forceinline__ int crow(int r, int hi) { return (r & 3) + 8 * (r >> 2) + 4 * hi; }
__device__ __forceinline__ unsigned cvtpk(float lo, float hi) { unsigned r; asm volatile("v_cvt_pk_bf16_f32 %0, %1, %2" : "=v"(r) : "v"(lo), "v"(hi)); return r; }

__device__ __forceinline__ void att_partialSM(f32x16& p0, f32x16& p1, float& m_reg, float& mn, float& alpha) {
  float pmax = p0[0];
#pragma unroll
  for (int r = 1; r < 16; ++r) pmax = fmaxf(pmax, p0[r]);
#pragma unroll
  for (int r = 0; r < 16; ++r) pmax = fmaxf(pmax, p1[r]);
  { auto rr = __builtin_amdgcn_permlane32_swap(__float_as_uint(pmax), __float_as_uint(pmax), false, false);
    pmax = fmaxf(__uint_as_float(rr[0]), __uint_as_float(rr[1])); }
  if (__builtin_expect(__all(pmax - m_reg <= ATT_THR), 1)) { mn = m_reg; alpha = 1.f; }
  else { mn = fmaxf(m_reg, pmax); alpha = __builtin_amdgcn_exp2f(m_reg - mn); m_reg = mn; }
#pragma unroll
  for (int r = 0; r < 16; ++r) p0[r] = __builtin_amdgcn_exp2f(p0[r] - mn);
#pragma unroll
  for (int r = 0; r < 16; ++r) p1[r] = p1[r] - mn;
}
__device__ __forceinline__ void att_finishSM(f32x16& p0, f32x16& p1, float alpha, float& l_reg, bf16x8& pa0, bf16x8& pa1, bf16x8& pa2, bf16x8& pa3) {
#pragma unroll
  for (int r = 0; r < 16; ++r) p1[r] = __builtin_amdgcn_exp2f(p1[r]);
  float ps = 0.f;
#pragma unroll
  for (int r = 0; r < 16; ++r) ps += p0[r];
#pragma unroll
  for (int r = 0; r < 16; ++r) ps += p1[r];
  { auto rr = __builtin_amdgcn_permlane32_swap(__float_as_uint(ps), __float_as_uint(ps), false, false);
    ps = __uint_as_float(rr[0]) + __uint_as_float(rr[1]); }
  l_reg = l_reg * alpha + ps;
#define PK4(P, BASE, OUT) do { unsigned a0 = cvtpk(P[BASE + 0], P[BASE + 1]), a1 = cvtpk(P[BASE + 2], P[BASE + 3]);   \
    unsigned b0 = cvtpk(P[BASE + 4], P[BASE + 5]), b1 = cvtpk(P[BASE + 6], P[BASE + 7]);                              \
    auto r0 = __builtin_amdgcn_permlane32_swap(a0, b0, false, false); auto r1 = __builtin_amdgcn_permlane32_swap(a1, b1, false, false); \
    u32x4 w = {r0[0], r1[0], r0[1], r1[1]}; OUT = *reinterpret_cast<bf16x8*>(&w); } while (0)
  PK4(p0, 0, pa0); PK4(p0, 8, pa1); PK4(p1, 0, pa2); PK4(p1, 8, pa3);
}
template <int ND0>
__device__ __forceinline__ void att_qkt(f32x16& p0, f32x16& p1, const char* Ks, const bf16x8* qr, int r32, int hi) {
#pragma unroll
  for (int r = 0; r < 16; ++r) { p0[r] = 0.f; p1[r] = 0.f; }
#pragma unroll
  for (int d0 = 0; d0 < ND0; ++d0) { const int cb = (d0 * 16 + hi * 8) * 2;
    const bf16x8 b0 = *reinterpret_cast<const bf16x8*>(Ks + KSWZ(r32, cb));
    const bf16x8 b1 = *reinterpret_cast<const bf16x8*>(Ks + KSWZ(32 + r32, cb));
    p0 = MFMA32(b0, qr[d0], p0);
    p1 = MFMA32(b1, qr[d0], p1); }
}
__device__ __forceinline__ int v_st64(int k, int c) { const int kk = (k & ~0xC) | ((k & 4) << 1) | ((k & 8) >> 1); return ((kk >> 3) * 2 + (c >> 5)) * 512 + ((kk & 7) * 32 + (c & 31)) * 2; }
__device__ __forceinline__ int v_rd_base(int lane) { return ((lane & 3) << 3) | (((lane >> 2) & 3) << 6) | (((lane >> 4) & 1) << 5) | (((lane >> 5) & 1) << 8); }
static constexpr int v_rd_off64(int d0, int ks, int half) { return d0 * 512 + ks * 2048 + half * 1024; }
template <int OFF> __device__ __forceinline__ s16x4 tr_read(int vb) {
  s16x4 r; asm volatile("ds_read_b64_tr_b16 %0, %1 offset:%2" : "=&v"(r) : "v"(vb), "i"(OFF) : "memory"); return r;
}
template <int D0> __device__ __forceinline__ void pv_one64(f32x16& od, int vb, bf16x8 pa0, bf16x8 pa1, bf16x8 pa2, bf16x8 pa3) {
  const s16x4 l0 = tr_read<v_rd_off64(D0, 0, 0)>(vb), h0 = tr_read<v_rd_off64(D0, 0, 1)>(vb), l1 = tr_read<v_rd_off64(D0, 1, 0)>(vb), h1 = tr_read<v_rd_off64(D0, 1, 1)>(vb);
  const s16x4 l2 = tr_read<v_rd_off64(D0, 2, 0)>(vb), h2 = tr_read<v_rd_off64(D0, 2, 1)>(vb), l3 = tr_read<v_rd_off64(D0, 3, 0)>(vb), h3 = tr_read<v_rd_off64(D0, 3, 1)>(vb);
  asm volatile("s_waitcnt lgkmcnt(0)" ::: "memory"); SBAR();
#define PKV(L, H) (bf16x8){L[0], L[1], L[2], L[3], H[0], H[1], H[2], H[3]}
  od = MFMA32(pa0, PKV(l0, h0), od);
  od = MFMA32(pa1, PKV(l1, h1), od);
  od = MFMA32(pa2, PKV(l2, h2), od);
  od = MFMA32(pa3, PKV(l3, h3), od);
}

__device__ __forceinline__ void mla_block(const bf16_t* __restrict__ Qb, const bf16_t* __restrict__ Kh, const bf16_t* __restrict__ Vh, bf16_t* __restrict__ Ob, int t0, char* lds) {
  constexpr int SHM_V = 64 * 64 * 2, SHM_K = 64 * 128 * 2, NT = NKEY / 64;
  const int tid = tidx(), wid = tid >> 6, lane = tid & 63, r32 = lane & 31, hi = lane >> 5;
  char* V_lds = lds; char* K_lds = lds + 2 * SHM_V;
  float* wsf = (float*)(lds + 2 * SHM_V + 2 * SHM_K) + wid * 64; float* li_l = wsf; float* al_l = wsf + 32;
  float m_reg = -1e30f, l_reg = 0.f; f32x16 o[2];
#pragma unroll
  for (int r = 0; r < 16; ++r) { o[0][r] = 0.f; o[1][r] = 0.f; }
  bf16x8 qr[6];
  { const bf16_t* Qw = Qb + (size_t)(wid * 32 + r32) * 96;
#pragma unroll
    for (int d0 = 0; d0 < 4; ++d0) qr[d0] = *(const bf16x8*)(Qw + d0 * 16 + hi * 8);
    const int t = t0 + wid * 32 + r32;
#pragma unroll
    for (int g = 0; g < 2; ++g) {
      const bf16x8 x1 = *(const bf16x8*)(Qw + 64 + g * 16), x2 = *(const bf16x8*)(Qw + 64 + g * 16 + 8);
      const float pos = g ? (float)(t & 63) : (float)(t >> 6);
      unsigned wv[4];
#pragma unroll
      for (int i = 0; i < 8; i += 2) {
        float o2[2];
#pragma unroll
        for (int q = 0; q < 2; ++q) { const float ang = pos * rope_inv(i + q); const float sn = __sinf(ang), cs = __cosf(ang);
          const float a = bf2f((bf16_t)x1[i + q]), b = bf2f((bf16_t)x2[i + q]);
          o2[q] = hi ? (a * sn + b * cs) : (a * cs - b * sn); }
        wv[i >> 1] = pack2(o2[0], o2[1]);
      }
      u32x4 w4 = {wv[0], wv[1], wv[2], wv[3]}; qr[4 + g] = *reinterpret_cast<bf16x8*>(&w4);
    }
  }
  const int kq0 = tid, kq1 = tid < 256 ? 512 + tid : tid;
  const int kr0 = kq0 / 12, kc0 = (kq0 - kr0 * 12) * 8, kr1 = kq1 / 12, kc1 = (kq1 - kr1 * 12) * 8; const bool k2 = tid < 256;
  const int kw0 = KSWZ(kr0, kc0 * 2), kw1 = KSWZ(kr1, kc1 * 2);
  const int vk = tid >> 3, vc = (tid & 7) * 8, vst = v_st64(vk, vc);
  const int vb0 = (int)(uintptr_t)V_lds + v_rd_base(lane);
  const int ko0 = kr0 * 128 + kc0, ko1 = kr1 * 128 + kc1, vo = vk * 64 + vc;
  uint4 sv_0, sk0_0, sk1_0, sv_1, sk0_1, sk1_1;
#define SLOAD(i, kk0) do { sv_##i = *(const uint4*)(Vh + ((kk0) * 64 + vo)); sk0_##i = *(const uint4*)(Kh + ((kk0) * 128 + ko0)); sk1_##i = *(const uint4*)(Kh + ((kk0) * 128 + ko1)); } while (0)
#define SWRITE(b, i) do { *(uint4*)(V_lds + (b) * SHM_V + vst) = sv_##i; *(uint4*)(K_lds + (b) * SHM_K + kw0) = sk0_##i; if (k2) *(uint4*)(K_lds + (b) * SHM_K + kw1) = sk1_##i; } while (0)
#define SWAIT() asm volatile("s_waitcnt vmcnt(3)" ::: "memory")
#define RESC(a) do { if (__any((a) < 1.f)) { if (hi == 0) al_l[r32] = (a); asm volatile("s_waitcnt lgkmcnt(0)" ::: "memory"); \
    _Pragma("unroll") for (int d = 0; d < 2; ++d) _Pragma("unroll") for (int r = 0; r < 16; ++r) o[d][r] *= al_l[crow(r, hi)]; } } while (0)
#define PV2(vb) do { pv_one64<0>(o[0], (vb), pa0, pa1, pa2, pa3); pv_one64<1>(o[1], (vb), pa0, pa1, pa2, pa3); } while (0)
  f32x16 pA0, pA1, pB0, pB1; float mnA, mnB, alA, alB; bf16x8 pa0, pa1, pa2, pa3;
  SLOAD(0, 0); asm volatile("s_waitcnt vmcnt(0)" ::: "memory"); SWRITE(0, 0); __syncthreads();
  att_qkt<6>(pA0, pA1, K_lds, qr, r32, hi); att_partialSM(pA0, pA1, m_reg, mnA, alA);
  SLOAD(1, 64); SLOAD(0, 128);
  SWAIT(); SWRITE(1, 1); __syncthreads();
  for (int j = 1; j + 1 < NT; j += 2) {
    SBAR(); att_qkt<6>(pB0, pB1, K_lds + SHM_K, qr, r32, hi);
    att_finishSM(pA0, pA1, alA, l_reg, pa0, pa1, pa2, pa3); SBAR();
    SLOAD(1, (j + 2) * 64); SBAR();
    PV2(vb0); att_partialSM(pB0, pB1, m_reg, mnB, alB);
    __syncthreads(); SWAIT(); SWRITE(0, 0);
    RESC(alB); __syncthreads();
    SBAR(); att_qkt<6>(pA0, pA1, K_lds, qr, r32, hi);
    att_finishSM(pB0, pB1, alB, l_reg, pa0, pa1, pa2, pa3); SBAR();
    if (j + 3 < NT) SLOAD(0, (j + 3) * 64); SBAR();
    PV2(vb0 + SHM_V); att_partialSM(pA0, pA1, m_reg, mnA, alA);
    __syncthreads(); SWAIT(); SWRITE(1, 1);
    RESC(alA); __syncthreads();
  }
  SBAR(); att_qkt<6>(pB0, pB1, K_lds + SHM_K, qr, r32, hi);
  att_finishSM(pA0, pA1, alA, l_reg, pa0, pa1, pa2, pa3); SBAR();
  PV2(vb0); att_partialSM(pB0, pB1, m_reg, mnB, alB);
  __syncthreads(); RESC(alB);
  att_finishSM(pB0, pB1, alB, l_reg, pa0, pa1, pa2, pa3); SBAR();
  PV2(vb0 + SHM_V);
  if (hi == 0) li_l[r32] = l_reg; asm volatile("s_waitcnt lgkmcnt(0)" ::: "memory");
  bf16_t* Ow = Ob + (size_t)(wid * 32) * D;
#pragma unroll
  for (int r = 0; r < 16; ++r) { const int orow = crow(r, hi); const float rl = __builtin_amdgcn_rcpf(li_l[orow]);
#pragma unroll
    for (int d0 = 0; d0 < 2; ++d0) Ow[(size_t)orow * D + d0 * 32 + r32] = f2bf(o[d0][r] * rl); }
  __syncthreads();
#undef SLOAD
#undef SWRITE
#undef SWAIT
}
__device__ __forceinline__ void ph_mla(const MP& p, char* lds) {
  const bf16_t* dq = (const bf16_t*)(p.ws + WS_DQ); const bf16_t* dk = (const bf16_t*)(p.ws + WS_DK); const bf16_t* dv = (const bf16_t*)(p.ws + WS_DV);
  bf16_t* abuf = (bf16_t*)(p.ws + WS_A);
  for (int item = blockIdx.x; item < 512; item += gridDim.x) {
    const int bh = (item & 7) + 8 * (item >> 8), qb = (item >> 3) & 31, b = bh >> 3, h = bh & 7;
    mla_block(dq + ((size_t)bh * SEQ + qb * 256) * 96, dk + (size_t)bh * NKEY * 128, dv + (size_t)bh * NKEY * 64,
              abuf + (size_t)(b * SEQ + qb * 256) * D + 512 + h * 64, qb * 256, lds);
  }
}

__device__ __forceinline__ int hgrn_step_cid(int b, int dir, int s) {
  if (s < 4) return 256 + b * 4 + (dir ? 3 - s : s);
  return b * 128 + (dir ? 131 - s : s - 4);
}
__device__ __forceinline__ void ph_hgrn_a(const MP& p, char* lds) {
  bf16_t* U = (bf16_t*)(p.ws + WS_U); float* LF = (float*)(p.ws + WS_LF); float* alast = (float*)(p.ws + WS_ALAST);
  bf16_t* KT = (bf16_t*)(p.ws + WS_A); bf16_t* VT = (bf16_t*)(p.ws + WS_H + USLOT);
  float* Ef = (float*)lds;
  bf16_t* Kn = (bf16_t*)(lds + 33792);
  bf16_t* Vn = (bf16_t*)(lds + 33792 + 17408);
  float* gsum = (float*)(lds + 33792 + 2 * 17408);
  const int t = tidx(), srow = t >> 3, scb = (t & 7) * 16, col = t & 127, grp = t >> 7;
  for (int item = blockIdx.x; item < NCHUNK * 8; item += gridDim.x) {
    const int cid = item >> 3, dir = (item >> 2) & 1, h = item & 3; const size_t row0 = (size_t)cid * 64;
    { const size_t go = (row0 + srow) * 512 + h * 128 + scb;
      const float* lp = LF + (size_t)dir * MROWS * 512 + go;
      const f32x4 e0 = *(const f32x4*)lp, e1 = *(const f32x4*)(lp + 4), e2 = *(const f32x4*)(lp + 8), e3 = *(const f32x4*)(lp + 12);
      const uint4 k0 = *(const uint4*)(U + (size_t)(1 + dir) * MROWS * 512 + go), k1 = *(const uint4*)(U + (size_t)(1 + dir) * MROWS * 512 + go + 8);
      float* ed = Ef + srow * 132 + scb; *(f32x4*)ed = e0; *(f32x4*)(ed + 4) = e1; *(f32x4*)(ed + 8) = e2; *(f32x4*)(ed + 12) = e3;
      *(uint4*)(Kn + srow * 136 + scb) = k0; *(uint4*)(Kn + srow * 136 + scb + 8) = k1;
      if (dir == 0) { const uint4 v0 = *(const uint4*)(U + (size_t)3 * MROWS * 512 + go), v1 = *(const uint4*)(U + (size_t)3 * MROWS * 512 + go + 8);
        *(uint4*)(Vn + srow * 136 + scb) = v0; *(uint4*)(Vn + srow * 136 + scb + 8) = v1; } }
    __syncthreads();
    float pre[16]; float run = 0.f;
#pragma unroll
    for (int i = 0; i < 16; ++i) { const int rr = grp * 16 + (dir ? 15 - i : i); run += Ef[rr * 132 + col]; pre[i] = run; }
    gsum[grp * 128 + col] = run;
    __syncthreads();
    const float g0 = gsum[col], g1 = gsum[128 + col], g2 = gsum[256 + col], g3 = gsum[384 + col];
    const float total = (g0 + g1) + (g2 + g3);
    float offs;
    if (dir == 0) offs = grp == 0 ? 0.f : (grp == 1 ? g0 : (grp == 2 ? g0 + g1 : g0 + g1 + g2));
    else offs = grp == 3 ? 0.f : (grp == 2 ? g3 : (grp == 1 ? g3 + g2 : g3 + g2 + g1));
    if (grp == 0) alast[((size_t)dir * NCHUNK + cid) * 512 + h * 128 + col] = __expf(total);
    unsigned kw[8];
#pragma unroll
    for (int i = 0; i < 16; i += 2) {
      const float ea = total - (offs + pre[dir ? 15 - i : i]), eb = total - (offs + pre[dir ? 14 - i : i + 1]);
      Ef[(grp * 16 + i) * 132 + col] = ea; Ef[(grp * 16 + i + 1) * 132 + col] = eb;
      const bf16_t ka = f2bf(bf2f(Kn[(grp * 16 + i) * 136 + col]) * __expf(ea)), kb = f2bf(bf2f(Kn[(grp * 16 + i + 1) * 136 + col]) * __expf(eb));
      Kn[(grp * 16 + i) * 136 + col] = ka; Kn[(grp * 16 + i + 1) * 136 + col] = kb; kw[i >> 1] = (unsigned)ka | ((unsigned)kb << 16);
    }
    { bf16_t* kt = KT + ((((size_t)dir * NCHUNK + cid) * 4 + h) * 128 + col) * 64 + grp * 16;
      *(uint4*)kt = make_uint4(kw[0], kw[1], kw[2], kw[3]); *(uint4*)(kt + 8) = make_uint4(kw[4], kw[5], kw[6], kw[7]); }
    if (dir == 0) {
      unsigned vw[8];
#pragma unroll
      for (int i = 0; i < 16; i += 2) vw[i >> 1] = (unsigned)Vn[(grp * 16 + i) * 136 + col] | ((unsigned)Vn[(grp * 16 + i + 1) * 136 + col] << 16);
      bf16_t* vt = VT + (((size_t)cid * 4 + h) * 128 + col) * 64 + grp * 16;
      *(uint4*)vt = make_uint4(vw[0], vw[1], vw[2], vw[3]); *(uint4*)(vt + 8) = make_uint4(vw[4], vw[5], vw[6], vw[7]);
    }
    __syncthreads();
    { const size_t go = (row0 + srow) * 512 + h * 128 + scb;
      float* lp = LF + (size_t)dir * MROWS * 512 + go; const float* ed = Ef + srow * 132 + scb;
      *(f32x4*)lp = *(const f32x4*)ed; *(f32x4*)(lp + 4) = *(const f32x4*)(ed + 4); *(f32x4*)(lp + 8) = *(const f32x4*)(ed + 8); *(f32x4*)(lp + 12) = *(const f32x4*)(ed + 12);
      bf16_t* up = U + (size_t)(1 + dir) * MROWS * 512 + go;
      *(uint4*)up = *(const uint4*)(Kn + srow * 136 + scb); *(uint4*)(up + 8) = *(const uint4*)(Kn + srow * 136 + scb + 8); }
    __syncthreads();
  }
}
__device__ __forceinline__ bf16_t* hgrn_sbuf(const MP& p, int bhd, int cid) {
  return cid < 256 ? (bf16_t*)p.out + ((size_t)bhd * 128 + (cid & 127)) * 16384 : (bf16_t*)(p.ws + WS_ODIR_CTX) + ((size_t)bhd * 4 + ((cid - 256) & 3)) * 16384;
}
__device__ __forceinline__ void ph_hgrn_b(const MP& p) {
  const int tid = tidx(), w = tid >> 6, lane = tid & 63, l15 = lane & 15, lq = lane >> 4;
  if (w < 4) {
    const bf16_t* KT = (const bf16_t*)(p.ws + WS_A); const bf16_t* VT = (const bf16_t*)(p.ws + WS_H + USLOT); const float* alast = (const float*)(p.ws + WS_ALAST);
    for (int item = blockIdx.x * 4 + w; item < 1024; item += gridDim.x * 4) {
      const int bhd = item >> 6, dkt = (item >> 3) & 7, dvt = item & 7, b = bhd >> 3, h = (bhd >> 1) & 3, dir = bhd & 1;
      f32x4 S = {0.f, 0.f, 0.f, 0.f};
      const size_t ktl = ((size_t)h * 128 + dkt * 16 + l15) * 64 + lq * 8, vtl = ((size_t)h * 128 + dvt * 16 + l15) * 64 + lq * 8;
      const size_t all = (size_t)h * 128 + dkt * 16 + lq * 4, sbl = (size_t)(dvt * 16 + l15) * 128 + dkt * 16 + lq * 4;
      const bf16_t* KTd = KT + (size_t)dir * NCHUNK * 4 * 8192; const float* ald = alast + (size_t)dir * NCHUNK * 512;
      uint4 kaA[2][2], vbA[2][2], kaB[2][2], vbB[2][2], kaC[2][2], vbC[2][2], kaD[2][2], vbD[2][2]; f32x4 alA[2], alB[2], alC[2], alD[2];
#define HB_LOAD(X, s0) _Pragma("unroll") for (int u = 0; u < 2; ++u) { const int cid = hgrn_step_cid(b, dir, (s0) + u);                              \
        const bf16_t* kt = KTd + (size_t)cid * (4 * 8192) + ktl; const bf16_t* vt = VT + (size_t)cid * (4 * 8192) + vtl;                              \
        ka##X[u][0] = *(const uint4*)kt; ka##X[u][1] = *(const uint4*)(kt + 32); vb##X[u][0] = *(const uint4*)vt; vb##X[u][1] = *(const uint4*)(vt + 32); \
        al##X[u] = *(const f32x4*)(ald + (size_t)cid * 512 + all); }
#define HB_STEP(X, s0) _Pragma("unroll") for (int u = 0; u < 2; ++u) { const int cid = hgrn_step_cid(b, dir, (s0) + u);                              \
        f32x4 T = {0.f, 0.f, 0.f, 0.f};                                                                                                              \
        T = MFMA16(*reinterpret_cast<bf16x8*>(&ka##X[u][0]), *reinterpret_cast<bf16x8*>(&vb##X[u][0]), T);                                           \
        T = MFMA16(*reinterpret_cast<bf16x8*>(&ka##X[u][1]), *reinterpret_cast<bf16x8*>(&vb##X[u][1]), T);                                           \
        const f32x4 Sp = S * al##X[u];                                                                                                               \
        uint2 sw; sw.x = pack2(Sp.x, Sp.y); sw.y = pack2(Sp.z, Sp.w);                                                                                \
        *(uint2*)(hgrn_sbuf(p, bhd, cid) + sbl) = sw;                                                                                                 \
        S = Sp + T; }
      HB_LOAD(A, 0); HB_LOAD(B, 2); HB_LOAD(C, 4);
      for (int s0 = 0; s0 < 132; s0 += 8) {
        if (s0 + 6 < 132) { HB_LOAD(D, s0 + 6); }
        HB_STEP(A, s0);
        if (s0 + 8 < 132) { HB_LOAD(A, s0 + 8); }
        HB_STEP(B, s0 + 2);
        if (s0 + 10 < 132) { HB_LOAD(B, s0 + 10); }
        if (s0 + 4 < 132) { HB_STEP(C, s0 + 4); }
        if (s0 + 12 < 132) { HB_LOAD(C, s0 + 12); }
        if (s0 + 6 < 132) { HB_STEP(D, s0 + 6); }
      }
#undef HB_LOAD
#undef HB_STEP
    }
  }
}
__device__ __forceinline__ void ph_hgrn_c(const MP& p, char* lds) {
  const bf16_t* U = (const bf16_t*)(p.ws + WS_U); const float* LF = (const float*)(p.ws + WS_LF); const bf16_t* VT = (const bf16_t*)(p.ws + WS_H + USLOT);
  bf16_t* abuf = (bf16_t*)(p.ws + WS_A); const float* onorm = p.in[11];
  char* Qs = lds; char* Ks = lds + 16384; char* Ss = lds + 32768; char* Vs = lds + 65536; char* As = lds + 81920; float* red = (float*)(lds + 90112);
  const int t = tidx(), lane = t & 63, w = t >> 6, wm = w >> 1, wn = w & 1, l15 = lane & 15, lq = lane >> 4;
  const int srow = t >> 3, scb = (t & 7) * 16;
  uint4 rq0, rq1, rk0, rk1, rv0, rv1, rs0, rs1, rs2, rs3; f32x4 re0, re1, re2, re3;
#define HC_LOAD(item_, dir_) do { const int bh_ = (item_) / 132, cp_ = (item_) - bh_ * 132, b_ = bh_ >> 2, h_ = bh_ & 3; \
    const int cid_ = cp_ < 128 ? b_ * 128 + cp_ : 256 + b_ * 4 + (cp_ - 128); \
    const size_t go_ = ((size_t)cid_ * 64 + srow) * 512 + h_ * 128 + scb; \
    rq0 = *(const uint4*)(U + go_); rq1 = *(const uint4*)(U + go_ + 8); \
    rk0 = *(const uint4*)(U + (size_t)(1 + (dir_)) * MROWS * 512 + go_); rk1 = *(const uint4*)(U + (size_t)(1 + (dir_)) * MROWS * 512 + go_ + 8); \
    const float* ep_ = LF + (size_t)(dir_) * MROWS * 512 + go_; re0 = *(const f32x4*)ep_; re1 = *(const f32x4*)(ep_ + 4); re2 = *(const f32x4*)(ep_ + 8); re3 = *(const f32x4*)(ep_ + 12); \
    if ((dir_) == 0) { const bf16_t* vt_ = VT + ((size_t)cid_ * 4 + h_) * 8192; rv0 = *(const uint4*)(vt_ + (size_t)t * 8); rv1 = *(const uint4*)(vt_ + (size_t)(t + 512) * 8); } \
    const bf16_t* sb_ = hgrn_sbuf(p, bh_ * 2 + (dir_), cid_); \
    rs0 = *(const uint4*)(sb_ + (size_t)t * 8); rs1 = *(const uint4*)(sb_ + (size_t)(t + 512) * 8); rs2 = *(const uint4*)(sb_ + (size_t)(t + 1024) * 8); rs3 = *(const uint4*)(sb_ + (size_t)(t + 1536) * 8); } while (0)
  if ((int)blockIdx.x < 8 * 132) HC_LOAD((int)blockIdx.x, 0);
  for (int item = blockIdx.x; item < 8 * 132; item += gridDim.x) {
    const int bh = item / 132, cpos = item - bh * 132, b = bh >> 2, h = bh & 3;
    const int cid = cpos < 128 ? b * 128 + cpos : 256 + b * 4 + (cpos - 128); const size_t row0 = (size_t)cid * 64;
    f32x4 acc[4];
#pragma unroll
    for (int j = 0; j < 4; ++j) acc[j] = (f32x4){0.f, 0.f, 0.f, 0.f};
    for (int dir = 0; dir < 2; ++dir) {
      {
        const unsigned qw[8] = {rq0.x, rq0.y, rq0.z, rq0.w, rq1.x, rq1.y, rq1.z, rq1.w};
        const float ev[16] = {re0.x, re0.y, re0.z, re0.w, re1.x, re1.y, re1.z, re1.w, re2.x, re2.y, re2.z, re2.w, re3.x, re3.y, re3.z, re3.w};
        unsigned ow[8];
#pragma unroll
        for (int i = 0; i < 8; ++i) ow[i] = pack2(__uint_as_float(qw[i] << 16) * __expf(-ev[2 * i]), __uint_as_float(qw[i] & 0xFFFF0000u) * __expf(-ev[2 * i + 1]));
        const int c0 = scb >> 3, sw = srow & 15;
        *(uint4*)(Qs + srow * 256 + ((c0 ^ sw) << 4)) = make_uint4(ow[0], ow[1], ow[2], ow[3]);
        *(uint4*)(Qs + srow * 256 + (((c0 + 1) ^ sw) << 4)) = make_uint4(ow[4], ow[5], ow[6], ow[7]);
        *(uint4*)(Ks + srow * 256 + ((c0 ^ sw) << 4)) = rk0;
        *(uint4*)(Ks + srow * 256 + (((c0 + 1) ^ sw) << 4)) = rk1;
        if (dir == 0) { { const int idx = t, r = idx >> 3, c = idx & 7; *(uint4*)(Vs + r * 128 + ((c ^ ((r >> 1) & 7)) << 4)) = rv0; }
                        { const int idx = t + 512, r = idx >> 3, c = idx & 7; *(uint4*)(Vs + r * 128 + ((c ^ ((r >> 1) & 7)) << 4)) = rv1; } }
        { const int idx = t, r = idx >> 4, c = idx & 15; *(uint4*)(Ss + r * 256 + ((c ^ (r & 15)) << 4)) = rs0; }
        { const int idx = t + 512, r = idx >> 4, c = idx & 15; *(uint4*)(Ss + r * 256 + ((c ^ (r & 15)) << 4)) = rs1; }
        { const int idx = t + 1024, r = idx >> 4, c = idx & 15; *(uint4*)(Ss + r * 256 + ((c ^ (r & 15)) << 4)) = rs2; }
        { const int idx = t + 1536, r = idx >> 4, c = idx & 15; *(uint4*)(Ss + r * 256 + ((c ^ (r & 15)) << 4)) = rs3; }
      }
      __syncthreads();
      if (dir == 0) HC_LOAD(item, 1); else if (item + (int)gridDim.x < 8 * 132) HC_LOAD(item + (int)gridDim.x, 0);
      bf16x8 af[4];
#pragma unroll
      for (int ks = 0; ks < 4; ++ks) af[ks] = *(const bf16x8*)(Qs + (wm * 16 + l15) * 256 + (((ks * 4 + lq) ^ l15) << 4));
      {
        f32x4 a2[2];
#pragma unroll
        for (int ni = 0; ni < 2; ++ni) { a2[ni] = (f32x4){0.f, 0.f, 0.f, 0.f};
#pragma unroll
          for (int ks = 0; ks < 4; ++ks) { const bf16x8 bf = *(const bf16x8*)(Ks + (wn * 32 + ni * 16 + l15) * 256 + (((ks * 4 + lq) ^ l15) << 4)); a2[ni] = MFMA16(bf, af[ks], a2[ni]); } }
        const int tt = wm * 16 + l15;
#pragma unroll
        for (int ni = 0; ni < 2; ++ni) { const int s0 = wn * 32 + ni * 16 + lq * 4; float v[4] = {a2[ni].x, a2[ni].y, a2[ni].z, a2[ni].w};
#pragma unroll
          for (int r = 0; r < 4; ++r) { const int s = s0 + r; const bool keep = dir ? (s >= tt) : (s <= tt); v[r] = keep ? v[r] : 0.f; }
          uint2 wv; wv.x = pack2(v[0], v[1]); wv.y = pack2(v[2], v[3]);
          *(uint2*)(As + tt * 128 + (((s0 >> 3) ^ ((tt >> 1) & 7)) << 4) + (s0 & 7) * 2) = wv; }
      }
#pragma unroll
      for (int ni = 0; ni < 4; ++ni) {
#pragma unroll
        for (int ks = 0; ks < 4; ++ks) { const bf16x8 bf = *(const bf16x8*)(Ss + (wn * 64 + ni * 16 + l15) * 256 + (((ks * 4 + lq) ^ l15) << 4)); acc[ni] = MFMA16(bf, af[ks], acc[ni]); } }
      __syncthreads();
      {
        const int tt = wm * 16 + l15; bf16x8 aa[2];
#pragma unroll
        for (int ks = 0; ks < 2; ++ks) aa[ks] = *(const bf16x8*)(As + tt * 128 + (((ks * 4 + lq) ^ ((tt >> 1) & 7)) << 4));
#pragma unroll
        for (int ni = 0; ni < 4; ++ni) { const int r = wn * 64 + ni * 16 + l15;
#pragma unroll
          for (int ks = 0; ks < 2; ++ks) { const bf16x8 bf = *(const bf16x8*)(Vs + r * 128 + (((ks * 4 + lq) ^ ((r >> 1) & 7)) << 4)); acc[ni] = MFMA16(bf, aa[ks], acc[ni]); } }
      }
      __syncthreads();
    }
    const int tt = wm * 16 + l15; float ss = 0.f;
#pragma unroll
    for (int ni = 0; ni < 4; ++ni) ss += acc[ni].x * acc[ni].x + acc[ni].y * acc[ni].y + acc[ni].z * acc[ni].z + acc[ni].w * acc[ni].w;
    ss += __shfl_xor(ss, 16); ss += __shfl_xor(ss, 32);
    if (lq == 0) red[tt * 2 + wn] = ss;
    __syncthreads();
    const float rstd = 1.f / sqrtf((red[tt * 2] + red[tt * 2 + 1]) * (1.f / 128.f) + EPS);
#pragma unroll
    for (int ni = 0; ni < 4; ++ni) {
      const int dv = wn * 64 + ni * 16 + lq * 4; const size_t go = (row0 + tt) * 512 + h * 128 + dv;
      const uint2 gw = *(const uint2*)(U + (size_t)4 * MROWS * 512 + go); const f32x4 on = *(const f32x4*)(onorm + dv);
      uint2 wv;
      wv.x = pack2(acc[ni].x * rstd * on.x * __uint_as_float(gw.x << 16), acc[ni].y * rstd * on.y * __uint_as_float(gw.x & 0xFFFF0000u));
      wv.y = pack2(acc[ni].z * rstd * on.z * __uint_as_float(gw.y << 16), acc[ni].w * rstd * on.w * __uint_as_float(gw.y & 0xFFFF0000u));
      *(uint2*)(abuf + (row0 + tt) * D + h * 128 + dv) = wv;
    }
    __syncthreads();
  }
#undef HC_LOAD
}

#define XB_TMO      128
#define XB_XCNT(j)  (256  + 64 * (j))
#define XB_XSUB(j)  (1280 + 64 * (j))
#define XB_XGEN(j)  (2304 + 64 * (j))
#define XB_TOP      3328
#define XB_TOPGEN   3392
#define XCD_BAR_WORDS 3456
#define XB_SPIN_CAP (1u << 20)
#define LAS __attribute__((address_space(3)))
__device__ __forceinline__ unsigned xb_ld(unsigned* p)              { return __hip_atomic_load(p, __ATOMIC_RELAXED, __HIP_MEMORY_SCOPE_AGENT); }
__device__ __forceinline__ unsigned xb_add(unsigned* p, unsigned v) { return __hip_atomic_fetch_add(p, v, __ATOMIC_RELAXED, __HIP_MEMORY_SCOPE_AGENT); }
__device__ __forceinline__ unsigned xb_xcc_id() { return (unsigned)__builtin_amdgcn_s_getreg((3 << 11) | 20) & 0xFu; }
#define XB_SPIN(cond, bar) do { unsigned _sp = 0; while (cond) { __builtin_amdgcn_s_sleep(1); \
    if ((++_sp & 255u) == 0u) { if (xb_ld(&(bar)[XB_TMO])) break; if (_sp > XB_SPIN_CAP) { atomicAdd(&(bar)[XB_TMO], 1u); break; } } } } while (0)
struct XcdBarrier { unsigned* bar; unsigned x; volatile LAS unsigned* st; };
__device__ __forceinline__ XcdBarrier xcd_barrier_post(unsigned* bar, volatile LAS unsigned* st) {
  XcdBarrier b; b.bar = bar; b.x = xb_xcc_id(); b.st = st;
  if (tidx() == 0) (void)xb_add(&bar[XB_XCNT(b.x)], 1u);
  return b;
}
__device__ __forceinline__ void xcd_barrier_complete(unsigned* bar, unsigned x, unsigned& nloc, unsigned& nx) {
  const unsigned G = gridDim.x * gridDim.y * gridDim.z;
  unsigned sum, cnt, mine, sp = 0u;
  for (;;) {
    sum = 0u; cnt = 0u; mine = 0u;
#pragma unroll
    for (unsigned j = 0; j < 16; ++j) { const unsigned c = xb_ld(&bar[XB_XCNT(j)]); sum += c; cnt += (c > 0u) ? 1u : 0u; mine = (j == x) ? c : mine; }
    if (sum == G) break;
    __builtin_amdgcn_s_sleep(1);
    if ((++sp & 255u) == 0u) { if (xb_ld(&bar[XB_TMO])) break; if (sp > XB_SPIN_CAP) { atomicAdd(&bar[XB_TMO], 1u); break; } }
  }
  nloc = mine > 0u ? mine : 1u; nx = cnt > 0u ? cnt : 1u;
}
__device__ __forceinline__ void xcd_barrier(const XcdBarrier& b) {
  asm volatile("s_waitcnt vmcnt(0)" ::: "memory");
  __syncthreads();
  if (tidx() == 0) {
    unsigned* bar = b.bar;
    __builtin_amdgcn_s_waitcnt(0);
    unsigned nloc = b.st[0], nx = b.st[1];
    if (nloc == 0u) { xcd_barrier_complete(bar, b.x, nloc, nx); b.st[0] = nloc; b.st[1] = nx; }
    const unsigned old = xb_add(&bar[XB_XSUB(b.x)], 1u);
    const unsigned gen = old / nloc;
    if (old + 1u == (gen + 1u) * nloc) {
      __builtin_amdgcn_fence(__ATOMIC_RELEASE, "agent");
      asm volatile("s_waitcnt vmcnt(0)" ::: "memory");
      const unsigned og = xb_add(&bar[XB_TOP], 1u);
      const unsigned tg = og / nx;
      if (og + 1u == (tg + 1u) * nx) xb_add(&bar[XB_TOPGEN], 1u);
      else XB_SPIN(xb_ld(&bar[XB_TOPGEN]) == tg, bar);
      __builtin_amdgcn_fence(__ATOMIC_ACQUIRE, "agent");
      xb_add(&bar[XB_XGEN(b.x)], 1u);
      asm volatile("s_waitcnt vmcnt(0)" ::: "memory");
    } else {
      XB_SPIN(xb_ld(&bar[XB_XGEN(b.x)]) == gen, bar);
      __builtin_amdgcn_fence(__ATOMIC_ACQUIRE, "agent");
      asm volatile("s_waitcnt vmcnt(0)" ::: "memory");
    }
  }
  __syncthreads();
}

  template <int D0> __device__ __forceinline__ void pv_one32(f32x16& od, int vb, bf16x8 pa0, bf16x8 pa1) {
    const s16x4 l0 = tr_read<v_rd_off64(D0, 0, 0)>(vb), h0 = tr_read<v_rd_off64(D0, 0, 1)>(vb), l1 = tr_read<v_rd_off64(D0, 1, 0)>(vb), h1 = tr_read<v_rd_off64(D0, 1, 1)>(vb);
    asm volatile("s_waitcnt lgkmcnt(0)" ::: "memory"); SBAR();
    od = MFMA32(pa0, PKV(l0, h0), od);
    od = MFMA32(pa1, PKV(l1, h1), od);
  }
  __device__ __forceinline__ void ph_na(const MP& p, char* lds) {
    const bf16_t* nq = (const bf16_t*)(p.ws + WS_NQ); const bf16_t* nk = (const bf16_t*)(p.ws + WS_NK); const bf16_t* nv = (const bf16_t*)(p.ws + WS_NV);
    bf16_t* A = (bf16_t*)(p.ws + WS_A);
    const int tid = tidx(), w = tid >> 6, lane = tid & 63, j = lane & 31, hi = lane >> 5;
    char* Kw = lds + w * 8192; char* Vw = Kw + 4096;
    float* rpbs = (float*)(lds + 65536);
    float* al_l = (float*)(lds + 65536 + 4096) + w * 64; float* li_l = al_l + 32;
    const int vb0 = (int)(uintptr_t)Vw + v_rd_base(lane);
    for (int item = blockIdx.x; item < 512; item += gridDim.x) {
      const int bh = (item & 7) + 8 * (item >> 8), patch = (item >> 3) & 31, b = bh >> 3, h = bh & 7, r0 = (patch >> 2) * 16, c0 = (patch & 3) * 16;
      for (int i = tid; i < 15 * 64; i += 512) { const int dr = i >> 6, dc = (i & 63) - 16; rpbs[i] = (dc >= 0 && dc < 31) ? p.in[16][(h * 15 + dr) * 31 + dc] * LOG2E : 0.f; }
      __syncthreads();
      const int ra = r0 + 2 * w, qrow = ra + (j >> 4), qc = c0 + (j & 15);
      int rs_q = qrow - 4; rs_q = rs_q < 0 ? 0 : (rs_q > 120 ? 120 : rs_q);
      int cs_q = qc - 8; cs_q = cs_q < 0 ? 0 : (cs_q > 48 ? 48 : cs_q);
      int rs0 = ra - 4; rs0 = rs0 < 0 ? 0 : (rs0 > 120 ? 120 : rs0);
      int rs1 = ra - 3; rs1 = rs1 < 0 ? 0 : (rs1 > 120 ? 120 : rs1);
      int cw = c0 - 8; cw = cw < 0 ? 0 : (cw > 32 ? 32 : cw);
      const int ntiles = 8 + (rs1 - rs0) + 8;
      const bf16_t* Kb = nk + (size_t)bh * NKEY * 64; const bf16_t* Vb = nv + (size_t)bh * NKEY * 64;
      bf16x8 qr[4];
      { const bf16_t* qp = nq + ((size_t)bh * SEQ + qrow * 64 + qc) * 64 + hi * 8;
#pragma unroll
        for (int d0 = 0; d0 < 4; ++d0) qr[d0] = *(const bf16x8*)(qp + d0 * 16); }
      f32x16 o[2];
#pragma unroll
      for (int r = 0; r < 16; ++r) { o[0][r] = 0.f; o[1][r] = 0.f; }
      float m_reg = -1e30f, l_reg = 0.f;
      int kwo[4], vwo[4];
#pragma unroll
      for (int i = 0; i < 4; ++i) { const int q = lane + 64 * i, row = q >> 3, c = q & 7; kwo[i] = row * 128 + ((c ^ ((row >> 1) & 7)) << 4); vwo[i] = v_st64(row, c * 8); }
      uint4 sk0, sk1, sk2, sk3, sv0, sv1, sv2, sv3;
#define NA_KBASE(tl) ((tl) < 8 ? (tl) * 32 : CT + (rs0 + (tl) - 8) * 64 + cw)
#define NA_L1(i) sk##i = *(const uint4*)(Kb + kb_ + (i) * 512); sv##i = *(const uint4*)(Vb + kb_ + (i) * 512);
#define NA_LOAD(tl) do { const size_t kb_ = (size_t)NA_KBASE(tl) * 64 + lane * 8; NA_L1(0) NA_L1(1) NA_L1(2) NA_L1(3) } while (0)
#define NA_W1(i) *(uint4*)(Kw + kwo[i]) = sk##i; *(uint4*)(Vw + vwo[i]) = sv##i;
#define NA_WRITE() do { NA_W1(0) NA_W1(1) NA_W1(2) NA_W1(3) } while (0)
      NA_LOAD(0); NA_WRITE();
      for (int tl = 0; tl < ntiles; ++tl) {
        if (tl + 1 < ntiles) NA_LOAD(tl + 1);
        f32x16 pt;
#pragma unroll
        for (int r = 0; r < 16; ++r) pt[r] = 0.f;
#pragma unroll
        for (int d0 = 0; d0 < 4; ++d0) { const bf16x8 kf = *(const bf16x8*)(Kw + j * 128 + (((d0 * 2 + hi) ^ ((j >> 1) & 7)) << 4)); pt = MFMA32(kf, qr[d0], pt); }
        if (tl >= 8) {
          const int kr = rs0 + tl - 8; const bool rowok = (kr >= rs_q) && (kr < rs_q + 8);
          int dr = kr - qrow + 7; dr = dr < 0 ? 0 : (dr > 14 ? 14 : dr);
          const float* bp = rpbs + dr * 64 + (cw - qc + 15 + 16) + 4 * hi; const int kc0 = cw + 4 * hi;
#pragma unroll
          for (int r = 0; r < 16; ++r) { const int cr = (r & 3) + 8 * (r >> 2); const int kc = kc0 + cr;
            const bool ok = rowok && (kc >= cs_q) && (kc < cs_q + 16); pt[r] = ok ? pt[r] + bp[cr] : -1e30f; }
        }
        float pmax = pt[0];
#pragma unroll
        for (int r = 1; r < 16; ++r) pmax = fmaxf(pmax, pt[r]);
        { auto rr = __builtin_amdgcn_permlane32_swap(__float_as_uint(pmax), __float_as_uint(pmax), false, false); pmax = fmaxf(__uint_as_float(rr[0]), __uint_as_float(rr[1])); }
        float mn, alpha;
        if (__all(pmax - m_reg <= ATT_THR)) { mn = m_reg; alpha = 1.f; }
        else { mn = fmaxf(m_reg, pmax); alpha = __builtin_amdgcn_exp2f(m_reg - mn); m_reg = mn; }
        float ps = 0.f;
#pragma unroll
        for (int r = 0; r < 16; ++r) { pt[r] = __builtin_amdgcn_exp2f(pt[r] - mn); ps += pt[r]; }
        { auto rr = __builtin_amdgcn_permlane32_swap(__float_as_uint(ps), __float_as_uint(ps), false, false); ps = __uint_as_float(rr[0]) + __uint_as_float(rr[1]); }
        l_reg = l_reg * alpha + ps;
        bf16x8 pa0, pa1; PK4(pt, 0, pa0); PK4(pt, 8, pa1);
        if (__any(alpha < 1.f)) { if (hi == 0) al_l[j] = alpha; asm volatile("s_waitcnt lgkmcnt(0)" ::: "memory");
#pragma unroll
          for (int d = 0; d < 2; ++d)
#pragma unroll
            for (int r = 0; r < 16; ++r) o[d][r] *= al_l[crow(r, hi)]; }
        pv_one32<0>(o[0], vb0, pa0, pa1); pv_one32<1>(o[1], vb0, pa0, pa1);
        if (tl + 1 < ntiles) NA_WRITE();
      }
#undef NA_LOAD
#undef NA_WRITE
#undef NA_KBASE
      if (hi == 0) li_l[j] = l_reg; asm volatile("s_waitcnt lgkmcnt(0)" ::: "memory");
#pragma unroll
      for (int r = 0; r < 16; ++r) { const int qq = crow(r, hi); const float rl = __builtin_amdgcn_rcpf(li_l[qq]);
        bf16_t* op = A + ((size_t)b * SEQ + (ra + (qq >> 4)) * 64 + c0 + (qq & 15)) * D + h * 64 + j;
        op[0] = f2bf(o[0][r] * rl); op[32] = f2bf(o[1][r] * rl); }
      __syncthreads();
    }
  }

__device__ __forceinline__ void ph_na_simple(const MP& p) {
  const bf16_t* nq = (const bf16_t*)(p.ws + WS_NQ); const bf16_t* nk = (const bf16_t*)(p.ws + WS_NK); const bf16_t* nv = (const bf16_t*)(p.ws + WS_NV);
  const float* rpb = p.in[16]; bf16_t* A = (bf16_t*)(p.ws + WS_A);
  for (int item = blockIdx.x; item < 256; item += gridDim.x) {
    const int bh = item >> 4, t = (item & 15) * 512 + tidx(), b = bh >> 3, hh = bh & 7;
    const int r = t >> 6, c = t & 63;
    int rs = r - 4; rs = rs < 0 ? 0 : (rs > 120 ? 120 : rs);
    int cs = c - 8; cs = cs < 0 ? 0 : (cs > 48 ? 48 : cs);
    float q[64], o[64];
    const bf16_t* qp = nq + ((size_t)bh * SEQ + t) * 64;
#pragma unroll
    for (int d = 0; d < 64; ++d) { q[d] = bf2f(qp[d]); o[d] = 0.f; }
    const bf16_t* Kb = nk + (size_t)bh * NKEY * 64; const bf16_t* Vb = nv + (size_t)bh * NKEY * 64;
    float mx = -3.0e38f, l = 0.f;
    for (int kk = 0; kk < 128 + CT; ++kk) {
      int key; float bias = 0.f;
      if (kk < 128) { const int kr_ = rs + (kk >> 4), kc = cs + (kk & 15); key = CT + kr_ * 64 + kc; bias = rpb[(hh * 15 + (kr_ - r + 7)) * 31 + (kc - c + 15)] * LOG2E; }
      else key = kk - 128;
      const bf16_t* kp = Kb + (size_t)key * 64; float s = bias;
#pragma unroll
      for (int d = 0; d < 64; d += 2) { const unsigned w = *(const unsigned*)(kp + d); s += q[d] * __uint_as_float(w << 16) + q[d + 1] * __uint_as_float(w & 0xFFFF0000u); }
      const float mn = fmaxf(mx, s), alpha = exp2f(mx - mn), pe = exp2f(s - mn);
      l = l * alpha + pe; mx = mn;
      const bf16_t* vp = Vb + (size_t)key * 64;
#pragma unroll
      for (int d = 0; d < 64; d += 2) { const unsigned w = *(const unsigned*)(vp + d); o[d] = o[d] * alpha + pe * __uint_as_float(w << 16); o[d + 1] = o[d + 1] * alpha + pe * __uint_as_float(w & 0xFFFF0000u); }
    }
    const float il = 1.f / l;
    bf16_t* op = A + (size_t)(b * SEQ + t) * D + hh * 64;
#pragma unroll
    for (int d = 0; d < 64; d += 2) *(unsigned*)(op + d) = pack2(o[d] * il, o[d + 1] * il);
  }
}

};

enum { PH_PRE = 0, PH_N1_0, PH_G1_0, PH_HA, PH_HB, PH_HC, PH_G2_0, PH_ROUTE_0, PH_MOE1_0, PH_MOE2_0, PH_COMB_0, PH_G1_1, PH_MLAUP, PH_MLA, PH_G2_1, PH_ROUTE_1, PH_MOE1_1, PH_MOE2_1, PH_FINAL, PH_COUNT };

#ifndef PROBE_PHASE
#define PROBE_PHASE (-1)
#endif
__global__ __launch_bounds__(512) void mega(MP p) {
  unsigned long long pt0 = 0, pt1 = 0;
  extern __shared__ __attribute__((aligned(16))) char smem[];
  char* ws = p.ws;
  MK k; k.wv = __builtin_amdgcn_readfirstlane((int)(threadIdx.x >> 6));
  volatile LAS unsigned* xbw = (volatile LAS unsigned*)(smem + LDS_BYTES - 16);
  if (k.tidx() == 0) { xbw[0] = 0u; xbw[1] = 0u; }
  __syncthreads();
  MK::XcdBarrier bar; bar.bar = (unsigned*)(ws + WS_CTL); bar.x = 0; bar.st = xbw;
  if (p.ph_hi - p.ph_lo > 1) bar = k.xcd_barrier_post((unsigned*)(ws + WS_CTL), xbw);
  const float* mods0 = (const float*)(ws + WS_MODS); const float* mods1 = mods0 + 3 * 6144;
  bf16_t* hbuf = (bf16_t*)(ws + WS_H); bf16_t* abuf = (bf16_t*)(ws + WS_A); bf16_t* U = (bf16_t*)(ws + WS_U); float* xc = (float*)(ws + WS_XC);
  if (p.ph_lo <= PH_PRE && PH_PRE < p.ph_hi) { if (PROBE_PHASE == PH_PRE) pt0 = __builtin_amdgcn_s_memrealtime(); k.ph_ada(p, smem); k.ph_conv_small(p, smem); k.ph_conv_moe(p, 0, smem);
    if (PH_PRE + 1 < p.ph_hi) k.xcd_barrier(bar);
    if (PROBE_PHASE == PH_PRE) pt1 = __builtin_amdgcn_s_memrealtime();
  }
  if (p.ph_lo <= PH_N1_0 && PH_N1_0 < p.ph_hi) { if (PROBE_PHASE == PH_N1_0) pt0 = __builtin_amdgcn_s_memrealtime(); k.ph_norm_mod(p.in[0], p.in[2], p.in[6], mods0, 0, 1024, hbuf, MROWS);
    if (PH_N1_0 + 1 < p.ph_hi) k.xcd_barrier(bar);
    if (PROBE_PHASE == PH_N1_0) pt1 = __builtin_amdgcn_s_memrealtime();
  }
  if (p.ph_lo <= PH_G1_0 && PH_G1_0 < p.ph_hi) { if (PROBE_PHASE == PH_G1_0) pt0 = __builtin_amdgcn_s_memrealtime(); { EpiABIn e; e.U = U; e.LF = (float*)(ws + WS_LF); e.lb = (const float*)(ws + WS_LB);
        k.gemm_phase8(hbuf, (const bf16_t*)(ws + WS_WT_ABIN), NLAT, MROWS, 3072, 1024, e, smem, 0, 3072); }
    if (PH_G1_0 + 1 < p.ph_hi) k.xcd_barrier(bar);
    if (PROBE_PHASE == PH_G1_0) pt1 = __builtin_amdgcn_s_memrealtime();
  }
  if (p.ph_lo <= PH_HA && PH_HA < p.ph_hi) { if (PROBE_PHASE == PH_HA) pt0 = __builtin_amdgcn_s_memrealtime(); k.ph_hgrn_a(p, smem); k.ph_pool_prep(U + 5 * (size_t)MROWS * 512, hbuf);
    if (PH_HA + 1 < p.ph_hi) k.xcd_barrier(bar);
    if (PROBE_PHASE == PH_HA) pt1 = __builtin_amdgcn_s_memrealtime();
  }
  if (p.ph_lo <= PH_HB && PH_HB < p.ph_hi) { if (PROBE_PHASE == PH_HB) pt0 = __builtin_amdgcn_s_memrealtime(); k.ph_hgrn_b(p);
    if (PH_HB + 1 < p.ph_hi) k.xcd_barrier(bar);
    if (PROBE_PHASE == PH_HB) pt1 = __builtin_amdgcn_s_memrealtime();
  }
  if (p.ph_lo <= PH_HC && PH_HC < p.ph_hi) { if (PROBE_PHASE == PH_HC) pt0 = __builtin_amdgcn_s_memrealtime(); k.ph_hgrn_c(p, smem);
    for (int tile = (int)gridDim.x - 1 - (int)blockIdx.x; tile < 4 * (MROWS / 256); tile += gridDim.x) { const int gi = tile / (MROWS / 256), mt = tile - gi * (MROWS / 256);
      MK::EpiEach<EpiPool> e; e.e.A = abuf; e.e.scale = p.in[13]; e.e.gi = gi; e.e.pad = 0;
      k.template gemm_tile<4>(hbuf + gi * 128, 512, nullptr, 0, MROWS, (const bf16_t*)(ws + WS_WT_POOL) + (size_t)gi * 128 * 128, 128, 128, mt * 256, 0, smem, e); }
    if (PH_HC + 1 < p.ph_hi) k.xcd_barrier(bar);
    if (PROBE_PHASE == PH_HC) pt1 = __builtin_amdgcn_s_memrealtime();
  }
  if (p.ph_lo <= PH_G2_0 && PH_G2_0 < p.ph_hi) { if (PROBE_PHASE == PH_G2_0) pt0 = __builtin_amdgcn_s_memrealtime(); { EpiOutRes e; e.base_lat = p.in[0]; e.base_ctx = p.in[2]; e.out_lat = p.out; e.out_ctx = xc; e.modl = mods0; e.g_off = 2048; e.pad = 0;
        k.gemm_phase8(abuf, (const bf16_t*)(ws + WS_WT_ABOUT), NLAT, MROWS, 1024, 1024, e, smem, 0, 1024); }
    if (PH_G2_0 + 1 < p.ph_hi) k.xcd_barrier(bar);
    if (PROBE_PHASE == PH_G2_0) pt1 = __builtin_amdgcn_s_memrealtime();
  }
  if (p.ph_lo <= PH_ROUTE_0 && PH_ROUTE_0 < p.ph_hi) { if (PROBE_PHASE == PH_ROUTE_0) pt0 = __builtin_amdgcn_s_memrealtime(); k.ph_router(p, 0, MROWS, smem);
    if (PH_ROUTE_0 + 1 < p.ph_hi) k.xcd_barrier(bar);
    if (PROBE_PHASE == PH_ROUTE_0) pt1 = __builtin_amdgcn_s_memrealtime();
  }
  if (p.ph_lo <= PH_MOE1_0 && PH_MOE1_0 < p.ph_hi) { if (PROBE_PHASE == PH_MOE1_0) pt0 = __builtin_amdgcn_s_memrealtime(); k.ph_moe1g(p, 0, smem);
    if (PH_MOE1_0 + 1 < p.ph_hi) k.xcd_barrier(bar);
    if (PROBE_PHASE == PH_MOE1_0) pt1 = __builtin_amdgcn_s_memrealtime();
  }
  if (p.ph_lo <= PH_MOE2_0 && PH_MOE2_0 < p.ph_hi) { if (PROBE_PHASE == PH_MOE2_0) pt0 = __builtin_amdgcn_s_memrealtime(); k.ph_moe2g(p, 0, smem);
    if (PH_MOE2_0 + 1 < p.ph_hi) k.xcd_barrier(bar);
    if (PROBE_PHASE == PH_MOE2_0) pt1 = __builtin_amdgcn_s_memrealtime();
  }
  if (p.ph_lo <= PH_COMB_0 && PH_COMB_0 < p.ph_hi) { if (PROBE_PHASE == PH_COMB_0) pt0 = __builtin_amdgcn_s_memrealtime(); k.ph_combine(p, 0, MROWS, 0);
    if (PH_COMB_0 + 1 < p.ph_hi) k.xcd_barrier(bar);
    if (PROBE_PHASE == PH_COMB_0) pt1 = __builtin_amdgcn_s_memrealtime();
  }
  if (p.ph_lo <= PH_G1_1 && PH_G1_1 < p.ph_hi) { if (PROBE_PHASE == PH_G1_1) pt0 = __builtin_amdgcn_s_memrealtime(); { EpiCDIn e; e.nq = (bf16_t*)(ws + WS_NQ); e.nk = (bf16_t*)(ws + WS_NK); e.nv = (bf16_t*)(ws + WS_NV); e.cq = (bf16_t*)(ws + WS_CQ); e.ckv = (bf16_t*)(ws + WS_CKV); e.kr = (float*)(ws + WS_KR);
        k.gemm_phase8(hbuf, (const bf16_t*)(ws + WS_WT_CDIN), NLAT, MROWS, 2048, 1024, e, smem, 512, 2048); }
    if (PH_G1_1 + 1 < p.ph_hi) k.xcd_barrier(bar);
    if (PROBE_PHASE == PH_G1_1) pt1 = __builtin_amdgcn_s_memrealtime();
  }
  if (p.ph_lo <= PH_MLAUP && PH_MLAUP < p.ph_hi) { if (PROBE_PHASE == PH_MLAUP) pt0 = __builtin_amdgcn_s_memrealtime(); {
        { MK::EpiMlaQ2 e; e.dq = (bf16_t*)(ws + WS_DQ); e.cq = (const bf16_t*)(ws + WS_CQ); const int ntn = 6;
          for (int tile = blockIdx.x; tile < (NLAT / 256) * ntn; tile += gridDim.x) { const int mt = tile / ntn, nt = tile - mt * ntn;
            k.template gemm_tile<4>(e.cq, 256, nullptr, 0, NLAT, (const bf16_t*)(ws + WS_WT_UQ), 256, 256, mt * 256, nt * 128, smem, e); } }
        { MK::EpiMlaKV2 e; e.dk = (bf16_t*)(ws + WS_DK); e.dv = (bf16_t*)(ws + WS_DV); e.ckv = (const bf16_t*)(ws + WS_CKV); const int ntn = 8;
          for (int tile = blockIdx.x; tile < (MROWS / 256) * ntn; tile += gridDim.x) { const int mt = tile / ntn, nt = tile - mt * ntn;
            k.template gemm_tile<4>(e.ckv, 128, nullptr, 0, MROWS, (const bf16_t*)(ws + WS_WT_UKV), 128, 128, mt * 256, nt * 128, smem, e); } }
        k.ph_kr_rope((const float*)(ws + WS_KR), (bf16_t*)(ws + WS_DK));
      }
    if (PH_MLAUP + 1 < p.ph_hi) k.xcd_barrier(bar);
    if (PROBE_PHASE == PH_MLAUP) pt1 = __builtin_amdgcn_s_memrealtime();
  }
  if (p.ph_lo <= PH_MLA && PH_MLA < p.ph_hi) { if (PROBE_PHASE == PH_MLA) pt0 = __builtin_amdgcn_s_memrealtime(); k.ph_mla(p, smem); k.ph_na(p, smem); k.ph_conv_moe(p, 1, smem);
    if (PH_MLA + 1 < p.ph_hi) k.xcd_barrier(bar);
    if (PROBE_PHASE == PH_MLA) pt1 = __builtin_amdgcn_s_memrealtime();
  }
  if (p.ph_lo <= PH_G2_1 && PH_G2_1 < p.ph_hi) { if (PROBE_PHASE == PH_G2_1) pt0 = __builtin_amdgcn_s_memrealtime(); { EpiOutRes e; e.base_lat = p.out; e.base_ctx = xc; e.out_lat = p.out; e.out_ctx = xc; e.modl = mods1; e.g_off = 2048; e.pad = 0;
        k.gemm_phase8(abuf, (const bf16_t*)(ws + WS_WT_CDOUT), NLAT, NLAT, 1024, 1024, e, smem, 0, 1024); }
    if (PH_G2_1 + 1 < p.ph_hi) k.xcd_barrier(bar);
    if (PROBE_PHASE == PH_G2_1) pt1 = __builtin_amdgcn_s_memrealtime();
  }
  if (p.ph_lo <= PH_ROUTE_1 && PH_ROUTE_1 < p.ph_hi) { if (PROBE_PHASE == PH_ROUTE_1) pt0 = __builtin_amdgcn_s_memrealtime(); k.ph_router(p, 1, NLAT, smem);
    if (PH_ROUTE_1 + 1 < p.ph_hi) k.xcd_barrier(bar);
    if (PROBE_PHASE == PH_ROUTE_1) pt1 = __builtin_amdgcn_s_memrealtime();
  }
  if (p.ph_lo <= PH_MOE1_1 && PH_MOE1_1 < p.ph_hi) { if (PROBE_PHASE == PH_MOE1_1) pt0 = __builtin_amdgcn_s_memrealtime(); k.ph_moe1g(p, 1, smem);
    if (PH_MOE1_1 + 1 < p.ph_hi) k.xcd_barrier(bar);
    if (PROBE_PHASE == PH_MOE1_1) pt1 = __builtin_amdgcn_s_memrealtime();
  }
  if (p.ph_lo <= PH_MOE2_1 && PH_MOE2_1 < p.ph_hi) { if (PROBE_PHASE == PH_MOE2_1) pt0 = __builtin_amdgcn_s_memrealtime(); k.ph_moe2g(p, 1, smem);
    if (PH_MOE2_1 + 1 < p.ph_hi) k.xcd_barrier(bar);
    if (PROBE_PHASE == PH_MOE2_1) pt1 = __builtin_amdgcn_s_memrealtime();
  }
  if (p.ph_lo <= PH_FINAL && PH_FINAL < p.ph_hi) { if (PROBE_PHASE == PH_FINAL) pt0 = __builtin_amdgcn_s_memrealtime(); k.ph_combine(p, 1, NLAT, 1);
    if (PH_FINAL + 1 < p.ph_hi) k.xcd_barrier(bar);
    if (PROBE_PHASE == PH_FINAL) pt1 = __builtin_amdgcn_s_memrealtime();
  }
  if (PROBE_PHASE >= 0 && blockIdx.x == 0) { const unsigned long long te = __builtin_amdgcn_s_memrealtime(), span = (pt1 - pt0) * 8ull; while (__builtin_amdgcn_s_memrealtime() - te < span) __builtin_amdgcn_s_sleep(32); }
}

static void run_phases(hipStream_t st, MP p, int lo, int hi) {
  for (int ph = lo; ph < hi; ++ph) { p.ph_lo = ph; p.ph_hi = ph + 1; hipLaunchKernelGGL(mega, dim3(256), dim3(512), LDS_BYTES, st, p); }
}

extern "C" void kernel_launch(void* const* d_in, const int* in_sizes, int n_in, void* d_out, int out_size, void* d_ws, size_t ws_size, hipStream_t stream) {
  static int ok = 0;
  if (!ok) {
    if (n_in != 29 || in_sizes[0] != NLAT * D || out_size != NLAT * D || ws_size < WS_END) {
      fprintf(stderr, "kernel_launch: unexpected shapes (n_in %d, in0 %d, out %d, ws %zu, need %zu)\n", n_in, n_in > 0 ? in_sizes[0] : -1, out_size, ws_size, (size_t)WS_END);
      return; }
    if (hipFuncSetAttribute((const void*)mega, hipFuncAttributeMaxDynamicSharedMemorySize, LDS_BYTES) != hipSuccess) { fprintf(stderr, "kernel_launch: hipFuncSetAttribute failed\n"); return; }
    ok = 1;
  }
  char* ws = (char*)d_ws; float* out = (float*)d_out;
  MP p; memset(&p, 0, sizeof(p));
  for (int i = 0; i < 29; ++i) p.in[i] = (const float*)d_in[i];
  p.out = out; p.ws = ws;
  hipMemsetAsync(ws + WS_CTL, 0, WS_MODS + 2 * 3 * 6144 * 4, stream);
  float* odir_ctx = (float*)(ws + WS_ODIR_CTX);
  bf16_t* abuf = (bf16_t*)(ws + WS_A); bf16_t* U = (bf16_t*)(ws + WS_U); float* LF = (float*)(ws + WS_LF);
  bf16_t* nq = (bf16_t*)(ws + WS_NQ); bf16_t* nk = (bf16_t*)(ws + WS_NK); bf16_t* nv = (bf16_t*)(ws + WS_NV);
  bf16_t* dq = (bf16_t*)(ws + WS_DQ); bf16_t* dk = (bf16_t*)(ws + WS_DK); bf16_t* dv = (bf16_t*)(ws + WS_DV);

  p.ph_lo = 0; p.ph_hi = PH_COUNT;
  void* args[] = {&p};
  const hipError_t le = hipLaunchCooperativeKernel((const void*)mega, dim3(256), dim3(512), args, LDS_BYTES, stream);
  if (le != hipSuccess) fprintf(stderr, "kernel_launch: cooperative launch failed: %s\n", hipGetErrorString(le));
}
```

```cpp
#include <hip/hip_runtime.h>
#include <stdint.h>
#include <cstdio>
#include <cstring>

typedef unsigned short bf16_t;
typedef float f32x4 __attribute__((ext_vector_type(4)));

constexpr int D = 1024, NB = 2, SEQ = 8192, CT = 256;
constexpr int NLAT = NB * SEQ;
constexpr int NCTX = NB * CT;
constexpr int MROWS = NLAT + NCTX;
constexpr int NKEY = CT + SEQ;
constexpr float EPS = 1e-6f;
constexpr float LOG2E = 1.4426950408889634f;
constexpr float NA_QSCALE = 0.125f * LOG2E;
constexpr float MLA_QSCALE = 0.10206207261596577f * LOG2E;

constexpr size_t alignup(size_t x) { return (x + 255) & ~(size_t)255; }
constexpr size_t WS_CTL      = 0;
constexpr size_t WS_MODS     = 65536;
constexpr size_t WS_LB       = WS_MODS + alignup(2 * 3 * 6144 * 4);
constexpr size_t WS_XC       = WS_LB + 4096;
constexpr size_t WS_ROUTE_E  = WS_XC + (size_t)NCTX * D * 4;
constexpr size_t WS_ROUTE_W  = WS_ROUTE_E + alignup((size_t)MROWS * 2 * 4);
constexpr size_t WS_RSTD_Q   = WS_ROUTE_W + alignup((size_t)MROWS * 2 * 4);
constexpr size_t WS_RSTD_KV  = WS_RSTD_Q + alignup((size_t)NLAT * 4);
constexpr size_t WS_ODIR_CTX = WS_RSTD_KV + alignup((size_t)MROWS * 4);
constexpr size_t WS_LIST     = WS_ODIR_CTX + (size_t)2 * NCTX * 512 * 4;
constexpr size_t WS_ALAST    = WS_LIST + (size_t)32 * MROWS * 4;
constexpr size_t WS_WT_ABIN  = WS_ALAST + (size_t)2 * (MROWS / 64) * 512 * 4;
constexpr size_t WS_WT_ABOUT = WS_WT_ABIN + (size_t)3072 * 1024 * 2;
constexpr size_t WS_WT_CDIN  = WS_WT_ABOUT + (size_t)1024 * 1024 * 2;
constexpr size_t WS_WT_CDOUT = WS_WT_CDIN + (size_t)2048 * 1024 * 2;
constexpr size_t WS_WT_UQ    = WS_WT_CDOUT + (size_t)1024 * 1024 * 2;
constexpr size_t WS_WT_UKV   = WS_WT_UQ + (size_t)768 * 256 * 2;
constexpr size_t WS_WT_POOL  = WS_WT_UKV + (size_t)1024 * 128 * 2;
constexpr size_t WS_WMOE     = WS_WT_POOL + (size_t)4 * 128 * 128 * 2;
constexpr size_t WS_H        = WS_WMOE + (size_t)32 * 512 * 1024 * 2 + (size_t)32 * 1024 * 256 * 2;
constexpr size_t WS_A        = WS_H + (size_t)MROWS * D * 2;
constexpr size_t WS_U        = WS_A + (size_t)MROWS * D * 2;
constexpr size_t USLOT       = (size_t)MROWS * 512 * 2;
constexpr size_t WS_LF       = WS_U + 6 * USLOT;
constexpr size_t WS_END      = WS_LF + (size_t)2 * MROWS * 512 * 4;
constexpr size_t WS_NQ   = WS_U;
constexpr size_t WS_NK   = WS_NQ + (size_t)NLAT * 512 * 2;
constexpr size_t WS_NV   = WS_NK + USLOT;
constexpr size_t WS_CQ   = WS_NV + USLOT;
constexpr size_t WS_CKV  = WS_CQ + (size_t)NLAT * 256 * 2;
constexpr size_t WS_KR   = WS_CKV + (size_t)MROWS * 128 * 2;
constexpr size_t WS_DQ   = WS_KR + (size_t)MROWS * 32 * 4;
constexpr size_t WS_L1END = WS_DQ + (size_t)NLAT * 768 * 2;
static_assert(WS_L1END <= WS_LF, "layer-1 overlay too big");
constexpr size_t WS_DK   = WS_LF;
constexpr size_t WS_DV   = WS_DK + (size_t)MROWS * 1024 * 2;
static_assert(WS_DV + (size_t)MROWS * 512 * 2 <= WS_END, "dk/dv overlay too big");
constexpr size_t WS_YBUF = WS_LF;
constexpr size_t WS_AMOE = WS_U;

__device__ __forceinline__ float bf2f(bf16_t h) { return __uint_as_float(((unsigned)h) << 16); }
__device__ __forceinline__ unsigned pack2(float a, float b) { unsigned r; asm("v_cvt_pk_bf16_f32 %0, %1, %2" : "=v"(r) : "v"(a), "v"(b)); return r; }
__device__ __forceinline__ bf16_t f2bf(float f) { return (bf16_t)(pack2(f, 0.f) & 0xFFFFu); }
__device__ __forceinline__ float sigmoidf_(float x) { return __builtin_amdgcn_rcpf(1.f + __expf(-x)); }
__device__ __forceinline__ float siluf_(float x) { return x * __builtin_amdgcn_rcpf(1.f + __expf(-x)); }
__device__ __forceinline__ float wave_sum(float v) {
#pragma unroll
  for (int o = 1; o < 64; o <<= 1) v += __shfl_xor(v, o);
  return v;
}
__device__ __forceinline__ int row_vec(int m) { return m < NLAT ? (m >> 13) : 2; }
__device__ __forceinline__ void row_bkey(int m, int& b, int& key) {
  if (m < NLAT) { b = m >> 13; key = CT + (m & 8191); } else { const int mm = m - NLAT; b = mm >> 8; key = mm & 255; }
}

__global__ __launch_bounds__(512) void k_ada(const float* __restrict__ c, const float* __restrict__ cctx, const float* __restrict__ ada_w,
                                             const float* __restrict__ ada_b, float* __restrict__ mods) {
  const int l = blockIdx.y, n0 = blockIdx.x * 64, j = threadIdx.x & 63, kg = threadIdx.x >> 6;
  __shared__ float sv[3][1024];
  __shared__ float red[8][3][64];
  for (int i = threadIdx.x; i < 1024; i += 512) { sv[0][i] = siluf_(c[i]); sv[1][i] = siluf_(c[1024 + i]); sv[2][i] = siluf_(cctx[i]); }
  __syncthreads();
  const float* W = ada_w + (size_t)l * 1024 * 6144 + n0 + j;
  float a0 = 0.f, a1 = 0.f, a2 = 0.f;
  for (int k = kg * 128; k < kg * 128 + 128; ++k) { const float w = W[(size_t)k * 6144]; a0 += sv[0][k] * w; a1 += sv[1][k] * w; a2 += sv[2][k] * w; }
  red[kg][0][j] = a0; red[kg][1][j] = a1; red[kg][2][j] = a2;
  __syncthreads();
  if (threadIdx.x < 192) {
    const int v = threadIdx.x >> 6, jj = threadIdx.x & 63; float s = 0.f;
    for (int g = 0; g < 8; ++g) s += red[g][v][jj];
    mods[(size_t)(l * 3 + v) * 6144 + n0 + jj] = s + ada_b[l * 6144 + n0 + jj];
  }
}
__global__ void k_lb(const float* __restrict__ logits, float* __restrict__ lb) {
  const int i = blockIdx.x * blockDim.x + threadIdx.x;
  if (i < 1024) { const int d = i >> 9, cc = i & 511; const float l0 = logits[(d * 2 + 0) * 512 + cc], l1 = logits[(d * 2 + 1) * 512 + cc]; lb[i] = 1.f / (1.f + expf(l1 - l0)); }
}

struct ConvArgs { const float* src; bf16_t* dst; const float* kscale; int K, N, Npad, mode; size_t sbs, dbs; };
__device__ __forceinline__ int moe_gu_row(int sel, int hidden) {
  return (hidden >> 4) * 32 + sel * 16 + (hidden & 15);
}
__global__ __launch_bounds__(512) void k_convT(ConvArgs a) {
  __shared__ float tile[64][65];
  const float* src = a.src + blockIdx.z * a.sbs; bf16_t* dst = a.dst + blockIdx.z * a.dbs;
  const int n0 = blockIdx.x * 64, k0 = blockIdx.y * 64, tx = threadIdx.x & 63, ty = threadIdx.x >> 6;
#pragma unroll
  for (int i = 0; i < 8; ++i) {
    const int k = k0 + ty + 8 * i, n = n0 + tx; float v = 0.f;
    if (n < a.N) { v = src[(size_t)k * a.N + n]; if (a.kscale) v *= a.kscale[k]; }
    tile[ty + 8 * i][tx] = v;
  }
  __syncthreads();
#pragma unroll
  for (int i = 0; i < 8; ++i) {
    const int nl = ty + 8 * i, n = n0 + nl;
    if (n < a.Npad) { int row = n; if (a.mode == 1) row = moe_gu_row(0, n); else if (a.mode == 2) row = moe_gu_row(1, n);
      dst[(size_t)row * a.K + k0 + tx] = f2bf(tile[tx][nl]); }
  }
}

__global__ __launch_bounds__(512) void k_norm_mod(const float* __restrict__ lat, const float* __restrict__ ctxr, const float* __restrict__ gain,
                                                  const float* __restrict__ modl, int sh_off, int sc_off, bf16_t* __restrict__ out, int nrows) {
  const int lane = threadIdx.x & 63, gw = blockIdx.x * 8 + (threadIdx.x >> 6);
  for (int row = gw; row < nrows; row += gridDim.x * 8) {
    const float* src = row < NLAT ? lat + (size_t)row * D : ctxr + (size_t)(row - NLAT) * D;
    const float* mv = modl + row_vec(row) * 6144;
    f32x4 x[4]; float ss = 0.f;
#pragma unroll
    for (int j = 0; j < 4; ++j) { x[j] = ((const f32x4*)src)[lane + 64 * j]; ss += x[j].x * x[j].x + x[j].y * x[j].y + x[j].z * x[j].z + x[j].w * x[j].w; }
    const float rstd = 1.f / sqrtf(wave_sum(ss) * (1.f / D) + EPS);
#pragma unroll
    for (int j = 0; j < 4; ++j) {
      const int n = (lane + 64 * j) * 4;
      const f32x4 g = *(const f32x4*)(gain + n), sc = *(const f32x4*)(mv + sc_off + n), sh = *(const f32x4*)(mv + sh_off + n);
      const f32x4 h = x[j] * rstd * g * (sc + 1.f) + sh;
      uint2 o; o.x = pack2(h.x, h.y); o.y = pack2(h.z, h.w);
      *(uint2*)(out + (size_t)row * D + n) = o;
    }
  }
}

struct EpiABIn {
  bf16_t* U; float* LF; const float* lb;
  __device__ __forceinline__ void apply(int m, int n, f32x4 v) const {
    const int seg = n >> 9, cn = n & 511; float o[4] = {v.x, v.y, v.z, v.w};
    bf16_t* dst;
    if (seg == 0) { dst = U; for (int i = 0; i < 4; ++i) o[i] = siluf_(o[i]); }
    else if (seg == 1 || seg == 2) { const int d = seg - 1; dst = U + (size_t)(1 + d) * MROWS * 512;
      f32x4 lg;
#pragma unroll
      for (int i = 0; i < 4; ++i) { const float l = lb[d * 512 + cn + i]; const float k = (1.f - l) * sigmoidf_(-o[i]); o[i] = k; lg[i] = __logf(1.f - k); }
      *(f32x4*)(LF + ((size_t)d * MROWS + m) * 512 + cn) = lg; }
    else if (seg == 3) dst = U + (size_t)3 * MROWS * 512;
    else if (seg == 4) { dst = U + (size_t)4 * MROWS * 512; for (int i = 0; i < 4; ++i) o[i] = siluf_(o[i]); }
    else dst = U + (size_t)5 * MROWS * 512;
    uint2 w; w.x = pack2(o[0], o[1]); w.y = pack2(o[2], o[3]);
    *(uint2*)(dst + (size_t)m * 512 + cn) = w;
  }
};
struct EpiPool {
  bf16_t* A; const float* scale; int gi; int pad;
  __device__ __forceinline__ void apply(int m, int n, f32x4 v) const {
    const int cn = gi * 128 + n; const f32x4 s = *(const f32x4*)(scale + cn); v = v * s;
    uint2 w; w.x = pack2(v.x, v.y); w.y = pack2(v.z, v.w);
    *(uint2*)(A + (size_t)m * D + 512 + cn) = w;
  }
};
struct EpiOutRes {
  const float* base_lat; const float* base_ctx; float* out_lat; float* out_ctx; const float* modl; int g_off; int pad;
  __device__ __forceinline__ void apply(int m, int n, f32x4 v) const {
    const f32x4 g = *(const f32x4*)(modl + row_vec(m) * 6144 + g_off + n);
    if (m < NLAT) { const f32x4 b = *(const f32x4*)(base_lat + (size_t)m * D + n); *(f32x4*)(out_lat + (size_t)m * D + n) = b + g * v; }
    else { const size_t o = (size_t)(m - NLAT) * D + n; const f32x4 b = *(const f32x4*)(base_ctx + o); *(f32x4*)(out_ctx + o) = b + g * v; }
  }
};
struct EpiCDIn {
  bf16_t *nq, *nk, *nv, *cq, *ckv; float* kr;
  __device__ __forceinline__ void apply(int m, int n, f32x4 v) const {
    int b, key; row_bkey(m, b, key);
    if (n < 1536) {
      const int which = n >> 9, hh = (n & 511) >> 6, dd = n & 63;
      if (which == 0) { if (m >= NLAT) return; v = v * NA_QSCALE;
        uint2 w; w.x = pack2(v.x, v.y); w.y = pack2(v.z, v.w);
        *(uint2*)(nq + (((size_t)(b * 8 + hh) * SEQ + (m & 8191)) * 64 + dd)) = w; }
      else { bf16_t* dst = which == 1 ? nk : nv; uint2 w; w.x = pack2(v.x, v.y); w.y = pack2(v.z, v.w);
        *(uint2*)(dst + (((size_t)(b * 8 + hh) * NKEY + key) * 64 + dd)) = w; }
    } else if (n < 1792) { if (m >= NLAT) return; uint2 w; w.x = pack2(v.x, v.y); w.y = pack2(v.z, v.w); *(uint2*)(cq + (size_t)m * 256 + (n - 1536)) = w; }
    else if (n < 1920) { uint2 w; w.x = pack2(v.x, v.y); w.y = pack2(v.z, v.w); *(uint2*)(ckv + (size_t)m * 128 + (n - 1792)) = w; }
    else if (n < 1952) { *(f32x4*)(kr + (size_t)m * 32 + (n - 1920)) = v; }
  }
};
struct EpiMlaQ {
  bf16_t* dq; const float* rstd;
  __device__ __forceinline__ void apply(int m, int n, f32x4 v) const {
    const int hh = n / 96, off = n - hh * 96; v = v * (rstd[m] * MLA_QSCALE);
    uint2 w; w.x = pack2(v.x, v.y); w.y = pack2(v.z, v.w);
    *(uint2*)(dq + (((size_t)((m >> 13) * 8 + hh) * SEQ + (m & 8191)) * 96 + off)) = w;
  }
};
struct EpiMlaKV {
  bf16_t *dk, *dv; const float* rstd;
  __device__ __forceinline__ void apply(int m, int n, f32x4 v) const {
    int b, key; row_bkey(m, b, key);
    const int hh = n >> 7, off = n & 127; v = v * rstd[m];
    uint2 w; w.x = pack2(v.x, v.y); w.y = pack2(v.z, v.w);
    if (off < 64) *(uint2*)(dk + (((size_t)(b * 8 + hh) * NKEY + key) * 128 + off)) = w;
    else *(uint2*)(dv + (((size_t)(b * 8 + hh) * NKEY + key) * 64 + (off - 64))) = w;
  }
};

template <class Epi>
__global__ __launch_bounds__(256) void k_gemm_naive(const bf16_t* __restrict__ A, int lda, const bf16_t* __restrict__ Bt, int ldb, int M, int N, int K, Epi epi) {
  __shared__ float As[32][68];
  __shared__ float Bs[32][68];
  const int m0 = blockIdx.y * 64, n0 = blockIdx.x * 64, t = threadIdx.x, tx = t & 15, ty = t >> 4;
  float acc[4][4];
#pragma unroll
  for (int i = 0; i < 4; ++i)
#pragma unroll
    for (int j = 0; j < 4; ++j) acc[i][j] = 0.f;
  const int lr = t >> 2, lk = (t & 3) * 8;
  for (int k0 = 0; k0 < K; k0 += 32) {
    uint4 ra = make_uint4(0, 0, 0, 0), rb = make_uint4(0, 0, 0, 0);
    if (m0 + lr < M) ra = *(const uint4*)(A + (size_t)(m0 + lr) * lda + k0 + lk);
    if (n0 + lr < N) rb = *(const uint4*)(Bt + (size_t)(n0 + lr) * ldb + k0 + lk);
    const unsigned wa[4] = {ra.x, ra.y, ra.z, ra.w}, wb[4] = {rb.x, rb.y, rb.z, rb.w};
#pragma unroll
    for (int i = 0; i < 4; ++i) {
      As[lk + 2 * i][lr] = __uint_as_float(wa[i] << 16); As[lk + 2 * i + 1][lr] = __uint_as_float(wa[i] & 0xFFFF0000u);
      Bs[lk + 2 * i][lr] = __uint_as_float(wb[i] << 16); Bs[lk + 2 * i + 1][lr] = __uint_as_float(wb[i] & 0xFFFF0000u);
    }
    __syncthreads();
#pragma unroll 8
    for (int kk = 0; kk < 32; ++kk) {
      const f32x4 a = *(const f32x4*)&As[kk][ty * 4], b = *(const f32x4*)&Bs[kk][tx * 4];
      const float av[4] = {a.x, a.y, a.z, a.w}, bv[4] = {b.x, b.y, b.z, b.w};
#pragma unroll
      for (int i = 0; i < 4; ++i)
#pragma unroll
        for (int j = 0; j < 4; ++j) acc[i][j] += av[i] * bv[j];
    }
    __syncthreads();
  }
#pragma unroll
  for (int i = 0; i < 4; ++i) {
    const int m = m0 + ty * 4 + i, n = n0 + tx * 4;
    if (m < M && n < N) { f32x4 v = {acc[i][0], acc[i][1], acc[i][2], acc[i][3]}; epi.apply(m, n, v); }
  }
}
template <class Epi>
static void launch_gemm_naive(hipStream_t st, const bf16_t* A, int lda, const bf16_t* Bt, int ldb, int M, int N, int K, Epi epi) {
  hipLaunchKernelGGL((k_gemm_naive<Epi>), dim3((N + 63) / 64, (M + 63) / 64), dim3(256), 0, st, A, lda, Bt, ldb, M, N, K, epi);
}

__device__ __forceinline__ int hgrn_step_row(int b, int dir, int s) {
  if (s < CT) return NLAT + b * CT + (dir ? (CT - 1 - s) : s);
  const int ls = s - CT; return b * SEQ + (dir ? (SEQ - 1 - ls) : ls);
}
__global__ __launch_bounds__(128) void k_hgrn_naive(const bf16_t* __restrict__ U, const float* __restrict__ LF, float* __restrict__ odir_lat, float* __restrict__ odir_ctx) {
  const int bid = blockIdx.x, dir = bid & 1, h = (bid >> 1) & 3, b = bid >> 3, e = threadIdx.x;
  __shared__ float sf[32][128];
  __shared__ float sk[32][128];
  __shared__ float sq[32][128];
  float Sreg[128];
#pragma unroll
  for (int d = 0; d < 128; ++d) Sreg[d] = 0.f;
  const bf16_t* Uq = U; const bf16_t* Uk = U + (size_t)(1 + dir) * MROWS * 512; const bf16_t* Uv = U + (size_t)3 * MROWS * 512;
  const float* lf = LF + (size_t)dir * MROWS * 512;
  for (int s0 = 0; s0 < NKEY; s0 += 32) {
    __syncthreads();
    for (int i = 0; i < 32; ++i) {
      const size_t off = (size_t)hgrn_step_row(b, dir, s0 + i) * 512 + h * 128 + e;
      sf[i][e] = expf(lf[off]); sk[i][e] = bf2f(Uk[off]); sq[i][e] = bf2f(Uq[off]);
    }
    __syncthreads();
    for (int i = 0; i < 32; ++i) {
      const int row = hgrn_step_row(b, dir, s0 + i);
      const float v = bf2f(Uv[(size_t)row * 512 + h * 128 + e]); float o = 0.f;
#pragma unroll
      for (int d = 0; d < 128; ++d) { Sreg[d] = sf[i][d] * Sreg[d] + sk[i][d] * v; o += Sreg[d] * sq[i][d]; }
      if (row < NLAT) odir_lat[((size_t)dir * NLAT + row) * 512 + h * 128 + e] = o;
      else odir_ctx[((size_t)dir * NCTX + (row - NLAT)) * 512 + h * 128 + e] = o;
    }
  }
}
__global__ __launch_bounds__(512) void k_hgrn_out(const float* __restrict__ odir_lat, const float* __restrict__ odir_ctx, const bf16_t* __restrict__ Ug,
                                                  const float* __restrict__ onorm_g, bf16_t* __restrict__ A) {
  const int lane = threadIdx.x & 63, gw = blockIdx.x * 8 + (threadIdx.x >> 6);
  for (int row = gw; row < MROWS; row += gridDim.x * 8) {
    const float* pf = row < NLAT ? odir_lat + (size_t)row * 512 : odir_ctx + (size_t)(row - NLAT) * 512;
    const float* pb = row < NLAT ? odir_lat + ((size_t)NLAT + row) * 512 : odir_ctx + ((size_t)NCTX + (row - NLAT)) * 512;
    const int c0 = lane * 8; float o[8]; float ss = 0.f;
#pragma unroll
    for (int i = 0; i < 8; ++i) { o[i] = pf[c0 + i] + pb[c0 + i]; ss += o[i] * o[i]; }
    ss += __shfl_xor(ss, 1); ss += __shfl_xor(ss, 2); ss += __shfl_xor(ss, 4); ss += __shfl_xor(ss, 8);
    const float rstd = 1.f / sqrtf(ss * (1.f / 128.f) + EPS);
    const uint4 gr = *(const uint4*)(Ug + (size_t)row * 512 + c0); const unsigned gw4[4] = {gr.x, gr.y, gr.z, gr.w};
    unsigned w[4];
#pragma unroll
    for (int i = 0; i < 4; ++i) {
      const float g0 = __uint_as_float(gw4[i] << 16), g1 = __uint_as_float(gw4[i] & 0xFFFF0000u);
      const int e0 = (c0 + 2 * i) & 127;
      w[i] = pack2(o[2 * i] * rstd * onorm_g[e0] * g0, o[2 * i + 1] * rstd * onorm_g[e0 + 1] * g1);
    }
    *(uint4*)(A + (size_t)row * D + c0) = make_uint4(w[0], w[1], w[2], w[3]);
  }
}
__global__ __launch_bounds__(512) void k_pool_prep(const bf16_t* __restrict__ Up, bf16_t* __restrict__ pd) {
  const int c = threadIdx.x;
  for (int row = blockIdx.x; row < MROWS; row += gridDim.x) {
    int base, t, n; if (row < NLAT) { base = row & ~8191; t = row & 8191; n = SEQ; } else { const int mm = row - NLAT; base = NLAT + (mm & ~255); t = mm & 255; n = CT; }
    const int gi = c >> 7, win = 2 << gi; int lo = t - win / 2, hi = t + win - win / 2; lo = lo < 0 ? 0 : lo; hi = hi > n ? n : hi;
    float s = 0.f; for (int r = lo; r < hi; ++r) s += bf2f(Up[(size_t)(base + r) * 512 + c]);
    pd[(size_t)row * 512 + c] = f2bf(s / (float)(hi - lo) - bf2f(Up[(size_t)row * 512 + c]));
  }
}

__global__ __launch_bounds__(512) void k_router(const float* __restrict__ lat, const float* __restrict__ ctxr, const float* __restrict__ gain, const float* __restrict__ modl,
                                                const float* __restrict__ wrg, const float* __restrict__ brg, const float* __restrict__ wre, const float* __restrict__ bre,
                                                bf16_t* __restrict__ out, int* __restrict__ re, float* __restrict__ rw, int nrows) {
  __shared__ float hs[8][1024];
  const int lane = threadIdx.x & 63, wv = threadIdx.x >> 6, gw = blockIdx.x * 8 + wv;
  const float* wp = lane < 4 ? wrg + lane : wre + ((lane - 4) & 31); const int wst = lane < 4 ? 4 : 32;
  const float bias = lane < 4 ? brg[lane] : bre[(lane - 4) & 31];
  for (int row = gw; row < nrows; row += gridDim.x * 8) {
    const float* src = row < NLAT ? lat + (size_t)row * D : ctxr + (size_t)(row - NLAT) * D;
    const float* mv = modl + row_vec(row) * 6144;
    f32x4 x[4]; float ss = 0.f;
#pragma unroll
    for (int j = 0; j < 4; ++j) { x[j] = ((const f32x4*)src)[lane + 64 * j]; ss += x[j].x * x[j].x + x[j].y * x[j].y + x[j].z * x[j].z + x[j].w * x[j].w; }
    const float rstd = 1.f / sqrtf(wave_sum(ss) * (1.f / D) + EPS);
#pragma unroll
    for (int j = 0; j < 4; ++j) {
      const int n = (lane + 64 * j) * 4;
      const f32x4 g = *(const f32x4*)(gain + n), sc = *(const f32x4*)(mv + 4096 + n), sh = *(const f32x4*)(mv + 3072 + n);
      const f32x4 h = x[j] * rstd * g * (sc + 1.f) + sh;
      uint2 o; o.x = pack2(h.x, h.y); o.y = pack2(h.z, h.w);
      *(uint2*)(out + (size_t)row * D + n) = o;
      *(f32x4*)&hs[wv][n] = h;
    }
    __builtin_amdgcn_wave_barrier();
    float acc = 0.f;
#pragma unroll 8
    for (int k = 0; k < 1024; ++k) acc += hs[wv][k] * wp[(size_t)k * wst];
    acc += bias;
    __builtin_amdgcn_wave_barrier();
    float gl[4];
#pragma unroll
    for (int i = 0; i < 4; ++i) gl[i] = __shfl(acc, i);
    int gi = 0; float gm = gl[0];
#pragma unroll
    for (int i = 1; i < 4; ++i) if (gl[i] > gm) { gm = gl[i]; gi = i; }
    float gs = 0.f;
#pragma unroll
    for (int i = 0; i < 4; ++i) gs += expf(gl[i] - gm);
    const float gp = 1.f / gs;
    float el[8];
#pragma unroll
    for (int i = 0; i < 8; ++i) el[i] = __shfl(acc, 4 + gi * 8 + i);
    int e1 = 0; float m1 = el[0];
#pragma unroll
    for (int i = 1; i < 8; ++i) if (el[i] > m1) { m1 = el[i]; e1 = i; }
    int e2 = 0; float m2 = -3.0e38f;
#pragma unroll
    for (int i = 0; i < 8; ++i) if (i != e1 && el[i] > m2) { m2 = el[i]; e2 = i; }
    const float w1 = 1.f / (1.f + expf(m2 - m1)), w2 = 1.f - w1;
    if (lane == 0) { re[row * 2] = gi * 8 + e1; re[row * 2 + 1] = gi * 8 + e2; rw[row * 2] = gp * w1; rw[row * 2 + 1] = gp * w2; }
  }
}

__global__ __launch_bounds__(256) void k_moe_naive(const bf16_t* __restrict__ H, const int* __restrict__ re, const float* __restrict__ rw,
                                                   const float* __restrict__ Wg, const float* __restrict__ Wu, const float* __restrict__ Wd, bf16_t* __restrict__ Y) {
  const int row = blockIdx.x, f = threadIdx.x;
  __shared__ float hs[1024];
  __shared__ float as_[256];
  for (int i = f; i < 1024; i += 256) hs[i] = bf2f(H[(size_t)row * D + i]);
  __syncthreads();
  for (int slot = 0; slot < 2; ++slot) {
    const int e = re[row * 2 + slot]; const float w = rw[row * 2 + slot];
    const float* wg = Wg + (size_t)e * 1024 * 256 + f; const float* wu = Wu + (size_t)e * 1024 * 256 + f;
    float g = 0.f, u = 0.f;
#pragma unroll 8
    for (int k = 0; k < 1024; ++k) { g += hs[k] * wg[(size_t)k * 256]; u += hs[k] * wu[(size_t)k * 256]; }
    as_[f] = siluf_(g) * u * w;
    __syncthreads();
    const float* wd = Wd + (size_t)e * 256 * 1024;
    float y[4] = {0.f, 0.f, 0.f, 0.f};
#pragma unroll 4
    for (int k = 0; k < 256; ++k) { const float a = as_[k];
#pragma unroll
      for (int i = 0; i < 4; ++i) y[i] += a * wd[(size_t)k * 1024 + f + 256 * i]; }
#pragma unroll
    for (int i = 0; i < 4; ++i) Y[((size_t)row * 2 + slot) * D + f + 256 * i] = f2bf(y[i]);
    __syncthreads();
  }
}

__global__ __launch_bounds__(512) void k_combine_norm(float* __restrict__ lat, float* __restrict__ ctxr, const bf16_t* __restrict__ Y, const float* __restrict__ modl_cur,
                                                      const float* __restrict__ gain, const float* __restrict__ modl_next, bf16_t* __restrict__ hout, int nrows, int final_) {
  const int lane = threadIdx.x & 63, gw = blockIdx.x * 8 + (threadIdx.x >> 6);
  for (int row = gw; row < nrows; row += gridDim.x * 8) {
    float* src = row < NLAT ? lat + (size_t)row * D : ctxr + (size_t)(row - NLAT) * D;
    const int v = row_vec(row);
    f32x4 x[4]; float ss = 0.f;
#pragma unroll
    for (int j = 0; j < 4; ++j) {
      const int n = (lane + 64 * j) * 4;
      const f32x4 g2 = *(const f32x4*)(modl_cur + v * 6144 + 5120 + n);
      const uint2 y0 = *(const uint2*)(Y + ((size_t)row * 2) * D + n), y1 = *(const uint2*)(Y + ((size_t)row * 2 + 1) * D + n);
      f32x4 ys;
      ys.x = __uint_as_float(y0.x << 16) + __uint_as_float(y1.x << 16); ys.y = __uint_as_float(y0.x & 0xFFFF0000u) + __uint_as_float(y1.x & 0xFFFF0000u);
      ys.z = __uint_as_float(y0.y << 16) + __uint_as_float(y1.y << 16); ys.w = __uint_as_float(y0.y & 0xFFFF0000u) + __uint_as_float(y1.y & 0xFFFF0000u);
      x[j] = ((const f32x4*)src)[lane + 64 * j] + g2 * ys;
      ss += x[j].x * x[j].x + x[j].y * x[j].y + x[j].z * x[j].z + x[j].w * x[j].w;
    }
    const float rstd = 1.f / sqrtf(wave_sum(ss) * (1.f / D) + EPS);
#pragma unroll
    for (int j = 0; j < 4; ++j) {
      const int n = (lane + 64 * j) * 4;
      const f32x4 g = *(const f32x4*)(gain + n);
      if (final_) { ((f32x4*)src)[lane + 64 * j] = x[j] * rstd * g; }
      else {
        ((f32x4*)src)[lane + 64 * j] = x[j];
        const f32x4 sc = *(const f32x4*)(modl_next + v * 6144 + 1024 + n), sh = *(const f32x4*)(modl_next + v * 6144 + n);
        const f32x4 h = x[j] * rstd * g * (sc + 1.f) + sh;
        uint2 o; o.x = pack2(h.x, h.y); o.y = pack2(h.z, h.w);
        *(uint2*)(hout + (size_t)row * D + n) = o;
      }
    }
  }
}

__global__ __launch_bounds__(512) void k_rowssq(const bf16_t* __restrict__ cq, const bf16_t* __restrict__ ckv, float* __restrict__ rq, float* __restrict__ rkv) {
  const int lane = threadIdx.x & 63, gw = blockIdx.x * 8 + (threadIdx.x >> 6);
  for (int row = gw; row < MROWS; row += gridDim.x * 8) {
    { const unsigned w = *(const unsigned*)(ckv + (size_t)row * 128 + lane * 2); const float a = __uint_as_float(w << 16), b = __uint_as_float(w & 0xFFFF0000u);
      const float ss = wave_sum(a * a + b * b); if (lane == 0) rkv[row] = 1.f / sqrtf(ss * (1.f / 128.f) + EPS); }
    if (row < NLAT) { const uint2 w = *(const uint2*)(cq + (size_t)row * 256 + lane * 4);
      const float a = __uint_as_float(w.x << 16), b = __uint_as_float(w.x & 0xFFFF0000u), c = __uint_as_float(w.y << 16), d = __uint_as_float(w.y & 0xFFFF0000u);
      const float ss = wave_sum(a * a + b * b + c * c + d * d); if (lane == 0) rq[row] = 1.f / sqrtf(ss * (1.f / 256.f) + EPS); }
  }
}
__device__ __forceinline__ float rope_inv(int i) { return exp2f(-(float)i * (13.287712379549449f / 8.f)); }
__global__ __launch_bounds__(256) void k_kr_rope(const float* __restrict__ kr, bf16_t* __restrict__ dk) {
  const int idx = blockIdx.x * 256 + threadIdx.x; if (idx >= MROWS * 32) return;
  const int m = idx >> 5, j = idx & 31; int b, key; row_bkey(m, b, key);
  float val = kr[idx];
  if (m < NLAT) {
    const int t = m & 8191; const int half = j >> 4, jj = j & 15, i = jj & 7;
    const float pos = half ? (float)(t & 63) : (float)(t >> 6);
    const float ang = pos * rope_inv(i); float sn, cs; sincosf(ang, &sn, &cs);
    const float x1 = kr[(size_t)m * 32 + half * 16 + i], x2 = kr[(size_t)m * 32 + half * 16 + 8 + i];
    val = (jj < 8) ? (x1 * cs - x2 * sn) : (x1 * sn + x2 * cs);
  }
  const bf16_t o = f2bf(val);
#pragma unroll
  for (int hh = 0; hh < 8; ++hh) dk[((size_t)(b * 8 + hh) * NKEY + key) * 128 + 64 + j] = o;
}

__global__ __launch_bounds__(64) void k_na_naive(const bf16_t* __restrict__ nq, const bf16_t* __restrict__ nk, const bf16_t* __restrict__ nv, const float* __restrict__ rpb,
                                                 bf16_t* __restrict__ A) {
  const int t = blockIdx.x * 64 + threadIdx.x, hh = blockIdx.y, b = blockIdx.z;
  const int r = t >> 6, c = t & 63;
  int rs = r - 4; rs = rs < 0 ? 0 : (rs > 120 ? 120 : rs);
  int cs = c - 8; cs = cs < 0 ? 0 : (cs > 48 ? 48 : cs);
  float q[64], o[64];
  const bf16_t* qp = nq + ((size_t)(b * 8 + hh) * SEQ + t) * 64;
#pragma unroll
  for (int d = 0; d < 64; ++d) { q[d] = bf2f(qp[d]); o[d] = 0.f; }
  const bf16_t* Kb = nk + (size_t)(b * 8 + hh) * NKEY * 64; const bf16_t* Vb = nv + (size_t)(b * 8 + hh) * NKEY * 64;
  float mx = -3.0e38f, l = 0.f;
  for (int kk = 0; kk < 128 + CT; ++kk) {
    int key; float bias = 0.f;
    if (kk < 128) { const int kr_ = rs + (kk >> 4), kc = cs + (kk & 15); key = CT + kr_ * 64 + kc; bias = rpb[(hh * 15 + (kr_ - r + 7)) * 31 + (kc - c + 15)] * LOG2E; }
    else key = kk - 128;
    const bf16_t* kp = Kb + (size_t)key * 64; float s = bias;
#pragma unroll
    for (int d = 0; d < 64; d += 2) { const unsigned w = *(const unsigned*)(kp + d); s += q[d] * __uint_as_float(w << 16) + q[d + 1] * __uint_as_float(w & 0xFFFF0000u); }
    const float mn = fmaxf(mx, s), alpha = exp2f(mx - mn), p = exp2f(s - mn);
    l = l * alpha + p; mx = mn;
    const bf16_t* vp = Vb + (size_t)key * 64;
#pragma unroll
    for (int d = 0; d < 64; d += 2) { const unsigned w = *(const unsigned*)(vp + d); o[d] = o[d] * alpha + p * __uint_as_float(w << 16); o[d + 1] = o[d + 1] * alpha + p * __uint_as_float(w & 0xFFFF0000u); }
  }
  const float il = 1.f / l;
  bf16_t* op = A + (size_t)(b * SEQ + t) * D + hh * 64;
#pragma unroll
  for (int d = 0; d < 64; d += 2) *(unsigned*)(op + d) = pack2(o[d] * il, o[d + 1] * il);
}
__global__ __launch_bounds__(64) void k_mla_naive(const bf16_t* __restrict__ dq, const bf16_t* __restrict__ dk, const bf16_t* __restrict__ dv, bf16_t* __restrict__ A) {
  const int t = blockIdx.x * 64 + threadIdx.x, hh = blockIdx.y, b = blockIdx.z;
  float q[96], o[64];
  const bf16_t* qp = dq + ((size_t)(b * 8 + hh) * SEQ + t) * 96;
#pragma unroll
  for (int d = 0; d < 96; ++d) q[d] = bf2f(qp[d]);
#pragma unroll
  for (int half = 0; half < 2; ++half) {
    const float pos = half ? (float)(t & 63) : (float)(t >> 6);
#pragma unroll
    for (int i = 0; i < 8; ++i) { float sn, cs; sincosf(pos * rope_inv(i), &sn, &cs);
      const float x1 = q[64 + half * 16 + i], x2 = q[64 + half * 16 + 8 + i];
      q[64 + half * 16 + i] = x1 * cs - x2 * sn; q[64 + half * 16 + 8 + i] = x1 * sn + x2 * cs; }
  }
#pragma unroll
  for (int d = 0; d < 64; ++d) o[d] = 0.f;
  const bf16_t* Kb = dk + (size_t)(b * 8 + hh) * NKEY * 128; const bf16_t* Vb = dv + (size_t)(b * 8 + hh) * NKEY * 64;
  float mx = -3.0e38f, l = 0.f;
  for (int k0 = 0; k0 < NKEY; k0 += 8) {
    float s[8]; float bm = -3.0e38f;
#pragma unroll
    for (int j = 0; j < 8; ++j) { const bf16_t* kp = Kb + (size_t)(k0 + j) * 128; float a = 0.f;
#pragma unroll
      for (int d = 0; d < 96; d += 2) { const unsigned w = *(const unsigned*)(kp + d); a += q[d] * __uint_as_float(w << 16) + q[d + 1] * __uint_as_float(w & 0xFFFF0000u); }
      s[j] = a; bm = fmaxf(bm, a); }
    const float mn = fmaxf(mx, bm), alpha = exp2f(mx - mn); mx = mn; l *= alpha;
#pragma unroll
    for (int d = 0; d < 64; ++d) o[d] *= alpha;
#pragma unroll
    for (int j = 0; j < 8; ++j) { const float p = exp2f(s[j] - mn); l += p; const bf16_t* vp = Vb + (size_t)(k0 + j) * 64;
#pragma unroll
      for (int d = 0; d < 64; d += 2) { const unsigned w = *(const unsigned*)(vp + d); o[d] += p * __uint_as_float(w << 16); o[d + 1] += p * __uint_as_float(w & 0xFFFF0000u); } }
  }
  const float il = 1.f / l;
  bf16_t* op = A + (size_t)(b * SEQ + t) * D + 512 + hh * 64;
#pragma unroll
  for (int d = 0; d < 64; d += 2) *(unsigned*)(op + d) = pack2(o[d] * il, o[d + 1] * il);
}

typedef short bf16x8 __attribute__((ext_vector_type(8)));
struct MP {
  const float* in[29];
  float* out; char* ws;
  int ph_lo, ph_hi;
};
constexpr int LDS_BYTES = 131072 + 1024;
constexpr int CNT_OFF = 16384;
typedef short s16x4 __attribute__((ext_vector_type(4)));
typedef float f32x16 __attribute__((ext_vector_type(16)));
typedef unsigned u32x4 __attribute__((ext_vector_type(4)));
constexpr float ATT_THR = 11.5f;
constexpr int NCHUNK = MROWS / 64;

struct MK {
  int wv;
  __device__ __forceinline__ int tidx() const { int l = (int)__lane_id(); asm volatile("" : "+v"(l)); return (wv << 6) | l; }
#define MFMA16(a, b, c) __builtin_amdgcn_mfma_f32_16x16x32_bf16(a, b, c, 0, 0, 0)


template <int MI, class Epi>
__device__ __forceinline__ void gemm_tile(const bf16_t* __restrict__ A, int lda, const int* __restrict__ gather, int gshift, int Mvalid,
                                          const bf16_t* __restrict__ Bt, int ldb, int K, int m0, int n0, char* lds, const Epi& epi) {
  constexpr int BM = 64 * MI, ABYTES = BM * 128, STAGE = ABYTES + 128 * 128;
  const int t = tidx(), lane = t & 63, w = t >> 6, wm = w >> 1, wn = w & 1, l15 = lane & 15, lq = lane >> 4;
  const int c = t & 7, r = t >> 3;
  const bf16_t* ap[MI];
#pragma unroll
  for (int i = 0; i < MI; ++i) { int m = m0 + r + 64 * i; m = m < Mvalid ? m : Mvalid - 1; const int row = gather ? (gather[m] >> gshift) : m; ap[i] = A + (size_t)row * lda + c * 8; }
  const bf16_t* bp0 = Bt + (size_t)(n0 + r) * ldb + c * 8; const bf16_t* bp1 = bp0 + (size_t)64 * ldb;
  const int wofs = r * 128 + ((c ^ ((r >> 1) & 7)) << 4);
  const int sw = (l15 >> 1) & 7, x0 = (lq ^ sw) << 4, x1 = x0 ^ 64;
  const int arow = (wm * 16 * MI + l15) * 128, brow = ABYTES + (wn * 64 + l15) * 128;
  f32x4 acc[MI][4];
#pragma unroll
  for (int i = 0; i < MI; ++i)
#pragma unroll
    for (int j = 0; j < 4; ++j) acc[i][j] = (f32x4){0.f, 0.f, 0.f, 0.f};
  uint4 ra[MI], rb0, rb1;
  const int KT = K >> 6;
#pragma unroll
  for (int i = 0; i < MI; ++i) ra[i] = *(const uint4*)(ap[i]);
  rb0 = *(const uint4*)bp0; rb1 = *(const uint4*)bp1;
#pragma unroll
  for (int i = 0; i < MI; ++i) *(uint4*)(lds + wofs + i * 8192) = ra[i];
  *(uint4*)(lds + ABYTES + wofs) = rb0; *(uint4*)(lds + ABYTES + wofs + 8192) = rb1;
  __syncthreads();
  for (int kt = 0; kt < KT; ++kt) {
    char* cur = lds + (kt & 1) * STAGE; char* nxt = lds + ((kt + 1) & 1) * STAGE;
    const bool more = kt + 1 < KT;
    if (more) {
      const int k0 = (kt + 1) << 6;
#pragma unroll
      for (int i = 0; i < MI; ++i) ra[i] = *(const uint4*)(ap[i] + k0);
      rb0 = *(const uint4*)(bp0 + k0); rb1 = *(const uint4*)(bp1 + k0);
    }
#pragma unroll
    for (int ks = 0; ks < 2; ++ks) {
      const int xo = ks ? x1 : x0;
      bf16x8 af[MI], bfv[4];
#pragma unroll
      for (int i = 0; i < MI; ++i) af[i] = *(const bf16x8*)(cur + arow + i * 2048 + xo);
#pragma unroll
      for (int j = 0; j < 4; ++j) bfv[j] = *(const bf16x8*)(cur + brow + j * 2048 + xo);
#pragma unroll
      for (int i = 0; i < MI; ++i)
#pragma unroll
        for (int j = 0; j < 4; ++j) acc[i][j] = MFMA16(bfv[j], af[i], acc[i][j]);
    }
    if (more) {
#pragma unroll
      for (int i = 0; i < MI; ++i) *(uint4*)(nxt + wofs + i * 8192) = ra[i];
      *(uint4*)(nxt + ABYTES + wofs) = rb0; *(uint4*)(nxt + ABYTES + wofs + 8192) = rb1;
    }
    __syncthreads();
  }
  epi.tile(acc, m0 + wm * 16 * MI + l15, n0 + wn * 64 + lq * 4, Mvalid);
}
template <class E> struct EpiEach {
  E e;
  template <int MI> __device__ __forceinline__ void tile(const f32x4 (&acc)[MI][4], int mb, int nb, int Mvalid) const {
#pragma unroll
    for (int i = 0; i < MI; ++i) { const int m = mb + i * 16; if (m < Mvalid) {
#pragma unroll
      for (int j = 0; j < 4; ++j) e.apply(m, nb + j * 16, acc[i][j]); } }
  }
};
template <int MI, class E>
__device__ __forceinline__ void gemm_phase(const bf16_t* A, int lda, const bf16_t* Bt, int ldb, int M, int N, int K, const E& e, char* lds) {
  constexpr int BM = 64 * MI; const int ntm = (M + BM - 1) / BM, ntn = N >> 7;
  EpiEach<E> ee; ee.e = e;
  for (int tile = blockIdx.x; tile < ntm * ntn; tile += gridDim.x) { const int mt = tile / ntn, nt = tile - mt * ntn; gemm_tile<MI>(A, lda, nullptr, 0, M, Bt, ldb, K, mt * BM, nt * 128, lds, ee); }
}

#define PG8_LAS __attribute__((address_space(3)))
static constexpr int BM = 256, BK = 64, HALF = 128, HTB = HALF * BK * 2, STAGE_BYTES = 8 * HTB, NXCD = 8, WGM = 8;
static __device__ __forceinline__ int lds_byte(int r, int c) { const int st = (r >> 4) * 2 + (c >> 5), rr = r & 15, cc = c & 31, ob = rr * 64 + cc * 2; return st * 1024 + (ob ^ (((ob >> 9) & 1) << 5)); }
static __device__ __forceinline__ void stage_rc(int b, int& R, int& C) { const int st = b / 1024, sb = b % 1024, swz = sb ^ (((sb >> 9) & 1) << 5); R = (st >> 1) * 16 + swz / 64; C = (st & 1) * 32 + (swz % 64) / 2; }
static __device__ __forceinline__ int perm32(int rho) { const int n = rho >> 4, i = rho & 15; return 8 * (i >> 2) + 4 * n + (i & 3); }

struct Unit { int pm, pn; };
struct Gemm { const bf16_t* A; const bf16_t* Bt; int M, N, K; };
struct StaticOrder {
    int nM, nN, nwg, G, c;
    __device__ void init(int M, int N, int G_, int c_) { nM = M / BM; nN = N / BM; nwg = nM * nN; G = G_; c = c_; }
    __device__ bool next(int i, Unit& u) const {
        const long L = (long)i * G + c; if (L >= nwg) return false;
        int wgid = (int)L; { const int q = nwg / NXCD, r = nwg % NXCD, xcd = wgid % NXCD, off = wgid / NXCD; wgid = (xcd < r ? xcd * (q + 1) : r * (q + 1) + (xcd - r) * q) + off; }
        const int nig = WGM * nN, gid = wgid / nig, fm = gid * WGM, gsz = (nM - fm) < WGM ? (nM - fm) : WGM;
        u.pm = fm + ((wgid % nig) % gsz); u.pn = (wgid % nig) / gsz; return true;
    }
    __device__ __forceinline__ void a_ready(const Unit&) const {}
    __device__ __forceinline__ void done(const Unit&) const {}
};
template <class Epi, class Sched>
__device__ __forceinline__ void pg8_phase(PG8_LAS unsigned char* lds, const Gemm g, const Sched& S, const Epi& E) {
    const int tid = tidx(), wid = __builtin_amdgcn_readfirstlane(tid >> 6), lane = tid & 63, wr = wid >> 2, wc = wid & 3, fr = lane & 15, fq = lane >> 4;
    const int K = g.K, nt = K / BK;
    unsigned voffA[2], voffB[2];
#pragma unroll
    for (int i = 0; i < 2; ++i) { int R, C; stage_rc(tid * 16 + i * 8192, R, C); const int Rb = Epi::PERM ? ((R & ~31) + perm32(R & 31)) : R;
        voffA[i] = (unsigned)(R * K + C) * 2u; voffB[i] = (unsigned)(Rb * K + C) * 2u; }
    const size_t kstep = (size_t)(BK * 2);
    const size_t hstep = (size_t)HALF * K * 2;
    const size_t tstep = 2 * hstep;
    const unsigned ldsw = (unsigned)wid * 1024u;
    const int aoff = lds_byte(wr * 64 + fr, fq * 8), boff = lds_byte(wc * 32 + fr, fq * 8);
#define PG8_SA(b, h) (((b) * 2 + (h)) * HTB)
#define PG8_SB(b, h) ((4 + (b) * 2 + (h)) * HTB)
#define PG8_STAGE(bufoff, gbase, voff) do { _Pragma("unroll") for (int _i = 0; _i < 2; ++_i) \
        __builtin_amdgcn_global_load_lds((const unsigned*)((const char*)(gbase) + (voff)[_i]), (PG8_LAS unsigned*)(lds + (bufoff) + ldsw + _i * 8192), 16, 0, 0); } while (0)
#define PG8_LDA(dst, b, h) do { _Pragma("unroll") for (int m = 0; m < 4; ++m) _Pragma("unroll") for (int k = 0; k < 2; ++k) dst[m][k] = *(const PG8_LAS bf16x8*)(lds + PG8_SA(b, h) + aoff + m * 2048 + k * 1024); } while (0)
#define PG8_LDB(dst, b, h) do { _Pragma("unroll") for (int n = 0; n < 2; ++n) _Pragma("unroll") for (int k = 0; k < 2; ++k) dst[n][k] = *(const PG8_LAS bf16x8*)(lds + PG8_SB(b, h) + boff + n * 2048 + k * 1024); } while (0)
#define PG8_MMA(ai, bj, At, Bt) do { __builtin_amdgcn_s_setprio(1); _Pragma("unroll") for (int m = 0; m < 4; ++m) _Pragma("unroll") for (int n = 0; n < 2; ++n) _Pragma("unroll") for (int k = 0; k < 2; ++k) \
        acc[ai][bj][m][n] = __builtin_amdgcn_mfma_f32_16x16x32_bf16(Bt[n][k], At[m][k], acc[ai][bj][m][n], 0, 0, 0); __builtin_amdgcn_s_setprio(0); } while (0)
#define PG8_WAIT_V(n) asm volatile("s_waitcnt vmcnt(" #n ")" ::: "memory")
#define PG8_WAIT_L(n) asm volatile("s_waitcnt lgkmcnt(" #n ")" ::: "memory")
#define PG8_BAR __builtin_amdgcn_s_barrier()
#define PG8_SCHED __builtin_amdgcn_sched_barrier(0)
    Unit cur, nxt; int ui = 0;
    if (!S.next(0, cur)) return;
    f32x4 acc[2][2][4][2];
#pragma unroll
    for (int a = 0; a < 2; ++a)
#pragma unroll
        for (int b = 0; b < 2; ++b)
#pragma unroll
            for (int m = 0; m < 4; ++m)
#pragma unroll
                for (int n = 0; n < 2; ++n) acc[a][b][m][n] = (f32x4){0.f, 0.f, 0.f, 0.f};
    bf16x8 At[4][2], B0[2][2], B1[2][2];
    const char* cA = (const char*)g.A + (size_t)cur.pm * tstep; const char* cB = (const char*)g.Bt + (size_t)cur.pn * tstep;
    S.a_ready(cur);
    PG8_STAGE(PG8_SB(0, 0), cB, voffB); PG8_STAGE(PG8_SA(0, 0), cA, voffA); PG8_STAGE(PG8_SB(0, 1), cB + hstep, voffB); PG8_STAGE(PG8_SA(0, 1), cA + hstep, voffA);
    if (wr == 1) PG8_BAR;
    PG8_WAIT_V(4); PG8_BAR;
    PG8_STAGE(PG8_SB(1, 0), cB + kstep, voffB); PG8_STAGE(PG8_SA(1, 0), cA + kstep, voffA); PG8_STAGE(PG8_SB(1, 1), cB + hstep + kstep, voffB);
    PG8_WAIT_V(6); PG8_BAR;
    for (;;) {
        const bool has_next = S.next(ui + 1, nxt);
        const char* nA = has_next ? (const char*)g.A + (size_t)nxt.pm * tstep : cA; const char* nB = has_next ? (const char*)g.Bt + (size_t)nxt.pn * tstep : cB;
        for (int t = 0; t < nt; t += 2) {
            const bool last = (t == nt - 2);
            const char* a1 = cA + (size_t)(t + 1) * kstep;
            const char* a2 = last ? nA : cA + (size_t)(t + 2) * kstep; const char* b2 = last ? nB : cB + (size_t)(t + 2) * kstep;
            const char* a3 = a2 + kstep; const char* b3 = b2 + kstep;
            if (last && has_next) S.a_ready(nxt);
            PG8_LDB(B0, 0, 0); PG8_SCHED; PG8_LDA(At, 0, 0); PG8_STAGE(PG8_SA(1, 1), a1 + hstep, voffA);
            PG8_WAIT_L(8); PG8_BAR; PG8_WAIT_L(0); PG8_MMA(0, 0, At, B0); PG8_BAR; PG8_SCHED;
            PG8_LDB(B1, 0, 1); PG8_STAGE(PG8_SB(0, 0), b2, voffB);
            PG8_BAR; PG8_WAIT_L(0); PG8_MMA(0, 1, At, B1); PG8_BAR;
            PG8_LDA(At, 0, 1); PG8_STAGE(PG8_SA(0, 0), a2, voffA);
            PG8_BAR; PG8_WAIT_L(0); PG8_MMA(1, 0, At, B0); PG8_BAR; PG8_SCHED;
            PG8_STAGE(PG8_SB(0, 1), b2 + hstep, voffB);
            PG8_WAIT_V(6); PG8_BAR; PG8_MMA(1, 1, At, B1); PG8_BAR;
            PG8_LDB(B0, 1, 0); PG8_SCHED; PG8_LDA(At, 1, 0); PG8_STAGE(PG8_SA(0, 1), a2 + hstep, voffA);
            PG8_WAIT_L(8); PG8_BAR; PG8_WAIT_L(0); PG8_MMA(0, 0, At, B0); PG8_BAR; PG8_SCHED;
            PG8_LDB(B1, 1, 1); PG8_STAGE(PG8_SB(1, 0), b3, voffB);
            PG8_BAR; PG8_WAIT_L(0); PG8_MMA(0, 1, At, B1); PG8_BAR;
            PG8_LDA(At, 1, 1); PG8_STAGE(PG8_SA(1, 0), a3, voffA);
            PG8_BAR; PG8_WAIT_L(0); PG8_MMA(1, 0, At, B0); PG8_BAR; PG8_SCHED;
            PG8_STAGE(PG8_SB(1, 1), b3 + hstep, voffB);
            PG8_WAIT_V(6); PG8_BAR; PG8_MMA(1, 1, At, B1); PG8_BAR;
        }
        if constexpr (!Epi::AFTER_DRAIN) { E(acc, cur, wr, wc, fr, fq); S.done(cur); }
        if (!has_next) break;
#pragma unroll
        for (int a = 0; a < 2; ++a)
#pragma unroll
            for (int b = 0; b < 2; ++b)
#pragma unroll
                for (int m = 0; m < 4; ++m)
#pragma unroll
                    for (int n = 0; n < 2; ++n) acc[a][b][m][n] = (f32x4){0.f, 0.f, 0.f, 0.f};
        cur = nxt; cA = nA; cB = nB; ++ui;
    }
    PG8_WAIT_V(0);
    if (wr == 0) PG8_BAR;
    PG8_BAR;
    if constexpr (Epi::AFTER_DRAIN) { E.fused(acc, cur, wr, wc, fr, fq, lds, wid, lane); S.done(cur); }
#undef PG8_SA
#undef PG8_SB
#undef PG8_STAGE
#undef PG8_LDA
#undef PG8_LDB
#undef PG8_MMA
#undef PG8_WAIT_V
#undef PG8_WAIT_L
#undef PG8_BAR
#undef PG8_SCHED
}

template <class E> struct Pg8Each {
  static constexpr bool PERM = false, AFTER_DRAIN = false; E e;
  __device__ __forceinline__ void operator()(const f32x4 (&acc)[2][2][4][2], const Unit& u, int wr, int wc, int fr, int fq) const {
#pragma unroll
    for (int ai = 0; ai < 2; ++ai)
#pragma unroll
      for (int m = 0; m < 4; ++m) { const int row = u.pm * BM + ai * HALF + wr * 64 + m * 16 + fr;
#pragma unroll
        for (int bj = 0; bj < 2; ++bj)
#pragma unroll
          for (int n = 0; n < 2; ++n) e.apply(row, u.pn * BM + bj * HALF + wc * 32 + n * 16 + fq * 4, acc[ai][bj][m][n]); }
  }
};
template <class E>
__device__ __forceinline__ void gemm_phase8(const bf16_t* A, const bf16_t* Bt, int Mbig, int M, int N, int K, const E& e, char* lds, int ctx_n0, int ctx_n1) {
  { Gemm g; g.A = A; g.Bt = Bt; g.M = Mbig; g.N = N; g.K = K; StaticOrder S; S.init(Mbig, N, (int)gridDim.x, (int)blockIdx.x); Pg8Each<E> pe; pe.e = e;
    pg8_phase((PG8_LAS unsigned char*)lds, g, S, pe); }
  if (M > Mbig) { EpiEach<E> ee; ee.e = e; const int ntm = (M - Mbig) >> 6, ntn = (ctx_n1 - ctx_n0) >> 7;
    for (int tile = (int)gridDim.x - 1 - (int)blockIdx.x; tile < ntm * ntn; tile += gridDim.x) { const int mt = tile / ntn, nt = tile - mt * ntn;
      gemm_tile<1>(A, K, nullptr, 0, M, Bt, K, K, Mbig + mt * 64, ctx_n0 + nt * 128, lds, ee); } }
}

template <int K>
static __device__ __forceinline__ float row_rstd4(const bf16_t* rowp, int lq) {
  constexpr int PER = K / 4; float ss = 0.f;
#pragma unroll
  for (int i = 0; i < PER / 8; ++i) { const uint4 v = *(const uint4*)(rowp + lq * PER + i * 8); const unsigned wv[4] = {v.x, v.y, v.z, v.w};
#pragma unroll
    for (int q = 0; q < 4; ++q) { const float a = __uint_as_float(wv[q] << 16), b = __uint_as_float(wv[q] & 0xFFFF0000u); ss += a * a + b * b; } }
  ss += __shfl_xor(ss, 16); ss += __shfl_xor(ss, 32);
  return 1.f / sqrtf(ss * (1.f / K) + EPS);
}
struct EpiMlaQ2 {
  bf16_t* dq; const bf16_t* cq;
  template <int MI> __device__ __forceinline__ void tile(const f32x4 (&acc)[MI][4], int mb, int nb, int Mvalid) const {
#pragma unroll
    for (int i = 0; i < MI; ++i) { const int m = mb + i * 16; const float rs = row_rstd4<256>(cq + (size_t)m * 256, (nb >> 2) & 3) * MLA_QSCALE;
#pragma unroll
      for (int j = 0; j < 4; ++j) { const int n = nb + j * 16; const int hh = n / 96, off = n - hh * 96; const f32x4 v = acc[i][j] * rs;
        uint2 wv; wv.x = pack2(v.x, v.y); wv.y = pack2(v.z, v.w);
        *(uint2*)(dq + (((size_t)((m >> 13) * 8 + hh) * SEQ + (m & 8191)) * 96 + off)) = wv; } }
  }
};
struct EpiMlaKV2 {
  bf16_t *dk, *dv; const bf16_t* ckv;
  template <int MI> __device__ __forceinline__ void tile(const f32x4 (&acc)[MI][4], int mb, int nb, int Mvalid) const {
#pragma unroll
    for (int i = 0; i < MI; ++i) { const int m = mb + i * 16; const float rs = row_rstd4<128>(ckv + (size_t)m * 128, (nb >> 2) & 3);
      int b, key; row_bkey(m, b, key);
#pragma unroll
      for (int j = 0; j < 4; ++j) { const int n = nb + j * 16; const int hh = n >> 7, off = n & 127; const f32x4 v = acc[i][j] * rs;
        uint2 wv; wv.x = pack2(v.x, v.y); wv.y = pack2(v.z, v.w);
        if (off < 64) *(uint2*)(dk + (((size_t)(b * 8 + hh) * NKEY + key) * 128 + off)) = wv;
        else *(uint2*)(dv + (((size_t)(b * 8 + hh) * NKEY + key) * 64 + (off - 64))) = wv; } }
  }
};
struct EpiMoe2 {
  bf16_t* Y; const int* list; int m_base;
  __device__ __forceinline__ void apply(int m, int n, f32x4 v) const {
    uint2 wv; wv.x = pack2(v.x, v.y); wv.y = pack2(v.z, v.w);
    *(uint2*)(Y + (size_t)list[m - m_base] * D + n) = wv;
  }
};

__device__ __forceinline__ void ph_ada(const MP& p, char* lds) {
  float* sv = (float*)lds;
  const float* c = p.in[1]; const float* cctx = p.in[3]; float* mods = (float*)(p.ws + WS_MODS);
  const int t = tidx();
  for (int i = t; i < 1024; i += 512) { sv[i] = siluf_(c[i]); sv[1024 + i] = siluf_(c[1024 + i]); sv[2048 + i] = siluf_(cctx[i]); }
  __syncthreads();
  for (int item = blockIdx.x; item < 256; item += gridDim.x) {
    const int l = item >> 7, kg = (item >> 4) & 7, cg = item & 15;
    if (t < 384) {
      const int col = cg * 384 + t;
      const float* W = p.in[4] + ((size_t)l * 1024 + kg * 128) * 6144 + col;
      float a0 = 0.f, a1 = 0.f, a2 = 0.f;
#pragma unroll 16
      for (int k = 0; k < 128; ++k) { const float wv = W[(size_t)k * 6144]; const int kk = kg * 128 + k; a0 += sv[kk] * wv; a1 += sv[1024 + kk] * wv; a2 += sv[2048 + kk] * wv; }
      if (kg == 0) { const float bb = p.in[5][l * 6144 + col]; a0 += bb; a1 += bb; a2 += bb; }
      atomicAdd(&mods[(size_t)(l * 3 + 0) * 6144 + col], a0); atomicAdd(&mods[(size_t)(l * 3 + 1) * 6144 + col], a1); atomicAdd(&mods[(size_t)(l * 3 + 2) * 6144 + col], a2);
    }
  }
  if (blockIdx.x == gridDim.x - 1) { float* lb = (float*)(p.ws + WS_LB);
    for (int i = t; i < 1024; i += 512) { const int d = i >> 9, cc = i & 511; const float l0 = p.in[10][(d * 2) * 512 + cc], l1 = p.in[10][(d * 2 + 1) * 512 + cc]; lb[i] = 1.f / (1.f + expf(l1 - l0)); } }
  __syncthreads();
}
__device__ __forceinline__ void conv_tiles(const float* src, bf16_t* dst, const float* kscale, int K, int N, int Npad, int mode, int batch, size_t sbs, size_t dbs, char* lds) {
  float* tile = (float*)lds;
  const int ntn = (Npad + 63) >> 6, ntk = K >> 7, per = ntn * ntk, t = tidx();
  for (int item = blockIdx.x; item < per * batch; item += gridDim.x) {
    const int bz = item / per, rem = item - bz * per, kb = rem / ntn, nb = rem - kb * ntn, n0 = nb * 64, k0 = kb * 128;
    const float* s = src + bz * sbs; bf16_t* d = dst + bz * dbs;
#pragma unroll
    for (int i = 0; i < 4; ++i) { const int idx = t + 512 * i, k = idx >> 4, n4 = (idx & 15) * 4; f32x4 v = {0.f, 0.f, 0.f, 0.f};
      if (n0 + n4 < N) { v = *(const f32x4*)(s + (size_t)(k0 + k) * N + n0 + n4); if (kscale) v = v * kscale[k0 + k]; }
      float* tp = tile + k * 65 + n4; tp[0] = v.x; tp[1] = v.y; tp[2] = v.z; tp[3] = v.w; }
    __syncthreads();
#pragma unroll
    for (int i = 0; i < 2; ++i) { const int idx = t + 512 * i, nl = idx >> 4, k8 = (idx & 15) * 8, n = n0 + nl;
      if (n < Npad) { int row = n; if (mode == 1) row = moe_gu_row(0, n); else if (mode == 2) row = moe_gu_row(1, n);
        const float* tp = tile + k8 * 65 + nl;
        uint4 o; o.x = pack2(tp[0], tp[65]); o.y = pack2(tp[130], tp[195]); o.z = pack2(tp[260], tp[325]); o.w = pack2(tp[390], tp[455]);
        *(uint4*)(d + (size_t)row * K + k0 + k8) = o; } }
    __syncthreads();
  }
}
struct ConvJob { const float* src; bf16_t* dst; const float* kscale; int K, N, Npad, mode, batch; size_t sbs, dbs; };
__device__ __forceinline__ void conv_item(const ConvJob& j, int item, char* lds) {
  unsigned* tile = (unsigned*)lds;
  const int ntn = (j.Npad + 63) >> 6, ntk = j.K >> 7, per = ntn * ntk, t = tidx();
  const int bz = item / per, rem = item - bz * per, kb = rem / ntn, nb = rem - kb * ntn, n0 = nb * 64, k0 = kb * 128;
  const float* s = j.src + bz * j.sbs; bf16_t* d = j.dst + bz * j.dbs;
#pragma unroll
  for (int i = 0; i < 2; ++i) { const int idx = t + 512 * i, kp = idx >> 4, n4 = (idx & 15) * 4; f32x4 v0 = {0.f, 0.f, 0.f, 0.f}, v1 = v0;
    if (n0 + n4 < j.N) { const float* sp = s + (size_t)(k0 + 2 * kp) * j.N + n0 + n4; v0 = *(const f32x4*)sp; v1 = *(const f32x4*)(sp + j.N);
      if (j.kscale) { v0 = v0 * j.kscale[k0 + 2 * kp]; v1 = v1 * j.kscale[k0 + 2 * kp + 1]; } }
    unsigned* tp = tile + n4 * 65 + kp; tp[0] = pack2(v0.x, v1.x); tp[65] = pack2(v0.y, v1.y); tp[130] = pack2(v0.z, v1.z); tp[195] = pack2(v0.w, v1.w); }
  __syncthreads();
#pragma unroll
  for (int i = 0; i < 2; ++i) { const int idx = t + 512 * i, nl = idx >> 4, k8 = (idx & 15) * 8, n = n0 + nl;
    if (n < j.Npad) { int row = n; if (j.mode == 1) row = moe_gu_row(0, n); else if (j.mode == 2) row = moe_gu_row(1, n);
      const unsigned* tp = tile + nl * 65 + (k8 >> 1);
      *(uint4*)(d + (size_t)row * j.K + k0 + k8) = make_uint4(tp[0], tp[1], tp[2], tp[3]); } }
  __syncthreads();
}
__device__ __forceinline__ int conv_count(int K, int Npad, int batch) { return ((Npad + 63) >> 6) * (K >> 7) * batch; }
__device__ __forceinline__ void ph_conv_all(const MP& p, char* lds) {
  char* ws = p.ws; bf16_t* wgu = (bf16_t*)(ws + WS_WMOE); bf16_t* wd = wgu + (size_t)32 * 512 * 1024;
  const int c0 = conv_count(1024, 3072, 1), c1 = c0 + conv_count(1024, 1024, 1), c2 = c1 + conv_count(1024, 2048, 1), c3 = c2 + conv_count(1024, 1024, 1),
            c4 = c3 + conv_count(256, 768, 1), c5 = c4 + conv_count(128, 1024, 1), c6 = c5 + conv_count(128, 128, 4),
            c7 = c6 + conv_count(1024, 256, 32), c8 = c7 + conv_count(1024, 256, 32), c9 = c8 + conv_count(256, 1024, 32);
  for (int it = blockIdx.x; it < c9; it += gridDim.x) {
    ConvJob j; int li;
    if (it < c0)      { li = it;      j = ConvJob{p.in[8],  (bf16_t*)(ws + WS_WT_ABIN),  nullptr, 1024, 3072, 3072, 0, 1, 0, 0}; }
    else if (it < c1) { li = it - c0; j = ConvJob{p.in[9],  (bf16_t*)(ws + WS_WT_ABOUT), nullptr, 1024, 1024, 1024, 0, 1, 0, 0}; }
    else if (it < c2) { li = it - c1; j = ConvJob{p.in[14], (bf16_t*)(ws + WS_WT_CDIN),  nullptr, 1024, 1952, 2048, 0, 1, 0, 0}; }
    else if (it < c3) { li = it - c2; j = ConvJob{p.in[15], (bf16_t*)(ws + WS_WT_CDOUT), nullptr, 1024, 1024, 1024, 0, 1, 0, 0}; }
    else if (it < c4) { li = it - c3; j = ConvJob{p.in[18], (bf16_t*)(ws + WS_WT_UQ),    p.in[17], 256, 768, 768, 0, 1, 0, 0}; }
    else if (it < c5) { li = it - c4; j = ConvJob{p.in[20], (bf16_t*)(ws + WS_WT_UKV),   p.in[19], 128, 1024, 1024, 0, 1, 0, 0}; }
    else if (it < c6) { li = it - c5; j = ConvJob{p.in[12], (bf16_t*)(ws + WS_WT_POOL),  nullptr, 128, 128, 128, 0, 4, (size_t)128 * 128, (size_t)128 * 128}; }
    else if (it < c7) { li = it - c6; j = ConvJob{p.in[25], wgu, nullptr, 1024, 256, 256, 1, 32, (size_t)1024 * 256, (size_t)512 * 1024}; }
    else if (it < c8) { li = it - c7; j = ConvJob{p.in[26], wgu, nullptr, 1024, 256, 256, 2, 32, (size_t)1024 * 256, (size_t)512 * 1024}; }
    else              { li = it - c8; j = ConvJob{p.in[27], wd,  nullptr, 256, 1024, 1024, 0, 32, (size_t)256 * 1024, (size_t)1024 * 256}; }
    conv_item(j, li, lds);
  }
}
__device__ __forceinline__ void ph_conv_small(const MP& p, char* lds) {
  char* ws = p.ws;
  conv_tiles(p.in[8], (bf16_t*)(ws + WS_WT_ABIN), nullptr, 1024, 3072, 3072, 0, 1, 0, 0, lds);
  conv_tiles(p.in[9], (bf16_t*)(ws + WS_WT_ABOUT), nullptr, 1024, 1024, 1024, 0, 1, 0, 0, lds);
  conv_tiles(p.in[14], (bf16_t*)(ws + WS_WT_CDIN), nullptr, 1024, 1952, 2048, 0, 1, 0, 0, lds);
  conv_tiles(p.in[15], (bf16_t*)(ws + WS_WT_CDOUT), nullptr, 1024, 1024, 1024, 0, 1, 0, 0, lds);
  conv_tiles(p.in[18], (bf16_t*)(ws + WS_WT_UQ), p.in[17], 256, 768, 768, 0, 1, 0, 0, lds);
  conv_tiles(p.in[20], (bf16_t*)(ws + WS_WT_UKV), p.in[19], 128, 1024, 1024, 0, 1, 0, 0, lds);
  conv_tiles(p.in[12], (bf16_t*)(ws + WS_WT_POOL), nullptr, 128, 128, 128, 0, 4, (size_t)128 * 128, (size_t)128 * 128, lds);
}
__device__ __forceinline__ void ph_conv_moe(const MP& p, int layer, char* lds) {
  bf16_t* wgu = (bf16_t*)(p.ws + WS_WMOE); bf16_t* wd = wgu + (size_t)32 * 512 * 1024;
  const size_t lo = (size_t)layer * 32 * 1024 * 256;
  const int c0 = conv_count(1024, 256, 32), c1 = c0 + conv_count(1024, 256, 32), c2 = c1 + conv_count(256, 1024, 32);
  for (int it = blockIdx.x; it < c2; it += gridDim.x) {
    ConvJob j; int li;
    if (it < c0)      { li = it;      j = ConvJob{p.in[25] + lo, wgu, nullptr, 1024, 256, 256, 1, 32, (size_t)1024 * 256, (size_t)512 * 1024}; }
    else if (it < c1) { li = it - c0; j = ConvJob{p.in[26] + lo, wgu, nullptr, 1024, 256, 256, 2, 32, (size_t)1024 * 256, (size_t)512 * 1024}; }
    else              { li = it - c1; j = ConvJob{p.in[27] + lo, wd,  nullptr, 256, 1024, 1024, 0, 32, (size_t)256 * 1024, (size_t)1024 * 256}; }
    conv_item(j, li, lds);
  }
}
__device__ __forceinline__ void ph_norm_mod(const float* lat, const float* ctxr, const float* gain, const float* modl, int sh_off, int sc_off, bf16_t* out, int nrows) {
  const int lane = tidx() & 63, gw = blockIdx.x * 8 + (tidx() >> 6);
  for (int row = gw; row < nrows; row += gridDim.x * 8) {
    const float* src = row < NLAT ? lat + (size_t)row * D : ctxr + (size_t)(row - NLAT) * D;
    const float* mv = modl + row_vec(row) * 6144;
    f32x4 x[4]; float ss = 0.f;
#pragma unroll
    for (int j = 0; j < 4; ++j) { x[j] = ((const f32x4*)src)[lane + 64 * j]; ss += x[j].x * x[j].x + x[j].y * x[j].y + x[j].z * x[j].z + x[j].w * x[j].w; }
    const float rstd = 1.f / sqrtf(wave_sum(ss) * (1.f / D) + EPS);
#pragma unroll
    for (int j = 0; j < 4; ++j) {
      const int n = (lane + 64 * j) * 4;
      const f32x4 g = *(const f32x4*)(gain + n), sc = *(const f32x4*)(mv + sc_off + n), sh = *(const f32x4*)(mv + sh_off + n);
      const f32x4 h = x[j] * rstd * g * (sc + 1.f) + sh;
      uint2 o; o.x = pack2(h.x, h.y); o.y = pack2(h.z, h.w);
      *(uint2*)(out + (size_t)row * D + n) = o;
    }
  }
}
template <int HALF>
__device__ __forceinline__ void pool_prep_col(const bf16_t* Up, bf16_t* pd, int r0, int seg_lo, int seg_hi, int c) {
  float a[32];
#pragma unroll
  for (int i = 0; i < 32; ++i) { const int r = r0 - 8 + i; const bool in = (r >= seg_lo) && (r < seg_hi); const int rc = in ? r : r0; const float v = bf2f(Up[(size_t)rc * 512 + c]); a[i] = in ? v : 0.f; }
  float sum = 0.f;
#pragma unroll
  for (int i = 8 - HALF; i < 8 + HALF; ++i) sum += a[i];
#pragma unroll
  for (int j = 0; j < 16; ++j) {
    const int t = r0 + j; int lo = t - HALF, hi = t + HALF; lo = lo < seg_lo ? seg_lo : lo; hi = hi > seg_hi ? seg_hi : hi;
    pd[(size_t)t * 512 + c] = f2bf(sum * __builtin_amdgcn_rcpf((float)(hi - lo)) - a[8 + j]);
    if (j < 15) sum += a[8 + j + HALF] - a[8 + j - HALF];
  }
}
__device__ __forceinline__ void ph_pool_prep(const bf16_t* Up, bf16_t* pd) {
  const int t = tidx(), cl = t & 127, rq = t >> 7;
  for (int item = blockIdx.x; item < NCHUNK * 4; item += gridDim.x) {
    const int cid = item >> 2, gi = item & 3, c = gi * 128 + cl, rc0 = cid * 64, r0 = rc0 + rq * 16; int seg_lo, seg_hi;
    if (rc0 < NLAT) { seg_lo = rc0 & ~8191; seg_hi = seg_lo + SEQ; } else { seg_lo = NLAT + ((rc0 - NLAT) & ~255); seg_hi = seg_lo + CT; }
    if (gi == 0) pool_prep_col<1>(Up, pd, r0, seg_lo, seg_hi, c);
    else if (gi == 1) pool_prep_col<2>(Up, pd, r0, seg_lo, seg_hi, c);
    else if (gi == 2) pool_prep_col<4>(Up, pd, r0, seg_lo, seg_hi, c);
    else pool_prep_col<8>(Up, pd, r0, seg_lo, seg_hi, c);
  }
}
__device__ __forceinline__ void ph_router(const MP& p, int layer, int nrows, char* lds) {
  float* hs = (float*)lds;
  float* part = (float*)(lds + 66048);
  float* lgs = (float*)(lds + 66048 + 24576);
  const float* lat = p.out; const float* ctxr = (const float*)(p.ws + WS_XC); const float* gain = p.in[7] + layer * 1024;
  const float* modl = (const float*)(p.ws + WS_MODS) + layer * 3 * 6144;
  const float* wrg = p.in[21] + layer * 1024 * 4; const float* brg = p.in[22] + layer * 4; const float* wre = p.in[23] + layer * 1024 * 32; const float* bre = p.in[24] + layer * 32;
  bf16_t* out = (bf16_t*)(p.ws + WS_H); float* rw = (float*)(p.ws + WS_ROUTE_W);
  int* cnt = (int*)(p.ws + WS_CTL + CNT_OFF) + layer * 32; int* list = (int*)(p.ws + WS_LIST);
  const int tid = tidx(), lane = tid & 63, w = tid >> 6, l15 = lane & 15, lq = lane >> 4;
  float Bq[8][4][3];
#pragma unroll
  for (int g = 0; g < 8; ++g)
#pragma unroll
    for (int u = 0; u < 4; ++u)
#pragma unroll
      for (int nt = 0; nt < 3; ++nt) { const int kk = w * 128 + 16 * g + 4 * lq + u, col = nt * 16 + l15;
        Bq[g][u][nt] = col < 4 ? wrg[kk * 4 + col] : (col < 36 ? wre[kk * 32 + (col - 4)] : 0.f); }
  const int ntiles = nrows >> 4;
  int* lcnt = (int*)(lds + 66048 + 24576 + 2304);
  int* lbase = lcnt + 32;
  int* pend = lbase + 32;
  int nloc = 0;
  if (tid < 32) lcnt[tid] = 0;
  f32x4 xa[2][4];
#define RT_LOAD(tile_) do { _Pragma("unroll") for (int rr = 0; rr < 2; ++rr) { const int row_ = (tile_) * 16 + 2 * w + rr; \
      const float* src_ = row_ < NLAT ? lat + (size_t)row_ * D : ctxr + (size_t)(row_ - NLAT) * D; \
      _Pragma("unroll") for (int j = 0; j < 4; ++j) xa[rr][j] = ((const f32x4*)src_)[lane + 64 * j]; } } while (0)
  if ((int)blockIdx.x < ntiles) RT_LOAD((int)blockIdx.x);
  for (int tile = blockIdx.x; tile < ntiles; tile += gridDim.x) {
#pragma unroll
    for (int rr = 0; rr < 2; ++rr) {
      const int lr = 2 * w + rr, row = tile * 16 + lr;
      const float* mv = modl + row_vec(row) * 6144;
      float ss = 0.f;
#pragma unroll
      for (int j = 0; j < 4; ++j) { const f32x4 x = xa[rr][j]; ss += x.x * x.x + x.y * x.y + x.z * x.z + x.w * x.w; }
      const float rstd = 1.f / sqrtf(wave_sum(ss) * (1.f / D) + EPS);
#pragma unroll
      for (int j = 0; j < 4; ++j) {
        const int n = (lane + 64 * j) * 4;
        const f32x4 g = *(const f32x4*)(gain + n), sc = *(const f32x4*)(mv + 4096 + n), sh = *(const f32x4*)(mv + 3072 + n);
        const f32x4 h = xa[rr][j] * rstd * g * (sc + 1.f) + sh;
        uint2 o; o.x = pack2(h.x, h.y); o.y = pack2(h.z, h.w);
        *(uint2*)(out + (size_t)row * D + n) = o;
        *(f32x4*)&hs[lr * 1032 + n] = h;
      }
    }
    __syncthreads();
    if (tile + (int)gridDim.x < ntiles) RT_LOAD(tile + (int)gridDim.x);
    f32x4 acc[3];
#pragma unroll
    for (int nt = 0; nt < 3; ++nt) acc[nt] = (f32x4){0.f, 0.f, 0.f, 0.f};
#pragma unroll
    for (int g = 0; g < 8; ++g) {
      const f32x4 a4 = *(const f32x4*)&hs[l15 * 1032 + w * 128 + 16 * g + 4 * lq];
      const float av[4] = {a4.x, a4.y, a4.z, a4.w};
#pragma unroll
      for (int u = 0; u < 4; ++u)
#pragma unroll
        for (int nt = 0; nt < 3; ++nt) acc[nt] = __builtin_amdgcn_mfma_f32_16x16x4f32(av[u], Bq[g][u][nt], acc[nt], 0, 0, 0);
    }
#pragma unroll
    for (int nt = 0; nt < 3; ++nt) { const float av[4] = {acc[nt].x, acc[nt].y, acc[nt].z, acc[nt].w};
#pragma unroll
      for (int r = 0; r < 4; ++r) part[(w * 16 + lq * 4 + r) * 48 + nt * 16 + l15] = av[r]; }
    __syncthreads();
    for (int i = tid; i < 16 * 36; i += 512) { const int row = i / 36, col = i - row * 36; float sacc = col < 4 ? brg[col] : bre[col - 4];
#pragma unroll
      for (int ww = 0; ww < 8; ++ww) sacc += part[(ww * 16 + row) * 48 + col];
      lgs[i] = sacc; }
    __syncthreads();
    if (tid < 32) {
      const int lr = tid >> 1, slot = tid & 1, row = tile * 16 + lr; const float* lg = lgs + lr * 36;
      int gi = 0; float gm = lg[0];
#pragma unroll
      for (int i = 1; i < 4; ++i) if (lg[i] > gm) { gm = lg[i]; gi = i; }
      float gs = 0.f;
#pragma unroll
      for (int i = 0; i < 4; ++i) gs += __expf(lg[i] - gm);
      const float gp = 1.f / gs;
      const float* el = lg + 4 + gi * 8;
      int e1 = 0; float m1 = el[0];
#pragma unroll
      for (int i = 1; i < 8; ++i) if (el[i] > m1) { m1 = el[i]; e1 = i; }
      int e2 = 0; float m2 = -3.0e38f;
#pragma unroll
      for (int i = 0; i < 8; ++i) if (i != e1 && el[i] > m2) { m2 = el[i]; e2 = i; }
      const float w1 = 1.f / (1.f + __expf(m2 - m1));
      const int ee = gi * 8 + (slot ? e2 : e1);
      rw[row * 2 + slot] = gp * (slot ? 1.f - w1 : w1);
      const int rk = atomicAdd(&lcnt[ee], 1);
      pend[nloc * 32 + tid] = (ee << 24) | (rk << 16) | (row & 0xFFFF) | 0;
    }
    ++nloc;
  }
  __syncthreads();
  if (tid < 32) lbase[tid] = lcnt[tid] ? atomicAdd(&cnt[tid], lcnt[tid]) : 0;
  __syncthreads();
  for (int i = tid; i < nloc * 32; i += 512) { const int v = pend[i], ee = (v >> 24) & 31, rk = (v >> 16) & 255, row = v & 0xFFFF;
    list[(size_t)ee * MROWS + lbase[ee] + rk] = row * 2 + (i & 1); }
  __syncthreads();
#undef RT_LOAD
}
__device__ __forceinline__ void moe_tables(const MP& p, int layer, int ntn_big, int ntn_small, int* tb) {
  const int* cnt = (const int*)(p.ws + WS_CTL + CNT_OFF) + layer * 32;
  __syncthreads();
  if (tidx() == 0) { int off = 0, tsb = 0, tss = 0;
    for (int e = 0; e < 32; ++e) { const int c = __hip_atomic_load(&cnt[e], __ATOMIC_RELAXED, __HIP_MEMORY_SCOPE_AGENT); tb[e] = c; tb[32 + e] = off; tb[64 + e] = tsb; tb[97 + e] = tss;
      off += c; tsb += (c >> 8) * ntn_big; tss += (((c & 255) + 63) >> 6) * ntn_small; }
    tb[96] = tsb; tb[129] = tss; }
  __syncthreads();
}
struct GUnit { unsigned a, b; int m0, n0, mvalid, e; };
struct MoeSched {
  const PG8_LAS int* tb; const char* wsb; unsigned Abase, Bbase, b_estride; int ntn, G, c, K, gather;
  __device__ __forceinline__ bool next(int i, GUnit& u) const {
    const int L = i * G + c; if (L >= tb[96]) return false;
    int e = 0;
#pragma unroll 1
    for (int q = 1; q < 32; ++q) if (tb[64 + q] <= L) e = q;
    const int lt = L - tb[64 + e], mt = lt / ntn, nt = lt - mt * ntn;
    u.e = e; u.m0 = mt * 256; u.n0 = nt * 256; u.mvalid = tb[e];
    u.b = Bbase + (unsigned)e * b_estride + (unsigned)(nt * 256 * K * 2);
    u.a = gather ? Abase : Abase + (unsigned)((tb[32 + e] + mt * 256) * K * 2);
    return true;
  }
  __device__ __forceinline__ void done(const GUnit&) const {}
  __device__ __forceinline__ void a_offsets(const GUnit& u, int tid, unsigned (&ao)[2][2]) const {
    const int* list = (const int*)(wsb + WS_LIST) + (size_t)u.e * MROWS;
#pragma unroll
    for (int i = 0; i < 2; ++i) { int R, C; stage_rc(tid * 16 + i * 8192, R, C);
#pragma unroll
      for (int h = 0; h < 2; ++h) {
        if (gather) { int r = u.m0 + h * 128 + R; r = r < u.mvalid ? r : u.mvalid - 1; const int tok = list[r] >> 1; ao[h][i] = (unsigned)(tok * K + C) * 2u; }
        else ao[h][i] = (unsigned)((h * 128 + R) * K + C) * 2u;
      } }
  }
};
template <class Epi, class Sched>
__device__ __forceinline__ void pg8g_phase(PG8_LAS unsigned char* lds, const char* wsb, const int K, const Sched& S, const Epi& E) {
    const int tid = tidx(), wid = __builtin_amdgcn_readfirstlane(tid >> 6), lane = tid & 63, wr = wid >> 2, wc = wid & 3, fr = lane & 15, fq = lane >> 4;
    const int nt = K / BK;
    unsigned voffB[2];
#pragma unroll
    for (int i = 0; i < 2; ++i) { int R, C; stage_rc(tid * 16 + i * 8192, R, C); const int Rb = Epi::PERM ? ((R & ~31) + perm32(R & 31)) : R;
        voffB[i] = (unsigned)(Rb * K + C) * 2u; }
    const unsigned kstep = (unsigned)(BK * 2);
    const unsigned hstep = (unsigned)(HALF * K * 2);
    const unsigned ldsw = (unsigned)wid * 1024u;
    const int aoff = lds_byte(wr * 64 + fr, fq * 8), boff = lds_byte(wc * 32 + fr, fq * 8);
#define PG8_SA(b, h) (((b) * 2 + (h)) * HTB)
#define PG8_SB(b, h) ((4 + (b) * 2 + (h)) * HTB)
#define PG8_STAGE(bufoff, gbase, voff) do { _Pragma("unroll") for (int _i = 0; _i < 2; ++_i) \
        __builtin_amdgcn_global_load_lds((const unsigned*)(wsb + (size_t)(gbase) + (voff)[_i]), (PG8_LAS unsigned*)(lds + (bufoff) + ldsw + _i * 8192), 16, 0, 0); } while (0)
#define PG8_STAGE_A(bufoff, gbase, o0, o1) do { \
        __builtin_amdgcn_global_load_lds((const unsigned*)(wsb + (size_t)(gbase) + (o0)), (PG8_LAS unsigned*)(lds + (bufoff) + ldsw), 16, 0, 0); \
        __builtin_amdgcn_global_load_lds((const unsigned*)(wsb + (size_t)(gbase) + (o1)), (PG8_LAS unsigned*)(lds + (bufoff) + ldsw + 8192), 16, 0, 0); } while (0)
#define PG8_LDA(dst, b, h) do { _Pragma("unroll") for (int m = 0; m < 4; ++m) _Pragma("unroll") for (int k = 0; k < 2; ++k) dst[m][k] = *(const PG8_LAS bf16x8*)(lds + PG8_SA(b, h) + aoff + m * 2048 + k * 1024); } while (0)
#define PG8_LDB(dst, b, h) do { _Pragma("unroll") for (int n = 0; n < 2; ++n) _Pragma("unroll") for (int k = 0; k < 2; ++k) dst[n][k] = *(const PG8_LAS bf16x8*)(lds + PG8_SB(b, h) + boff + n * 2048 + k * 1024); } while (0)
#define PG8_MMA(ai, bj, At, Bt) do { __builtin_amdgcn_s_setprio(1); _Pragma("unroll") for (int m = 0; m < 4; ++m) _Pragma("unroll") for (int n = 0; n < 2; ++n) _Pragma("unroll") for (int k = 0; k < 2; ++k) \
        acc[ai][bj][m][n] = __builtin_amdgcn_mfma_f32_16x16x32_bf16(Bt[n][k], At[m][k], acc[ai][bj][m][n], 0, 0, 0); __builtin_amdgcn_s_setprio(0); } while (0)
#define PG8_WAIT_V(n) asm volatile("s_waitcnt vmcnt(" #n ")" ::: "memory")
#define PG8_WAIT_L(n) asm volatile("s_waitcnt lgkmcnt(" #n ")" ::: "memory")
#define PG8_BAR __builtin_amdgcn_s_barrier()
#define PG8_SCHED __builtin_amdgcn_sched_barrier(0)
    GUnit cur, nxt; int ui = 0;
    if (!S.next(0, cur)) return;
    f32x4 acc[2][2][4][2];
#pragma unroll
    for (int a = 0; a < 2; ++a)
#pragma unroll
        for (int b = 0; b < 2; ++b)
#pragma unroll
            for (int m = 0; m < 4; ++m)
#pragma unroll
                for (int n = 0; n < 2; ++n) acc[a][b][m][n] = (f32x4){0.f, 0.f, 0.f, 0.f};
    bf16x8 At[4][2], B0[2][2], B1[2][2];
    unsigned cA = cur.a, cB = cur.b;
    unsigned aoc[2][2];
    S.a_offsets(cur, tid, aoc);
    PG8_STAGE(PG8_SB(0, 0), cB, voffB); PG8_STAGE_A(PG8_SA(0, 0), cA, aoc[0][0], aoc[0][1]); PG8_STAGE(PG8_SB(0, 1), cB + hstep, voffB); PG8_STAGE_A(PG8_SA(0, 1), cA, aoc[1][0], aoc[1][1]);
    if (wr == 1) PG8_BAR;
    PG8_WAIT_V(4); PG8_BAR;
    PG8_STAGE(PG8_SB(1, 0), cB + kstep, voffB); PG8_STAGE_A(PG8_SA(1, 0), cA + kstep, aoc[0][0], aoc[0][1]); PG8_STAGE(PG8_SB(1, 1), cB + hstep + kstep, voffB);
    PG8_WAIT_V(6); PG8_BAR;
    for (;;) {
        const bool has_next = S.next(ui + 1, nxt);
        const unsigned nA = has_next ? nxt.a : cA, nB = has_next ? nxt.b : cB;
        for (int t = 0; t < nt; t += 2) {
            const bool last = (t == nt - 2);
            const unsigned a1 = cA + (unsigned)(t + 1) * kstep;
            const unsigned a2 = last ? nA : cA + (unsigned)(t + 2) * kstep, b2 = last ? nB : cB + (unsigned)(t + 2) * kstep;
            const unsigned a3 = a2 + kstep, b3 = b2 + kstep;
            if (last && has_next) {
              PG8_STAGE_A(PG8_SA(1, 1), a1, aoc[1][0], aoc[1][1]); S.a_offsets(nxt, tidx(), aoc); PG8_SCHED;
              PG8_LDB(B0, 0, 0); PG8_SCHED; PG8_LDA(At, 0, 0);
            } else { PG8_LDB(B0, 0, 0); PG8_SCHED; PG8_LDA(At, 0, 0); PG8_STAGE_A(PG8_SA(1, 1), a1, aoc[1][0], aoc[1][1]); }
            PG8_WAIT_L(8); PG8_BAR; PG8_WAIT_L(0); PG8_MMA(0, 0, At, B0); PG8_BAR; PG8_SCHED;
            PG8_LDB(B1, 0, 1); PG8_STAGE(PG8_SB(0, 0), b2, voffB);
            PG8_BAR; PG8_WAIT_L(0); PG8_MMA(0, 1, At, B1); PG8_BAR;
            PG8_LDA(At, 0, 1); PG8_STAGE_A(PG8_SA(0, 0), a2, aoc[0][0], aoc[0][1]);
            PG8_BAR; PG8_WAIT_L(0); PG8_MMA(1, 0, At, B0); PG8_BAR; PG8_SCHED;
            PG8_STAGE(PG8_SB(0, 1), b2 + hstep, voffB);
            PG8_WAIT_V(6); PG8_BAR; PG8_MMA(1, 1, At, B1); PG8_BAR;
            PG8_LDB(B0, 1, 0); PG8_SCHED; PG8_LDA(At, 1, 0); PG8_STAGE_A(PG8_SA(0, 1), a2, aoc[1][0], aoc[1][1]);
            PG8_WAIT_L(8); PG8_BAR; PG8_WAIT_L(0); PG8_MMA(0, 0, At, B0); PG8_BAR; PG8_SCHED;
            PG8_LDB(B1, 1, 1); PG8_STAGE(PG8_SB(1, 0), b3, voffB);
            PG8_BAR; PG8_WAIT_L(0); PG8_MMA(0, 1, At, B1); PG8_BAR;
            PG8_LDA(At, 1, 1); PG8_STAGE_A(PG8_SA(1, 0), a3, aoc[0][0], aoc[0][1]);
            PG8_BAR; PG8_WAIT_L(0); PG8_MMA(1, 0, At, B0); PG8_BAR; PG8_SCHED;
            PG8_STAGE(PG8_SB(1, 1), b3 + hstep, voffB);
            PG8_WAIT_V(6); PG8_BAR; PG8_MMA(1, 1, At, B1); PG8_BAR;
        }
        if constexpr (!Epi::AFTER_DRAIN) { const int l2 = tidx() & 63; E(acc, cur, wr, wc, l2 & 15, l2 >> 4); S.done(cur); }
        if (!has_next) break;
#pragma unroll
        for (int a = 0; a < 2; ++a)
#pragma unroll
            for (int b = 0; b < 2; ++b)
#pragma unroll
                for (int m = 0; m < 4; ++m)
#pragma unroll
                    for (int n = 0; n < 2; ++n) acc[a][b][m][n] = (f32x4){0.f, 0.f, 0.f, 0.f};
        cur = nxt; cA = nA; cB = nB; ++ui;
    }
    PG8_WAIT_V(0);
    if (wr == 0) PG8_BAR;
    PG8_BAR;
    if constexpr (Epi::AFTER_DRAIN) { E.fused(acc, cur, wr, wc, fr, fq, lds, wid, lane); S.done(cur); }
#undef PG8_SA
#undef PG8_SB
#undef PG8_STAGE
#undef PG8_STAGE_A
#undef PG8_LDA
#undef PG8_LDB
#undef PG8_MMA
#undef PG8_WAIT_V
#undef PG8_WAIT_L
#undef PG8_BAR
#undef PG8_SCHED

#undef PG8_MMA
#undef PG8_WAIT_V
#undef PG8_WAIT_L
#undef PG8_BAR
#undef PG8_SCHED
}

struct EpiMoe1G {
  static constexpr bool PERM = false, AFTER_DRAIN = false;
  char* wsb; const PG8_LAS int* tb;
  __device__ __forceinline__ void operator()(const f32x4 (&acc)[2][2][4][2], const GUnit& u, int wr, int wc, int fr, int fq) const {
    const int* list = (const int*)(wsb + WS_LIST) + (size_t)u.e * MROWS; const int off_e = tb[32 + u.e]; const float* rw = (const float*)(wsb + WS_ROUTE_W); bf16_t* amoe = (bf16_t*)(wsb + WS_AMOE);
    const int rbase = u.m0 + wr * 64 + fr;
    int ent[2][4]; float wg[2][4];
#pragma unroll
    for (int ai = 0; ai < 2; ++ai)
#pragma unroll
      for (int m = 0; m < 4; ++m) { int r = rbase + ai * HALF + m * 16; r = r < u.mvalid ? r : u.mvalid - 1; ent[ai][m] = list[r]; }
#pragma unroll
    for (int ai = 0; ai < 2; ++ai)
#pragma unroll
      for (int m = 0; m < 4; ++m) wg[ai][m] = rw[ent[ai][m]];
#pragma unroll
    for (int ai = 0; ai < 2; ++ai)
#pragma unroll
      for (int m = 0; m < 4; ++m) { const int r = rbase + ai * HALF + m * 16;
        if (r < u.mvalid) { const float wgt = wg[ai][m];
#pragma unroll
          for (int bj = 0; bj < 2; ++bj) { const f32x4 g = acc[ai][bj][m][0], uu = acc[ai][bj][m][1];
            const int hidden = ((u.n0 + bj * HALF + wc * 32) >> 1) + fq * 4;
            uint2 wv; wv.x = pack2(siluf_(g.x) * uu.x * wgt, siluf_(g.y) * uu.y * wgt); wv.y = pack2(siluf_(g.z) * uu.z * wgt, siluf_(g.w) * uu.w * wgt);
            *(uint2*)(amoe + (size_t)(off_e + r) * 256 + hidden) = wv; } } }
  }
};
struct EpiMoe2G {
  static constexpr bool PERM = false, AFTER_DRAIN = false;
  char* wsb;
  __device__ __forceinline__ void operator()(const f32x4 (&acc)[2][2][4][2], const GUnit& u, int wr, int wc, int fr, int fq) const {
    const int* list = (const int*)(wsb + WS_LIST) + (size_t)u.e * MROWS; bf16_t* Y = (bf16_t*)(wsb + WS_YBUF);
    const int rbase = u.m0 + wr * 64 + fr;
    int ent[2][4];
#pragma unroll
    for (int ai = 0; ai < 2; ++ai)
#pragma unroll
      for (int m = 0; m < 4; ++m) { int r = rbase + ai * HALF + m * 16; r = r < u.mvalid ? r : u.mvalid - 1; ent[ai][m] = list[r]; }
#pragma unroll
    for (int ai = 0; ai < 2; ++ai)
#pragma unroll
      for (int m = 0; m < 4; ++m) { const int r = rbase + ai * HALF + m * 16;
        if (r < u.mvalid) { bf16_t* yp = Y + (size_t)ent[ai][m] * D + u.n0 + wc * 32 + fq * 4;
#pragma unroll
          for (int bj = 0; bj < 2; ++bj)
#pragma unroll
            for (int n = 0; n < 2; ++n) { const f32x4 v = acc[ai][bj][m][n]; uint2 wv; wv.x = pack2(v.x, v.y); wv.y = pack2(v.z, v.w); *(uint2*)(yp + bj * HALF + n * 16) = wv; } } }
  }
};
struct EpiMoe1S {
  bf16_t* amoe; const int* list; const float* rw; int off_e;
  template <int MI> __device__ __forceinline__ void tile(const f32x4 (&acc)[MI][4], int mb, int nb, int Mvalid) const {
    const int lq4 = nb & 15, cb = nb - lq4;
#pragma unroll
    for (int i = 0; i < MI; ++i) { const int m = mb + i * 16; if (m < Mvalid) { const float wgt = rw[list[m]];
#pragma unroll
      for (int pr = 0; pr < 2; ++pr) { const f32x4 g = acc[i][2 * pr], u = acc[i][2 * pr + 1];
        uint2 wv; wv.x = pack2(siluf_(g.x) * u.x * wgt, siluf_(g.y) * u.y * wgt); wv.y = pack2(siluf_(g.z) * u.z * wgt, siluf_(g.w) * u.w * wgt);
        *(uint2*)(amoe + (size_t)(off_e + m) * 256 + ((cb + pr * 32) >> 1) + lq4) = wv; } } }
  }
};
__device__ __forceinline__ int moe_small_expert(const int* tb, int tile) { int e = 0;
#pragma unroll 1
  for (int q = 1; q < 32; ++q) if (tb[97 + q] <= tile) e = q;
  return e; }
__device__ __forceinline__ void ph_moe1g(const MP& p, int layer, char* lds) {
  int* tb = (int*)(lds + 131072);
  moe_tables(p, layer, 2, 4, tb);
  { MoeSched S; S.tb = (const PG8_LAS int*)tb; S.wsb = p.ws; S.Abase = (unsigned)WS_H; S.Bbase = (unsigned)WS_WMOE; S.b_estride = 512u * 1024u * 2u;
    S.ntn = 2; S.G = (int)gridDim.x; S.c = (int)blockIdx.x; S.K = 1024; S.gather = 1;
    EpiMoe1G E; E.wsb = p.ws; E.tb = S.tb;
    pg8g_phase((PG8_LAS unsigned char*)lds, p.ws, 1024, S, E); }
  __syncthreads();
  for (int tile = (int)gridDim.x - 1 - (int)blockIdx.x; tile < tb[129]; tile += gridDim.x) {
    const int e = moe_small_expert(tb, tile), lt = tile - tb[97 + e], mt = lt >> 2, nt = lt & 3;
    EpiMoe1S ep; ep.amoe = (bf16_t*)(p.ws + WS_AMOE); ep.list = (const int*)(p.ws + WS_LIST) + (size_t)e * MROWS; ep.rw = (const float*)(p.ws + WS_ROUTE_W); ep.off_e = tb[32 + e];
    gemm_tile<1>((const bf16_t*)(p.ws + WS_H), D, ep.list, 1, tb[e], (const bf16_t*)(p.ws + WS_WMOE) + (size_t)e * 512 * 1024, 1024, 1024, (tb[e] & ~255) + mt * 64, nt * 128, lds, ep);
  }
}
__device__ __forceinline__ void ph_moe2g(const MP& p, int layer, char* lds) {
  int* tb = (int*)(lds + 131072);
  moe_tables(p, layer, 4, 8, tb);
  { MoeSched S; S.tb = (const PG8_LAS int*)tb; S.wsb = p.ws; S.Abase = (unsigned)WS_AMOE; S.Bbase = (unsigned)(WS_WMOE + (size_t)32 * 512 * 1024 * 2); S.b_estride = 1024u * 256u * 2u;
    S.ntn = 4; S.G = (int)gridDim.x; S.c = (int)blockIdx.x; S.K = 256; S.gather = 0;
    EpiMoe2G E; E.wsb = p.ws;
    pg8g_phase((PG8_LAS unsigned char*)lds, p.ws, 256, S, E); }
  __syncthreads();
  const bf16_t* wd = (const bf16_t*)(p.ws + WS_WMOE) + (size_t)32 * 512 * 1024;
  for (int tile = (int)gridDim.x - 1 - (int)blockIdx.x; tile < tb[129]; tile += gridDim.x) {
    const int e = moe_small_expert(tb, tile), lt = tile - tb[97 + e], mt = lt >> 3, nt = lt & 7;
    EpiEach<EpiMoe2> ep; ep.e.Y = (bf16_t*)(p.ws + WS_YBUF); ep.e.list = (const int*)(p.ws + WS_LIST) + (size_t)e * MROWS; ep.e.m_base = 0;
    gemm_tile<1>((const bf16_t*)(p.ws + WS_AMOE) + (size_t)tb[32 + e] * 256, 256, nullptr, 0, tb[e], wd + (size_t)e * 1024 * 256, 256, 256, (tb[e] & ~255) + mt * 64, nt * 128, lds, ep);
  }
}
__device__ __forceinline__ void ph_combine(const MP& p, int layer, int nrows, int final_) {
  float* lat = p.out; float* ctxr = (float*)(p.ws + WS_XC); const bf16_t* Y = (const bf16_t*)(p.ws + WS_YBUF);
  const float* modl_cur = (const float*)(p.ws + WS_MODS) + layer * 3 * 6144; const float* modl_next = (const float*)(p.ws + WS_MODS) + 3 * 6144;
  const float* gain = final_ ? p.in[28] : p.in[6] + 1024; bf16_t* hout = (bf16_t*)(p.ws + WS_H);
  const int lane = tidx() & 63, gw = blockIdx.x * 8 + (tidx() >> 6);
  for (int row = gw; row < nrows; row += gridDim.x * 8) {
    float* src = row < NLAT ? lat + (size_t)row * D : ctxr + (size_t)(row - NLAT) * D;
    const int v = row_vec(row);
    f32x4 x[4]; float ss = 0.f;
#pragma unroll
    for (int j = 0; j < 4; ++j) {
      const int n = (lane + 64 * j) * 4;
      const f32x4 g2 = *(const f32x4*)(modl_cur + v * 6144 + 5120 + n);
      const uint2 y0 = *(const uint2*)(Y + ((size_t)row * 2) * D + n), y1 = *(const uint2*)(Y + ((size_t)row * 2 + 1) * D + n);
      f32x4 ys;
      ys.x = __uint_as_float(y0.x << 16) + __uint_as_float(y1.x << 16); ys.y = __uint_as_float(y0.x & 0xFFFF0000u) + __uint_as_float(y1.x & 0xFFFF0000u);
      ys.z = __uint_as_float(y0.y << 16) + __uint_as_float(y1.y << 16); ys.w = __uint_as_float(y0.y & 0xFFFF0000u) + __uint_as_float(y1.y & 0xFFFF0000u);
      x[j] = ((const f32x4*)src)[lane + 64 * j] + g2 * ys;
      ss += x[j].x * x[j].x + x[j].y * x[j].y + x[j].z * x[j].z + x[j].w * x[j].w;
    }
    const float rstd = 1.f / sqrtf(wave_sum(ss) * (1.f / D) + EPS);
#pragma unroll
    for (int j = 0; j < 4; ++j) {
      const int n = (lane + 64 * j) * 4;
      const f32x4 g = *(const f32x4*)(gain + n);
      if (final_) { ((f32x4*)src)[lane + 64 * j] = x[j] * rstd * g; }
      else {
        ((f32x4*)src)[lane + 64 * j] = x[j];
        const f32x4 sc = *(const f32x4*)(modl_next + v * 6144 + 1024 + n), sh = *(const f32x4*)(modl_next + v * 6144 + n);
        const f32x4 h = x[j] * rstd * g * (sc + 1.f) + sh;
        uint2 o; o.x = pack2(h.x, h.y); o.y = pack2(h.z, h.w);
        *(uint2*)(hout + (size_t)row * D + n) = o;
      }
    }
  }
}
__device__ __forceinline__ void ph_kr_rope(const float* kr, bf16_t* dk) {
  for (int idx = blockIdx.x * 512 + tidx(); idx < MROWS * 32; idx += gridDim.x * 512) {
    const int m = idx >> 5, j = idx & 31; int b, key; row_bkey(m, b, key);
    float val = kr[idx];
    if (m < NLAT) {
      const int t = m & 8191; const int half = j >> 4, jj = j & 15, i = jj & 7;
      const float pos = half ? (float)(t & 63) : (float)(t >> 6);
      float sn, cs; sincosf(pos * rope_inv(i), &sn, &cs);
      const float x1 = kr[(size_t)m * 32 + half * 16 + i], x2 = kr[(size_t)m * 32 + half * 16 + 8 + i];
      val = (jj < 8) ? (x1 * cs - x2 * sn) : (x1 * sn + x2 * cs);
    }
    const bf16_t o = f2bf(val);
#pragma unroll
    for (int hh = 0; hh < 8; ++hh) dk[((size_t)(b * 8 + hh) * NKEY + key) * 128 + 64 + j] = o;
  }
}

#define MFMA32(a, b, c) __builtin_amdgcn_mfma_f32_32x32x16_bf16(a, b, c, 0, 0, 0)
#define KSWZ(row, colB) ((row) * 256 + ((colB) ^ (((row) & 7) << 4)))
#define SBAR() __builtin_amdgcn_sched_barrier(0)
__device__ __forceinline__ int crow(int r, int hi) { return (r & 3) + 8 * (r >> 2) + 4 * hi; }
__device__ __forceinline__ unsigned cvtpk(float lo, float hi) { unsigned r; asm volatile("v_cvt_pk_bf16_f32 %0, %1, %2" : "=v"(r) : "v"(lo), "v"(hi)); return r; }

__device__ __forceinline__ void att_partialSM(f32x16& p0, f32x16& p1, float& m_reg, float& mn, float& alpha) {
  float pmax = p0[0];
#pragma unroll
  for (int r = 1; r < 16; ++r) pmax = fmaxf(pmax, p0[r]);
#pragma unroll
  for (int r = 0; r < 16; ++r) pmax = fmaxf(pmax, p1[r]);
  { auto rr = __builtin_amdgcn_permlane32_swap(__float_as_uint(pmax), __float_as_uint(pmax), false, false);
    pmax = fmaxf(__uint_as_float(rr[0]), __uint_as_float(rr[1])); }
  if (__builtin_expect(__all(pmax - m_reg <= ATT_THR), 1)) { mn = m_reg; alpha = 1.f; }
  else { mn = fmaxf(m_reg, pmax); alpha = __builtin_amdgcn_exp2f(m_reg - mn); m_reg = mn; }
#pragma unroll
  for (int r = 0; r < 16; ++r) p0[r] = __builtin_amdgcn_exp2f(p0[r] - mn);
#pragma unroll
  for (int r = 0; r < 16; ++r) p1[r] = p1[r] - mn;
}
__device__ __forceinline__ void att_finishSM(f32x16& p0, f32x16& p1, float alpha, float& l_reg, bf16x8& pa0, bf16x8& pa1, bf16x8& pa2, bf16x8& pa3) {
#pragma unroll
  for (int r = 0; r < 16; ++r) p1[r] = __builtin_amdgcn_exp2f(p1[r]);
  float ps = 0.f;
#pragma unroll
  for (int r = 0; r < 16; ++r) ps += p0[r];
#pragma unroll
  for (int r = 0; r < 16; ++r) ps += p1[r];
  { auto rr = __builtin_amdgcn_permlane32_swap(__float_as_uint(ps), __float_as_uint(ps), false, false);
    ps = __uint_as_float(rr[0]) + __uint_as_float(rr[1]); }
  l_reg = l_reg * alpha + ps;
#define PK4(P, BASE, OUT) do { unsigned a0 = cvtpk(P[BASE + 0], P[BASE + 1]), a1 = cvtpk(P[BASE + 2], P[BASE + 3]);   \
    unsigned b0 = cvtpk(P[BASE + 4], P[BASE + 5]), b1 = cvtpk(P[BASE + 6], P[BASE + 7]);                              \
    auto r0 = __builtin_amdgcn_permlane32_swap(a0, b0, false, false); auto r1 = __builtin_amdgcn_permlane32_swap(a1, b1, false, false); \
    u32x4 w = {r0[0], r1[0], r0[1], r1[1]}; OUT = *reinterpret_cast<bf16x8*>(&w); } while (0)
  PK4(p0, 0, pa0); PK4(p0, 8, pa1); PK4(p1, 0, pa2); PK4(p1, 8, pa3);
}
template <int ND0>
__device__ __forceinline__ void att_qkt(f32x16& p0, f32x16& p1, const char* Ks, const bf16x8* qr, int r32, int hi) {
#pragma unroll
  for (int r = 0; r < 16; ++r) { p0[r] = 0.f; p1[r] = 0.f; }
#pragma unroll
  for (int d0 = 0; d0 < ND0; ++d0) { const int cb = (d0 * 16 + hi * 8) * 2;
    const bf16x8 b0 = *reinterpret_cast<const bf16x8*>(Ks + KSWZ(r32, cb));
    const bf16x8 b1 = *reinterpret_cast<const bf16x8*>(Ks + KSWZ(32 + r32, cb));
    p0 = MFMA32(b0, qr[d0], p0);
    p1 = MFMA32(b1, qr[d0], p1); }
}
__device__ __forceinline__ int v_st64(int k, int c) { const int kk = (k & ~0xC) | ((k & 4) << 1) | ((k & 8) >> 1); return ((kk >> 3) * 2 + (c >> 5)) * 512 + ((kk & 7) * 32 + (c & 31)) * 2; }
__device__ __forceinline__ int v_rd_base(int lane) { return ((lane & 3) << 3) | (((lane >> 2) & 3) << 6) | (((lane >> 4) & 1) << 5) | (((lane >> 5) & 1) << 8); }
static constexpr int v_rd_off64(int d0, int ks, int half) { return d0 * 512 + ks * 2048 + half * 1024; }
template <int OFF> __device__ __forceinline__ s16x4 tr_read(int vb) {
  s16x4 r; asm volatile("ds_read_b64_tr_b16 %0, %1 offset:%2" : "=&v"(r) : "v"(vb), "i"(OFF) : "memory"); return r;
}
template <int D0> __device__ __forceinline__ void pv_one64(f32x16& od, int vb, bf16x8 pa0, bf16x8 pa1, bf16x8 pa2, bf16x8 pa3) {
  const s16x4 l0 = tr_read<v_rd_off64(D0, 0, 0)>(vb), h0 = tr_read<v_rd_off64(D0, 0, 1)>(vb), l1 = tr_read<v_rd_off64(D0, 1, 0)>(vb), h1 = tr_read<v_rd_off64(D0, 1, 1)>(vb);
  const s16x4 l2 = tr_read<v_rd_off64(D0, 2, 0)>(vb), h2 = tr_read<v_rd_off64(D0, 2, 1)>(vb), l3 = tr_read<v_rd_off64(D0, 3, 0)>(vb), h3 = tr_read<v_rd_off64(D0, 3, 1)>(vb);
  asm volatile("s_waitcnt lgkmcnt(0)" ::: "memory"); SBAR();
#define PKV(L, H) (bf16x8){L[0], L[1], L[2], L[3], H[0], H[1], H[2], H[3]}
  od = MFMA32(pa0, PKV(l0, h0), od);
  od = MFMA32(pa1, PKV(l1, h1), od);
  od = MFMA32(pa2, PKV(l2, h2), od);
  od = MFMA32(pa3, PKV(l3, h3), od);
}

__device__ __forceinline__ void mla_block(const bf16_t* __restrict__ Qb, const bf16_t* __restrict__ Kh, const bf16_t* __restrict__ Vh, bf16_t* __restrict__ Ob, int t0, char* lds) {
  constexpr int SHM_V = 64 * 64 * 2, SHM_K = 64 * 128 * 2, NT = NKEY / 64;
  const int tid = tidx(), wid = tid >> 6, lane = tid & 63, r32 = lane & 31, hi = lane >> 5;
  char* V_lds = lds; char* K_lds = lds + 2 * SHM_V;
  float* wsf = (float*)(lds + 2 * SHM_V + 2 * SHM_K) + wid * 64; float* li_l = wsf; float* al_l = wsf + 32;
  float m_reg = -1e30f, l_reg = 0.f; f32x16 o[2];
#pragma unroll
  for (int r = 0; r < 16; ++r) { o[0][r] = 0.f; o[1][r] = 0.f; }
  bf16x8 qr[6];
  { const bf16_t* Qw = Qb + (size_t)(wid * 32 + r32) * 96;
#pragma unroll
    for (int d0 = 0; d0 < 4; ++d0) qr[d0] = *(const bf16x8*)(Qw + d0 * 16 + hi * 8);
    const int t = t0 + wid * 32 + r32;
#pragma unroll
    for (int g = 0; g < 2; ++g) {
      const bf16x8 x1 = *(const bf16x8*)(Qw + 64 + g * 16), x2 = *(const bf16x8*)(Qw + 64 + g * 16 + 8);
      const float pos = g ? (float)(t & 63) : (float)(t >> 6);
      unsigned wv[4];
#pragma unroll
      for (int i = 0; i < 8; i += 2) {
        float o2[2];
#pragma unroll
        for (int q = 0; q < 2; ++q) { const float ang = pos * rope_inv(i + q); const float sn = __sinf(ang), cs = __cosf(ang);
          const float a = bf2f((bf16_t)x1[i + q]), b = bf2f((bf16_t)x2[i + q]);
          o2[q] = hi ? (a * sn + b * cs) : (a * cs - b * sn); }
        wv[i >> 1] = pack2(o2[0], o2[1]);
      }
      u32x4 w4 = {wv[0], wv[1], wv[2], wv[3]}; qr[4 + g] = *reinterpret_cast<bf16x8*>(&w4);
    }
  }
  const int kq0 = tid, kq1 = tid < 256 ? 512 + tid : tid;
  const int kr0 = kq0 / 12, kc0 = (kq0 - kr0 * 12) * 8, kr1 = kq1 / 12, kc1 = (kq1 - kr1 * 12) * 8; const bool k2 = tid < 256;
  const int kw0 = KSWZ(kr0, kc0 * 2), kw1 = KSWZ(kr1, kc1 * 2);
  const int vk = tid >> 3, vc = (tid & 7) * 8, vst = v_st64(vk, vc);
  const int vb0 = (int)(uintptr_t)V_lds + v_rd_base(lane);
  const int ko0 = kr0 * 128 + kc0, ko1 = kr1 * 128 + kc1, vo = vk * 64 + vc;
  uint4 sv_0, sk0_0, sk1_0, sv_1, sk0_1, sk1_1;
#define SLOAD(i, kk0) do { sv_##i = *(const uint4*)(Vh + ((kk0) * 64 + vo)); sk0_##i = *(const uint4*)(Kh + ((kk0) * 128 + ko0)); sk1_##i = *(const uint4*)(Kh + ((kk0) * 128 + ko1)); } while (0)
#define SWRITE(b, i) do { *(uint4*)(V_lds + (b) * SHM_V + vst) = sv_##i; *(uint4*)(K_lds + (b) * SHM_K + kw0) = sk0_##i; if (k2) *(uint4*)(K_lds + (b) * SHM_K + kw1) = sk1_##i; } while (0)
#define SWAIT() asm volatile("s_waitcnt vmcnt(3)" ::: "memory")
#define RESC(a) do { if (__any((a) < 1.f)) { if (hi == 0) al_l[r32] = (a); asm volatile("s_waitcnt lgkmcnt(0)" ::: "memory"); \
    _Pragma("unroll") for (int d = 0; d < 2; ++d) _Pragma("unroll") for (int r = 0; r < 16; ++r) o[d][r] *= al_l[crow(r, hi)]; } } while (0)
#define PV2(vb) do { pv_one64<0>(o[0], (vb), pa0, pa1, pa2, pa3); pv_one64<1>(o[1], (vb), pa0, pa1, pa2, pa3); } while (0)
  f32x16 pA0, pA1, pB0, pB1; float mnA, mnB, alA, alB; bf16x8 pa0, pa1, pa2, pa3;
  SLOAD(0, 0); asm volatile("s_waitcnt vmcnt(0)" ::: "memory"); SWRITE(0, 0); __syncthreads();
  att_qkt<6>(pA0, pA1, K_lds, qr, r32, hi); att_partialSM(pA0, pA1, m_reg, mnA, alA);
  SLOAD(1, 64); SLOAD(0, 128);
  SWAIT(); SWRITE(1, 1); __syncthreads();
  for (int j = 1; j + 1 < NT; j += 2) {
    SBAR(); att_qkt<6>(pB0, pB1, K_lds + SHM_K, qr, r32, hi);
    att_finishSM(pA0, pA1, alA, l_reg, pa0, pa1, pa2, pa3); SBAR();
    SLOAD(1, (j + 2) * 64); SBAR();
    PV2(vb0); att_partialSM(pB0, pB1, m_reg, mnB, alB);
    __syncthreads(); SWAIT(); SWRITE(0, 0);
    RESC(alB); __syncthreads();
    SBAR(); att_qkt<6>(pA0, pA1, K_lds, qr, r32, hi);
    att_finishSM(pB0, pB1, alB, l_reg, pa0, pa1, pa2, pa3); SBAR();
    if (j + 3 < NT) SLOAD(0, (j + 3) * 64); SBAR();
    PV2(vb0 + SHM_V); att_partialSM(pA0, pA1, m_reg, mnA, alA);
    __syncthreads(); SWAIT(); SWRITE(1, 1);
    RESC(alA); __syncthreads();
  }
  SBAR(); att_qkt<6>(pB0, pB1, K_lds + SHM_K, qr, r32, hi);
  att_finishSM(pA0, pA1, alA, l_reg, pa0, pa1, pa2, pa3); SBAR();
  PV2(vb0); att_partialSM(pB0, pB1, m_reg, mnB, alB);
  __syncthreads(); RESC(alB);
  att_finishSM(pB0, pB1, alB, l_reg, pa0, pa1, pa2, pa3); SBAR();
  PV2(vb0 + SHM_V);
  if (hi == 0) li_l[r32] = l_reg; asm volatile("s_waitcnt lgkmcnt(0)" ::: "memory");
  bf16_t* Ow = Ob + (size_t)(wid * 32) * D;
#pragma unroll
  for (int r = 0; r < 16; ++r) { const int orow = crow(r, hi); const float rl = __builtin_amdgcn_rcpf(li_l[orow]);
#pragma unroll
    for (int d0 = 0; d0 < 2; ++d0) Ow[(size_t)orow * D + d0 * 32 + r32] = f2bf(o[d0][r] * rl); }
  __syncthreads();
#undef SLOAD
#undef SWRITE
#undef SWAIT
}
__device__ __forceinline__ void ph_mla(const MP& p, char* lds) {
  const bf16_t* dq = (const bf16_t*)(p.ws + WS_DQ); const bf16_t* dk = (const bf16_t*)(p.ws + WS_DK); const bf16_t* dv = (const bf16_t*)(p.ws + WS_DV);
  bf16_t* abuf = (bf16_t*)(p.ws + WS_A);
  for (int item = blockIdx.x; item < 512; item += gridDim.x) {
    const int bh = (item & 7) + 8 * (item >> 8), qb = (item >> 3) & 31, b = bh >> 3, h = bh & 7;
    mla_block(dq + ((size_t)bh * SEQ + qb * 256) * 96, dk + (size_t)bh * NKEY * 128, dv + (size_t)bh * NKEY * 64,
              abuf + (size_t)(b * SEQ + qb * 256) * D + 512 + h * 64, qb * 256, lds);
  }
}

__device__ __forceinline__ int hgrn_step_cid(int b, int dir, int s) {
  if (s < 4) return 256 + b * 4 + (dir ? 3 - s : s);
  return b * 128 + (dir ? 131 - s : s - 4);
}
__device__ __forceinline__ void ph_hgrn_a(const MP& p, char* lds) {
  bf16_t* U = (bf16_t*)(p.ws + WS_U); float* LF = (float*)(p.ws + WS_LF); float* alast = (float*)(p.ws + WS_ALAST);
  bf16_t* KT = (bf16_t*)(p.ws + WS_A); bf16_t* VT = (bf16_t*)(p.ws + WS_H + USLOT);
  float* Ef = (float*)lds;
  bf16_t* Kn = (bf16_t*)(lds + 33792);
  bf16_t* Vn = (bf16_t*)(lds + 33792 + 17408);
  float* gsum = (float*)(lds + 33792 + 2 * 17408);
  const int t = tidx(), srow = t >> 3, scb = (t & 7) * 16, col = t & 127, grp = t >> 7;
  for (int item = blockIdx.x; item < NCHUNK * 8; item += gridDim.x) {
    const int cid = item >> 3, dir = (item >> 2) & 1, h = item & 3; const size_t row0 = (size_t)cid * 64;
    { const size_t go = (row0 + srow) * 512 + h * 128 + scb;
      const float* lp = LF + (size_t)dir * MROWS * 512 + go;
      const f32x4 e0 = *(const f32x4*)lp, e1 = *(const f32x4*)(lp + 4), e2 = *(const f32x4*)(lp + 8), e3 = *(const f32x4*)(lp + 12);
      const uint4 k0 = *(const uint4*)(U + (size_t)(1 + dir) * MROWS * 512 + go), k1 = *(const uint4*)(U + (size_t)(1 + dir) * MROWS * 512 + go + 8);
      float* ed = Ef + srow * 132 + scb; *(f32x4*)ed = e0; *(f32x4*)(ed + 4) = e1; *(f32x4*)(ed + 8) = e2; *(f32x4*)(ed + 12) = e3;
      *(uint4*)(Kn + srow * 136 + scb) = k0; *(uint4*)(Kn + srow * 136 + scb + 8) = k1;
      if (dir == 0) { const uint4 v0 = *(const uint4*)(U + (size_t)3 * MROWS * 512 + go), v1 = *(const uint4*)(U + (size_t)3 * MROWS * 512 + go + 8);
        *(uint4*)(Vn + srow * 136 + scb) = v0; *(uint4*)(Vn + srow * 136 + scb + 8) = v1; } }
    __syncthreads();
    float pre[16]; float run = 0.f;
#pragma unroll
    for (int i = 0; i < 16; ++i) { const int rr = grp * 16 + (dir ? 15 - i : i); run += Ef[rr * 132 + col]; pre[i] = run; }
    gsum[grp * 128 + col] = run;
    __syncthreads();
    const float g0 = gsum[col], g1 = gsum[128 + col], g2 = gsum[256 + col], g3 = gsum[384 + col];
    const float total = (g0 + g1) + (g2 + g3);
    float offs;
    if (dir == 0) offs = grp == 0 ? 0.f : (grp == 1 ? g0 : (grp == 2 ? g0 + g1 : g0 + g1 + g2));
    else offs = grp == 3 ? 0.f : (grp == 2 ? g3 : (grp == 1 ? g3 + g2 : g3 + g2 + g1));
    if (grp == 0) alast[((size_t)dir * NCHUNK + cid) * 512 + h * 128 + col] = __expf(total);
    unsigned kw[8];
    float* lfo = LF + ((size_t)dir * MROWS + row0 + grp * 16) * 512 + h * 128 + col;
    bf16_t* uko = U + (size_t)(1 + dir) * MROWS * 512 + (row0 + grp * 16) * 512 + h * 128 + col;
#pragma unroll
    for (int i = 0; i < 16; i += 2) {
      const float ea = total - (offs + pre[dir ? 15 - i : i]), eb = total - (offs + pre[dir ? 14 - i : i + 1]);
      lfo[(size_t)i * 512] = ea; lfo[(size_t)(i + 1) * 512] = eb;
      const bf16_t ka = f2bf(bf2f(Kn[(grp * 16 + i) * 136 + col]) * __expf(ea)), kb = f2bf(bf2f(Kn[(grp * 16 + i + 1) * 136 + col]) * __expf(eb));
      uko[(size_t)i * 512] = ka; uko[(size_t)(i + 1) * 512] = kb; kw[i >> 1] = (unsigned)ka | ((unsigned)kb << 16);
    }
    { bf16_t* kt = KT + ((((size_t)dir * NCHUNK + cid) * 4 + h) * 128 + col) * 64 + grp * 16;
      *(uint4*)kt = make_uint4(kw[0], kw[1], kw[2], kw[3]); *(uint4*)(kt + 8) = make_uint4(kw[4], kw[5], kw[6], kw[7]); }
    if (dir == 0) {
      unsigned vw[8];
#pragma unroll
      for (int i = 0; i < 16; i += 2) vw[i >> 1] = (unsigned)Vn[(grp * 16 + i) * 136 + col] | ((unsigned)Vn[(grp * 16 + i + 1) * 136 + col] << 16);
      bf16_t* vt = VT + (((size_t)cid * 4 + h) * 128 + col) * 64 + grp * 16;
      *(uint4*)vt = make_uint4(vw[0], vw[1], vw[2], vw[3]); *(uint4*)(vt + 8) = make_uint4(vw[4], vw[5], vw[6], vw[7]);
    }
    __syncthreads();
  }
}
__device__ __forceinline__ bf16_t* hgrn_sbuf(const MP& p, int bhd, int cid) {
  return cid < 256 ? (bf16_t*)p.out + ((size_t)bhd * 128 + (cid & 127)) * 16384 : (bf16_t*)(p.ws + WS_ODIR_CTX) + ((size_t)bhd * 4 + ((cid - 256) & 3)) * 16384;
}
__device__ __forceinline__ void ph_hgrn_b(const MP& p) {
  const int tid = tidx(), w = tid >> 6, lane = tid & 63, l15 = lane & 15, lq = lane >> 4;
  if (w < 4) {
    const bf16_t* KT = (const bf16_t*)(p.ws + WS_A); const bf16_t* VT = (const bf16_t*)(p.ws + WS_H + USLOT); const float* alast = (const float*)(p.ws + WS_ALAST);
    for (int item = blockIdx.x * 4 + w; item < 1024; item += gridDim.x * 4) {
      const int bhd = item >> 6, dkt = (item >> 3) & 7, dvt = item & 7, b = bhd >> 3, h = (bhd >> 1) & 3, dir = bhd & 1;
      f32x4 S = {0.f, 0.f, 0.f, 0.f};
      uint4 kaA[2][2], vbA[2][2], kaB[2][2], vbB[2][2], kaC[2][2], vbC[2][2], kaD[2][2], vbD[2][2]; float alA[2], alB[2], alC[2], alD[2];
#define HB_LOAD(X, s0) _Pragma("unroll") for (int u = 0; u < 2; ++u) { const int cid = hgrn_step_cid(b, dir, (s0) + u);                              \
        const bf16_t* kt = KT + ((((size_t)dir * NCHUNK + cid) * 4 + h) * 128 + dkt * 16 + l15) * 64 + lq * 8;                                       \
        const bf16_t* vt = VT + (((size_t)cid * 4 + h) * 128 + dvt * 16 + l15) * 64 + lq * 8;                                                       \
        ka##X[u][0] = *(const uint4*)kt; ka##X[u][1] = *(const uint4*)(kt + 32); vb##X[u][0] = *(const uint4*)vt; vb##X[u][1] = *(const uint4*)(vt + 32); \
        al##X[u] = alast[((size_t)dir * NCHUNK + cid) * 512 + h * 128 + dkt * 16 + l15]; }
#define HB_STEP(X, s0) _Pragma("unroll") for (int u = 0; u < 2; ++u) { const int cid = hgrn_step_cid(b, dir, (s0) + u);                              \
        f32x4 T = {0.f, 0.f, 0.f, 0.f};                                                                                                              \
        T = MFMA16(*reinterpret_cast<bf16x8*>(&vb##X[u][0]), *reinterpret_cast<bf16x8*>(&ka##X[u][0]), T);                                           \
        T = MFMA16(*reinterpret_cast<bf16x8*>(&vb##X[u][1]), *reinterpret_cast<bf16x8*>(&ka##X[u][1]), T);                                           \
        const f32x4 Sp = S * al##X[u];                                                                                                               \
        bf16_t* sb = hgrn_sbuf(p, bhd, cid) + (size_t)(dvt * 16 + lq * 4) * 128 + dkt * 16 + l15;                                                    \
        sb[0] = f2bf(Sp.x); sb[128] = f2bf(Sp.y); sb[256] = f2bf(Sp.z); sb[384] = f2bf(Sp.w);                                                       \
        S = Sp + T; }
      HB_LOAD(A, 0); HB_LOAD(B, 2); HB_LOAD(C, 4);
      for (int s0 = 0; s0 < 132; s0 += 8) {
        if (s0 + 6 < 132) { HB_LOAD(D, s0 + 6); }
        HB_STEP(A, s0);
        if (s0 + 8 < 132) { HB_LOAD(A, s0 + 8); }
        HB_STEP(B, s0 + 2);
        if (s0 + 10 < 132) { HB_LOAD(B, s0 + 10); }
        if (s0 + 4 < 132) { HB_STEP(C, s0 + 4); }
        if (s0 + 12 < 132) { HB_LOAD(C, s0 + 12); }
        if (s0 + 6 < 132) { HB_STEP(D, s0 + 6); }
      }
#undef HB_LOAD
#undef HB_STEP
    }
  }
}
__device__ __forceinline__ void ph_hgrn_c(const MP& p, char* lds) {
  const bf16_t* U = (const bf16_t*)(p.ws + WS_U); const float* LF = (const float*)(p.ws + WS_LF); const bf16_t* VT = (const bf16_t*)(p.ws + WS_H + USLOT);
  bf16_t* abuf = (bf16_t*)(p.ws + WS_A); const float* onorm = p.in[11];
  char* Qs = lds; char* Ks = lds + 16384; char* Ss = lds + 32768; char* Vs = lds + 65536; char* As = lds + 81920; float* red = (float*)(lds + 90112);
  const int t = tidx(), lane = t & 63, w = t >> 6, wm = w >> 1, wn = w & 1, l15 = lane & 15, lq = lane >> 4;
  const int srow = t >> 3, scb = (t & 7) * 16;
  uint4 rq0, rq1, rk0, rk1, rv0, rv1, rs0, rs1, rs2, rs3; f32x4 re0, re1, re2, re3;
#define HC_LOAD(item_, dir_) do { const int bh_ = (item_) / 132, cp_ = (item_) - bh_ * 132, b_ = bh_ >> 2, h_ = bh_ & 3; \
    const int cid_ = cp_ < 128 ? b_ * 128 + cp_ : 256 + b_ * 4 + (cp_ - 128); \
    const size_t go_ = ((size_t)cid_ * 64 + srow) * 512 + h_ * 128 + scb; \
    rq0 = *(const uint4*)(U + go_); rq1 = *(const uint4*)(U + go_ + 8); \
    rk0 = *(const uint4*)(U + (size_t)(1 + (dir_)) * MROWS * 512 + go_); rk1 = *(const uint4*)(U + (size_t)(1 + (dir_)) * MROWS * 512 + go_ + 8); \
    const float* ep_ = LF + (size_t)(dir_) * MROWS * 512 + go_; re0 = *(const f32x4*)ep_; re1 = *(const f32x4*)(ep_ + 4); re2 = *(const f32x4*)(ep_ + 8); re3 = *(const f32x4*)(ep_ + 12); \
    if ((dir_) == 0) { const bf16_t* vt_ = VT + ((size_t)cid_ * 4 + h_) * 8192; rv0 = *(const uint4*)(vt_ + (size_t)t * 8); rv1 = *(const uint4*)(vt_ + (size_t)(t + 512) * 8); } \
    const bf16_t* sb_ = hgrn_sbuf(p, bh_ * 2 + (dir_), cid_); \
    rs0 = *(const uint4*)(sb_ + (size_t)t * 8); rs1 = *(const uint4*)(sb_ + (size_t)(t + 512) * 8); rs2 = *(const uint4*)(sb_ + (size_t)(t + 1024) * 8); rs3 = *(const uint4*)(sb_ + (size_t)(t + 1536) * 8); } while (0)
  if ((int)blockIdx.x < 8 * 132) HC_LOAD((int)blockIdx.x, 0);
  for (int item = blockIdx.x; item < 8 * 132; item += gridDim.x) {
    const int bh = item / 132, cpos = item - bh * 132, b = bh >> 2, h = bh & 3;
    const int cid = cpos < 128 ? b * 128 + cpos : 256 + b * 4 + (cpos - 128); const size_t row0 = (size_t)cid * 64;
    f32x4 acc[4];
#pragma unroll
    for (int j = 0; j < 4; ++j) acc[j] = (f32x4){0.f, 0.f, 0.f, 0.f};
    for (int dir = 0; dir < 2; ++dir) {
      {
        const unsigned qw[8] = {rq0.x, rq0.y, rq0.z, rq0.w, rq1.x, rq1.y, rq1.z, rq1.w};
        const float ev[16] = {re0.x, re0.y, re0.z, re0.w, re1.x, re1.y, re1.z, re1.w, re2.x, re2.y, re2.z, re2.w, re3.x, re3.y, re3.z, re3.w};
        unsigned ow[8];
#pragma unroll
        for (int i = 0; i < 8; ++i) ow[i] = pack2(__uint_as_float(qw[i] << 16) * __expf(-ev[2 * i]), __uint_as_float(qw[i] & 0xFFFF0000u) * __expf(-ev[2 * i + 1]));
        const int c0 = scb >> 3, sw = srow & 15;
        *(uint4*)(Qs + srow * 256 + ((c0 ^ sw) << 4)) = make_uint4(ow[0], ow[1], ow[2], ow[3]);
        *(uint4*)(Qs + srow * 256 + (((c0 + 1) ^ sw) << 4)) = make_uint4(ow[4], ow[5], ow[6], ow[7]);
        *(uint4*)(Ks + srow * 256 + ((c0 ^ sw) << 4)) = rk0;
        *(uint4*)(Ks + srow * 256 + (((c0 + 1) ^ sw) << 4)) = rk1;
        if (dir == 0) { { const int idx = t, r = idx >> 3, c = idx & 7; *(uint4*)(Vs + r * 128 + ((c ^ ((r >> 1) & 7)) << 4)) = rv0; }
                        { const int idx = t + 512, r = idx >> 3, c = idx & 7; *(uint4*)(Vs + r * 128 + ((c ^ ((r >> 1) & 7)) << 4)) = rv1; } }
        { const int idx = t, r = idx >> 4, c = idx & 15; *(uint4*)(Ss + r * 256 + ((c ^ (r & 15)) << 4)) = rs0; }
        { const int idx = t + 512, r = idx >> 4, c = idx & 15; *(uint4*)(Ss + r * 256 + ((c ^ (r & 15)) << 4)) = rs1; }
        { const int idx = t + 1024, r = idx >> 4, c = idx & 15; *(uint4*)(Ss + r * 256 + ((c ^ (r & 15)) << 4)) = rs2; }
        { const int idx = t + 1536, r = idx >> 4, c = idx & 15; *(uint4*)(Ss + r * 256 + ((c ^ (r & 15)) << 4)) = rs3; }
      }
      __syncthreads();
      if (dir == 0) HC_LOAD(item, 1); else if (item + (int)gridDim.x < 8 * 132) HC_LOAD(item + (int)gridDim.x, 0);
      bf16x8 af[4];
#pragma unroll
      for (int ks = 0; ks < 4; ++ks) af[ks] = *(const bf16x8*)(Qs + (wm * 16 + l15) * 256 + (((ks * 4 + lq) ^ l15) << 4));
      {
        f32x4 a2[2];
#pragma unroll
        for (int ni = 0; ni < 2; ++ni) { a2[ni] = (f32x4){0.f, 0.f, 0.f, 0.f};
#pragma unroll
          for (int ks = 0; ks < 4; ++ks) { const bf16x8 bf = *(const bf16x8*)(Ks + (wn * 32 + ni * 16 + l15) * 256 + (((ks * 4 + lq) ^ l15) << 4)); a2[ni] = MFMA16(bf, af[ks], a2[ni]); } }
        const int tt = wm * 16 + l15;
#pragma unroll
        for (int ni = 0; ni < 2; ++ni) { const int s0 = wn * 32 + ni * 16 + lq * 4; float v[4] = {a2[ni].x, a2[ni].y, a2[ni].z, a2[ni].w};
#pragma unroll
          for (int r = 0; r < 4; ++r) { const int s = s0 + r; const bool keep = dir ? (s >= tt) : (s <= tt); v[r] = keep ? v[r] : 0.f; }
          uint2 wv; wv.x = pack2(v[0], v[1]); wv.y = pack2(v[2], v[3]);
          *(uint2*)(As + tt * 128 + (((s0 >> 3) ^ ((tt >> 1) & 7)) << 4) + (s0 & 7) * 2) = wv; }
      }
#pragma unroll
      for (int ni = 0; ni < 4; ++ni) {
#pragma unroll
        for (int ks = 0; ks < 4; ++ks) { const bf16x8 bf = *(const bf16x8*)(Ss + (wn * 64 + ni * 16 + l15) * 256 + (((ks * 4 + lq) ^ l15) << 4)); acc[ni] = MFMA16(bf, af[ks], acc[ni]); } }
      __syncthreads();
      {
        const int tt = wm * 16 + l15; bf16x8 aa[2];
#pragma unroll
        for (int ks = 0; ks < 2; ++ks) aa[ks] = *(const bf16x8*)(As + tt * 128 + (((ks * 4 + lq) ^ ((tt >> 1) & 7)) << 4));
#pragma unroll
        for (int ni = 0; ni < 4; ++ni) { const int r = wn * 64 + ni * 16 + l15;
#pragma unroll
          for (int ks = 0; ks < 2; ++ks) { const bf16x8 bf = *(const bf16x8*)(Vs + r * 128 + (((ks * 4 + lq) ^ ((r >> 1) & 7)) << 4)); acc[ni] = MFMA16(bf, aa[ks], acc[ni]); } }
      }
      __syncthreads();
    }
    const int tt = wm * 16 + l15; float ss = 0.f;
#pragma unroll
    for (int ni = 0; ni < 4; ++ni) ss += acc[ni].x * acc[ni].x + acc[ni].y * acc[ni].y + acc[ni].z * acc[ni].z + acc[ni].w * acc[ni].w;
    ss += __shfl_xor(ss, 16); ss += __shfl_xor(ss, 32);
    if (lq == 0) red[tt * 2 + wn] = ss;
    __syncthreads();
    const float rstd = 1.f / sqrtf((red[tt * 2] + red[tt * 2 + 1]) * (1.f / 128.f) + EPS);
#pragma unroll
    for (int ni = 0; ni < 4; ++ni) {
      const int dv = wn * 64 + ni * 16 + lq * 4; const size_t go = (row0 + tt) * 512 + h * 128 + dv;
      const uint2 gw = *(const uint2*)(U + (size_t)4 * MROWS * 512 + go); const f32x4 on = *(const f32x4*)(onorm + dv);
      uint2 wv;
      wv.x = pack2(acc[ni].x * rstd * on.x * __uint_as_float(gw.x << 16), acc[ni].y * rstd * on.y * __uint_as_float(gw.x & 0xFFFF0000u));
      wv.y = pack2(acc[ni].z * rstd * on.z * __uint_as_float(gw.y << 16), acc[ni].w * rstd * on.w * __uint_as_float(gw.y & 0xFFFF0000u));
      *(uint2*)(abuf + (row0 + tt) * D + h * 128 + dv) = wv;
    }
    __syncthreads();
  }
#undef HC_LOAD
}

#define XB_TMO      128
#define XB_XCNT(j)  (256  + 64 * (j))
#define XB_XSUB(j)  (1280 + 64 * (j))
#define XB_XGEN(j)  (2304 + 64 * (j))
#define XB_TOP      3328
#define XB_TOPGEN   3392
#define XCD_BAR_WORDS 3456
#define XB_SPIN_CAP (1u << 20)
#define LAS __attribute__((address_space(3)))
__device__ __forceinline__ unsigned xb_ld(unsigned* p)              { return __hip_atomic_load(p, __ATOMIC_RELAXED, __HIP_MEMORY_SCOPE_AGENT); }
__device__ __forceinline__ unsigned xb_add(unsigned* p, unsigned v) { return __hip_atomic_fetch_add(p, v, __ATOMIC_RELAXED, __HIP_MEMORY_SCOPE_AGENT); }
__device__ __forceinline__ unsigned xb_xcc_id() { return (unsigned)__builtin_amdgcn_s_getreg((3 << 11) | 20) & 0xFu; }
#define XB_SPIN(cond, bar) do { unsigned _sp = 0; while (cond) { __builtin_amdgcn_s_sleep(1); \
    if ((++_sp & 255u) == 0u) { if (xb_ld(&(bar)[XB_TMO])) break; if (_sp > XB_SPIN_CAP) { atomicAdd(&(bar)[XB_TMO], 1u); break; } } } } while (0)
struct XcdBarrier { unsigned* bar; unsigned x; volatile LAS unsigned* st; };
__device__ __forceinline__ XcdBarrier xcd_barrier_post(unsigned* bar, volatile LAS unsigned* st) {
  XcdBarrier b; b.bar = bar; b.x = xb_xcc_id(); b.st = st;
  if (tidx() == 0) (void)xb_add(&bar[XB_XCNT(b.x)], 1u);
  return b;
}
__device__ __forceinline__ void xcd_barrier_complete(unsigned* bar, unsigned x, unsigned& nloc, unsigned& nx) {
  const unsigned G = gridDim.x * gridDim.y * gridDim.z;
  unsigned sum, cnt, mine, sp = 0u;
  for (;;) {
    sum = 0u; cnt = 0u; mine = 0u;
#pragma unroll
    for (unsigned j = 0; j < 16; ++j) { const unsigned c = xb_ld(&bar[XB_XCNT(j)]); sum += c; cnt += (c > 0u) ? 1u : 0u; mine = (j == x) ? c : mine; }
    if (sum == G) break;
    __builtin_amdgcn_s_sleep(1);
    if ((++sp & 255u) == 0u) { if (xb_ld(&bar[XB_TMO])) break; if (sp > XB_SPIN_CAP) { atomicAdd(&bar[XB_TMO], 1u); break; } }
  }
  nloc = mine > 0u ? mine : 1u; nx = cnt > 0u ? cnt : 1u;
}
__device__ __forceinline__ void xcd_barrier(const XcdBarrier& b) {
  asm volatile("s_waitcnt vmcnt(0)" ::: "memory");
  __syncthreads();
  if (tidx() == 0) {
    unsigned* bar = b.bar;
    __builtin_amdgcn_s_waitcnt(0);
    unsigned nloc = b.st[0], nx = b.st[1];
    if (nloc == 0u) { xcd_barrier_complete(bar, b.x, nloc, nx); b.st[0] = nloc; b.st[1] = nx; }
    const unsigned old = xb_add(&bar[XB_XSUB(b.x)], 1u);
    const unsigned gen = old / nloc;
    if (old + 1u == (gen + 1u) * nloc) {
      __builtin_amdgcn_fence(__ATOMIC_RELEASE, "agent");
      asm volatile("s_waitcnt vmcnt(0)" ::: "memory");
      const unsigned og = xb_add(&bar[XB_TOP], 1u);
      const unsigned tg = og / nx;
      if (og + 1u == (tg + 1u) * nx) xb_add(&bar[XB_TOPGEN], 1u);
      else XB_SPIN(xb_ld(&bar[XB_TOPGEN]) == tg, bar);
      __builtin_amdgcn_fence(__ATOMIC_ACQUIRE, "agent");
      xb_add(&bar[XB_XGEN(b.x)], 1u);
      asm volatile("s_waitcnt vmcnt(0)" ::: "memory");
    } else {
      XB_SPIN(xb_ld(&bar[XB_XGEN(b.x)]) == gen, bar);
      __builtin_amdgcn_fence(__ATOMIC_ACQUIRE, "agent");
      asm volatile("s_waitcnt vmcnt(0)" ::: "memory");
    }
  }
  __syncthreads();
}

  template <int D0> __device__ __forceinline__ void pv_one32(f32x16& od, int vb, bf16x8 pa0, bf16x8 pa1) {
    const s16x4 l0 = tr_read<v_rd_off64(D0, 0, 0)>(vb), h0 = tr_read<v_rd_off64(D0, 0, 1)>(vb), l1 = tr_read<v_rd_off64(D0, 1, 0)>(vb), h1 = tr_read<v_rd_off64(D0, 1, 1)>(vb);
    asm volatile("s_waitcnt lgkmcnt(0)" ::: "memory"); SBAR();
    od = MFMA32(pa0, PKV(l0, h0), od);
    od = MFMA32(pa1, PKV(l1, h1), od);
  }
  __device__ __forceinline__ void ph_na(const MP& p, char* lds) {
    const bf16_t* nq = (const bf16_t*)(p.ws + WS_NQ); const bf16_t* nk = (const bf16_t*)(p.ws + WS_NK); const bf16_t* nv = (const bf16_t*)(p.ws + WS_NV);
    bf16_t* A = (bf16_t*)(p.ws + WS_A);
    const int tid = tidx(), w = tid >> 6, lane = tid & 63, j = lane & 31, hi = lane >> 5;
    char* Kw = lds + w * 8192; char* Vw = Kw + 4096;
    float* rpbs = (float*)(lds + 65536);
    float* al_l = (float*)(lds + 65536 + 4096) + w * 64; float* li_l = al_l + 32;
    const int vb0 = (int)(uintptr_t)Vw + v_rd_base(lane);
    for (int item = blockIdx.x; item < 512; item += gridDim.x) {
      const int bh = (item & 7) + 8 * (item >> 8), patch = (item >> 3) & 31, b = bh >> 3, h = bh & 7, r0 = (patch >> 2) * 16, c0 = (patch & 3) * 16;
      for (int i = tid; i < 15 * 64; i += 512) { const int dr = i >> 6, dc = (i & 63) - 16; rpbs[i] = (dc >= 0 && dc < 31) ? p.in[16][(h * 15 + dr) * 31 + dc] * LOG2E : 0.f; }
      __syncthreads();
      const int ra = r0 + 2 * w, qrow = ra + (j >> 4), qc = c0 + (j & 15);
      int rs_q = qrow - 4; rs_q = rs_q < 0 ? 0 : (rs_q > 120 ? 120 : rs_q);
      int cs_q = qc - 8; cs_q = cs_q < 0 ? 0 : (cs_q > 48 ? 48 : cs_q);
      int rs0 = ra - 4; rs0 = rs0 < 0 ? 0 : (rs0 > 120 ? 120 : rs0);
      int rs1 = ra - 3; rs1 = rs1 < 0 ? 0 : (rs1 > 120 ? 120 : rs1);
      int cw = c0 - 8; cw = cw < 0 ? 0 : (cw > 32 ? 32 : cw);
      const int ntiles = 8 + (rs1 - rs0) + 8;
      const bf16_t* Kb = nk + (size_t)bh * NKEY * 64; const bf16_t* Vb = nv + (size_t)bh * NKEY * 64;
      bf16x8 qr[4];
      { const bf16_t* qp = nq + ((size_t)bh * SEQ + qrow * 64 + qc) * 64 + hi * 8;
#pragma unroll
        for (int d0 = 0; d0 < 4; ++d0) qr[d0] = *(const bf16x8*)(qp + d0 * 16); }
      f32x16 o[2];
#pragma unroll
      for (int r = 0; r < 16; ++r) { o[0][r] = 0.f; o[1][r] = 0.f; }
      float m_reg = -1e30f, l_reg = 0.f;
      int kwo[4], vwo[4];
#pragma unroll
      for (int i = 0; i < 4; ++i) { const int q = lane + 64 * i, row = q >> 3, c = q & 7; kwo[i] = row * 128 + ((c ^ ((row >> 1) & 7)) << 4); vwo[i] = v_st64(row, c * 8); }
      uint4 sk0, sk1, sk2, sk3, sv0, sv1, sv2, sv3;
#define NA_KBASE(tl) ((tl) < 8 ? (tl) * 32 : CT + (rs0 + (tl) - 8) * 64 + cw)
#define NA_L1(i) sk##i = *(const uint4*)(Kb + kb_ + (i) * 512); sv##i = *(const uint4*)(Vb + kb_ + (i) * 512);
#define NA_LOAD(tl) do { const size_t kb_ = (size_t)NA_KBASE(tl) * 64 + lane * 8; NA_L1(0) NA_L1(1) NA_L1(2) NA_L1(3) } while (0)
#define NA_W1(i) *(uint4*)(Kw + kwo[i]) = sk##i; *(uint4*)(Vw + vwo[i]) = sv##i;
#define NA_WRITE() do { NA_W1(0) NA_W1(1) NA_W1(2) NA_W1(3) } while (0)
      NA_LOAD(0); NA_WRITE();
      for (int tl = 0; tl < ntiles; ++tl) {
        if (tl + 1 < ntiles) NA_LOAD(tl + 1);
        f32x16 pt;
#pragma unroll
        for (int r = 0; r < 16; ++r) pt[r] = 0.f;
#pragma unroll
        for (int d0 = 0; d0 < 4; ++d0) { const bf16x8 kf = *(const bf16x8*)(Kw + j * 128 + (((d0 * 2 + hi) ^ ((j >> 1) & 7)) << 4)); pt = MFMA32(kf, qr[d0], pt); }
        if (tl >= 8) {
          const int kr = rs0 + tl - 8; const bool rowok = (kr >= rs_q) && (kr < rs_q + 8);
          int dr = kr - qrow + 7; dr = dr < 0 ? 0 : (dr > 14 ? 14 : dr);
          const float* bp = rpbs + dr * 64 + (cw - qc + 15 + 16) + 4 * hi; const int kc0 = cw + 4 * hi;
#pragma unroll
          for (int r = 0; r < 16; ++r) { const int cr = (r & 3) + 8 * (r >> 2); const int kc = kc0 + cr;
            const bool ok = rowok && (kc >= cs_q) && (kc < cs_q + 16); pt[r] = ok ? pt[r] + bp[cr] : -1e30f; }
        }
        float pmax = pt[0];
#pragma unroll
        for (int r = 1; r < 16; ++r) pmax = fmaxf(pmax, pt[r]);
        { auto rr = __builtin_amdgcn_permlane32_swap(__float_as_uint(pmax), __float_as_uint(pmax), false, false); pmax = fmaxf(__uint_as_float(rr[0]), __uint_as_float(rr[1])); }
        float mn, alpha;
        if (__all(pmax - m_reg <= ATT_THR)) { mn = m_reg; alpha = 1.f; }
        else { mn = fmaxf(m_reg, pmax); alpha = __builtin_amdgcn_exp2f(m_reg - mn); m_reg = mn; }
        float ps = 0.f;
#pragma unroll
        for (int r = 0; r < 16; ++r) { pt[r] = __builtin_amdgcn_exp2f(pt[r] - mn); ps += pt[r]; }
        { auto rr = __builtin_amdgcn_permlane32_swap(__float_as_uint(ps), __float_as_uint(ps), false, false); ps = __uint_as_float(rr[0]) + __uint_as_float(rr[1]); }
        l_reg = l_reg * alpha + ps;
        bf16x8 pa0, pa1; PK4(pt, 0, pa0); PK4(pt, 8, pa1);
        if (__any(alpha < 1.f)) { if (hi == 0) al_l[j] = alpha; asm volatile("s_waitcnt lgkmcnt(0)" ::: "memory");
#pragma unroll
          for (int d = 0; d < 2; ++d)
#pragma unroll
            for (int r = 0; r < 16; ++r) o[d][r] *= al_l[crow(r, hi)]; }
        pv_one32<0>(o[0], vb0, pa0, pa1); pv_one32<1>(o[1], vb0, pa0, pa1);
        if (tl + 1 < ntiles) NA_WRITE();
      }
#undef NA_LOAD
#undef NA_WRITE
#undef NA_KBASE
      if (hi == 0) li_l[j] = l_reg; asm volatile("s_waitcnt lgkmcnt(0)" ::: "memory");
#pragma unroll
      for (int r = 0; r < 16; ++r) { const int qq = crow(r, hi); const float rl = __builtin_amdgcn_rcpf(li_l[qq]);
        bf16_t* op = A + ((size_t)b * SEQ + (ra + (qq >> 4)) * 64 + c0 + (qq & 15)) * D + h * 64 + j;
        op[0] = f2bf(o[0][r] * rl); op[32] = f2bf(o[1][r] * rl); }
      __syncthreads();
    }
  }

__device__ __forceinline__ void ph_na_simple(const MP& p) {
  const bf16_t* nq = (const bf16_t*)(p.ws + WS_NQ); const bf16_t* nk = (const bf16_t*)(p.ws + WS_NK); const bf16_t* nv = (const bf16_t*)(p.ws + WS_NV);
  const float* rpb = p.in[16]; bf16_t* A = (bf16_t*)(p.ws + WS_A);
  for (int item = blockIdx.x; item < 256; item += gridDim.x) {
    const int bh = item >> 4, t = (item & 15) * 512 + tidx(), b = bh >> 3, hh = bh & 7;
    const int r = t >> 6, c = t & 63;
    int rs = r - 4; rs = rs < 0 ? 0 : (rs > 120 ? 120 : rs);
    int cs = c - 8; cs = cs < 0 ? 0 : (cs > 48 ? 48 : cs);
    float q[64], o[64];
    const bf16_t* qp = nq + ((size_t)bh * SEQ + t) * 64;
#pragma unroll
    for (int d = 0; d < 64; ++d) { q[d] = bf2f(qp[d]); o[d] = 0.f; }
    const bf16_t* Kb = nk + (size_t)bh * NKEY * 64; const bf16_t* Vb = nv + (size_t)bh * NKEY * 64;
    float mx = -3.0e38f, l = 0.f;
    for (int kk = 0; kk < 128 + CT; ++kk) {
      int key; float bias = 0.f;
      if (kk < 128) { const int kr_ = rs + (kk >> 4), kc = cs + (kk & 15); key = CT + kr_ * 64 + kc; bias = rpb[(hh * 15 + (kr_ - r + 7)) * 31 + (kc - c + 15)] * LOG2E; }
      else key = kk - 128;
      const bf16_t* kp = Kb + (size_t)key * 64; float s = bias;
#pragma unroll
      for (int d = 0; d < 64; d += 2) { const unsigned w = *(const unsigned*)(kp + d); s += q[d] * __uint_as_float(w << 16) + q[d + 1] * __uint_as_float(w & 0xFFFF0000u); }
      const float mn = fmaxf(mx, s), alpha = exp2f(mx - mn), pe = exp2f(s - mn);
      l = l * alpha + pe; mx = mn;
      const bf16_t* vp = Vb + (size_t)key * 64;
#pragma unroll
      for (int d = 0; d < 64; d += 2) { const unsigned w = *(const unsigned*)(vp + d); o[d] = o[d] * alpha + pe * __uint_as_float(w << 16); o[d + 1] = o[d + 1] * alpha + pe * __uint_as_float(w & 0xFFFF0000u); }
    }
    const float il = 1.f / l;
    bf16_t* op = A + (size_t)(b * SEQ + t) * D + hh * 64;
#pragma unroll
    for (int d = 0; d < 64; d += 2) *(unsigned*)(op + d) = pack2(o[d] * il, o[d + 1] * il);
  }
}

};

enum { PH_PRE = 0, PH_N1_0, PH_G1_0, PH_HA, PH_HB, PH_HC, PH_G2_0, PH_ROUTE_0, PH_MOE1_0, PH_MOE2_0, PH_COMB_0, PH_G1_1, PH_MLAUP, PH_MLA, PH_G2_1, PH_ROUTE_1, PH_MOE1_1, PH_MOE2_1, PH_FINAL, PH_COUNT };

#ifndef PROBE_PHASE
#define PROBE_PHASE (-1)
#endif
#define PROBE_SUB(id, stmt) do { if (PROBE_PHASE == (id)) { __syncthreads(); pt0 = __builtin_amdgcn_s_memrealtime(); stmt; __syncthreads(); pt1 = __builtin_amdgcn_s_memrealtime(); } else { stmt; } } while (0)
__global__ __launch_bounds__(512) void mega(MP p) {
  unsigned long long pt0 = 0, pt1 = 0;
  extern __shared__ __attribute__((aligned(16))) char smem[];
  char* ws = p.ws;
  MK k; k.wv = __builtin_amdgcn_readfirstlane((int)(threadIdx.x >> 6));
  volatile LAS unsigned* xbw = (volatile LAS unsigned*)(smem + LDS_BYTES - 16);
  if (k.tidx() == 0) { xbw[0] = 0u; xbw[1] = 0u; }
  __syncthreads();
  MK::XcdBarrier bar; bar.bar = (unsigned*)(ws + WS_CTL); bar.x = 0; bar.st = xbw;
  if (p.ph_hi - p.ph_lo > 1) bar = k.xcd_barrier_post((unsigned*)(ws + WS_CTL), xbw);
  const float* mods0 = (const float*)(ws + WS_MODS); const float* mods1 = mods0 + 3 * 6144;
  bf16_t* hbuf = (bf16_t*)(ws + WS_H); bf16_t* abuf = (bf16_t*)(ws + WS_A); bf16_t* U = (bf16_t*)(ws + WS_U); float* xc = (float*)(ws + WS_XC);
  if (p.ph_lo <= PH_PRE && PH_PRE < p.ph_hi) { if (PROBE_PHASE == PH_PRE) pt0 = __builtin_amdgcn_s_memrealtime(); PROBE_SUB(112, k.ph_ada(p, smem)); PROBE_SUB(113, k.ph_conv_all(p, smem));
    if (PH_PRE + 1 < p.ph_hi) k.xcd_barrier(bar);
    if (PROBE_PHASE == PH_PRE) pt1 = __builtin_amdgcn_s_memrealtime();
  }
  if (p.ph_lo <= PH_N1_0 && PH_N1_0 < p.ph_hi) { if (PROBE_PHASE == PH_N1_0) pt0 = __builtin_amdgcn_s_memrealtime(); k.ph_norm_mod(p.in[0], p.in[2], p.in[6], mods0, 0, 1024, hbuf, MROWS);
    if (PH_N1_0 + 1 < p.ph_hi) k.xcd_barrier(bar);
    if (PROBE_PHASE == PH_N1_0) pt1 = __builtin_amdgcn_s_memrealtime();
  }
  if (p.ph_lo <= PH_G1_0 && PH_G1_0 < p.ph_hi) { if (PROBE_PHASE == PH_G1_0) pt0 = __builtin_amdgcn_s_memrealtime(); { EpiABIn e; e.U = U; e.LF = (float*)(ws + WS_LF); e.lb = (const float*)(ws + WS_LB);
        k.gemm_phase8(hbuf, (const bf16_t*)(ws + WS_WT_ABIN), NLAT, MROWS, 3072, 1024, e, smem, 0, 3072); }
    if (PH_G1_0 + 1 < p.ph_hi) k.xcd_barrier(bar);
    if (PROBE_PHASE == PH_G1_0) pt1 = __builtin_amdgcn_s_memrealtime();
  }
  if (p.ph_lo <= PH_HA && PH_HA < p.ph_hi) { if (PROBE_PHASE == PH_HA) pt0 = __builtin_amdgcn_s_memrealtime(); PROBE_SUB(100, k.ph_hgrn_a(p, smem)); PROBE_SUB(101, k.ph_pool_prep(U + 5 * (size_t)MROWS * 512, hbuf));
    if (PH_HA + 1 < p.ph_hi) k.xcd_barrier(bar);
    if (PROBE_PHASE == PH_HA) pt1 = __builtin_amdgcn_s_memrealtime();
  }
  if (p.ph_lo <= PH_HB && PH_HB < p.ph_hi) { if (PROBE_PHASE == PH_HB) pt0 = __builtin_amdgcn_s_memrealtime(); k.ph_hgrn_b(p);
    if (PH_HB + 1 < p.ph_hi) k.xcd_barrier(bar);
    if (PROBE_PHASE == PH_HB) pt1 = __builtin_amdgcn_s_memrealtime();
  }
  if (p.ph_lo <= PH_HC && PH_HC < p.ph_hi) { if (PROBE_PHASE == PH_HC) pt0 = __builtin_amdgcn_s_memrealtime(); PROBE_SUB(102, k.ph_hgrn_c(p, smem));
    for (int tile = (int)gridDim.x - 1 - (int)blockIdx.x; tile < 4 * (MROWS / 256); tile += gridDim.x) { const int gi = tile / (MROWS / 256), mt = tile - gi * (MROWS / 256);
      MK::EpiEach<EpiPool> e; e.e.A = abuf; e.e.scale = p.in[13]; e.e.gi = gi; e.e.pad = 0;
      k.template gemm_tile<4>(hbuf + gi * 128, 512, nullptr, 0, MROWS, (const bf16_t*)(ws + WS_WT_POOL) + (size_t)gi * 128 * 128, 128, 128, mt * 256, 0, smem, e); }
    if (PH_HC + 1 < p.ph_hi) k.xcd_barrier(bar);
    if (PROBE_PHASE == PH_HC) pt1 = __builtin_amdgcn_s_memrealtime();
  }
  if (p.ph_lo <= PH_G2_0 && PH_G2_0 < p.ph_hi) { if (PROBE_PHASE == PH_G2_0) pt0 = __builtin_amdgcn_s_memrealtime(); { EpiOutRes e; e.base_lat = p.in[0]; e.base_ctx = p.in[2]; e.out_lat = p.out; e.out_ctx = xc; e.modl = mods0; e.g_off = 2048; e.pad = 0;
        k.gemm_phase8(abuf, (const bf16_t*)(ws + WS_WT_ABOUT), NLAT, MROWS, 1024, 1024, e, smem, 0, 1024); }
    if (PH_G2_0 + 1 < p.ph_hi) k.xcd_barrier(bar);
    if (PROBE_PHASE == PH_G2_0) pt1 = __builtin_amdgcn_s_memrealtime();
  }
  if (p.ph_lo <= PH_ROUTE_0 && PH_ROUTE_0 < p.ph_hi) { if (PROBE_PHASE == PH_ROUTE_0) pt0 = __builtin_amdgcn_s_memrealtime(); k.ph_router(p, 0, MROWS, smem);
    if (PH_ROUTE_0 + 1 < p.ph_hi) k.xcd_barrier(bar);
    if (PROBE_PHASE == PH_ROUTE_0) pt1 = __builtin_amdgcn_s_memrealtime();
  }
  if (p.ph_lo <= PH_MOE1_0 && PH_MOE1_0 < p.ph_hi) { if (PROBE_PHASE == PH_MOE1_0) pt0 = __builtin_amdgcn_s_memrealtime(); k.ph_moe1g(p, 0, smem);
    if (PH_MOE1_0 + 1 < p.ph_hi) k.xcd_barrier(bar);
    if (PROBE_PHASE == PH_MOE1_0) pt1 = __builtin_amdgcn_s_memrealtime();
  }
  if (p.ph_lo <= PH_MOE2_0 && PH_MOE2_0 < p.ph_hi) { if (PROBE_PHASE == PH_MOE2_0) pt0 = __builtin_amdgcn_s_memrealtime(); k.ph_moe2g(p, 0, smem);
    if (PH_MOE2_0 + 1 < p.ph_hi) k.xcd_barrier(bar);
    if (PROBE_PHASE == PH_MOE2_0) pt1 = __builtin_amdgcn_s_memrealtime();
  }
  if (p.ph_lo <= PH_COMB_0 && PH_COMB_0 < p.ph_hi) { if (PROBE_PHASE == PH_COMB_0) pt0 = __builtin_amdgcn_s_memrealtime(); k.ph_combine(p, 0, MROWS, 0);
    if (PH_COMB_0 + 1 < p.ph_hi) k.xcd_barrier(bar);
    if (PROBE_PHASE == PH_COMB_0) pt1 = __builtin_amdgcn_s_memrealtime();
  }
  if (p.ph_lo <= PH_G1_1 && PH_G1_1 < p.ph_hi) { if (PROBE_PHASE == PH_G1_1) pt0 = __builtin_amdgcn_s_memrealtime(); { EpiCDIn e; e.nq = (bf16_t*)(ws + WS_NQ); e.nk = (bf16_t*)(ws + WS_NK); e.nv = (bf16_t*)(ws + WS_NV); e.cq = (bf16_t*)(ws + WS_CQ); e.ckv = (bf16_t*)(ws + WS_CKV); e.kr = (float*)(ws + WS_KR);
        k.gemm_phase8(hbuf, (const bf16_t*)(ws + WS_WT_CDIN), NLAT, MROWS, 2048, 1024, e, smem, 512, 2048); }
    if (PH_G1_1 + 1 < p.ph_hi) k.xcd_barrier(bar);
    if (PROBE_PHASE == PH_G1_1) pt1 = __builtin_amdgcn_s_memrealtime();
  }
  if (p.ph_lo <= PH_MLAUP && PH_MLAUP < p.ph_hi) { if (PROBE_PHASE == PH_MLAUP) pt0 = __builtin_amdgcn_s_memrealtime(); {
        { MK::EpiMlaQ2 e; e.dq = (bf16_t*)(ws + WS_DQ); e.cq = (const bf16_t*)(ws + WS_CQ); const int ntn = 6;
          for (int tile = blockIdx.x; tile < (NLAT / 256) * ntn; tile += gridDim.x) { const int mt = tile / ntn, nt = tile - mt * ntn;
            k.template gemm_tile<4>(e.cq, 256, nullptr, 0, NLAT, (const bf16_t*)(ws + WS_WT_UQ), 256, 256, mt * 256, nt * 128, smem, e); } }
        { MK::EpiMlaKV2 e; e.dk = (bf16_t*)(ws + WS_DK); e.dv = (bf16_t*)(ws + WS_DV); e.ckv = (const bf16_t*)(ws + WS_CKV); const int ntn = 8;
          for (int tile = blockIdx.x; tile < (MROWS / 256) * ntn; tile += gridDim.x) { const int mt = tile / ntn, nt = tile - mt * ntn;
            k.template gemm_tile<4>(e.ckv, 128, nullptr, 0, MROWS, (const bf16_t*)(ws + WS_WT_UKV), 128, 128, mt * 256, nt * 128, smem, e); } }
        k.ph_kr_rope((const float*)(ws + WS_KR), (bf16_t*)(ws + WS_DK));
      }
    if (PH_MLAUP + 1 < p.ph_hi) k.xcd_barrier(bar);
    if (PROBE_PHASE == PH_MLAUP) pt1 = __builtin_amdgcn_s_memrealtime();
  }
  if (p.ph_lo <= PH_MLA && PH_MLA < p.ph_hi) { if (PROBE_PHASE == PH_MLA) pt0 = __builtin_amdgcn_s_memrealtime(); PROBE_SUB(104, k.ph_mla(p, smem)); PROBE_SUB(105, k.ph_na(p, smem)); PROBE_SUB(106, k.ph_conv_moe(p, 1, smem));
    if (PH_MLA + 1 < p.ph_hi) k.xcd_barrier(bar);
    if (PROBE_PHASE == PH_MLA) pt1 = __builtin_amdgcn_s_memrealtime();
  }
  if (p.ph_lo <= PH_G2_1 && PH_G2_1 < p.ph_hi) { if (PROBE_PHASE == PH_G2_1) pt0 = __builtin_amdgcn_s_memrealtime(); { EpiOutRes e; e.base_lat = p.out; e.base_ctx = xc; e.out_lat = p.out; e.out_ctx = xc; e.modl = mods1; e.g_off = 2048; e.pad = 0;
        k.gemm_phase8(abuf, (const bf16_t*)(ws + WS_WT_CDOUT), NLAT, NLAT, 1024, 1024, e, smem, 0, 1024); }
    if (PH_G2_1 + 1 < p.ph_hi) k.xcd_barrier(bar);
    if (PROBE_PHASE == PH_G2_1) pt1 = __builtin_amdgcn_s_memrealtime();
  }
  if (p.ph_lo <= PH_ROUTE_1 && PH_ROUTE_1 < p.ph_hi) { if (PROBE_PHASE == PH_ROUTE_1) pt0 = __builtin_amdgcn_s_memrealtime(); k.ph_router(p, 1, NLAT, smem);
    if (PH_ROUTE_1 + 1 < p.ph_hi) k.xcd_barrier(bar);
    if (PROBE_PHASE == PH_ROUTE_1) pt1 = __builtin_amdgcn_s_memrealtime();
  }
  if (p.ph_lo <= PH_MOE1_1 && PH_MOE1_1 < p.ph_hi) { if (PROBE_PHASE == PH_MOE1_1) pt0 = __builtin_amdgcn_s_memrealtime(); k.ph_moe1g(p, 1, smem);
    if (PH_MOE1_1 + 1 < p.ph_hi) k.xcd_barrier(bar);
    if (PROBE_PHASE == PH_MOE1_1) pt1 = __builtin_amdgcn_s_memrealtime();
  }
  if (p.ph_lo <= PH_MOE2_1 && PH_MOE2_1 < p.ph_hi) { if (PROBE_PHASE == PH_MOE2_1) pt0 = __builtin_amdgcn_s_memrealtime(); k.ph_moe2g(p, 1, smem);
    if (PH_MOE2_1 + 1 < p.ph_hi) k.xcd_barrier(bar);
    if (PROBE_PHASE == PH_MOE2_1) pt1 = __builtin_amdgcn_s_memrealtime();
  }
  if (p.ph_lo <= PH_FINAL && PH_FINAL < p.ph_hi) { if (PROBE_PHASE == PH_FINAL) pt0 = __builtin_amdgcn_s_memrealtime(); k.ph_combine(p, 1, NLAT, 1);
    if (PH_FINAL + 1 < p.ph_hi) k.xcd_barrier(bar);
    if (PROBE_PHASE == PH_FINAL) pt1 = __builtin_amdgcn_s_memrealtime();
  }
  if (PROBE_PHASE >= 0 && blockIdx.x == 0) { const unsigned long long te = __builtin_amdgcn_s_memrealtime(), span = (pt1 - pt0) * 8ull; while (__builtin_amdgcn_s_memrealtime() - te < span) __builtin_amdgcn_s_sleep(32); }
}

static void run_phases(hipStream_t st, MP p, int lo, int hi) {
  for (int ph = lo; ph < hi; ++ph) { p.ph_lo = ph; p.ph_hi = ph + 1; hipLaunchKernelGGL(mega, dim3(256), dim3(512), LDS_BYTES, st, p); }
}

extern "C" void kernel_launch(void* const* d_in, const int* in_sizes, int n_in, void* d_out, int out_size, void* d_ws, size_t ws_size, hipStream_t stream) {
  static int ok = 0;
  if (!ok) {
    if (n_in != 29 || in_sizes[0] != NLAT * D || out_size != NLAT * D || ws_size < WS_END) {
      fprintf(stderr, "kernel_launch: unexpected shapes (n_in %d, in0 %d, out %d, ws %zu, need %zu)\n", n_in, n_in > 0 ? in_sizes[0] : -1, out_size, ws_size, (size_t)WS_END);
      return; }
    if (hipFuncSetAttribute((const void*)mega, hipFuncAttributeMaxDynamicSharedMemorySize, LDS_BYTES) != hipSuccess) { fprintf(stderr, "kernel_launch: hipFuncSetAttribute failed\n"); return; }
    ok = 1;
  }
  char* ws = (char*)d_ws; float* out = (float*)d_out;
  MP p; memset(&p, 0, sizeof(p));
  for (int i = 0; i < 29; ++i) p.in[i] = (const float*)d_in[i];
  p.out = out; p.ws = ws;
  hipMemsetAsync(ws + WS_CTL, 0, WS_MODS + 2 * 3 * 6144 * 4, stream);
  float* odir_ctx = (float*)(ws + WS_ODIR_CTX);
  bf16_t* abuf = (bf16_t*)(ws + WS_A); bf16_t* U = (bf16_t*)(ws + WS_U); float* LF = (float*)(ws + WS_LF);
  bf16_t* nq = (bf16_t*)(ws + WS_NQ); bf16_t* nk = (bf16_t*)(ws + WS_NK); bf16_t* nv = (bf16_t*)(ws + WS_NV);
  bf16_t* dq = (bf16_t*)(ws + WS_DQ); bf16_t* dk = (bf16_t*)(ws + WS_DK); bf16_t* dv = (bf16_t*)(ws + WS_DV);

  p.ph_lo = 0; p.ph_hi = PH_COUNT;
  void* args[] = {&p};
  const hipError_t le = hipLaunchCooperativeKernel((const void*)mega, dim3(256), dim3(512), args, LDS_BYTES, stream);
  if (le != hipSuccess) fprintf(stderr, "kernel_launch: cooperative launch failed: %s\n", hipGetErrorString(le));
}
```

```cpp
#include <hip/hip_runtime.h>
#include <stdint.h>
#include <cstdio>
#include <cstring>

typedef unsigned short bf16_t;
typedef float f32x4 __attribute__((ext_vector_type(4)));

constexpr int D = 1024, NB = 2, SEQ = 8192, CT = 256;
constexpr int NLAT = NB * SEQ;
constexpr int NCTX = NB * CT;
constexpr int MROWS = NLAT + NCTX;
constexpr int NKEY = CT + SEQ;
constexpr float EPS = 1e-6f;
constexpr float LOG2E = 1.4426950408889634f;
constexpr float NA_QSCALE = 0.125f * LOG2E;
constexpr float MLA_QSCALE = 0.10206207261596577f * LOG2E;

constexpr size_t alignup(size_t x) { return (x + 255) & ~(size_t)255; }
constexpr size_t WS_CTL      = 0;
constexpr size_t WS_MODS     = 65536;
constexpr size_t WS_LB       = WS_MODS + alignup(2 * 3 * 6144 * 4);
constexpr size_t WS_XC       = WS_LB + 4096;
constexpr size_t WS_ROUTE_E  = WS_XC + (size_t)NCTX * D * 4;
constexpr size_t WS_ROUTE_W  = WS_ROUTE_E + alignup((size_t)MROWS * 2 * 4);
constexpr size_t WS_RSTD_Q   = WS_ROUTE_W + alignup((size_t)MROWS * 2 * 4);
constexpr size_t WS_RSTD_KV  = WS_RSTD_Q + alignup((size_t)NLAT * 4);
constexpr size_t WS_ODIR_CTX = WS_RSTD_KV + alignup((size_t)MROWS * 4);
constexpr size_t WS_LIST     = WS_ODIR_CTX + (size_t)2 * NCTX * 512 * 4;
constexpr size_t WS_ALAST    = WS_LIST + (size_t)32 * MROWS * 4;
constexpr size_t WS_WT_ABIN  = WS_ALAST + (size_t)2 * (MROWS / 64) * 512 * 4;
constexpr size_t WS_WT_ABOUT = WS_WT_ABIN + (size_t)3072 * 1024 * 2;
constexpr size_t WS_WT_CDIN  = WS_WT_ABOUT + (size_t)1024 * 1024 * 2;
constexpr size_t WS_WT_CDOUT = WS_WT_CDIN + (size_t)2048 * 1024 * 2;
constexpr size_t WS_WT_UQ    = WS_WT_CDOUT + (size_t)1024 * 1024 * 2;
constexpr size_t WS_WT_UKV   = WS_WT_UQ + (size_t)768 * 256 * 2;
constexpr size_t WS_WT_POOL  = WS_WT_UKV + (size_t)1024 * 128 * 2;
constexpr size_t WS_WMOE     = WS_WT_POOL + (size_t)4 * 128 * 128 * 2;
constexpr size_t WS_H        = WS_WMOE + (size_t)32 * 512 * 1024 * 2 + (size_t)32 * 1024 * 256 * 2;
constexpr size_t WS_A        = WS_H + (size_t)MROWS * D * 2;
constexpr size_t WS_U        = WS_A + (size_t)MROWS * D * 2;
constexpr size_t USLOT       = (size_t)MROWS * 512 * 2;
constexpr size_t WS_LF       = WS_U + 6 * USLOT;
constexpr size_t WS_END      = WS_LF + (size_t)2 * MROWS * 512 * 4;
constexpr size_t WS_NQ   = WS_U;
constexpr size_t WS_NK   = WS_NQ + (size_t)NLAT * 512 * 2;
constexpr size_t WS_NV   = WS_NK + USLOT;
constexpr size_t WS_CQ   = WS_NV + USLOT;
constexpr size_t WS_CKV  = WS_CQ + (size_t)NLAT * 256 * 2;
constexpr size_t WS_KR   = WS_CKV + (size_t)MROWS * 128 * 2;
constexpr size_t WS_DQ   = WS_KR + (size_t)MROWS * 32 * 4;
constexpr size_t WS_L1END = WS_DQ + (size_t)NLAT * 768 * 2;
static_assert(WS_L1END <= WS_LF, "layer-1 overlay too big");
constexpr size_t WS_DK   = WS_LF;
constexpr size_t WS_DV   = WS_DK + (size_t)MROWS * 1024 * 2;
static_assert(WS_DV + (size_t)MROWS * 512 * 2 <= WS_END, "dk/dv overlay too big");
constexpr size_t WS_YBUF = WS_LF;
constexpr size_t WS_AMOE = WS_U;

__device__ __forceinline__ float bf2f(bf16_t h) { return __uint_as_float(((unsigned)h) << 16); }
__device__ __forceinline__ unsigned pack2(float a, float b) { unsigned r; asm("v_cvt_pk_bf16_f32 %0, %1, %2" : "=v"(r) : "v"(a), "v"(b)); return r; }
__device__ __forceinline__ bf16_t f2bf(float f) { return (bf16_t)(pack2(f, 0.f) & 0xFFFFu); }
__device__ __forceinline__ float sigmoidf_(float x) { return __builtin_amdgcn_rcpf(1.f + __expf(-x)); }
__device__ __forceinline__ float siluf_(float x) { return x * __builtin_amdgcn_rcpf(1.f + __expf(-x)); }
__device__ __forceinline__ float wave_sum(float v) {
#pragma unroll
  for (int o = 1; o < 64; o <<= 1) v += __shfl_xor(v, o);
  return v;
}
__device__ __forceinline__ int row_vec(int m) { return m < NLAT ? (m >> 13) : 2; }
__device__ __forceinline__ void row_bkey(int m, int& b, int& key) {
  if (m < NLAT) { b = m >> 13; key = CT + (m & 8191); } else { const int mm = m - NLAT; b = mm >> 8; key = mm & 255; }
}

__global__ __launch_bounds__(512) void k_ada(const float* __restrict__ c, const float* __restrict__ cctx, const float* __restrict__ ada_w,
                                             const float* __restrict__ ada_b, float* __restrict__ mods) {
  const int l = blockIdx.y, n0 = blockIdx.x * 64, j = threadIdx.x & 63, kg = threadIdx.x >> 6;
  __shared__ float sv[3][1024];
  __shared__ float red[8][3][64];
  for (int i = threadIdx.x; i < 1024; i += 512) { sv[0][i] = siluf_(c[i]); sv[1][i] = siluf_(c[1024 + i]); sv[2][i] = siluf_(cctx[i]); }
  __syncthreads();
  const float* W = ada_w + (size_t)l * 1024 * 6144 + n0 + j;
  float a0 = 0.f, a1 = 0.f, a2 = 0.f;
  for (int k = kg * 128; k < kg * 128 + 128; ++k) { const float w = W[(size_t)k * 6144]; a0 += sv[0][k] * w; a1 += sv[1][k] * w; a2 += sv[2][k] * w; }
  red[kg][0][j] = a0; red[kg][1][j] = a1; red[kg][2][j] = a2;
  __syncthreads();
  if (threadIdx.x < 192) {
    const int v = threadIdx.x >> 6, jj = threadIdx.x & 63; float s = 0.f;
    for (int g = 0; g < 8; ++g) s += red[g][v][jj];
    mods[(size_t)(l * 3 + v) * 6144 + n0 + jj] = s + ada_b[l * 6144 + n0 + jj];
  }
}
__global__ void k_lb(const float* __restrict__ logits, float* __restrict__ lb) {
  const int i = blockIdx.x * blockDim.x + threadIdx.x;
  if (i < 1024) { const int d = i >> 9, cc = i & 511; const float l0 = logits[(d * 2 + 0) * 512 + cc], l1 = logits[(d * 2 + 1) * 512 + cc]; lb[i] = 1.f / (1.f + expf(l1 - l0)); }
}

struct ConvArgs { const float* src; bf16_t* dst; const float* kscale; int K, N, Npad, mode; size_t sbs, dbs; };
__device__ __forceinline__ int moe_gu_row(int sel, int hidden) {
  return (hidden >> 4) * 32 + sel * 16 + (hidden & 15);
}
__global__ __launch_bounds__(512) void k_convT(ConvArgs a) {
  __shared__ float tile[64][65];
  const float* src = a.src + blockIdx.z * a.sbs; bf16_t* dst = a.dst + blockIdx.z * a.dbs;
  const int n0 = blockIdx.x * 64, k0 = blockIdx.y * 64, tx = threadIdx.x & 63, ty = threadIdx.x >> 6;
#pragma unroll
  for (int i = 0; i < 8; ++i) {
    const int k = k0 + ty + 8 * i, n = n0 + tx; float v = 0.f;
    if (n < a.N) { v = src[(size_t)k * a.N + n]; if (a.kscale) v *= a.kscale[k]; }
    tile[ty + 8 * i][tx] = v;
  }
  __syncthreads();
#pragma unroll
  for (int i = 0; i < 8; ++i) {
    const int nl = ty + 8 * i, n = n0 + nl;
    if (n < a.Npad) { int row = n; if (a.mode == 1) row = moe_gu_row(0, n); else if (a.mode == 2) row = moe_gu_row(1, n);
      dst[(size_t)row * a.K + k0 + tx] = f2bf(tile[tx][nl]); }
  }
}

__global__ __launch_bounds__(512) void k_norm_mod(const float* __restrict__ lat, const float* __restrict__ ctxr, const float* __restrict__ gain,
                                                  const float* __restrict__ modl, int sh_off, int sc_off, bf16_t* __restrict__ out, int nrows) {
  const int lane = threadIdx.x & 63, gw = blockIdx.x * 8 + (threadIdx.x >> 6);
  for (int row = gw; row < nrows; row += gridDim.x * 8) {
    const float* src = row < NLAT ? lat + (size_t)row * D : ctxr + (size_t)(row - NLAT) * D;
    const float* mv = modl + row_vec(row) * 6144;
    f32x4 x[4]; float ss = 0.f;
#pragma unroll
    for (int j = 0; j < 4; ++j) { x[j] = ((const f32x4*)src)[lane + 64 * j]; ss += x[j].x * x[j].x + x[j].y * x[j].y + x[j].z * x[j].z + x[j].w * x[j].w; }
    const float rstd = 1.f / sqrtf(wave_sum(ss) * (1.f / D) + EPS);
#pragma unroll
    for (int j = 0; j < 4; ++j) {
      const int n = (lane + 64 * j) * 4;
      const f32x4 g = *(const f32x4*)(gain + n), sc = *(const f32x4*)(mv + sc_off + n), sh = *(const f32x4*)(mv + sh_off + n);
      const f32x4 h = x[j] * rstd * g * (sc + 1.f) + sh;
      uint2 o; o.x = pack2(h.x, h.y); o.y = pack2(h.z, h.w);
      *(uint2*)(out + (size_t)row * D + n) = o;
    }
  }
}

struct EpiABIn {
  bf16_t* U; float* LF; const float* lb;
  __device__ __forceinline__ void apply(int m, int n, f32x4 v) const {
    const int seg = n >> 9, cn = n & 511; float o[4] = {v.x, v.y, v.z, v.w};
    bf16_t* dst;
    if (seg == 0) { dst = U; for (int i = 0; i < 4; ++i) o[i] = siluf_(o[i]); }
    else if (seg == 1 || seg == 2) { *(f32x4*)(LF + ((size_t)(seg - 1) * MROWS + m) * 512 + cn) = v; return; }
    else if (seg == 3) dst = U + (size_t)3 * MROWS * 512;
    else if (seg == 4) { dst = U + (size_t)4 * MROWS * 512; for (int i = 0; i < 4; ++i) o[i] = siluf_(o[i]); }
    else dst = U + (size_t)5 * MROWS * 512;
    uint2 w; w.x = pack2(o[0], o[1]); w.y = pack2(o[2], o[3]);
    *(uint2*)(dst + (size_t)m * 512 + cn) = w;
  }
};
struct EpiPool {
  bf16_t* A; const float* scale; int gi; int pad;
  __device__ __forceinline__ void apply(int m, int n, f32x4 v) const {
    const int cn = gi * 128 + n; const f32x4 s = *(const f32x4*)(scale + cn); v = v * s;
    uint2 w; w.x = pack2(v.x, v.y); w.y = pack2(v.z, v.w);
    *(uint2*)(A + (size_t)m * D + 512 + cn) = w;
  }
};
struct EpiOutRes {
  const float* base_lat; const float* base_ctx; float* out_lat; float* out_ctx; const float* modl; int g_off; int pad;
  __device__ __forceinline__ void apply(int m, int n, f32x4 v) const {
    const f32x4 g = *(const f32x4*)(modl + row_vec(m) * 6144 + g_off + n);
    if (m < NLAT) { const f32x4 b = *(const f32x4*)(base_lat + (size_t)m * D + n); *(f32x4*)(out_lat + (size_t)m * D + n) = b + g * v; }
    else { const size_t o = (size_t)(m - NLAT) * D + n; const f32x4 b = *(const f32x4*)(base_ctx + o); *(f32x4*)(out_ctx + o) = b + g * v; }
  }
};
struct EpiCDIn {
  bf16_t *nq, *nk, *nv, *cq, *ckv; float* kr;
  __device__ __forceinline__ void apply(int m, int n, f32x4 v) const {
    int b, key; row_bkey(m, b, key);
    if (n < 1536) {
      const int which = n >> 9, hh = (n & 511) >> 6, dd = n & 63;
      if (which == 0) { if (m >= NLAT) return; v = v * NA_QSCALE;
        uint2 w; w.x = pack2(v.x, v.y); w.y = pack2(v.z, v.w);
        *(uint2*)(nq + (((size_t)(b * 8 + hh) * SEQ + (m & 8191)) * 64 + dd)) = w; }
      else { bf16_t* dst = which == 1 ? nk : nv; uint2 w; w.x = pack2(v.x, v.y); w.y = pack2(v.z, v.w);
        *(uint2*)(dst + (((size_t)(b * 8 + hh) * NKEY + key) * 64 + dd)) = w; }
    } else if (n < 1792) { if (m >= NLAT) return; uint2 w; w.x = pack2(v.x, v.y); w.y = pack2(v.z, v.w); *(uint2*)(cq + (size_t)m * 256 + (n - 1536)) = w; }
    else if (n < 1920) { uint2 w; w.x = pack2(v.x, v.y); w.y = pack2(v.z, v.w); *(uint2*)(ckv + (size_t)m * 128 + (n - 1792)) = w; }
    else if (n < 1952) { *(f32x4*)(kr + (size_t)m * 32 + (n - 1920)) = v; }
  }
};
struct EpiMlaQ {
  bf16_t* dq; const float* rstd;
  __device__ __forceinline__ void apply(int m, int n, f32x4 v) const {
    const int hh = n / 96, off = n - hh * 96; v = v * (rstd[m] * MLA_QSCALE);
    uint2 w; w.x = pack2(v.x, v.y); w.y = pack2(v.z, v.w);
    *(uint2*)(dq + (((size_t)((m >> 13) * 8 + hh) * SEQ + (m & 8191)) * 96 + off)) = w;
  }
};
struct EpiMlaKV {
  bf16_t *dk, *dv; const float* rstd;
  __device__ __forceinline__ void apply(int m, int n, f32x4 v) const {
    int b, key; row_bkey(m, b, key);
    const int hh = n >> 7, off = n & 127; v = v * rstd[m];
    uint2 w; w.x = pack2(v.x, v.y); w.y = pack2(v.z, v.w);
    if (off < 64) *(uint2*)(dk + (((size_t)(b * 8 + hh) * NKEY + key) * 128 + off)) = w;
    else *(uint2*)(dv + (((size_t)(b * 8 + hh) * NKEY + key) * 64 + (off - 64))) = w;
  }
};

template <class Epi>
__global__ __launch_bounds__(256) void k_gemm_naive(const bf16_t* __restrict__ A, int lda, const bf16_t* __restrict__ Bt, int ldb, int M, int N, int K, Epi epi) {
  __shared__ float As[32][68];
  __shared__ float Bs[32][68];
  const int m0 = blockIdx.y * 64, n0 = blockIdx.x * 64, t = threadIdx.x, tx = t & 15, ty = t >> 4;
  float acc[4][4];
#pragma unroll
  for (int i = 0; i < 4; ++i)
#pragma unroll
    for (int j = 0; j < 4; ++j) acc[i][j] = 0.f;
  const int lr = t >> 2, lk = (t & 3) * 8;
  for (int k0 = 0; k0 < K; k0 += 32) {
    uint4 ra = make_uint4(0, 0, 0, 0), rb = make_uint4(0, 0, 0, 0);
    if (m0 + lr < M) ra = *(const uint4*)(A + (size_t)(m0 + lr) * lda + k0 + lk);
    if (n0 + lr < N) rb = *(const uint4*)(Bt + (size_t)(n0 + lr) * ldb + k0 + lk);
    const unsigned wa[4] = {ra.x, ra.y, ra.z, ra.w}, wb[4] = {rb.x, rb.y, rb.z, rb.w};
#pragma unroll
    for (int i = 0; i < 4; ++i) {
      As[lk + 2 * i][lr] = __uint_as_float(wa[i] << 16); As[lk + 2 * i + 1][lr] = __uint_as_float(wa[i] & 0xFFFF0000u);
      Bs[lk + 2 * i][lr] = __uint_as_float(wb[i] << 16); Bs[lk + 2 * i + 1][lr] = __uint_as_float(wb[i] & 0xFFFF0000u);
    }
    __syncthreads();
#pragma unroll 8
    for (int kk = 0; kk < 32; ++kk) {
      const f32x4 a = *(const f32x4*)&As[kk][ty * 4], b = *(const f32x4*)&Bs[kk][tx * 4];
      const float av[4] = {a.x, a.y, a.z, a.w}, bv[4] = {b.x, b.y, b.z, b.w};
#pragma unroll
      for (int i = 0; i < 4; ++i)
#pragma unroll
        for (int j = 0; j < 4; ++j) acc[i][j] += av[i] * bv[j];
    }
    __syncthreads();
  }
#pragma unroll
  for (int i = 0; i < 4; ++i) {
    const int m = m0 + ty * 4 + i, n = n0 + tx * 4;
    if (m < M && n < N) { f32x4 v = {acc[i][0], acc[i][1], acc[i][2], acc[i][3]}; epi.apply(m, n, v); }
  }
}
template <class Epi>
static void launch_gemm_naive(hipStream_t st, const bf16_t* A, int lda, const bf16_t* Bt, int ldb, int M, int N, int K, Epi epi) {
  hipLaunchKernelGGL((k_gemm_naive<Epi>), dim3((N + 63) / 64, (M + 63) / 64), dim3(256), 0, st, A, lda, Bt, ldb, M, N, K, epi);
}

__device__ __forceinline__ int hgrn_step_row(int b, int dir, int s) {
  if (s < CT) return NLAT + b * CT + (dir ? (CT - 1 - s) : s);
  const int ls = s - CT; return b * SEQ + (dir ? (SEQ - 1 - ls) : ls);
}
__global__ __launch_bounds__(128) void k_hgrn_naive(const bf16_t* __restrict__ U, const float* __restrict__ LF, float* __restrict__ odir_lat, float* __restrict__ odir_ctx) {
  const int bid = blockIdx.x, dir = bid & 1, h = (bid >> 1) & 3, b = bid >> 3, e = threadIdx.x;
  __shared__ float sf[32][128];
  __shared__ float sk[32][128];
  __shared__ float sq[32][128];
  float Sreg[128];
#pragma unroll
  for (int d = 0; d < 128; ++d) Sreg[d] = 0.f;
  const bf16_t* Uq = U; const bf16_t* Uk = U + (size_t)(1 + dir) * MROWS * 512; const bf16_t* Uv = U + (size_t)3 * MROWS * 512;
  const float* lf = LF + (size_t)dir * MROWS * 512;
  for (int s0 = 0; s0 < NKEY; s0 += 32) {
    __syncthreads();
    for (int i = 0; i < 32; ++i) {
      const size_t off = (size_t)hgrn_step_row(b, dir, s0 + i) * 512 + h * 128 + e;
      sf[i][e] = expf(lf[off]); sk[i][e] = bf2f(Uk[off]); sq[i][e] = bf2f(Uq[off]);
    }
    __syncthreads();
    for (int i = 0; i < 32; ++i) {
      const int row = hgrn_step_row(b, dir, s0 + i);
      const float v = bf2f(Uv[(size_t)row * 512 + h * 128 + e]); float o = 0.f;
#pragma unroll
      for (int d = 0; d < 128; ++d) { Sreg[d] = sf[i][d] * Sreg[d] + sk[i][d] * v; o += Sreg[d] * sq[i][d]; }
      if (row < NLAT) odir_lat[((size_t)dir * NLAT + row) * 512 + h * 128 + e] = o;
      else odir_ctx[((size_t)dir * NCTX + (row - NLAT)) * 512 + h * 128 + e] = o;
    }
  }
}
__global__ __launch_bounds__(512) void k_hgrn_out(const float* __restrict__ odir_lat, const float* __restrict__ odir_ctx, const bf16_t* __restrict__ Ug,
                                                  const float* __restrict__ onorm_g, bf16_t* __restrict__ A) {
  const int lane = threadIdx.x & 63, gw = blockIdx.x * 8 + (threadIdx.x >> 6);
  for (int row = gw; row < MROWS; row += gridDim.x * 8) {
    const float* pf = row < NLAT ? odir_lat + (size_t)row * 512 : odir_ctx + (size_t)(row - NLAT) * 512;
    const float* pb = row < NLAT ? odir_lat + ((size_t)NLAT + row) * 512 : odir_ctx + ((size_t)NCTX + (row - NLAT)) * 512;
    const int c0 = lane * 8; float o[8]; float ss = 0.f;
#pragma unroll
    for (int i = 0; i < 8; ++i) { o[i] = pf[c0 + i] + pb[c0 + i]; ss += o[i] * o[i]; }
    ss += __shfl_xor(ss, 1); ss += __shfl_xor(ss, 2); ss += __shfl_xor(ss, 4); ss += __shfl_xor(ss, 8);
    const float rstd = 1.f / sqrtf(ss * (1.f / 128.f) + EPS);
    const uint4 gr = *(const uint4*)(Ug + (size_t)row * 512 + c0); const unsigned gw4[4] = {gr.x, gr.y, gr.z, gr.w};
    unsigned w[4];
#pragma unroll
    for (int i = 0; i < 4; ++i) {
      const float g0 = __uint_as_float(gw4[i] << 16), g1 = __uint_as_float(gw4[i] & 0xFFFF0000u);
      const int e0 = (c0 + 2 * i) & 127;
      w[i] = pack2(o[2 * i] * rstd * onorm_g[e0] * g0, o[2 * i + 1] * rstd * onorm_g[e0 + 1] * g1);
    }
    *(uint4*)(A + (size_t)row * D + c0) = make_uint4(w[0], w[1], w[2], w[3]);
  }
}
__global__ __launch_bounds__(512) void k_pool_prep(const bf16_t* __restrict__ Up, bf16_t* __restrict__ pd) {
  const int c = threadIdx.x;
  for (int row = blockIdx.x; row < MROWS; row += gridDim.x) {
    int base, t, n; if (row < NLAT) { base = row & ~8191; t = row & 8191; n = SEQ; } else { const int mm = row - NLAT; base = NLAT + (mm & ~255); t = mm & 255; n = CT; }
    const int gi = c >> 7, win = 2 << gi; int lo = t - win / 2, hi = t + win - win / 2; lo = lo < 0 ? 0 : lo; hi = hi > n ? n : hi;
    float s = 0.f; for (int r = lo; r < hi; ++r) s += bf2f(Up[(size_t)(base + r) * 512 + c]);
    pd[(size_t)row * 512 + c] = f2bf(s / (float)(hi - lo) - bf2f(Up[(size_t)row * 512 + c]));
  }
}

__global__ __launch_bounds__(512) void k_router(const float* __restrict__ lat, const float* __restrict__ ctxr, const float* __restrict__ gain, const float* __restrict__ modl,
                                                const float* __restrict__ wrg, const float* __restrict__ brg, const float* __restrict__ wre, const float* __restrict__ bre,
                                                bf16_t* __restrict__ out, int* __restrict__ re, float* __restrict__ rw, int nrows) {
  __shared__ float hs[8][1024];
  const int lane = threadIdx.x & 63, wv = threadIdx.x >> 6, gw = blockIdx.x * 8 + wv;
  const float* wp = lane < 4 ? wrg + lane : wre + ((lane - 4) & 31); const int wst = lane < 4 ? 4 : 32;
  const float bias = lane < 4 ? brg[lane] : bre[(lane - 4) & 31];
  for (int row = gw; row < nrows; row += gridDim.x * 8) {
    const float* src = row < NLAT ? lat + (size_t)row * D : ctxr + (size_t)(row - NLAT) * D;
    const float* mv = modl + row_vec(row) * 6144;
    f32x4 x[4]; float ss = 0.f;
#pragma unroll
    for (int j = 0; j < 4; ++j) { x[j] = ((const f32x4*)src)[lane + 64 * j]; ss += x[j].x * x[j].x + x[j].y * x[j].y + x[j].z * x[j].z + x[j].w * x[j].w; }
    const float rstd = 1.f / sqrtf(wave_sum(ss) * (1.f / D) + EPS);
#pragma unroll
    for (int j = 0; j < 4; ++j) {
      const int n = (lane + 64 * j) * 4;
      const f32x4 g = *(const f32x4*)(gain + n), sc = *(const f32x4*)(mv + 4096 + n), sh = *(const f32x4*)(mv + 3072 + n);
      const f32x4 h = x[j] * rstd * g * (sc + 1.f) + sh;
      uint2 o; o.x = pack2(h.x, h.y); o.y = pack2(h.z, h.w);
      *(uint2*)(out + (size_t)row * D + n) = o;
      *(f32x4*)&hs[wv][n] = h;
    }
    __builtin_amdgcn_wave_barrier();
    float acc = 0.f;
#pragma unroll 8
    for (int k = 0; k < 1024; ++k) acc += hs[wv][k] * wp[(size_t)k * wst];
    acc += bias;
    __builtin_amdgcn_wave_barrier();
    float gl[4];
#pragma unroll
    for (int i = 0; i < 4; ++i) gl[i] = __shfl(acc, i);
    int gi = 0; float gm = gl[0];
#pragma unroll
    for (int i = 1; i < 4; ++i) if (gl[i] > gm) { gm = gl[i]; gi = i; }
    float gs = 0.f;
#pragma unroll
    for (int i = 0; i < 4; ++i) gs += expf(gl[i] - gm);
    const float gp = 1.f / gs;
    float el[8];
#pragma unroll
    for (int i = 0; i < 8; ++i) el[i] = __shfl(acc, 4 + gi * 8 + i);
    int e1 = 0; float m1 = el[0];
#pragma unroll
    for (int i = 1; i < 8; ++i) if (el[i] > m1) { m1 = el[i]; e1 = i; }
    int e2 = 0; float m2 = -3.0e38f;
#pragma unroll
    for (int i = 0; i < 8; ++i) if (i != e1 && el[i] > m2) { m2 = el[i]; e2 = i; }
    const float w1 = 1.f / (1.f + expf(m2 - m1)), w2 = 1.f - w1;
    if (lane == 0) { re[row * 2] = gi * 8 + e1; re[row * 2 + 1] = gi * 8 + e2; rw[row * 2] = gp * w1; rw[row * 2 + 1] = gp * w2; }
  }
}

__global__ __launch_bounds__(256) void k_moe_naive(const bf16_t* __restrict__ H, const int* __restrict__ re, const float* __restrict__ rw,
                                                   const float* __restrict__ Wg, const float* __restrict__ Wu, const float* __restrict__ Wd, bf16_t* __restrict__ Y) {
  const int row = blockIdx.x, f = threadIdx.x;
  __shared__ float hs[1024];
  __shared__ float as_[256];
  for (int i = f; i < 1024; i += 256) hs[i] = bf2f(H[(size_t)row * D + i]);
  __syncthreads();
  for (int slot = 0; slot < 2; ++slot) {
    const int e = re[row * 2 + slot]; const float w = rw[row * 2 + slot];
    const float* wg = Wg + (size_t)e * 1024 * 256 + f; const float* wu = Wu + (size_t)e * 1024 * 256 + f;
    float g = 0.f, u = 0.f;
#pragma unroll 8
    for (int k = 0; k < 1024; ++k) { g += hs[k] * wg[(size_t)k * 256]; u += hs[k] * wu[(size_t)k * 256]; }
    as_[f] = siluf_(g) * u * w;
    __syncthreads();
    const float* wd = Wd + (size_t)e * 256 * 1024;
    float y[4] = {0.f, 0.f, 0.f, 0.f};
#pragma unroll 4
    for (int k = 0; k < 256; ++k) { const float a = as_[k];
#pragma unroll
      for (int i = 0; i < 4; ++i) y[i] += a * wd[(size_t)k * 1024 + f + 256 * i]; }
#pragma unroll
    for (int i = 0; i < 4; ++i) Y[((size_t)row * 2 + slot) * D + f + 256 * i] = f2bf(y[i]);
    __syncthreads();
  }
}

__global__ __launch_bounds__(512) void k_combine_norm(float* __restrict__ lat, float* __restrict__ ctxr, const bf16_t* __restrict__ Y, const float* __restrict__ modl_cur,
                                                      const float* __restrict__ gain, const float* __restrict__ modl_next, bf16_t* __restrict__ hout, int nrows, int final_) {
  const int lane = threadIdx.x & 63, gw = blockIdx.x * 8 + (threadIdx.x >> 6);
  for (int row = gw; row < nrows; row += gridDim.x * 8) {
    float* src = row < NLAT ? lat + (size_t)row * D : ctxr + (size_t)(row - NLAT) * D;
    const int v = row_vec(row);
    f32x4 x[4]; float ss = 0.f;
#pragma unroll
    for (int j = 0; j < 4; ++j) {
      const int n = (lane + 64 * j) * 4;
      const f32x4 g2 = *(const f32x4*)(modl_cur + v * 6144 + 5120 + n);
      const uint2 y0 = *(const uint2*)(Y + ((size_t)row * 2) * D + n), y1 = *(const uint2*)(Y + ((size_t)row * 2 + 1) * D + n);
      f32x4 ys;
      ys.x = __uint_as_float(y0.x << 16) + __uint_as_float(y1.x << 16); ys.y = __uint_as_float(y0.x & 0xFFFF0000u) + __uint_as_float(y1.x & 0xFFFF0000u);
      ys.z = __uint_as_float(y0.y << 16) + __uint_as_float(y1.y << 16); ys.w = __uint_as_float(y0.y & 0xFFFF0000u) + __uint_as_float(y1.y & 0xFFFF0000u);
      x[j] = ((const f32x4*)src)[lane + 64 * j] + g2 * ys;
      ss += x[j].x * x[j].x + x[j].y * x[j].y + x[j].z * x[j].z + x[j].w * x[j].w;
    }
    const float rstd = 1.f / sqrtf(wave_sum(ss) * (1.f / D) + EPS);
#pragma unroll
    for (int j = 0; j < 4; ++j) {
      const int n = (lane + 64 * j) * 4;
      const f32x4 g = *(const f32x4*)(gain + n);
      if (final_) { ((f32x4*)src)[lane + 64 * j] = x[j] * rstd * g; }
      else {
        ((f32x4*)src)[lane + 64 * j] = x[j];
        const f32x4 sc = *(const f32x4*)(modl_next + v * 6144 + 1024 + n), sh = *(const f32x4*)(modl_next + v * 6144 + n);
        const f32x4 h = x[j] * rstd * g * (sc + 1.f) + sh;
        uint2 o; o.x = pack2(h.x, h.y); o.y = pack2(h.z, h.w);
        *(uint2*)(hout + (size_t)row * D + n) = o;
      }
    }
  }
}

__global__ __launch_bounds__(512) void k_rowssq(const bf16_t* __restrict__ cq, const bf16_t* __restrict__ ckv, float* __restrict__ rq, float* __restrict__ rkv) {
  const int lane = threadIdx.x & 63, gw = blockIdx.x * 8 + (threadIdx.x >> 6);
  for (int row = gw; row < MROWS; row += gridDim.x * 8) {
    { const unsigned w = *(const unsigned*)(ckv + (size_t)row * 128 + lane * 2); const float a = __uint_as_float(w << 16), b = __uint_as_float(w & 0xFFFF0000u);
      const float ss = wave_sum(a * a + b * b); if (lane == 0) rkv[row] = 1.f / sqrtf(ss * (1.f / 128.f) + EPS); }
    if (row < NLAT) { const uint2 w = *(const uint2*)(cq + (size_t)row * 256 + lane * 4);
      const float a = __uint_as_float(w.x << 16), b = __uint_as_float(w.x & 0xFFFF0000u), c = __uint_as_float(w.y << 16), d = __uint_as_float(w.y & 0xFFFF0000u);
      const float ss = wave_sum(a * a + b * b + c * c + d * d); if (lane == 0) rq[row] = 1.f / sqrtf(ss * (1.f / 256.f) + EPS); }
  }
}
__device__ __forceinline__ float rope_inv(int i) { return exp2f(-(float)i * (13.287712379549449f / 8.f)); }
__global__ __launch_bounds__(256) void k_kr_rope(const float* __restrict__ kr, bf16_t* __restrict__ dk) {
  const int idx = blockIdx.x * 256 + threadIdx.x; if (idx >= MROWS * 32) return;
  const int m = idx >> 5, j = idx & 31; int b, key; row_bkey(m, b, key);
  float val = kr[idx];
  if (m < NLAT) {
    const int t = m & 8191; const int half = j >> 4, jj = j & 15, i = jj & 7;
    const float pos = half ? (float)(t & 63) : (float)(t >> 6);
    const float ang = pos * rope_inv(i); float sn, cs; sincosf(ang, &sn, &cs);
    const float x1 = kr[(size_t)m * 32 + half * 16 + i], x2 = kr[(size_t)m * 32 + half * 16 + 8 + i];
    val = (jj < 8) ? (x1 * cs - x2 * sn) : (x1 * sn + x2 * cs);
  }
  const bf16_t o = f2bf(val);
#pragma unroll
  for (int hh = 0; hh < 8; ++hh) dk[((size_t)(b * 8 + hh) * NKEY + key) * 128 + 64 + j] = o;
}

__global__ __launch_bounds__(64) void k_na_naive(const bf16_t* __restrict__ nq, const bf16_t* __restrict__ nk, const bf16_t* __restrict__ nv, const float* __restrict__ rpb,
                                                 bf16_t* __restrict__ A) {
  const int t = blockIdx.x * 64 + threadIdx.x, hh = blockIdx.y, b = blockIdx.z;
  const int r = t >> 6, c = t & 63;
  int rs = r - 4; rs = rs < 0 ? 0 : (rs > 120 ? 120 : rs);
  int cs = c - 8; cs = cs < 0 ? 0 : (cs > 48 ? 48 : cs);
  float q[64], o[64];
  const bf16_t* qp = nq + ((size_t)(b * 8 + hh) * SEQ + t) * 64;
#pragma unroll
  for (int d = 0; d < 64; ++d) { q[d] = bf2f(qp[d]); o[d] = 0.f; }
  const bf16_t* Kb = nk + (size_t)(b * 8 + hh) * NKEY * 64; const bf16_t* Vb = nv + (size_t)(b * 8 + hh) * NKEY * 64;
  float mx = -3.0e38f, l = 0.f;
  for (int kk = 0; kk < 128 + CT; ++kk) {
    int key; float bias = 0.f;
    if (kk < 128) { const int kr_ = rs + (kk >> 4), kc = cs + (kk & 15); key = CT + kr_ * 64 + kc; bias = rpb[(hh * 15 + (kr_ - r + 7)) * 31 + (kc - c + 15)] * LOG2E; }
    else key = kk - 128;
    const bf16_t* kp = Kb + (size_t)key * 64; float s = bias;
#pragma unroll
    for (int d = 0; d < 64; d += 2) { const unsigned w = *(const unsigned*)(kp + d); s += q[d] * __uint_as_float(w << 16) + q[d + 1] * __uint_as_float(w & 0xFFFF0000u); }
    const float mn = fmaxf(mx, s), alpha = exp2f(mx - mn), p = exp2f(s - mn);
    l = l * alpha + p; mx = mn;
    const bf16_t* vp = Vb + (size_t)key * 64;
#pragma unroll
    for (int d = 0; d < 64; d += 2) { const unsigned w = *(const unsigned*)(vp + d); o[d] = o[d] * alpha + p * __uint_as_float(w << 16); o[d + 1] = o[d + 1] * alpha + p * __uint_as_float(w & 0xFFFF0000u); }
  }
  const float il = 1.f / l;
  bf16_t* op = A + (size_t)(b * SEQ + t) * D + hh * 64;
#pragma unroll
  for (int d = 0; d < 64; d += 2) *(unsigned*)(op + d) = pack2(o[d] * il, o[d + 1] * il);
}
__global__ __launch_bounds__(64) void k_mla_naive(const bf16_t* __restrict__ dq, const bf16_t* __restrict__ dk, const bf16_t* __restrict__ dv, bf16_t* __restrict__ A) {
  const int t = blockIdx.x * 64 + threadIdx.x, hh = blockIdx.y, b = blockIdx.z;
  float q[96], o[64];
  const bf16_t* qp = dq + ((size_t)(b * 8 + hh) * SEQ + t) * 96;
#pragma unroll
  for (int d = 0; d < 96; ++d) q[d] = bf2f(qp[d]);
#pragma unroll
  for (int half = 0; half < 2; ++half) {
    const float pos = half ? (float)(t & 63) : (float)(t >> 6);
#pragma unroll
    for (int i = 0; i < 8; ++i) { float sn, cs; sincosf(pos * rope_inv(i), &sn, &cs);
      const float x1 = q[64 + half * 16 + i], x2 = q[64 + half * 16 + 8 + i];
      q[64 + half * 16 + i] = x1 * cs - x2 * sn; q[64 + half * 16 + 8 + i] = x1 * sn + x2 * cs; }
  }
#pragma unroll
  for (int d = 0; d < 64; ++d) o[d] = 0.f;
  const bf16_t* Kb = dk + (size_t)(b * 8 + hh) * NKEY * 128; const bf16_t* Vb = dv + (size_t)(b * 8 + hh) * NKEY * 64;
  float mx = -3.0e38f, l = 0.f;
  for (int k0 = 0; k0 < NKEY; k0 += 8) {
    float s[8]; float bm = -3.0e38f;
#pragma unroll
    for (int j = 0; j < 8; ++j) { const bf16_t* kp = Kb + (size_t)(k0 + j) * 128; float a = 0.f;
#pragma unroll
      for (int d = 0; d < 96; d += 2) { const unsigned w = *(const unsigned*)(kp + d); a += q[d] * __uint_as_float(w << 16) + q[d + 1] * __uint_as_float(w & 0xFFFF0000u); }
      s[j] = a; bm = fmaxf(bm, a); }
    const float mn = fmaxf(mx, bm), alpha = exp2f(mx - mn); mx = mn; l *= alpha;
#pragma unroll
    for (int d = 0; d < 64; ++d) o[d] *= alpha;
#pragma unroll
    for (int j = 0; j < 8; ++j) { const float p = exp2f(s[j] - mn); l += p; const bf16_t* vp = Vb + (size_t)(k0 + j) * 64;
#pragma unroll
      for (int d = 0; d < 64; d += 2) { const unsigned w = *(const unsigned*)(vp + d); o[d] += p * __uint_as_float(w << 16); o[d + 1] += p * __uint_as_float(w & 0xFFFF0000u); } }
  }
  const float il = 1.f / l;
  bf16_t* op = A + (size_t)(b * SEQ + t) * D + 512 + hh * 64;
#pragma unroll
  for (int d = 0; d < 64; d += 2) *(unsigned*)(op + d) = pack2(o[d] * il, o[d + 1] * il);
}

typedef short bf16x8 __attribute__((ext_vector_type(8)));
struct MP {
  const float* in[29];
  float* out; char* ws;
  int ph_lo, ph_hi;
};
constexpr int LDS_BYTES = 131072 + 1024;
constexpr int CNT_OFF = 16384;
typedef short s16x4 __attribute__((ext_vector_type(4)));
typedef float f32x16 __attribute__((ext_vector_type(16)));
typedef unsigned u32x4 __attribute__((ext_vector_type(4)));
constexpr float ATT_THR = 11.5f;
constexpr int NCHUNK = MROWS / 64;

struct MK {
  int wv;
  __device__ __forceinline__ int tidx() const { int l = (int)__lane_id(); asm volatile("" : "+v"(l)); return (wv << 6) | l; }
#define MFMA16(a, b, c) __builtin_amdgcn_mfma_f32_16x16x32_bf16(a, b, c, 0, 0, 0)


template <int MI, class Epi>
__device__ __forceinline__ void gemm_tile(const bf16_t* __restrict__ A, int lda, const int* __restrict__ gather, int gshift, int Mvalid,
                                          const bf16_t* __restrict__ Bt, int ldb, int K, int m0, int n0, char* lds, const Epi& epi) {
  constexpr int BM = 64 * MI, ABYTES = BM * 128, STAGE = ABYTES + 128 * 128;
  const int t = tidx(), lane = t & 63, w = t >> 6, wm = w >> 1, wn = w & 1, l15 = lane & 15, lq = lane >> 4;
  const int c = t & 7, r = t >> 3;
  const bf16_t* ap[MI];
#pragma unroll
  for (int i = 0; i < MI; ++i) { int m = m0 + r + 64 * i; m = m < Mvalid ? m : Mvalid - 1; const int row = gather ? (gather[m] >> gshift) : m; ap[i] = A + (size_t)row * lda + c * 8; }
  const bf16_t* bp0 = Bt + (size_t)(n0 + r) * ldb + c * 8; const bf16_t* bp1 = bp0 + (size_t)64 * ldb;
  const int wofs = r * 128 + ((c ^ ((r >> 1) & 7)) << 4);
  const int sw = (l15 >> 1) & 7, x0 = (lq ^ sw) << 4, x1 = x0 ^ 64;
  const int arow = (wm * 16 * MI + l15) * 128, brow = ABYTES + (wn * 64 + l15) * 128;
  f32x4 acc[MI][4];
#pragma unroll
  for (int i = 0; i < MI; ++i)
#pragma unroll
    for (int j = 0; j < 4; ++j) acc[i][j] = (f32x4){0.f, 0.f, 0.f, 0.f};
  uint4 ra[MI], rb0, rb1;
  const int KT = K >> 6;
#pragma unroll
  for (int i = 0; i < MI; ++i) ra[i] = *(const uint4*)(ap[i]);
  rb0 = *(const uint4*)bp0; rb1 = *(const uint4*)bp1;
#pragma unroll
  for (int i = 0; i < MI; ++i) *(uint4*)(lds + wofs + i * 8192) = ra[i];
  *(uint4*)(lds + ABYTES + wofs) = rb0; *(uint4*)(lds + ABYTES + wofs + 8192) = rb1;
  __syncthreads();
  for (int kt = 0; kt < KT; ++kt) {
    char* cur = lds + (kt & 1) * STAGE; char* nxt = lds + ((kt + 1) & 1) * STAGE;
    const bool more = kt + 1 < KT;
    if (more) {
      const int k0 = (kt + 1) << 6;
#pragma unroll
      for (int i = 0; i < MI; ++i) ra[i] = *(const uint4*)(ap[i] + k0);
      rb0 = *(const uint4*)(bp0 + k0); rb1 = *(const uint4*)(bp1 + k0);
    }
#pragma unroll
    for (int ks = 0; ks < 2; ++ks) {
      const int xo = ks ? x1 : x0;
      bf16x8 af[MI], bfv[4];
#pragma unroll
      for (int i = 0; i < MI; ++i) af[i] = *(const bf16x8*)(cur + arow + i * 2048 + xo);
#pragma unroll
      for (int j = 0; j < 4; ++j) bfv[j] = *(const bf16x8*)(cur + brow + j * 2048 + xo);
#pragma unroll
      for (int i = 0; i < MI; ++i)
#pragma unroll
        for (int j = 0; j < 4; ++j) acc[i][j] = MFMA16(bfv[j], af[i], acc[i][j]);
    }
    if (more) {
#pragma unroll
      for (int i = 0; i < MI; ++i) *(uint4*)(nxt + wofs + i * 8192) = ra[i];
      *(uint4*)(nxt + ABYTES + wofs) = rb0; *(uint4*)(nxt + ABYTES + wofs + 8192) = rb1;
    }
    __syncthreads();
  }
  epi.tile(acc, m0 + wm * 16 * MI + l15, n0 + wn * 64 + lq * 4, Mvalid);
}
template <class E> struct EpiEach {
  E e;
  template <int MI> __device__ __forceinline__ void tile(const f32x4 (&acc)[MI][4], int mb, int nb, int Mvalid) const {
#pragma unroll
    for (int i = 0; i < MI; ++i) { const int m = mb + i * 16; if (m < Mvalid) {
#pragma unroll
      for (int j = 0; j < 4; ++j) e.apply(m, nb + j * 16, acc[i][j]); } }
  }
};
template <int MI, class E>
__device__ __forceinline__ void gemm_phase(const bf16_t* A, int lda, const bf16_t* Bt, int ldb, int M, int N, int K, const E& e, char* lds) {
  constexpr int BM = 64 * MI; const int ntm = (M + BM - 1) / BM, ntn = N >> 7;
  EpiEach<E> ee; ee.e = e;
  for (int tile = blockIdx.x; tile < ntm * ntn; tile += gridDim.x) { const int mt = tile / ntn, nt = tile - mt * ntn; gemm_tile<MI>(A, lda, nullptr, 0, M, Bt, ldb, K, mt * BM, nt * 128, lds, ee); }
}

#define PG8_LAS __attribute__((address_space(3)))
static constexpr int BM = 256, BK = 64, HALF = 128, HTB = HALF * BK * 2, STAGE_BYTES = 8 * HTB, NXCD = 8, WGM = 8;
static __device__ __forceinline__ int lds_byte(int r, int c) { const int st = (r >> 4) * 2 + (c >> 5), rr = r & 15, cc = c & 31, ob = rr * 64 + cc * 2; return st * 1024 + (ob ^ (((ob >> 9) & 1) << 5)); }
static __device__ __forceinline__ void stage_rc(int b, int& R, int& C) { const int st = b / 1024, sb = b % 1024, swz = sb ^ (((sb >> 9) & 1) << 5); R = (st >> 1) * 16 + swz / 64; C = (st & 1) * 32 + (swz % 64) / 2; }
static __device__ __forceinline__ int perm32(int rho) { const int n = rho >> 4, i = rho & 15; return 8 * (i >> 2) + 4 * n + (i & 3); }

struct Unit { int pm, pn; };
struct Gemm { const bf16_t* A; const bf16_t* Bt; int M, N, K; };
struct StaticOrder {
    int nM, nN, nwg, G, c;
    __device__ void init(int M, int N, int G_, int c_) { nM = M / BM; nN = N / BM; nwg = nM * nN; G = G_; c = c_; }
    __device__ bool next(int i, Unit& u) const {
        const long L = (long)i * G + c; if (L >= nwg) return false;
        int wgid = (int)L; { const int q = nwg / NXCD, r = nwg % NXCD, xcd = wgid % NXCD, off = wgid / NXCD; wgid = (xcd < r ? xcd * (q + 1) : r * (q + 1) + (xcd - r) * q) + off; }
        const int nig = WGM * nN, gid = wgid / nig, fm = gid * WGM, gsz = (nM - fm) < WGM ? (nM - fm) : WGM;
        u.pm = fm + ((wgid % nig) % gsz); u.pn = (wgid % nig) / gsz; return true;
    }
    __device__ __forceinline__ void a_ready(const Unit&) const {}
    __device__ __forceinline__ void done(const Unit&) const {}
};
template <class Epi, class Sched>
__device__ __forceinline__ void pg8_phase(PG8_LAS unsigned char* lds, const Gemm g, const Sched& S, const Epi& E) {
    const int tid = tidx(), wid = __builtin_amdgcn_readfirstlane(tid >> 6), lane = tid & 63, wr = wid >> 2, wc = wid & 3, fr = lane & 15, fq = lane >> 4;
    const int K = g.K, nt = K / BK;
    unsigned voffA[2], voffB[2];
#pragma unroll
    for (int i = 0; i < 2; ++i) { int R, C; stage_rc(tid * 16 + i * 8192, R, C); const int Rb = Epi::PERM ? ((R & ~31) + perm32(R & 31)) : R;
        voffA[i] = (unsigned)(R * K + C) * 2u; voffB[i] = (unsigned)(Rb * K + C) * 2u; }
    const size_t kstep = (size_t)(BK * 2);
    const size_t hstep = (size_t)HALF * K * 2;
    const size_t tstep = 2 * hstep;
    const unsigned ldsw = (unsigned)wid * 1024u;
    const int aoff = lds_byte(wr * 64 + fr, fq * 8), boff = lds_byte(wc * 32 + fr, fq * 8);
#define PG8_SA(b, h) (((b) * 2 + (h)) * HTB)
#define PG8_SB(b, h) ((4 + (b) * 2 + (h)) * HTB)
#define PG8_STAGE(bufoff, gbase, voff) do { _Pragma("unroll") for (int _i = 0; _i < 2; ++_i) \
        __builtin_amdgcn_global_load_lds((const unsigned*)((const char*)(gbase) + (voff)[_i]), (PG8_LAS unsigned*)(lds + (bufoff) + ldsw + _i * 8192), 16, 0, 0); } while (0)
#define PG8_LDA(dst, b, h) do { _Pragma("unroll") for (int m = 0; m < 4; ++m) _Pragma("unroll") for (int k = 0; k < 2; ++k) dst[m][k] = *(const PG8_LAS bf16x8*)(lds + PG8_SA(b, h) + aoff + m * 2048 + k * 1024); } while (0)
#define PG8_LDB(dst, b, h) do { _Pragma("unroll") for (int n = 0; n < 2; ++n) _Pragma("unroll") for (int k = 0; k < 2; ++k) dst[n][k] = *(const PG8_LAS bf16x8*)(lds + PG8_SB(b, h) + boff + n * 2048 + k * 1024); } while (0)
#define PG8_MMA(ai, bj, At, Bt) do { __builtin_amdgcn_s_setprio(1); _Pragma("unroll") for (int m = 0; m < 4; ++m) _Pragma("unroll") for (int n = 0; n < 2; ++n) _Pragma("unroll") for (int k = 0; k < 2; ++k) \
        acc[ai][bj][m][n] = __builtin_amdgcn_mfma_f32_16x16x32_bf16(Bt[n][k], At[m][k], acc[ai][bj][m][n], 0, 0, 0); __builtin_amdgcn_s_setprio(0); } while (0)
#define PG8_WAIT_V(n) asm volatile("s_waitcnt vmcnt(" #n ")" ::: "memory")
#define PG8_WAIT_L(n) asm volatile("s_waitcnt lgkmcnt(" #n ")" ::: "memory")
#define PG8_BAR __builtin_amdgcn_s_barrier()
#define PG8_SCHED __builtin_amdgcn_sched_barrier(0)
    Unit cur, nxt; int ui = 0;
    if (!S.next(0, cur)) return;
    f32x4 acc[2][2][4][2];
#pragma unroll
    for (int a = 0; a < 2; ++a)
#pragma unroll
        for (int b = 0; b < 2; ++b)
#pragma unroll
            for (int m = 0; m < 4; ++m)
#pragma unroll
                for (int n = 0; n < 2; ++n) acc[a][b][m][n] = (f32x4){0.f, 0.f, 0.f, 0.f};
    bf16x8 At[4][2], B0[2][2], B1[2][2];
    const char* cA = (const char*)g.A + (size_t)cur.pm * tstep; const char* cB = (const char*)g.Bt + (size_t)cur.pn * tstep;
    S.a_ready(cur);
    PG8_STAGE(PG8_SB(0, 0), cB, voffB); PG8_STAGE(PG8_SA(0, 0), cA, voffA); PG8_STAGE(PG8_SB(0, 1), cB + hstep, voffB); PG8_STAGE(PG8_SA(0, 1), cA + hstep, voffA);
    if (wr == 1) PG8_BAR;
    PG8_WAIT_V(4); PG8_BAR;
    PG8_STAGE(PG8_SB(1, 0), cB + kstep, voffB); PG8_STAGE(PG8_SA(1, 0), cA + kstep, voffA); PG8_STAGE(PG8_SB(1, 1), cB + hstep + kstep, voffB);
    PG8_WAIT_V(6); PG8_BAR;
    for (;;) {
        const bool has_next = S.next(ui + 1, nxt);
        const char* nA = has_next ? (const char*)g.A + (size_t)nxt.pm * tstep : cA; const char* nB = has_next ? (const char*)g.Bt + (size_t)nxt.pn * tstep : cB;
        for (int t = 0; t < nt; t += 2) {
            const bool last = (t == nt - 2);
            const char* a1 = cA + (size_t)(t + 1) * kstep;
            const char* a2 = last ? nA : cA + (size_t)(t + 2) * kstep; const char* b2 = last ? nB : cB + (size_t)(t + 2) * kstep;
            const char* a3 = a2 + kstep; const char* b3 = b2 + kstep;
            if (last && has_next) S.a_ready(nxt);
            PG8_LDB(B0, 0, 0); PG8_SCHED; PG8_LDA(At, 0, 0); PG8_STAGE(PG8_SA(1, 1), a1 + hstep, voffA);
            PG8_WAIT_L(8); PG8_BAR; PG8_WAIT_L(0); PG8_MMA(0, 0, At, B0); PG8_BAR; PG8_SCHED;
            PG8_LDB(B1, 0, 1); PG8_STAGE(PG8_SB(0, 0), b2, voffB);
            PG8_BAR; PG8_WAIT_L(0); PG8_MMA(0, 1, At, B1); PG8_BAR;
            PG8_LDA(At, 0, 1); PG8_STAGE(PG8_SA(0, 0), a2, voffA);
            PG8_BAR; PG8_WAIT_L(0); PG8_MMA(1, 0, At, B0); PG8_BAR; PG8_SCHED;
            PG8_STAGE(PG8_SB(0, 1), b2 + hstep, voffB);
            PG8_WAIT_V(6); PG8_BAR; PG8_MMA(1, 1, At, B1); PG8_BAR;
            PG8_LDB(B0, 1, 0); PG8_SCHED; PG8_LDA(At, 1, 0); PG8_STAGE(PG8_SA(0, 1), a2 + hstep, voffA);
            PG8_WAIT_L(8); PG8_BAR; PG8_WAIT_L(0); PG8_MMA(0, 0, At, B0); PG8_BAR; PG8_SCHED;
            PG8_LDB(B1, 1, 1); PG8_STAGE(PG8_SB(1, 0), b3, voffB);
            PG8_BAR; PG8_WAIT_L(0); PG8_MMA(0, 1, At, B1); PG8_BAR;
            PG8_LDA(At, 1, 1); PG8_STAGE(PG8_SA(1, 0), a3, voffA);
            PG8_BAR; PG8_WAIT_L(0); PG8_MMA(1, 0, At, B0); PG8_BAR; PG8_SCHED;
            PG8_STAGE(PG8_SB(1, 1), b3 + hstep, voffB);
            PG8_WAIT_V(6); PG8_BAR; PG8_MMA(1, 1, At, B1); PG8_BAR;
        }
        if constexpr (!Epi::AFTER_DRAIN) { E(acc, cur, wr, wc, fr, fq); S.done(cur); }
        if (!has_next) break;
#pragma unroll
        for (int a = 0; a < 2; ++a)
#pragma unroll
            for (int b = 0; b < 2; ++b)
#pragma unroll
                for (int m = 0; m < 4; ++m)
#pragma unroll
                    for (int n = 0; n < 2; ++n) acc[a][b][m][n] = (f32x4){0.f, 0.f, 0.f, 0.f};
        cur = nxt; cA = nA; cB = nB; ++ui;
    }
    PG8_WAIT_V(0);
    if (wr == 0) PG8_BAR;
    PG8_BAR;
    if constexpr (Epi::AFTER_DRAIN) { E.fused(acc, cur, wr, wc, fr, fq, lds, wid, lane); S.done(cur); }
#undef PG8_SA
#undef PG8_SB
#undef PG8_STAGE
#undef PG8_LDA
#undef PG8_LDB
#undef PG8_MMA
#undef PG8_WAIT_V
#undef PG8_WAIT_L
#undef PG8_BAR
#undef PG8_SCHED
}

template <class E> struct Pg8Each {
  static constexpr bool PERM = false, AFTER_DRAIN = false; E e;
  __device__ __forceinline__ void operator()(const f32x4 (&acc)[2][2][4][2], const Unit& u, int wr, int wc, int fr, int fq) const {
#pragma unroll
    for (int ai = 0; ai < 2; ++ai)
#pragma unroll
      for (int m = 0; m < 4; ++m) { const int row = u.pm * BM + ai * HALF + wr * 64 + m * 16 + fr;
#pragma unroll
        for (int bj = 0; bj < 2; ++bj)
#pragma unroll
          for (int n = 0; n < 2; ++n) e.apply(row, u.pn * BM + bj * HALF + wc * 32 + n * 16 + fq * 4, acc[ai][bj][m][n]); }
  }
};
template <class E>
__device__ __forceinline__ void gemm_phase8(const bf16_t* A, const bf16_t* Bt, int Mbig, int M, int N, int K, const E& e, char* lds, int ctx_n0, int ctx_n1) {
  { Gemm g; g.A = A; g.Bt = Bt; g.M = Mbig; g.N = N; g.K = K; StaticOrder S; S.init(Mbig, N, (int)gridDim.x, (int)blockIdx.x); Pg8Each<E> pe; pe.e = e;
    pg8_phase((PG8_LAS unsigned char*)lds, g, S, pe); }
  if (M > Mbig) { EpiEach<E> ee; ee.e = e; const int ntm = (M - Mbig) >> 6, ntn = (ctx_n1 - ctx_n0) >> 7;
    for (int tile = (int)gridDim.x - 1 - (int)blockIdx.x; tile < ntm * ntn; tile += gridDim.x) { const int mt = tile / ntn, nt = tile - mt * ntn;
      gemm_tile<1>(A, K, nullptr, 0, M, Bt, K, K, Mbig + mt * 64, ctx_n0 + nt * 128, lds, ee); } }
}

template <int K>
static __device__ __forceinline__ float row_rstd4(const bf16_t* rowp, int lq) {
  constexpr int PER = K / 4; float ss = 0.f;
#pragma unroll
  for (int i = 0; i < PER / 8; ++i) { const uint4 v = *(const uint4*)(rowp + lq * PER + i * 8); const unsigned wv[4] = {v.x, v.y, v.z, v.w};
#pragma unroll
    for (int q = 0; q < 4; ++q) { const float a = __uint_as_float(wv[q] << 16), b = __uint_as_float(wv[q] & 0xFFFF0000u); ss += a * a + b * b; } }
  ss += __shfl_xor(ss, 16); ss += __shfl_xor(ss, 32);
  return 1.f / sqrtf(ss * (1.f / K) + EPS);
}
struct EpiMlaQ2 {
  bf16_t* dq; const bf16_t* cq;
  template <int MI> __device__ __forceinline__ void tile(const f32x4 (&acc)[MI][4], int mb, int nb, int Mvalid) const {
#pragma unroll
    for (int i = 0; i < MI; ++i) { const int m = mb + i * 16; const float rs = row_rstd4<256>(cq + (size_t)m * 256, (nb >> 2) & 3) * MLA_QSCALE;
#pragma unroll
      for (int j = 0; j < 4; ++j) { const int n = nb + j * 16; const int hh = n / 96, off = n - hh * 96; const f32x4 v = acc[i][j] * rs;
        uint2 wv; wv.x = pack2(v.x, v.y); wv.y = pack2(v.z, v.w);
        *(uint2*)(dq + (((size_t)((m >> 13) * 8 + hh) * SEQ + (m & 8191)) * 96 + off)) = wv; } }
  }
};
struct EpiMlaKV2 {
  bf16_t *dk, *dv; const bf16_t* ckv;
  template <int MI> __device__ __forceinline__ void tile(const f32x4 (&acc)[MI][4], int mb, int nb, int Mvalid) const {
#pragma unroll
    for (int i = 0; i < MI; ++i) { const int m = mb + i * 16; const float rs = row_rstd4<128>(ckv + (size_t)m * 128, (nb >> 2) & 3);
      int b, key; row_bkey(m, b, key);
#pragma unroll
      for (int j = 0; j < 4; ++j) { const int n = nb + j * 16; const int hh = n >> 7, off = n & 127; const f32x4 v = acc[i][j] * rs;
        uint2 wv; wv.x = pack2(v.x, v.y); wv.y = pack2(v.z, v.w);
        if (off < 64) *(uint2*)(dk + (((size_t)(b * 8 + hh) * NKEY + key) * 128 + off)) = wv;
        else *(uint2*)(dv + (((size_t)(b * 8 + hh) * NKEY + key) * 64 + (off - 64))) = wv; } }
  }
};
struct EpiMoe2 {
  bf16_t* Y; const int* list; int m_base;
  __device__ __forceinline__ void apply(int m, int n, f32x4 v) const {
    uint2 wv; wv.x = pack2(v.x, v.y); wv.y = pack2(v.z, v.w);
    *(uint2*)(Y + (size_t)list[m - m_base] * D + n) = wv;
  }
};

__device__ __forceinline__ void ph_ada(const MP& p, char* lds) {
  float* sv = (float*)lds;
  const float* c = p.in[1]; const float* cctx = p.in[3]; float* mods = (float*)(p.ws + WS_MODS);
  const int t = tidx();
  for (int i = t; i < 1024; i += 512) { sv[i] = siluf_(c[i]); sv[1024 + i] = siluf_(c[1024 + i]); sv[2048 + i] = siluf_(cctx[i]); }
  __syncthreads();
  for (int item = blockIdx.x; item < 256; item += gridDim.x) {
    const int l = item >> 7, kg = (item >> 4) & 7, cg = item & 15;
    if (t < 384) {
      const int col = cg * 384 + t;
      const float* W = p.in[4] + ((size_t)l * 1024 + kg * 128) * 6144 + col;
      float a0 = 0.f, a1 = 0.f, a2 = 0.f;
#pragma unroll 16
      for (int k = 0; k < 128; ++k) { const float wv = W[(size_t)k * 6144]; const int kk = kg * 128 + k; a0 += sv[kk] * wv; a1 += sv[1024 + kk] * wv; a2 += sv[2048 + kk] * wv; }
      if (kg == 0) { const float bb = p.in[5][l * 6144 + col]; a0 += bb; a1 += bb; a2 += bb; }
      atomicAdd(&mods[(size_t)(l * 3 + 0) * 6144 + col], a0); atomicAdd(&mods[(size_t)(l * 3 + 1) * 6144 + col], a1); atomicAdd(&mods[(size_t)(l * 3 + 2) * 6144 + col], a2);
    }
  }
  if (blockIdx.x == gridDim.x - 1) { float* lb = (float*)(p.ws + WS_LB);
    for (int i = t; i < 1024; i += 512) { const int d = i >> 9, cc = i & 511; const float l0 = p.in[10][(d * 2) * 512 + cc], l1 = p.in[10][(d * 2 + 1) * 512 + cc]; lb[i] = 1.f / (1.f + expf(l1 - l0)); } }
  __syncthreads();
}
__device__ __forceinline__ void conv_tiles(const float* src, bf16_t* dst, const float* kscale, int K, int N, int Npad, int mode, int batch, size_t sbs, size_t dbs, char* lds) {
  float* tile = (float*)lds;
  const int ntn = (Npad + 63) >> 6, ntk = K >> 7, per = ntn * ntk, t = tidx();
  for (int item = blockIdx.x; item < per * batch; item += gridDim.x) {
    const int bz = item / per, rem = item - bz * per, kb = rem / ntn, nb = rem - kb * ntn, n0 = nb * 64, k0 = kb * 128;
    const float* s = src + bz * sbs; bf16_t* d = dst + bz * dbs;
#pragma unroll
    for (int i = 0; i < 4; ++i) { const int idx = t + 512 * i, k = idx >> 4, n4 = (idx & 15) * 4; f32x4 v = {0.f, 0.f, 0.f, 0.f};
      if (n0 + n4 < N) { v = *(const f32x4*)(s + (size_t)(k0 + k) * N + n0 + n4); if (kscale) v = v * kscale[k0 + k]; }
      float* tp = tile + k * 65 + n4; tp[0] = v.x; tp[1] = v.y; tp[2] = v.z; tp[3] = v.w; }
    __syncthreads();
#pragma unroll
    for (int i = 0; i < 2; ++i) { const int idx = t + 512 * i, nl = idx >> 4, k8 = (idx & 15) * 8, n = n0 + nl;
      if (n < Npad) { int row = n; if (mode == 1) row = moe_gu_row(0, n); else if (mode == 2) row = moe_gu_row(1, n);
        const float* tp = tile + k8 * 65 + nl;
        uint4 o; o.x = pack2(tp[0], tp[65]); o.y = pack2(tp[130], tp[195]); o.z = pack2(tp[260], tp[325]); o.w = pack2(tp[390], tp[455]);
        *(uint4*)(d + (size_t)row * K + k0 + k8) = o; } }
    __syncthreads();
  }
}
struct ConvJob { const float* src; bf16_t* dst; const float* kscale; int K, N, Npad, mode, batch; size_t sbs, dbs; };
__device__ __forceinline__ void conv_item(const ConvJob& j, int item, char* lds) {
  unsigned* tile = (unsigned*)lds;
  const int ntn = (j.Npad + 63) >> 6, ntk = j.K >> 7, per = ntn * ntk, t = tidx();
  const int bz = item / per, rem = item - bz * per, kb = rem / ntn, nb = rem - kb * ntn, n0 = nb * 64, k0 = kb * 128;
  const float* s = j.src + bz * j.sbs; bf16_t* d = j.dst + bz * j.dbs;
#pragma unroll
  for (int i = 0; i < 2; ++i) { const int idx = t + 512 * i, kp = idx >> 4, n4 = (idx & 15) * 4; f32x4 v0 = {0.f, 0.f, 0.f, 0.f}, v1 = v0;
    if (n0 + n4 < j.N) { const float* sp = s + (size_t)(k0 + 2 * kp) * j.N + n0 + n4; v0 = *(const f32x4*)sp; v1 = *(const f32x4*)(sp + j.N);
      if (j.kscale) { v0 = v0 * j.kscale[k0 + 2 * kp]; v1 = v1 * j.kscale[k0 + 2 * kp + 1]; } }
    unsigned* tp = tile + n4 * 65 + kp; tp[0] = pack2(v0.x, v1.x); tp[65] = pack2(v0.y, v1.y); tp[130] = pack2(v0.z, v1.z); tp[195] = pack2(v0.w, v1.w); }
  __syncthreads();
#pragma unroll
  for (int i = 0; i < 2; ++i) { const int idx = t + 512 * i, nl = idx >> 4, k8 = (idx & 15) * 8, n = n0 + nl;
    if (n < j.Npad) { int row = n; if (j.mode == 1) row = moe_gu_row(0, n); else if (j.mode == 2) row = moe_gu_row(1, n);
      const unsigned* tp = tile + nl * 65 + (k8 >> 1);
      *(uint4*)(d + (size_t)row * j.K + k0 + k8) = make_uint4(tp[0], tp[1], tp[2], tp[3]); } }
  __syncthreads();
}
__device__ __forceinline__ int conv_count(int K, int Npad, int batch) { return ((Npad + 63) >> 6) * (K >> 7) * batch; }
__device__ __forceinline__ void ph_conv_all(const MP& p, char* lds) {
  char* ws = p.ws; bf16_t* wgu = (bf16_t*)(ws + WS_WMOE); bf16_t* wd = wgu + (size_t)32 * 512 * 1024;
  const int c0 = conv_count(1024, 3072, 1), c1 = c0 + conv_count(1024, 1024, 1), c2 = c1 + conv_count(1024, 2048, 1), c3 = c2 + conv_count(1024, 1024, 1),
            c4 = c3 + conv_count(256, 768, 1), c5 = c4 + conv_count(128, 1024, 1), c6 = c5 + conv_count(128, 128, 4),
            c7 = c6 + conv_count(1024, 256, 32), c8 = c7 + conv_count(1024, 256, 32), c9 = c8 + conv_count(256, 1024, 32);
  for (int it = blockIdx.x; it < c9; it += gridDim.x) {
    ConvJob j; int li;
    if (it < c0)      { li = it;      j = ConvJob{p.in[8],  (bf16_t*)(ws + WS_WT_ABIN),  nullptr, 1024, 3072, 3072, 0, 1, 0, 0}; }
    else if (it < c1) { li = it - c0; j = ConvJob{p.in[9],  (bf16_t*)(ws + WS_WT_ABOUT), nullptr, 1024, 1024, 1024, 0, 1, 0, 0}; }
    else if (it < c2) { li = it - c1; j = ConvJob{p.in[14], (bf16_t*)(ws + WS_WT_CDIN),  nullptr, 1024, 1952, 2048, 0, 1, 0, 0}; }
    else if (it < c3) { li = it - c2; j = ConvJob{p.in[15], (bf16_t*)(ws + WS_WT_CDOUT), nullptr, 1024, 1024, 1024, 0, 1, 0, 0}; }
    else if (it < c4) { li = it - c3; j = ConvJob{p.in[18], (bf16_t*)(ws + WS_WT_UQ),    p.in[17], 256, 768, 768, 0, 1, 0, 0}; }
    else if (it < c5) { li = it - c4; j = ConvJob{p.in[20], (bf16_t*)(ws + WS_WT_UKV),   p.in[19], 128, 1024, 1024, 0, 1, 0, 0}; }
    else if (it < c6) { li = it - c5; j = ConvJob{p.in[12], (bf16_t*)(ws + WS_WT_POOL),  nullptr, 128, 128, 128, 0, 4, (size_t)128 * 128, (size_t)128 * 128}; }
    else if (it < c7) { li = it - c6; j = ConvJob{p.in[25], wgu, nullptr, 1024, 256, 256, 1, 32, (size_t)1024 * 256, (size_t)512 * 1024}; }
    else if (it < c8) { li = it - c7; j = ConvJob{p.in[26], wgu, nullptr, 1024, 256, 256, 2, 32, (size_t)1024 * 256, (size_t)512 * 1024}; }
    else              { li = it - c8; j = ConvJob{p.in[27], wd,  nullptr, 256, 1024, 1024, 0, 32, (size_t)256 * 1024, (size_t)1024 * 256}; }
    conv_item(j, li, lds);
  }
}
__device__ __forceinline__ void ph_conv_small(const MP& p, char* lds) {
  char* ws = p.ws;
  conv_tiles(p.in[8], (bf16_t*)(ws + WS_WT_ABIN), nullptr, 1024, 3072, 3072, 0, 1, 0, 0, lds);
  conv_tiles(p.in[9], (bf16_t*)(ws + WS_WT_ABOUT), nullptr, 1024, 1024, 1024, 0, 1, 0, 0, lds);
  conv_tiles(p.in[14], (bf16_t*)(ws + WS_WT_CDIN), nullptr, 1024, 1952, 2048, 0, 1, 0, 0, lds);
  conv_tiles(p.in[15], (bf16_t*)(ws + WS_WT_CDOUT), nullptr, 1024, 1024, 1024, 0, 1, 0, 0, lds);
  conv_tiles(p.in[18], (bf16_t*)(ws + WS_WT_UQ), p.in[17], 256, 768, 768, 0, 1, 0, 0, lds);
  conv_tiles(p.in[20], (bf16_t*)(ws + WS_WT_UKV), p.in[19], 128, 1024, 1024, 0, 1, 0, 0, lds);
  conv_tiles(p.in[12], (bf16_t*)(ws + WS_WT_POOL), nullptr, 128, 128, 128, 0, 4, (size_t)128 * 128, (size_t)128 * 128, lds);
}
__device__ __forceinline__ void ph_conv_moe(const MP& p, int layer, char* lds) {
  bf16_t* wgu = (bf16_t*)(p.ws + WS_WMOE); bf16_t* wd = wgu + (size_t)32 * 512 * 1024;
  const size_t lo = (size_t)layer * 32 * 1024 * 256;
  const int c0 = conv_count(1024, 256, 32), c1 = c0 + conv_count(1024, 256, 32), c2 = c1 + conv_count(256, 1024, 32);
  for (int it = blockIdx.x; it < c2; it += gridDim.x) {
    ConvJob j; int li;
    if (it < c0)      { li = it;      j = ConvJob{p.in[25] + lo, wgu, nullptr, 1024, 256, 256, 1, 32, (size_t)1024 * 256, (size_t)512 * 1024}; }
    else if (it < c1) { li = it - c0; j = ConvJob{p.in[26] + lo, wgu, nullptr, 1024, 256, 256, 2, 32, (size_t)1024 * 256, (size_t)512 * 1024}; }
    else              { li = it - c1; j = ConvJob{p.in[27] + lo, wd,  nullptr, 256, 1024, 1024, 0, 32, (size_t)256 * 1024, (size_t)1024 * 256}; }
    conv_item(j, li, lds);
  }
}
__device__ __forceinline__ void ph_norm_mod(const float* lat, const float* ctxr, const float* gain, const float* modl, int sh_off, int sc_off, bf16_t* out, int nrows) {
  const int lane = tidx() & 63, gw = blockIdx.x * 8 + (tidx() >> 6);
  for (int row = gw; row < nrows; row += gridDim.x * 8) {
    const float* src = row < NLAT ? lat + (size_t)row * D : ctxr + (size_t)(row - NLAT) * D;
    const float* mv = modl + row_vec(row) * 6144;
    f32x4 x[4]; float ss = 0.f;
#pragma unroll
    for (int j = 0; j < 4; ++j) { x[j] = ((const f32x4*)src)[lane + 64 * j]; ss += x[j].x * x[j].x + x[j].y * x[j].y + x[j].z * x[j].z + x[j].w * x[j].w; }
    const float rstd = 1.f / sqrtf(wave_sum(ss) * (1.f / D) + EPS);
#pragma unroll
    for (int j = 0; j < 4; ++j) {
      const int n = (lane + 64 * j) * 4;
      const f32x4 g = *(const f32x4*)(gain + n), sc = *(const f32x4*)(mv + sc_off + n), sh = *(const f32x4*)(mv + sh_off + n);
      const f32x4 h = x[j] * rstd * g * (sc + 1.f) + sh;
      uint2 o; o.x = pack2(h.x, h.y); o.y = pack2(h.z, h.w);
      *(uint2*)(out + (size_t)row * D + n) = o;
    }
  }
}
template <int HALF>
__device__ __forceinline__ void pool_prep_col(const bf16_t* Up, bf16_t* pd, int r0, int seg_lo, int seg_hi, int c) {
  float a[32];
#pragma unroll
  for (int i = 0; i < 32; ++i) { const int r = r0 - 8 + i; const bool in = (r >= seg_lo) && (r < seg_hi); const int rc = in ? r : r0; const float v = bf2f(Up[(size_t)rc * 512 + c]); a[i] = in ? v : 0.f; }
  float sum = 0.f;
#pragma unroll
  for (int i = 8 - HALF; i < 8 + HALF; ++i) sum += a[i];
#pragma unroll
  for (int j = 0; j < 16; ++j) {
    const int t = r0 + j; int lo = t - HALF, hi = t + HALF; lo = lo < seg_lo ? seg_lo : lo; hi = hi > seg_hi ? seg_hi : hi;
    pd[(size_t)t * 512 + c] = f2bf(sum * __builtin_amdgcn_rcpf((float)(hi - lo)) - a[8 + j]);
    if (j < 15) sum += a[8 + j + HALF] - a[8 + j - HALF];
  }
}
__device__ __forceinline__ void ph_pool_prep(const bf16_t* Up, bf16_t* pd) {
  const int t = tidx(), cl = t & 127, rq = t >> 7;
  for (int item = blockIdx.x; item < NCHUNK * 4; item += gridDim.x) {
    const int cid = item >> 2, gi = item & 3, c = gi * 128 + cl, rc0 = cid * 64, r0 = rc0 + rq * 16; int seg_lo, seg_hi;
    if (rc0 < NLAT) { seg_lo = rc0 & ~8191; seg_hi = seg_lo + SEQ; } else { seg_lo = NLAT + ((rc0 - NLAT) & ~255); seg_hi = seg_lo + CT; }
    if (gi == 0) pool_prep_col<1>(Up, pd, r0, seg_lo, seg_hi, c);
    else if (gi == 1) pool_prep_col<2>(Up, pd, r0, seg_lo, seg_hi, c);
    else if (gi == 2) pool_prep_col<4>(Up, pd, r0, seg_lo, seg_hi, c);
    else pool_prep_col<8>(Up, pd, r0, seg_lo, seg_hi, c);
  }
}
__device__ __forceinline__ void ph_router(const MP& p, int layer, int nrows, char* lds) {
  float* hs = (float*)lds;
  float* part = (float*)(lds + 66048);
  float* lgs = (float*)(lds + 66048 + 24576);
  const float* lat = p.out; const float* ctxr = (const float*)(p.ws + WS_XC); const float* gain = p.in[7] + layer * 1024;
  const float* modl = (const float*)(p.ws + WS_MODS) + layer * 3 * 6144;
  const float* wrg = p.in[21] + layer * 1024 * 4; const float* brg = p.in[22] + layer * 4; const float* wre = p.in[23] + layer * 1024 * 32; const float* bre = p.in[24] + layer * 32;
  bf16_t* out = (bf16_t*)(p.ws + WS_H); float* rw = (float*)(p.ws + WS_ROUTE_W);
  int* cnt = (int*)(p.ws + WS_CTL + CNT_OFF) + layer * 32; int* list = (int*)(p.ws + WS_LIST);
  const int tid = tidx(), lane = tid & 63, w = tid >> 6, l15 = lane & 15, lq = lane >> 4;
  float Bq[8][4][3];
#pragma unroll
  for (int g = 0; g < 8; ++g)
#pragma unroll
    for (int u = 0; u < 4; ++u)
#pragma unroll
      for (int nt = 0; nt < 3; ++nt) { const int kk = w * 128 + 16 * g + 4 * lq + u, col = nt * 16 + l15;
        Bq[g][u][nt] = col < 4 ? wrg[kk * 4 + col] : (col < 36 ? wre[kk * 32 + (col - 4)] : 0.f); }
  const int ntiles = nrows >> 4;
  int* lcnt = (int*)(lds + 66048 + 24576 + 2304);
  int* lbase = lcnt + 32;
  int* pend = lbase + 32;
  int nloc = 0;
  if (tid < 32) lcnt[tid] = 0;
  f32x4 xa[2][4];
#define RT_LOAD(tile_) do { _Pragma("unroll") for (int rr = 0; rr < 2; ++rr) { const int row_ = (tile_) * 16 + 2 * w + rr; \
      const float* src_ = row_ < NLAT ? lat + (size_t)row_ * D : ctxr + (size_t)(row_ - NLAT) * D; \
      _Pragma("unroll") for (int j = 0; j < 4; ++j) xa[rr][j] = ((const f32x4*)src_)[lane + 64 * j]; } } while (0)
  if ((int)blockIdx.x < ntiles) RT_LOAD((int)blockIdx.x);
  for (int tile = blockIdx.x; tile < ntiles; tile += gridDim.x) {
#pragma unroll
    for (int rr = 0; rr < 2; ++rr) {
      const int lr = 2 * w + rr, row = tile * 16 + lr;
      const float* mv = modl + row_vec(row) * 6144;
      float ss = 0.f;
#pragma unroll
      for (int j = 0; j < 4; ++j) { const f32x4 x = xa[rr][j]; ss += x.x * x.x + x.y * x.y + x.z * x.z + x.w * x.w; }
      const float rstd = 1.f / sqrtf(wave_sum(ss) * (1.f / D) + EPS);
#pragma unroll
      for (int j = 0; j < 4; ++j) {
        const int n = (lane + 64 * j) * 4;
        const f32x4 g = *(const f32x4*)(gain + n), sc = *(const f32x4*)(mv + 4096 + n), sh = *(const f32x4*)(mv + 3072 + n);
        const f32x4 h = xa[rr][j] * rstd * g * (sc + 1.f) + sh;
        uint2 o; o.x = pack2(h.x, h.y); o.y = pack2(h.z, h.w);
        *(uint2*)(out + (size_t)row * D + n) = o;
        *(f32x4*)&hs[lr * 1032 + n] = h;
      }
    }
    __syncthreads();
    if (tile + (int)gridDim.x < ntiles) RT_LOAD(tile + (int)gridDim.x);
    f32x4 acc[3];
#pragma unroll
    for (int nt = 0; nt < 3; ++nt) acc[nt] = (f32x4){0.f, 0.f, 0.f, 0.f};
#pragma unroll
    for (int g = 0; g < 8; ++g) {
      const f32x4 a4 = *(const f32x4*)&hs[l15 * 1032 + w * 128 + 16 * g + 4 * lq];
      const float av[4] = {a4.x, a4.y, a4.z, a4.w};
#pragma unroll
      for (int u = 0; u < 4; ++u)
#pragma unroll
        for (int nt = 0; nt < 3; ++nt) acc[nt] = __builtin_amdgcn_mfma_f32_16x16x4f32(av[u], Bq[g][u][nt], acc[nt], 0, 0, 0);
    }
#pragma unroll
    for (int nt = 0; nt < 3; ++nt) { const float av[4] = {acc[nt].x, acc[nt].y, acc[nt].z, acc[nt].w};
#pragma unroll
      for (int r = 0; r < 4; ++r) part[(w * 16 + lq * 4 + r) * 48 + nt * 16 + l15] = av[r]; }
    __syncthreads();
    for (int i = tid; i < 16 * 36; i += 512) { const int row = i / 36, col = i - row * 36; float sacc = col < 4 ? brg[col] : bre[col - 4];
#pragma unroll
      for (int ww = 0; ww < 8; ++ww) sacc += part[(ww * 16 + row) * 48 + col];
      lgs[i] = sacc; }
    __syncthreads();
    if (tid < 32) {
      const int lr = tid >> 1, slot = tid & 1, row = tile * 16 + lr; const float* lg = lgs + lr * 36;
      int gi = 0; float gm = lg[0];
#pragma unroll
      for (int i = 1; i < 4; ++i) if (lg[i] > gm) { gm = lg[i]; gi = i; }
      float gs = 0.f;
#pragma unroll
      for (int i = 0; i < 4; ++i) gs += __expf(lg[i] - gm);
      const float gp = 1.f / gs;
      const float* el = lg + 4 + gi * 8;
      int e1 = 0; float m1 = el[0];
#pragma unroll
      for (int i = 1; i < 8; ++i) if (el[i] > m1) { m1 = el[i]; e1 = i; }
      int e2 = 0; float m2 = -3.0e38f;
#pragma unroll
      for (int i = 0; i < 8; ++i) if (i != e1 && el[i] > m2) { m2 = el[i]; e2 = i; }
      const float w1 = 1.f / (1.f + __expf(m2 - m1));
      const int ee = gi * 8 + (slot ? e2 : e1);
      rw[row * 2 + slot] = gp * (slot ? 1.f - w1 : w1);
      const int rk = atomicAdd(&lcnt[ee], 1);
      pend[nloc * 32 + tid] = (ee << 24) | (rk << 16) | (row & 0xFFFF) | 0;
    }
    ++nloc;
  }
  __syncthreads();
  if (tid < 32) lbase[tid] = lcnt[tid] ? atomicAdd(&cnt[tid], lcnt[tid]) : 0;
  __syncthreads();
  for (int i = tid; i < nloc * 32; i += 512) { const int v = pend[i], ee = (v >> 24) & 31, rk = (v >> 16) & 255, row = v & 0xFFFF;
    list[(size_t)ee * MROWS + lbase[ee] + rk] = row * 2 + (i & 1); }
  __syncthreads();
#undef RT_LOAD
}
__device__ __forceinline__ void moe_tables(const MP& p, int layer, int ntn_big, int ntn_small, int* tb) {
  const int* cnt = (const int*)(p.ws + WS_CTL + CNT_OFF) + layer * 32;
  __syncthreads();
  if (tidx() == 0) { int off = 0, tsb = 0, tss = 0;
    for (int e = 0; e < 32; ++e) { const int c = __hip_atomic_load(&cnt[e], __ATOMIC_RELAXED, __HIP_MEMORY_SCOPE_AGENT); tb[e] = c; tb[32 + e] = off; tb[64 + e] = tsb; tb[97 + e] = tss;
      off += c; tsb += (c >> 8) * ntn_big; tss += (((c & 255) + 63) >> 6) * ntn_small; }
    tb[96] = tsb; tb[129] = tss; }
  __syncthreads();
}
struct GUnit { unsigned a, b; int m0, n0, mvalid, e; };
struct MoeSched {
  const PG8_LAS int* tb; const char* wsb; unsigned Abase, Bbase, b_estride; int ntn, G, c, K, gather;
  __device__ __forceinline__ bool next(int i, GUnit& u) const {
    const int L = i * G + c; if (L >= tb[96]) return false;
    int e = 0;
#pragma unroll 1
    for (int q = 1; q < 32; ++q) if (tb[64 + q] <= L) e = q;
    const int lt = L - tb[64 + e], mt = lt / ntn, nt = lt - mt * ntn;
    u.e = e; u.m0 = mt * 256; u.n0 = nt * 256; u.mvalid = tb[e];
    u.b = Bbase + (unsigned)e * b_estride + (unsigned)(nt * 256 * K * 2);
    u.a = gather ? Abase : Abase + (unsigned)((tb[32 + e] + mt * 256) * K * 2);
    return true;
  }
  __device__ __forceinline__ void done(const GUnit&) const {}
  __device__ __forceinline__ void a_offsets(const GUnit& u, int tid, unsigned (&ao)[2][2]) const {
    const int* list = (const int*)(wsb + WS_LIST) + (size_t)u.e * MROWS;
#pragma unroll
    for (int i = 0; i < 2; ++i) { int R, C; stage_rc(tid * 16 + i * 8192, R, C);
#pragma unroll
      for (int h = 0; h < 2; ++h) {
        if (gather) { int r = u.m0 + h * 128 + R; r = r < u.mvalid ? r : u.mvalid - 1; const int tok = list[r] >> 1; ao[h][i] = (unsigned)(tok * K + C) * 2u; }
        else ao[h][i] = (unsigned)((h * 128 + R) * K + C) * 2u;
      } }
  }
};
template <class Epi, class Sched>
__device__ __forceinline__ void pg8g_phase(PG8_LAS unsigned char* lds, const char* wsb, const int K, const Sched& S, const Epi& E) {
    const int tid = tidx(), wid = __builtin_amdgcn_readfirstlane(tid >> 6), lane = tid & 63, wr = wid >> 2, wc = wid & 3, fr = lane & 15, fq = lane >> 4;
    const int nt = K / BK;
    unsigned voffB[2];
#pragma unroll
    for (int i = 0; i < 2; ++i) { int R, C; stage_rc(tid * 16 + i * 8192, R, C); const int Rb = Epi::PERM ? ((R & ~31) + perm32(R & 31)) : R;
        voffB[i] = (unsigned)(Rb * K + C) * 2u; }
    const unsigned kstep = (unsigned)(BK * 2);
    const unsigned hstep = (unsigned)(HALF * K * 2);
    const unsigned ldsw = (unsigned)wid * 1024u;
    const int aoff = lds_byte(wr * 64 + fr, fq * 8), boff = lds_byte(wc * 32 + fr, fq * 8);
#define PG8_SA(b, h) (((b) * 2 + (h)) * HTB)
#define PG8_SB(b, h) ((4 + (b) * 2 + (h)) * HTB)
#define PG8_STAGE(bufoff, gbase, voff) do { _Pragma("unroll") for (int _i = 0; _i < 2; ++_i) \
        __builtin_amdgcn_global_load_lds((const unsigned*)(wsb + (size_t)(gbase) + (voff)[_i]), (PG8_LAS unsigned*)(lds + (bufoff) + ldsw + _i * 8192), 16, 0, 0); } while (0)
#define PG8_STAGE_A(bufoff, gbase, o0, o1) do { \
        __builtin_amdgcn_global_load_lds((const unsigned*)(wsb + (size_t)(gbase) + (o0)), (PG8_LAS unsigned*)(lds + (bufoff) + ldsw), 16, 0, 0); \
        __builtin_amdgcn_global_load_lds((const unsigned*)(wsb + (size_t)(gbase) + (o1)), (PG8_LAS unsigned*)(lds + (bufoff) + ldsw + 8192), 16, 0, 0); } while (0)
#define PG8_LDA(dst, b, h) do { _Pragma("unroll") for (int m = 0; m < 4; ++m) _Pragma("unroll") for (int k = 0; k < 2; ++k) dst[m][k] = *(const PG8_LAS bf16x8*)(lds + PG8_SA(b, h) + aoff + m * 2048 + k * 1024); } while (0)
#define PG8_LDB(dst, b, h) do { _Pragma("unroll") for (int n = 0; n < 2; ++n) _Pragma("unroll") for (int k = 0; k < 2; ++k) dst[n][k] = *(const PG8_LAS bf16x8*)(lds + PG8_SB(b, h) + boff + n * 2048 + k * 1024); } while (0)
#define PG8_MMA(ai, bj, At, Bt) do { __builtin_amdgcn_s_setprio(1); _Pragma("unroll") for (int m = 0; m < 4; ++m) _Pragma("unroll") for (int n = 0; n < 2; ++n) _Pragma("unroll") for (int k = 0; k < 2; ++k) \
        acc[ai][bj][m][n] = __builtin_amdgcn_mfma_f32_16x16x32_bf16(Bt[n][k], At[m][k], acc[ai][bj][m][n], 0, 0, 0); __builtin_amdgcn_s_setprio(0); } while (0)
#define PG8_WAIT_V(n) asm volatile("s_waitcnt vmcnt(" #n ")" ::: "memory")
#define PG8_WAIT_L(n) asm volatile("s_waitcnt lgkmcnt(" #n ")" ::: "memory")
#define PG8_BAR __builtin_amdgcn_s_barrier()
#define PG8_SCHED __builtin_amdgcn_sched_barrier(0)
    GUnit cur, nxt; int ui = 0;
    if (!S.next(0, cur)) return;
    f32x4 acc[2][2][4][2];
#pragma unroll
    for (int a = 0; a < 2; ++a)
#pragma unroll
        for (int b = 0; b < 2; ++b)
#pragma unroll
            for (int m = 0; m < 4; ++m)
#pragma unroll
                for (int n = 0; n < 2; ++n) acc[a][b][m][n] = (f32x4){0.f, 0.f, 0.f, 0.f};
    bf16x8 At[4][2], B0[2][2], B1[2][2];
    unsigned cA = cur.a, cB = cur.b;
    unsigned aoc[2][2];
    S.a_offsets(cur, tid, aoc);
    PG8_STAGE(PG8_SB(0, 0), cB, voffB); PG8_STAGE_A(PG8_SA(0, 0), cA, aoc[0][0], aoc[0][1]); PG8_STAGE(PG8_SB(0, 1), cB + hstep, voffB); PG8_STAGE_A(PG8_SA(0, 1), cA, aoc[1][0], aoc[1][1]);
    if (wr == 1) PG8_BAR;
    PG8_WAIT_V(4); PG8_BAR;
    PG8_STAGE(PG8_SB(1, 0), cB + kstep, voffB); PG8_STAGE_A(PG8_SA(1, 0), cA + kstep, aoc[0][0], aoc[0][1]); PG8_STAGE(PG8_SB(1, 1), cB + hstep + kstep, voffB);
    PG8_WAIT_V(6); PG8_BAR;
    for (;;) {
        const bool has_next = S.next(ui + 1, nxt);
        const unsigned nA = has_next ? nxt.a : cA, nB = has_next ? nxt.b : cB;
        for (int t = 0; t < nt; t += 2) {
            const bool last = (t == nt - 2);
            const unsigned a1 = cA + (unsigned)(t + 1) * kstep;
            const unsigned a2 = last ? nA : cA + (unsigned)(t + 2) * kstep, b2 = last ? nB : cB + (unsigned)(t + 2) * kstep;
            const unsigned a3 = a2 + kstep, b3 = b2 + kstep;
            if (last && has_next) {
              PG8_STAGE_A(PG8_SA(1, 1), a1, aoc[1][0], aoc[1][1]); S.a_offsets(nxt, tidx(), aoc); PG8_SCHED;
              PG8_LDB(B0, 0, 0); PG8_SCHED; PG8_LDA(At, 0, 0);
            } else { PG8_LDB(B0, 0, 0); PG8_SCHED; PG8_LDA(At, 0, 0); PG8_STAGE_A(PG8_SA(1, 1), a1, aoc[1][0], aoc[1][1]); }
            PG8_WAIT_L(8); PG8_BAR; PG8_WAIT_L(0); PG8_MMA(0, 0, At, B0); PG8_BAR; PG8_SCHED;
            PG8_LDB(B1, 0, 1); PG8_STAGE(PG8_SB(0, 0), b2, voffB);
            PG8_BAR; PG8_WAIT_L(0); PG8_MMA(0, 1, At, B1); PG8_BAR;
            PG8_LDA(At, 0, 1); PG8_STAGE_A(PG8_SA(0, 0), a2, aoc[0][0], aoc[0][1]);
            PG8_BAR; PG8_WAIT_L(0); PG8_MMA(1, 0, At, B0); PG8_BAR; PG8_SCHED;
            PG8_STAGE(PG8_SB(0, 1), b2 + hstep, voffB);
            PG8_WAIT_V(6); PG8_BAR; PG8_MMA(1, 1, At, B1); PG8_BAR;
            PG8_LDB(B0, 1, 0); PG8_SCHED; PG8_LDA(At, 1, 0); PG8_STAGE_A(PG8_SA(0, 1), a2, aoc[1][0], aoc[1][1]);
            PG8_WAIT_L(8); PG8_BAR; PG8_WAIT_L(0); PG8_MMA(0, 0, At, B0); PG8_BAR; PG8_SCHED;
            PG8_LDB(B1, 1, 1); PG8_STAGE(PG8_SB(1, 0), b3, voffB);
            PG8_BAR; PG8_WAIT_L(0); PG8_MMA(0, 1, At, B1); PG8_BAR;
            PG8_LDA(At, 1, 1); PG8_STAGE_A(PG8_SA(1, 0), a3, aoc[0][0], aoc[0][1]);
            PG8_BAR; PG8_WAIT_L(0); PG8_MMA(1, 0, At, B0); PG8_BAR; PG8_SCHED;
            PG8_STAGE(PG8_SB(1, 1), b3 + hstep, voffB);
            PG8_WAIT_V(6); PG8_BAR; PG8_MMA(1, 1, At, B1); PG8_BAR;
        }
        if constexpr (!Epi::AFTER_DRAIN) { const int l2 = tidx() & 63; E(acc, cur, wr, wc, l2 & 15, l2 >> 4); S.done(cur); }
        if (!has_next) break;
#pragma unroll
        for (int a = 0; a < 2; ++a)
#pragma unroll
            for (int b = 0; b < 2; ++b)
#pragma unroll
                for (int m = 0; m < 4; ++m)
#pragma unroll
                    for (int n = 0; n < 2; ++n) acc[a][b][m][n] = (f32x4){0.f, 0.f, 0.f, 0.f};
        cur = nxt; cA = nA; cB = nB; ++ui;
    }
    PG8_WAIT_V(0);
    if (wr == 0) PG8_BAR;
    PG8_BAR;
    if constexpr (Epi::AFTER_DRAIN) { E.fused(acc, cur, wr, wc, fr, fq, lds, wid, lane); S.done(cur); }
#undef PG8_SA
#undef PG8_SB
#undef PG8_STAGE
#undef PG8_STAGE_A
#undef PG8_LDA
#undef PG8_LDB
#undef PG8_MMA
#undef PG8_WAIT_V
#undef PG8_WAIT_L
#undef PG8_BAR
#undef PG8_SCHED

#undef PG8_MMA
#undef PG8_WAIT_V
#undef PG8_WAIT_L
#undef PG8_BAR
#undef PG8_SCHED
}

struct EpiMoe1G {
  static constexpr bool PERM = false, AFTER_DRAIN = false;
  char* wsb; const PG8_LAS int* tb;
  __device__ __forceinline__ void operator()(const f32x4 (&acc)[2][2][4][2], const GUnit& u, int wr, int wc, int fr, int fq) const {
    const int* list = (const int*)(wsb + WS_LIST) + (size_t)u.e * MROWS; const int off_e = tb[32 + u.e]; const float* rw = (const float*)(wsb + WS_ROUTE_W); bf16_t* amoe = (bf16_t*)(wsb + WS_AMOE);
    const int rbase = u.m0 + wr * 64 + fr;
    int ent[2][4]; float wg[2][4];
#pragma unroll
    for (int ai = 0; ai < 2; ++ai)
#pragma unroll
      for (int m = 0; m < 4; ++m) { int r = rbase + ai * HALF + m * 16; r = r < u.mvalid ? r : u.mvalid - 1; ent[ai][m] = list[r]; }
#pragma unroll
    for (int ai = 0; ai < 2; ++ai)
#pragma unroll
      for (int m = 0; m < 4; ++m) wg[ai][m] = rw[ent[ai][m]];
#pragma unroll
    for (int ai = 0; ai < 2; ++ai)
#pragma unroll
      for (int m = 0; m < 4; ++m) { const int r = rbase + ai * HALF + m * 16;
        if (r < u.mvalid) { const float wgt = wg[ai][m];
#pragma unroll
          for (int bj = 0; bj < 2; ++bj) { const f32x4 g = acc[ai][bj][m][0], uu = acc[ai][bj][m][1];
            const int hidden = ((u.n0 + bj * HALF + wc * 32) >> 1) + fq * 4;
            uint2 wv; wv.x = pack2(siluf_(g.x) * uu.x * wgt, siluf_(g.y) * uu.y * wgt); wv.y = pack2(siluf_(g.z) * uu.z * wgt, siluf_(g.w) * uu.w * wgt);
            *(uint2*)(amoe + (size_t)(off_e + r) * 256 + hidden) = wv; } } }
  }
};
struct EpiMoe2G {
  static constexpr bool PERM = false, AFTER_DRAIN = false;
  char* wsb;
  __device__ __forceinline__ void operator()(const f32x4 (&acc)[2][2][4][2], const GUnit& u, int wr, int wc, int fr, int fq) const {
    const int* list = (const int*)(wsb + WS_LIST) + (size_t)u.e * MROWS; bf16_t* Y = (bf16_t*)(wsb + WS_YBUF);
    const int rbase = u.m0 + wr * 64 + fr;
    int ent[2][4];
#pragma unroll
    for (int ai = 0; ai < 2; ++ai)
#pragma unroll
      for (int m = 0; m < 4; ++m) { int r = rbase + ai * HALF + m * 16; r = r < u.mvalid ? r : u.mvalid - 1; ent[ai][m] = list[r]; }
#pragma unroll
    for (int ai = 0; ai < 2; ++ai)
#pragma unroll
      for (int m = 0; m < 4; ++m) { const int r = rbase + ai * HALF + m * 16;
        if (r < u.mvalid) { bf16_t* yp = Y + (size_t)ent[ai][m] * D + u.n0 + wc * 32 + fq * 4;
#pragma unroll
          for (int bj = 0; bj < 2; ++bj)
#pragma unroll
            for (int n = 0; n < 2; ++n) { const f32x4 v = acc[ai][bj][m][n]; uint2 wv; wv.x = pack2(v.x, v.y); wv.y = pack2(v.z, v.w); *(uint2*)(yp + bj * HALF + n * 16) = wv; } } }
  }
};
struct EpiMoe1S {
  bf16_t* amoe; const int* list; const float* rw; int off_e;
  template <int MI> __device__ __forceinline__ void tile(const f32x4 (&acc)[MI][4], int mb, int nb, int Mvalid) const {
    const int lq4 = nb & 15, cb = nb - lq4;
#pragma unroll
    for (int i = 0; i < MI; ++i) { const int m = mb + i * 16; if (m < Mvalid) { const float wgt = rw[list[m]];
#pragma unroll
      for (int pr = 0; pr < 2; ++pr) { const f32x4 g = acc[i][2 * pr], u = acc[i][2 * pr + 1];
        uint2 wv; wv.x = pack2(siluf_(g.x) * u.x * wgt, siluf_(g.y) * u.y * wgt); wv.y = pack2(siluf_(g.z) * u.z * wgt, siluf_(g.w) * u.w * wgt);
        *(uint2*)(amoe + (size_t)(off_e + m) * 256 + ((cb + pr * 32) >> 1) + lq4) = wv; } } }
  }
};
__device__ __forceinline__ int moe_small_expert(const int* tb, int tile) { int e = 0;
#pragma unroll 1
  for (int q = 1; q < 32; ++q) if (tb[97 + q] <= tile) e = q;
  return e; }
__device__ __forceinline__ void ph_moe1g(const MP& p, int layer, char* lds) {
  int* tb = (int*)(lds + 131072);
  moe_tables(p, layer, 2, 4, tb);
  { MoeSched S; S.tb = (const PG8_LAS int*)tb; S.wsb = p.ws; S.Abase = (unsigned)WS_H; S.Bbase = (unsigned)WS_WMOE; S.b_estride = 512u * 1024u * 2u;
    S.ntn = 2; S.G = (int)gridDim.x; S.c = (int)blockIdx.x; S.K = 1024; S.gather = 1;
    EpiMoe1G E; E.wsb = p.ws; E.tb = S.tb;
    pg8g_phase((PG8_LAS unsigned char*)lds, p.ws, 1024, S, E); }
  __syncthreads();
  for (int tile = (int)gridDim.x - 1 - (int)blockIdx.x; tile < tb[129]; tile += gridDim.x) {
    const int e = moe_small_expert(tb, tile), lt = tile - tb[97 + e], mt = lt >> 2, nt = lt & 3;
    EpiMoe1S ep; ep.amoe = (bf16_t*)(p.ws + WS_AMOE); ep.list = (const int*)(p.ws + WS_LIST) + (size_t)e * MROWS; ep.rw = (const float*)(p.ws + WS_ROUTE_W); ep.off_e = tb[32 + e];
    gemm_tile<1>((const bf16_t*)(p.ws + WS_H), D, ep.list, 1, tb[e], (const bf16_t*)(p.ws + WS_WMOE) + (size_t)e * 512 * 1024, 1024, 1024, (tb[e] & ~255) + mt * 64, nt * 128, lds, ep);
  }
}
__device__ __forceinline__ void ph_moe2g(const MP& p, int layer, char* lds) {
  int* tb = (int*)(lds + 131072);
  moe_tables(p, layer, 4, 8, tb);
  { MoeSched S; S.tb = (const PG8_LAS int*)tb; S.wsb = p.ws; S.Abase = (unsigned)WS_AMOE; S.Bbase = (unsigned)(WS_WMOE + (size_t)32 * 512 * 1024 * 2); S.b_estride = 1024u * 256u * 2u;
    S.ntn = 4; S.G = (int)gridDim.x; S.c = (int)blockIdx.x; S.K = 256; S.gather = 0;
    EpiMoe2G E; E.wsb = p.ws;
    pg8g_phase((PG8_LAS unsigned char*)lds, p.ws, 256, S, E); }
  __syncthreads();
  const bf16_t* wd = (const bf16_t*)(p.ws + WS_WMOE) + (size_t)32 * 512 * 1024;
  for (int tile = (int)gridDim.x - 1 - (int)blockIdx.x; tile < tb[129]; tile += gridDim.x) {
    const int e = moe_small_expert(tb, tile), lt = tile - tb[97 + e], mt = lt >> 3, nt = lt & 7;
    EpiEach<EpiMoe2> ep; ep.e.Y = (bf16_t*)(p.ws + WS_YBUF); ep.e.list = (const int*)(p.ws + WS_LIST) + (size_t)e * MROWS; ep.e.m_base = 0;
    gemm_tile<1>((const bf16_t*)(p.ws + WS_AMOE) + (size_t)tb[32 + e] * 256, 256, nullptr, 0, tb[e], wd + (size_t)e * 1024 * 256, 256, 256, (tb[e] & ~255) + mt * 64, nt * 128, lds, ep);
  }
}
__device__ __forceinline__ void ph_combine(const MP& p, int layer, int nrows, int final_) {
  float* lat = p.out; float* ctxr = (float*)(p.ws + WS_XC); const bf16_t* Y = (const bf16_t*)(p.ws + WS_YBUF);
  const float* modl_cur = (const float*)(p.ws + WS_MODS) + layer * 3 * 6144; const float* modl_next = (const float*)(p.ws + WS_MODS) + 3 * 6144;
  const float* gain = final_ ? p.in[28] : p.in[6] + 1024; bf16_t* hout = (bf16_t*)(p.ws + WS_H);
  const int lane = tidx() & 63, gw = blockIdx.x * 8 + (tidx() >> 6);
  for (int row = gw; row < nrows; row += gridDim.x * 8) {
    float* src = row < NLAT ? lat + (size_t)row * D : ctxr + (size_t)(row - NLAT) * D;
    const int v = row_vec(row);
    f32x4 x[4]; float ss = 0.f;
#pragma unroll
    for (int j = 0; j < 4; ++j) {
      const int n = (lane + 64 * j) * 4;
      const f32x4 g2 = *(const f32x4*)(modl_cur + v * 6144 + 5120 + n);
      const uint2 y0 = *(const uint2*)(Y + ((size_t)row * 2) * D + n), y1 = *(const uint2*)(Y + ((size_t)row * 2 + 1) * D + n);
      f32x4 ys;
      ys.x = __uint_as_float(y0.x << 16) + __uint_as_float(y1.x << 16); ys.y = __uint_as_float(y0.x & 0xFFFF0000u) + __uint_as_float(y1.x & 0xFFFF0000u);
      ys.z = __uint_as_float(y0.y << 16) + __uint_as_float(y1.y << 16); ys.w = __uint_as_float(y0.y & 0xFFFF0000u) + __uint_as_float(y1.y & 0xFFFF0000u);
      x[j] = ((const f32x4*)src)[lane + 64 * j] + g2 * ys;
      ss += x[j].x * x[j].x + x[j].y * x[j].y + x[j].z * x[j].z + x[j].w * x[j].w;
    }
    const float rstd = 1.f / sqrtf(wave_sum(ss) * (1.f / D) + EPS);
#pragma unroll
    for (int j = 0; j < 4; ++j) {
      const int n = (lane + 64 * j) * 4;
      const f32x4 g = *(const f32x4*)(gain + n);
      if (final_) { ((f32x4*)src)[lane + 64 * j] = x[j] * rstd * g; }
      else {
        ((f32x4*)src)[lane + 64 * j] = x[j];
        const f32x4 sc = *(const f32x4*)(modl_next + v * 6144 + 1024 + n), sh = *(const f32x4*)(modl_next + v * 6144 + n);
        const f32x4 h = x[j] * rstd * g * (sc + 1.f) + sh;
        uint2 o; o.x = pack2(h.x, h.y); o.y = pack2(h.z, h.w);
        *(uint2*)(hout + (size_t)row * D + n) = o;
      }
    }
  }
}
__device__ __forceinline__ void ph_kr_rope(const float* kr, bf16_t* dk) {
  for (int idx = blockIdx.x * 512 + tidx(); idx < MROWS * 32; idx += gridDim.x * 512) {
    const int m = idx >> 5, j = idx & 31; int b, key; row_bkey(m, b, key);
    float val = kr[idx];
    if (m < NLAT) {
      const int t = m & 8191; const int half = j >> 4, jj = j & 15, i = jj & 7;
      const float pos = half ? (float)(t & 63) : (float)(t >> 6);
      float sn, cs; sincosf(pos * rope_inv(i), &sn, &cs);
      const float x1 = kr[(size_t)m * 32 + half * 16 + i], x2 = kr[(size_t)m * 32 + half * 16 + 8 + i];
      val = (jj < 8) ? (x1 * cs - x2 * sn) : (x1 * sn + x2 * cs);
    }
    const bf16_t o = f2bf(val);
#pragma unroll
    for (int hh = 0; hh < 8; ++hh) dk[((size_t)(b * 8 + hh) * NKEY + key) * 128 + 64 + j] = o;
  }
}

#define MFMA32(a, b, c) __builtin_amdgcn_mfma_f32_32x32x16_bf16(a, b, c, 0, 0, 0)
#define KSWZ(row, colB) ((row) * 256 + ((colB) ^ (((row) & 7) << 4)))
#define SBAR() __builtin_amdgcn_sched_barrier(0)
__device__ __forceinline__ int crow(int r, int hi) { return (r & 3) + 8 * (r >> 2) + 4 * hi; }
__device__ __forceinline__ unsigned cvtpk(float lo, float hi) { unsigned r; asm volatile("v_cvt_pk_bf16_f32 %0, %1, %2" : "=v"(r) : "v"(lo), "v"(hi)); return r; }

__device__ __forceinline__ void att_partialSM(f32x16& p0, f32x16& p1, float& m_reg, float& mn, float& alpha) {
  float pmax = p0[0];
#pragma unroll
  for (int r = 1; r < 16; ++r) pmax = fmaxf(pmax, p0[r]);
#pragma unroll
  for (int r = 0; r < 16; ++r) pmax = fmaxf(pmax, p1[r]);
  { auto rr = __builtin_amdgcn_permlane32_swap(__float_as_uint(pmax), __float_as_uint(pmax), false, false);
    pmax = fmaxf(__uint_as_float(rr[0]), __uint_as_float(rr[1])); }
  if (__builtin_expect(__all(pmax - m_reg <= ATT_THR), 1)) { mn = m_reg; alpha = 1.f; }
  else { mn = fmaxf(m_reg, pmax); alpha = __builtin_amdgcn_exp2f(m_reg - mn); m_reg = mn; }
#pragma unroll
  for (int r = 0; r < 16; ++r) p0[r] = __builtin_amdgcn_exp2f(p0[r] - mn);
#pragma unroll
  for (int r = 0; r < 16; ++r) p1[r] = p1[r] - mn;
}
__device__ __forceinline__ void att_partialSM_rel(f32x16& p0, f32x16& p1, float& m_reg, float& alpha) {
  float pmax = p0[0];
#pragma unroll
  for (int r = 1; r < 16; ++r) pmax = fmaxf(pmax, p0[r]);
#pragma unroll
  for (int r = 0; r < 16; ++r) pmax = fmaxf(pmax, p1[r]);
  { auto rr = __builtin_amdgcn_permlane32_swap(__float_as_uint(pmax), __float_as_uint(pmax), false, false);
    pmax = fmaxf(__uint_as_float(rr[0]), __uint_as_float(rr[1])); }
  if (__builtin_expect(__all(pmax <= ATT_THR), 1)) { alpha = 1.f;
#pragma unroll
    for (int r = 0; r < 16; ++r) p0[r] = __builtin_amdgcn_exp2f(p0[r]);
  } else { const float d = fmaxf(pmax, 0.f); alpha = __builtin_amdgcn_exp2f(-d); m_reg += d;
#pragma unroll
    for (int r = 0; r < 16; ++r) p0[r] = __builtin_amdgcn_exp2f(p0[r] - d);
#pragma unroll
    for (int r = 0; r < 16; ++r) p1[r] = p1[r] - d; }
}
__device__ __forceinline__ void att_finishSM(f32x16& p0, f32x16& p1, float alpha, float& l_reg, bf16x8& pa0, bf16x8& pa1, bf16x8& pa2, bf16x8& pa3) {
#pragma unroll
  for (int r = 0; r < 16; ++r) p1[r] = __builtin_amdgcn_exp2f(p1[r]);
  float ps = 0.f;
#pragma unroll
  for (int r = 0; r < 16; ++r) ps += p0[r];
#pragma unroll
  for (int r = 0; r < 16; ++r) ps += p1[r];
  { auto rr = __builtin_amdgcn_permlane32_swap(__float_as_uint(ps), __float_as_uint(ps), false, false);
    ps = __uint_as_float(rr[0]) + __uint_as_float(rr[1]); }
  l_reg = l_reg * alpha + ps;
#define PK4(P, BASE, OUT) do { unsigned a0 = cvtpk(P[BASE + 0], P[BASE + 1]), a1 = cvtpk(P[BASE + 2], P[BASE + 3]);   \
    unsigned b0 = cvtpk(P[BASE + 4], P[BASE + 5]), b1 = cvtpk(P[BASE + 6], P[BASE + 7]);                              \
    auto r0 = __builtin_amdgcn_permlane32_swap(a0, b0, false, false); auto r1 = __builtin_amdgcn_permlane32_swap(a1, b1, false, false); \
    u32x4 w = {r0[0], r1[0], r0[1], r1[1]}; OUT = *reinterpret_cast<bf16x8*>(&w); } while (0)
  PK4(p0, 0, pa0); PK4(p0, 8, pa1); PK4(p1, 0, pa2); PK4(p1, 8, pa3);
}
template <int ND0>
__device__ __forceinline__ void att_qkt(f32x16& p0, f32x16& p1, const char* Ks, const bf16x8* qr, int r32, int hi, float init = 0.f) {
#pragma unroll
  for (int r = 0; r < 16; ++r) { p0[r] = init; p1[r] = init; }
#pragma unroll
  for (int d0 = 0; d0 < ND0; ++d0) { const int cb = (d0 * 16 + hi * 8) * 2;
    const bf16x8 b0 = *reinterpret_cast<const bf16x8*>(Ks + KSWZ(r32, cb));
    const bf16x8 b1 = *reinterpret_cast<const bf16x8*>(Ks + KSWZ(32 + r32, cb));
    p0 = MFMA32(b0, qr[d0], p0);
    p1 = MFMA32(b1, qr[d0], p1); }
}
__device__ __forceinline__ int v_st64(int k, int c) { const int kk = (k & ~0xC) | ((k & 4) << 1) | ((k & 8) >> 1); return ((kk >> 3) * 2 + (c >> 5)) * 512 + ((kk & 7) * 32 + (c & 31)) * 2; }
__device__ __forceinline__ int v_rd_base(int lane) { return ((lane & 3) << 3) | (((lane >> 2) & 3) << 6) | (((lane >> 4) & 1) << 5) | (((lane >> 5) & 1) << 8); }
static constexpr int v_rd_off64(int d0, int ks, int half) { return d0 * 512 + ks * 2048 + half * 1024; }
template <int OFF> __device__ __forceinline__ s16x4 tr_read(int vb) {
  s16x4 r; asm volatile("ds_read_b64_tr_b16 %0, %1 offset:%2" : "=&v"(r) : "v"(vb), "i"(OFF) : "memory"); return r;
}
template <int D0> __device__ __forceinline__ void pv_one64(f32x16& od, int vb, bf16x8 pa0, bf16x8 pa1, bf16x8 pa2, bf16x8 pa3) {
  const s16x4 l0 = tr_read<v_rd_off64(D0, 0, 0)>(vb), h0 = tr_read<v_rd_off64(D0, 0, 1)>(vb), l1 = tr_read<v_rd_off64(D0, 1, 0)>(vb), h1 = tr_read<v_rd_off64(D0, 1, 1)>(vb);
  const s16x4 l2 = tr_read<v_rd_off64(D0, 2, 0)>(vb), h2 = tr_read<v_rd_off64(D0, 2, 1)>(vb), l3 = tr_read<v_rd_off64(D0, 3, 0)>(vb), h3 = tr_read<v_rd_off64(D0, 3, 1)>(vb);
  asm volatile("s_waitcnt lgkmcnt(0)" ::: "memory"); SBAR();
#define PKV(L, H) (bf16x8){L[0], L[1], L[2], L[3], H[0], H[1], H[2], H[3]}
  od = MFMA32(pa0, PKV(l0, h0), od);
  od = MFMA32(pa1, PKV(l1, h1), od);
  od = MFMA32(pa2, PKV(l2, h2), od);
  od = MFMA32(pa3, PKV(l3, h3), od);
}

__device__ __forceinline__ void mla_block(const bf16_t* __restrict__ Qb, const bf16_t* __restrict__ Kh, const bf16_t* __restrict__ Vh, bf16_t* __restrict__ Ob, int t0, char* lds) {
  constexpr int SHM_V = 64 * 64 * 2, SHM_K = 64 * 128 * 2, NT = NKEY / 64;
  const int tid = tidx(), wid = tid >> 6, lane = tid & 63, r32 = lane & 31, hi = lane >> 5;
  char* V_lds = lds; char* K_lds = lds + 2 * SHM_V;
  float* wsf = (float*)(lds + 2 * SHM_V + 2 * SHM_K) + wid * 64; float* li_l = wsf; float* al_l = wsf + 32;
  float m_reg = -1e30f, l_reg = 0.f; f32x16 o[2];
#pragma unroll
  for (int r = 0; r < 16; ++r) { o[0][r] = 0.f; o[1][r] = 0.f; }
  bf16x8 qr[6];
  { const bf16_t* Qw = Qb + (size_t)(wid * 32 + r32) * 96;
#pragma unroll
    for (int d0 = 0; d0 < 4; ++d0) qr[d0] = *(const bf16x8*)(Qw + d0 * 16 + hi * 8);
    const int t = t0 + wid * 32 + r32;
#pragma unroll
    for (int g = 0; g < 2; ++g) {
      const bf16x8 x1 = *(const bf16x8*)(Qw + 64 + g * 16), x2 = *(const bf16x8*)(Qw + 64 + g * 16 + 8);
      const float pos = g ? (float)(t & 63) : (float)(t >> 6);
      unsigned wv[4];
#pragma unroll
      for (int i = 0; i < 8; i += 2) {
        float o2[2];
#pragma unroll
        for (int q = 0; q < 2; ++q) { const float ang = pos * rope_inv(i + q); const float sn = __sinf(ang), cs = __cosf(ang);
          const float a = bf2f((bf16_t)x1[i + q]), b = bf2f((bf16_t)x2[i + q]);
          o2[q] = hi ? (a * sn + b * cs) : (a * cs - b * sn); }
        wv[i >> 1] = pack2(o2[0], o2[1]);
      }
      u32x4 w4 = {wv[0], wv[1], wv[2], wv[3]}; qr[4 + g] = *reinterpret_cast<bf16x8*>(&w4);
    }
  }
  const int kq0 = tid, kq1 = tid < 256 ? 512 + tid : tid;
  const int kr0 = kq0 / 12, kc0 = (kq0 - kr0 * 12) * 8, kr1 = kq1 / 12, kc1 = (kq1 - kr1 * 12) * 8; const bool k2 = tid < 256;
  const int kw0 = KSWZ(kr0, kc0 * 2), kw1 = KSWZ(kr1, kc1 * 2);
  const int vk = tid >> 3, vc = (tid & 7) * 8, vst = v_st64(vk, vc);
  const int vb0 = (int)(uintptr_t)V_lds + v_rd_base(lane);
  const int ko0 = kr0 * 128 + kc0, ko1 = kr1 * 128 + kc1, vo = vk * 64 + vc;
  uint4 sv_0, sk0_0, sk1_0, sv_1, sk0_1, sk1_1;
#define SLOAD(i, kk0) do { sv_##i = *(const uint4*)(Vh + ((kk0) * 64 + vo)); sk0_##i = *(const uint4*)(Kh + ((kk0) * 128 + ko0)); sk1_##i = *(const uint4*)(Kh + ((kk0) * 128 + ko1)); } while (0)
#define SWRITE(b, i) do { *(uint4*)(V_lds + (b) * SHM_V + vst) = sv_##i; *(uint4*)(K_lds + (b) * SHM_K + kw0) = sk0_##i; if (k2) *(uint4*)(K_lds + (b) * SHM_K + kw1) = sk1_##i; } while (0)
#define SWAIT() asm volatile("s_waitcnt vmcnt(3)" ::: "memory")
#define RESC(a) do { if (__any((a) < 1.f)) { if (hi == 0) al_l[r32] = (a); asm volatile("s_waitcnt lgkmcnt(0)" ::: "memory"); \
    _Pragma("unroll") for (int d = 0; d < 2; ++d) _Pragma("unroll") for (int r = 0; r < 16; ++r) o[d][r] *= al_l[crow(r, hi)]; } } while (0)
#define PV2(vb) do { pv_one64<0>(o[0], (vb), pa0, pa1, pa2, pa3); pv_one64<1>(o[1], (vb), pa0, pa1, pa2, pa3); } while (0)
  f32x16 pA0, pA1, pB0, pB1; float mnA, mnB, alA, alB; bf16x8 pa0, pa1, pa2, pa3;
  SLOAD(0, 0); asm volatile("s_waitcnt vmcnt(0)" ::: "memory"); SWRITE(0, 0); __syncthreads();
  att_qkt<6>(pA0, pA1, K_lds, qr, r32, hi); att_partialSM(pA0, pA1, m_reg, mnA, alA);
  SLOAD(1, 64); SLOAD(0, 128);
  SWAIT(); SWRITE(1, 1); __syncthreads();
  for (int j = 1; j + 1 < NT; j += 2) {
    SBAR(); att_qkt<6>(pB0, pB1, K_lds + SHM_K, qr, r32, hi, -m_reg);
    att_finishSM(pA0, pA1, alA, l_reg, pa0, pa1, pa2, pa3); SBAR();
    SLOAD(1, (j + 2) * 64); SBAR();
    PV2(vb0); att_partialSM_rel(pB0, pB1, m_reg, alB);
    __syncthreads(); SWAIT(); SWRITE(0, 0);
    RESC(alB); __syncthreads();
    SBAR(); att_qkt<6>(pA0, pA1, K_lds, qr, r32, hi, -m_reg);
    att_finishSM(pB0, pB1, alB, l_reg, pa0, pa1, pa2, pa3); SBAR();
    if (j + 3 < NT) SLOAD(0, (j + 3) * 64); SBAR();
    PV2(vb0 + SHM_V); att_partialSM_rel(pA0, pA1, m_reg, alA);
    __syncthreads(); SWAIT(); SWRITE(1, 1);
    RESC(alA); __syncthreads();
  }
  SBAR(); att_qkt<6>(pB0, pB1, K_lds + SHM_K, qr, r32, hi, -m_reg);
  att_finishSM(pA0, pA1, alA, l_reg, pa0, pa1, pa2, pa3); SBAR();
  PV2(vb0); att_partialSM_rel(pB0, pB1, m_reg, alB);
  __syncthreads(); RESC(alB);
  att_finishSM(pB0, pB1, alB, l_reg, pa0, pa1, pa2, pa3); SBAR();
  PV2(vb0 + SHM_V);
  if (hi == 0) li_l[r32] = l_reg; asm volatile("s_waitcnt lgkmcnt(0)" ::: "memory");
  bf16_t* Ow = Ob + (size_t)(wid * 32) * D;
#pragma unroll
  for (int r = 0; r < 16; ++r) { const int orow = crow(r, hi); const float rl = __builtin_amdgcn_rcpf(li_l[orow]);
#pragma unroll
    for (int d0 = 0; d0 < 2; ++d0) Ow[(size_t)orow * D + d0 * 32 + r32] = f2bf(o[d0][r] * rl); }
  __syncthreads();
#undef SLOAD
#undef SWRITE
#undef SWAIT
}
__device__ __forceinline__ void ph_mla(const MP& p, char* lds) {
  const bf16_t* dq = (const bf16_t*)(p.ws + WS_DQ); const bf16_t* dk = (const bf16_t*)(p.ws + WS_DK); const bf16_t* dv = (const bf16_t*)(p.ws + WS_DV);
  bf16_t* abuf = (bf16_t*)(p.ws + WS_A);
  for (int item = blockIdx.x; item < 512; item += gridDim.x) {
    const int bh = (item & 7) + 8 * (item >> 8), qb = (item >> 3) & 31, b = bh >> 3, h = bh & 7;
    mla_block(dq + ((size_t)bh * SEQ + qb * 256) * 96, dk + (size_t)bh * NKEY * 128, dv + (size_t)bh * NKEY * 64,
              abuf + (size_t)(b * SEQ + qb * 256) * D + 512 + h * 64, qb * 256, lds);
  }
}

__device__ __forceinline__ int hgrn_step_cid(int b, int dir, int s) {
  if (s < 4) return 256 + b * 4 + (dir ? 3 - s : s);
  return b * 128 + (dir ? 131 - s : s - 4);
}
__device__ __forceinline__ void ph_hgrn_a(const MP& p, char* lds) {
  bf16_t* U = (bf16_t*)(p.ws + WS_U); float* LF = (float*)(p.ws + WS_LF); float* alast = (float*)(p.ws + WS_ALAST);
  bf16_t* KT = (bf16_t*)(p.ws + WS_A); bf16_t* VT = (bf16_t*)(p.ws + WS_H + USLOT);
  float* Ef = (float*)lds;
  bf16_t* Kn = (bf16_t*)(lds + 33792);
  bf16_t* Vn = (bf16_t*)(lds + 33792 + 17408);
  float* gsum = (float*)(lds + 33792 + 2 * 17408);
  const int t = tidx(), srow = t >> 3, scb = (t & 7) * 16, col = t & 127, grp = t >> 7;
  for (int item = blockIdx.x; item < NCHUNK * 8; item += gridDim.x) {
    const int cid = item >> 3, dir = (item >> 2) & 1, h = item & 3; const size_t row0 = (size_t)cid * 64;
    { const size_t go = (row0 + srow) * 512 + h * 128 + scb;
      const float* lp = LF + (size_t)dir * MROWS * 512 + go;
      const f32x4 z0 = *(const f32x4*)lp, z1 = *(const f32x4*)(lp + 4), z2 = *(const f32x4*)(lp + 8), z3 = *(const f32x4*)(lp + 12);
      const float* lbp = (const float*)(p.ws + WS_LB) + dir * 512 + h * 128 + scb;
      const f32x4 l0 = *(const f32x4*)lbp, l1 = *(const f32x4*)(lbp + 4), l2 = *(const f32x4*)(lbp + 8), l3 = *(const f32x4*)(lbp + 12);
      const float zv[16] = {z0.x, z0.y, z0.z, z0.w, z1.x, z1.y, z1.z, z1.w, z2.x, z2.y, z2.z, z2.w, z3.x, z3.y, z3.z, z3.w};
      const float lv[16] = {l0.x, l0.y, l0.z, l0.w, l1.x, l1.y, l1.z, l1.w, l2.x, l2.y, l2.z, l2.w, l3.x, l3.y, l3.z, l3.w};
      float kf[16], ef[16];
#pragma unroll
      for (int i = 0; i < 16; ++i) { kf[i] = (1.f - lv[i]) * sigmoidf_(-zv[i]); ef[i] = __logf(1.f - kf[i]); }
      float* ed = Ef + srow * 132 + scb;
      *(f32x4*)ed = (f32x4){ef[0], ef[1], ef[2], ef[3]}; *(f32x4*)(ed + 4) = (f32x4){ef[4], ef[5], ef[6], ef[7]}; *(f32x4*)(ed + 8) = (f32x4){ef[8], ef[9], ef[10], ef[11]}; *(f32x4*)(ed + 12) = (f32x4){ef[12], ef[13], ef[14], ef[15]};
      *(uint4*)(Kn + srow * 136 + scb) = make_uint4(pack2(kf[0], kf[1]), pack2(kf[2], kf[3]), pack2(kf[4], kf[5]), pack2(kf[6], kf[7]));
      *(uint4*)(Kn + srow * 136 + scb + 8) = make_uint4(pack2(kf[8], kf[9]), pack2(kf[10], kf[11]), pack2(kf[12], kf[13]), pack2(kf[14], kf[15]));
      if (dir == 0) { const uint4 v0 = *(const uint4*)(U + (size_t)3 * MROWS * 512 + go), v1 = *(const uint4*)(U + (size_t)3 * MROWS * 512 + go + 8);
        *(uint4*)(Vn + srow * 136 + scb) = v0; *(uint4*)(Vn + srow * 136 + scb + 8) = v1; } }
    __syncthreads();
    float pre[16]; float run = 0.f;
#pragma unroll
    for (int i = 0; i < 16; ++i) { const int rr = grp * 16 + (dir ? 15 - i : i); run += Ef[rr * 132 + col]; pre[i] = run; }
    gsum[grp * 128 + col] = run;
    __syncthreads();
    const float g0 = gsum[col], g1 = gsum[128 + col], g2 = gsum[256 + col], g3 = gsum[384 + col];
    const float total = (g0 + g1) + (g2 + g3);
    float offs;
    if (dir == 0) offs = grp == 0 ? 0.f : (grp == 1 ? g0 : (grp == 2 ? g0 + g1 : g0 + g1 + g2));
    else offs = grp == 3 ? 0.f : (grp == 2 ? g3 : (grp == 1 ? g3 + g2 : g3 + g2 + g1));
    if (grp == 0) alast[((size_t)dir * NCHUNK + cid) * 512 + h * 128 + col] = __expf(total);
    unsigned kw[8];
    float* lfo = LF + ((size_t)dir * MROWS + row0 + grp * 16) * 512 + h * 128 + col;
    bf16_t* uko = U + (size_t)(1 + dir) * MROWS * 512 + (row0 + grp * 16) * 512 + h * 128 + col;
#pragma unroll
    for (int i = 0; i < 16; i += 2) {
      const float ea = total - (offs + pre[dir ? 15 - i : i]), eb = total - (offs + pre[dir ? 14 - i : i + 1]);
      lfo[(size_t)i * 512] = ea; lfo[(size_t)(i + 1) * 512] = eb;
      const bf16_t ka = f2bf(bf2f(Kn[(grp * 16 + i) * 136 + col]) * __expf(ea)), kb = f2bf(bf2f(Kn[(grp * 16 + i + 1) * 136 + col]) * __expf(eb));
      uko[(size_t)i * 512] = ka; uko[(size_t)(i + 1) * 512] = kb; kw[i >> 1] = (unsigned)ka | ((unsigned)kb << 16);
    }
    { bf16_t* kt = KT + ((((size_t)dir * NCHUNK + cid) * 4 + h) * 128 + col) * 64 + grp * 16;
      *(uint4*)kt = make_uint4(kw[0], kw[1], kw[2], kw[3]); *(uint4*)(kt + 8) = make_uint4(kw[4], kw[5], kw[6], kw[7]); }
    if (dir == 0) {
      unsigned vw[8];
#pragma unroll
      for (int i = 0; i < 16; i += 2) vw[i >> 1] = (unsigned)Vn[(grp * 16 + i) * 136 + col] | ((unsigned)Vn[(grp * 16 + i + 1) * 136 + col] << 16);
      bf16_t* vt = VT + (((size_t)cid * 4 + h) * 128 + col) * 64 + grp * 16;
      *(uint4*)vt = make_uint4(vw[0], vw[1], vw[2], vw[3]); *(uint4*)(vt + 8) = make_uint4(vw[4], vw[5], vw[6], vw[7]);
    }
    __syncthreads();
  }
}
__device__ __forceinline__ bf16_t* hgrn_sbuf(const MP& p, int bhd, int cid) {
  return cid < 256 ? (bf16_t*)p.out + ((size_t)bhd * 128 + (cid & 127)) * 16384 : (bf16_t*)(p.ws + WS_ODIR_CTX) + ((size_t)bhd * 4 + ((cid - 256) & 3)) * 16384;
}
__device__ __forceinline__ void ph_hgrn_b(const MP& p) {
  const int tid = tidx(), w = tid >> 6, lane = tid & 63, l15 = lane & 15, lq = lane >> 4;
  if (w < 4) {
    const bf16_t* KT = (const bf16_t*)(p.ws + WS_A); const bf16_t* VT = (const bf16_t*)(p.ws + WS_H + USLOT); const float* alast = (const float*)(p.ws + WS_ALAST);
    for (int item = blockIdx.x * 4 + w; item < 1024; item += gridDim.x * 4) {
      const int bhd = item >> 6, dkt = (item >> 3) & 7, dvt = item & 7, b = bhd >> 3, h = (bhd >> 1) & 3, dir = bhd & 1;
      f32x4 S = {0.f, 0.f, 0.f, 0.f};
      uint4 kaA[2][2], vbA[2][2], kaB[2][2], vbB[2][2], kaC[2][2], vbC[2][2], kaD[2][2], vbD[2][2]; float alA[2], alB[2], alC[2], alD[2];
#define HB_LOAD(X, s0) _Pragma("unroll") for (int u = 0; u < 2; ++u) { const int cid = hgrn_step_cid(b, dir, (s0) + u);                              \
        const bf16_t* kt = KT + ((((size_t)dir * NCHUNK + cid) * 4 + h) * 128 + dkt * 16 + l15) * 64 + lq * 8;                                       \
        const bf16_t* vt = VT + (((size_t)cid * 4 + h) * 128 + dvt * 16 + l15) * 64 + lq * 8;                                                       \
        ka##X[u][0] = *(const uint4*)kt; ka##X[u][1] = *(const uint4*)(kt + 32); vb##X[u][0] = *(const uint4*)vt; vb##X[u][1] = *(const uint4*)(vt + 32); \
        al##X[u] = alast[((size_t)dir * NCHUNK + cid) * 512 + h * 128 + dkt * 16 + l15]; }
#define HB_STEP(X, s0) _Pragma("unroll") for (int u = 0; u < 2; ++u) { const int cid = hgrn_step_cid(b, dir, (s0) + u);                              \
        f32x4 T = {0.f, 0.f, 0.f, 0.f};                                                                                                              \
        T = MFMA16(*reinterpret_cast<bf16x8*>(&vb##X[u][0]), *reinterpret_cast<bf16x8*>(&ka##X[u][0]), T);                                           \
        T = MFMA16(*reinterpret_cast<bf16x8*>(&vb##X[u][1]), *reinterpret_cast<bf16x8*>(&ka##X[u][1]), T);                                           \
        const f32x4 Sp = S * al##X[u];                                                                                                               \
        bf16_t* sb = hgrn_sbuf(p, bhd, cid) + (size_t)(dvt * 16 + lq * 4) * 128 + dkt * 16 + l15;                                                    \
        sb[0] = f2bf(Sp.x); sb[128] = f2bf(Sp.y); sb[256] = f2bf(Sp.z); sb[384] = f2bf(Sp.w);                                                       \
        S = Sp + T; }
      HB_LOAD(A, 0); HB_LOAD(B, 2); HB_LOAD(C, 4);
      for (int s0 = 0; s0 < 132; s0 += 8) {
        if (s0 + 6 < 132) { HB_LOAD(D, s0 + 6); }
        HB_STEP(A, s0);
        if (s0 + 8 < 132) { HB_LOAD(A, s0 + 8); }
        HB_STEP(B, s0 + 2);
        if (s0 + 10 < 132) { HB_LOAD(B, s0 + 10); }
        if (s0 + 4 < 132) { HB_STEP(C, s0 + 4); }
        if (s0 + 12 < 132) { HB_LOAD(C, s0 + 12); }
        if (s0 + 6 < 132) { HB_STEP(D, s0 + 6); }
      }
#undef HB_LOAD
#undef HB_STEP
    }
  }
}
__device__ __forceinline__ void ph_hgrn_c(const MP& p, char* lds) {
  const bf16_t* U = (const bf16_t*)(p.ws + WS_U); const float* LF = (const float*)(p.ws + WS_LF); const bf16_t* VT = (const bf16_t*)(p.ws + WS_H + USLOT);
  bf16_t* abuf = (bf16_t*)(p.ws + WS_A); const float* onorm = p.in[11];
  char* Qs = lds; char* Ks = lds + 16384; char* Ss = lds + 32768; char* Vs = lds + 65536; char* As = lds + 81920; float* red = (float*)(lds + 90112);
  const int t = tidx(), lane = t & 63, w = t >> 6, wm = w >> 1, wn = w & 1, l15 = lane & 15, lq = lane >> 4;
  const int srow = t >> 3, scb = (t & 7) * 16;
  uint4 rq0, rq1, rk0, rk1, rv0, rv1, rs0, rs1, rs2, rs3; f32x4 re0, re1, re2, re3;
#define HC_LOAD(item_, dir_) do { const int bh_ = (item_) / 132, cp_ = (item_) - bh_ * 132, b_ = bh_ >> 2, h_ = bh_ & 3; \
    const int cid_ = cp_ < 128 ? b_ * 128 + cp_ : 256 + b_ * 4 + (cp_ - 128); \
    const size_t go_ = ((size_t)cid_ * 64 + srow) * 512 + h_ * 128 + scb; \
    rq0 = *(const uint4*)(U + go_); rq1 = *(const uint4*)(U + go_ + 8); \
    rk0 = *(const uint4*)(U + (size_t)(1 + (dir_)) * MROWS * 512 + go_); rk1 = *(const uint4*)(U + (size_t)(1 + (dir_)) * MROWS * 512 + go_ + 8); \
    const float* ep_ = LF + (size_t)(dir_) * MROWS * 512 + go_; re0 = *(const f32x4*)ep_; re1 = *(const f32x4*)(ep_ + 4); re2 = *(const f32x4*)(ep_ + 8); re3 = *(const f32x4*)(ep_ + 12); \
    if ((dir_) == 0) { const bf16_t* vt_ = VT + ((size_t)cid_ * 4 + h_) * 8192; rv0 = *(const uint4*)(vt_ + (size_t)t * 8); rv1 = *(const uint4*)(vt_ + (size_t)(t + 512) * 8); } \
    const bf16_t* sb_ = hgrn_sbuf(p, bh_ * 2 + (dir_), cid_); \
    rs0 = *(const uint4*)(sb_ + (size_t)t * 8); rs1 = *(const uint4*)(sb_ + (size_t)(t + 512) * 8); rs2 = *(const uint4*)(sb_ + (size_t)(t + 1024) * 8); rs3 = *(const uint4*)(sb_ + (size_t)(t + 1536) * 8); } while (0)
  if ((int)blockIdx.x < 8 * 132) HC_LOAD((int)blockIdx.x, 0);
  for (int item = blockIdx.x; item < 8 * 132; item += gridDim.x) {
    const int bh = item / 132, cpos = item - bh * 132, b = bh >> 2, h = bh & 3;
    const int cid = cpos < 128 ? b * 128 + cpos : 256 + b * 4 + (cpos - 128); const size_t row0 = (size_t)cid * 64;
    f32x4 acc[4];
#pragma unroll
    for (int j = 0; j < 4; ++j) acc[j] = (f32x4){0.f, 0.f, 0.f, 0.f};
    for (int dir = 0; dir < 2; ++dir) {
      {
        const unsigned qw[8] = {rq0.x, rq0.y, rq0.z, rq0.w, rq1.x, rq1.y, rq1.z, rq1.w};
        const float ev[16] = {re0.x, re0.y, re0.z, re0.w, re1.x, re1.y, re1.z, re1.w, re2.x, re2.y, re2.z, re2.w, re3.x, re3.y, re3.z, re3.w};
        unsigned ow[8];
#pragma unroll
        for (int i = 0; i < 8; ++i) ow[i] = pack2(__uint_as_float(qw[i] << 16) * __expf(-ev[2 * i]), __uint_as_float(qw[i] & 0xFFFF0000u) * __expf(-ev[2 * i + 1]));
        const int c0 = scb >> 3, sw = srow & 15;
        *(uint4*)(Qs + srow * 256 + ((c0 ^ sw) << 4)) = make_uint4(ow[0], ow[1], ow[2], ow[3]);
        *(uint4*)(Qs + srow * 256 + (((c0 + 1) ^ sw) << 4)) = make_uint4(ow[4], ow[5], ow[6], ow[7]);
        *(uint4*)(Ks + srow * 256 + ((c0 ^ sw) << 4)) = rk0;
        *(uint4*)(Ks + srow * 256 + (((c0 + 1) ^ sw) << 4)) = rk1;
        if (dir == 0) { { const int idx = t, r = idx >> 3, c = idx & 7; *(uint4*)(Vs + r * 128 + ((c ^ ((r >> 1) & 7)) << 4)) = rv0; }
                        { const int idx = t + 512, r = idx >> 3, c = idx & 7; *(uint4*)(Vs + r * 128 + ((c ^ ((r >> 1) & 7)) << 4)) = rv1; } }
        { const int idx = t, r = idx >> 4, c = idx & 15; *(uint4*)(Ss + r * 256 + ((c ^ (r & 15)) << 4)) = rs0; }
        { const int idx = t + 512, r = idx >> 4, c = idx & 15; *(uint4*)(Ss + r * 256 + ((c ^ (r & 15)) << 4)) = rs1; }
        { const int idx = t + 1024, r = idx >> 4, c = idx & 15; *(uint4*)(Ss + r * 256 + ((c ^ (r & 15)) << 4)) = rs2; }
        { const int idx = t + 1536, r = idx >> 4, c = idx & 15; *(uint4*)(Ss + r * 256 + ((c ^ (r & 15)) << 4)) = rs3; }
      }
      __syncthreads();
      if (dir == 0) HC_LOAD(item, 1); else if (item + (int)gridDim.x < 8 * 132) HC_LOAD(item + (int)gridDim.x, 0);
      bf16x8 af[4];
#pragma unroll
      for (int ks = 0; ks < 4; ++ks) af[ks] = *(const bf16x8*)(Qs + (wm * 16 + l15) * 256 + (((ks * 4 + lq) ^ l15) << 4));
      {
        f32x4 a2[2];
#pragma unroll
        for (int ni = 0; ni < 2; ++ni) { a2[ni] = (f32x4){0.f, 0.f, 0.f, 0.f};
#pragma unroll
          for (int ks = 0; ks < 4; ++ks) { const bf16x8 bf = *(const bf16x8*)(Ks + (wn * 32 + ni * 16 + l15) * 256 + (((ks * 4 + lq) ^ l15) << 4)); a2[ni] = MFMA16(bf, af[ks], a2[ni]); } }
        const int tt = wm * 16 + l15;
#pragma unroll
        for (int ni = 0; ni < 2; ++ni) { const int s0 = wn * 32 + ni * 16 + lq * 4; float v[4] = {a2[ni].x, a2[ni].y, a2[ni].z, a2[ni].w};
#pragma unroll
          for (int r = 0; r < 4; ++r) { const int s = s0 + r; const bool keep = dir ? (s >= tt) : (s <= tt); v[r] = keep ? v[r] : 0.f; }
          uint2 wv; wv.x = pack2(v[0], v[1]); wv.y = pack2(v[2], v[3]);
          *(uint2*)(As + tt * 128 + (((s0 >> 3) ^ ((tt >> 1) & 7)) << 4) + (s0 & 7) * 2) = wv; }
      }
#pragma unroll
      for (int ni = 0; ni < 4; ++ni) {
#pragma unroll
        for (int ks = 0; ks < 4; ++ks) { const bf16x8 bf = *(const bf16x8*)(Ss + (wn * 64 + ni * 16 + l15) * 256 + (((ks * 4 + lq) ^ l15) << 4)); acc[ni] = MFMA16(bf, af[ks], acc[ni]); } }
      __syncthreads();
      {
        const int tt = wm * 16 + l15; bf16x8 aa[2];
#pragma unroll
        for (int ks = 0; ks < 2; ++ks) aa[ks] = *(const bf16x8*)(As + tt * 128 + (((ks * 4 + lq) ^ ((tt >> 1) & 7)) << 4));
#pragma unroll
        for (int ni = 0; ni < 4; ++ni) { const int r = wn * 64 + ni * 16 + l15;
#pragma unroll
          for (int ks = 0; ks < 2; ++ks) { const bf16x8 bf = *(const bf16x8*)(Vs + r * 128 + (((ks * 4 + lq) ^ ((r >> 1) & 7)) << 4)); acc[ni] = MFMA16(bf, aa[ks], acc[ni]); } }
      }
      __syncthreads();
    }
    const int tt = wm * 16 + l15; float ss = 0.f;
#pragma unroll
    for (int ni = 0; ni < 4; ++ni) ss += acc[ni].x * acc[ni].x + acc[ni].y * acc[ni].y + acc[ni].z * acc[ni].z + acc[ni].w * acc[ni].w;
    ss += __shfl_xor(ss, 16); ss += __shfl_xor(ss, 32);
    if (lq == 0) red[tt * 2 + wn] = ss;
    __syncthreads();
    const float rstd = 1.f / sqrtf((red[tt * 2] + red[tt * 2 + 1]) * (1.f / 128.f) + EPS);
#pragma unroll
    for (int ni = 0; ni < 4; ++ni) {
      const int dv = wn * 64 + ni * 16 + lq * 4; const size_t go = (row0 + tt) * 512 + h * 128 + dv;
      const uint2 gw = *(const uint2*)(U + (size_t)4 * MROWS * 512 + go); const f32x4 on = *(const f32x4*)(onorm + dv);
      uint2 wv;
      wv.x = pack2(acc[ni].x * rstd * on.x * __uint_as_float(gw.x << 16), acc[ni].y * rstd * on.y * __uint_as_float(gw.x & 0xFFFF0000u));
      wv.y = pack2(acc[ni].z * rstd * on.z * __uint_as_float(gw.y << 16), acc[ni].w * rstd * on.w * __uint_as_float(gw.y & 0xFFFF0000u));
      *(uint2*)(abuf + (row0 + tt) * D + h * 128 + dv) = wv;
    }
    __syncthreads();
  }
#undef HC_LOAD
}

#define XB_TMO      128
#define XB_XCNT(j)  (256  + 64 * (j))
#define XB_XSUB(j)  (1280 + 64 * (j))
#define XB_XGEN(j)  (2304 + 64 * (j))
#define XB_TOP      3328
#define XB_TOPGEN   3392
#define XCD_BAR_WORDS 3456
#define XB_SPIN_CAP (1u << 20)
#define LAS __attribute__((address_space(3)))
__device__ __forceinline__ unsigned xb_ld(unsigned* p)              { return __hip_atomic_load(p, __ATOMIC_RELAXED, __HIP_MEMORY_SCOPE_AGENT); }
__device__ __forceinline__ unsigned xb_add(unsigned* p, unsigned v) { return __hip_atomic_fetch_add(p, v, __ATOMIC_RELAXED, __HIP_MEMORY_SCOPE_AGENT); }
__device__ __forceinline__ unsigned xb_xcc_id() { return (unsigned)__builtin_amdgcn_s_getreg((3 << 11) | 20) & 0xFu; }
#define XB_SPIN(cond, bar) do { unsigned _sp = 0; while (cond) { __builtin_amdgcn_s_sleep(1); \
    if ((++_sp & 255u) == 0u) { if (xb_ld(&(bar)[XB_TMO])) break; if (_sp > XB_SPIN_CAP) { atomicAdd(&(bar)[XB_TMO], 1u); break; } } } } while (0)
struct XcdBarrier { unsigned* bar; unsigned x; volatile LAS unsigned* st; };
__device__ __forceinline__ XcdBarrier xcd_barrier_post(unsigned* bar, volatile LAS unsigned* st) {
  XcdBarrier b; b.bar = bar; b.x = xb_xcc_id(); b.st = st;
  if (tidx() == 0) (void)xb_add(&bar[XB_XCNT(b.x)], 1u);
  return b;
}
__device__ __forceinline__ void xcd_barrier_complete(unsigned* bar, unsigned x, unsigned& nloc, unsigned& nx) {
  const unsigned G = gridDim.x * gridDim.y * gridDim.z;
  unsigned sum, cnt, mine, sp = 0u;
  for (;;) {
    sum = 0u; cnt = 0u; mine = 0u;
#pragma unroll
    for (unsigned j = 0; j < 16; ++j) { const unsigned c = xb_ld(&bar[XB_XCNT(j)]); sum += c; cnt += (c > 0u) ? 1u : 0u; mine = (j == x) ? c : mine; }
    if (sum == G) break;
    __builtin_amdgcn_s_sleep(1);
    if ((++sp & 255u) == 0u) { if (xb_ld(&bar[XB_TMO])) break; if (sp > XB_SPIN_CAP) { atomicAdd(&bar[XB_TMO], 1u); break; } }
  }
  nloc = mine > 0u ? mine : 1u; nx = cnt > 0u ? cnt : 1u;
}
__device__ __forceinline__ void xcd_barrier(const XcdBarrier& b) {
  asm volatile("s_waitcnt vmcnt(0)" ::: "memory");
  __syncthreads();
  if (tidx() == 0) {
    unsigned* bar = b.bar;
    __builtin_amdgcn_s_waitcnt(0);
    unsigned nloc = b.st[0], nx = b.st[1];
    if (nloc == 0u) { xcd_barrier_complete(bar, b.x, nloc, nx); b.st[0] = nloc; b.st[1] = nx; }
    const unsigned old = xb_add(&bar[XB_XSUB(b.x)], 1u);
    const unsigned gen = old / nloc;
    if (old + 1u == (gen + 1u) * nloc) {
      __builtin_amdgcn_fence(__ATOMIC_RELEASE, "agent");
      asm volatile("s_waitcnt vmcnt(0)" ::: "memory");
      const unsigned og = xb_add(&bar[XB_TOP], 1u);
      const unsigned tg = og / nx;
      if (og + 1u == (tg + 1u) * nx) xb_add(&bar[XB_TOPGEN], 1u);
      else XB_SPIN(xb_ld(&bar[XB_TOPGEN]) == tg, bar);
      __builtin_amdgcn_fence(__ATOMIC_ACQUIRE, "agent");
      xb_add(&bar[XB_XGEN(b.x)], 1u);
      asm volatile("s_waitcnt vmcnt(0)" ::: "memory");
    } else {
      XB_SPIN(xb_ld(&bar[XB_XGEN(b.x)]) == gen, bar);
      __builtin_amdgcn_fence(__ATOMIC_ACQUIRE, "agent");
      asm volatile("s_waitcnt vmcnt(0)" ::: "memory");
    }
  }
  __syncthreads();
}

  template <int D0> __device__ __forceinline__ void pv_one32(f32x16& od, int vb, bf16x8 pa0, bf16x8 pa1) {
    const s16x4 l0 = tr_read<v_rd_off64(D0, 0, 0)>(vb), h0 = tr_read<v_rd_off64(D0, 0, 1)>(vb), l1 = tr_read<v_rd_off64(D0, 1, 0)>(vb), h1 = tr_read<v_rd_off64(D0, 1, 1)>(vb);
    asm volatile("s_waitcnt lgkmcnt(0)" ::: "memory"); SBAR();
    od = MFMA32(pa0, PKV(l0, h0), od);
    od = MFMA32(pa1, PKV(l1, h1), od);
  }
  __device__ __forceinline__ void ph_na(const MP& p, char* lds) {
    const bf16_t* nq = (const bf16_t*)(p.ws + WS_NQ); const bf16_t* nk = (const bf16_t*)(p.ws + WS_NK); const bf16_t* nv = (const bf16_t*)(p.ws + WS_NV);
    bf16_t* A = (bf16_t*)(p.ws + WS_A);
    const int tid = tidx(), w = tid >> 6, lane = tid & 63, j = lane & 31, hi = lane >> 5;
    char* Kw = lds + w * 8192; char* Vw = Kw + 4096;
    float* rpbs = (float*)(lds + 65536);
    float* al_l = (float*)(lds + 65536 + 4096) + w * 64; float* li_l = al_l + 32;
    const int vb0 = (int)(uintptr_t)Vw + v_rd_base(lane);
    for (int item = blockIdx.x; item < 512; item += gridDim.x) {
      const int bh = (item & 7) + 8 * (item >> 8), patch = (item >> 3) & 31, b = bh >> 3, h = bh & 7, r0 = (patch >> 2) * 16, c0 = (patch & 3) * 16;
      for (int i = tid; i < 15 * 64; i += 512) { const int dr = i >> 6, dc = (i & 63) - 16; rpbs[i] = (dc >= 0 && dc < 31) ? p.in[16][(h * 15 + dr) * 31 + dc] * LOG2E : 0.f; }
      __syncthreads();
      const int ra = r0 + 2 * w, qrow = ra + (j >> 4), qc = c0 + (j & 15);
      int rs_q = qrow - 4; rs_q = rs_q < 0 ? 0 : (rs_q > 120 ? 120 : rs_q);
      int cs_q = qc - 8; cs_q = cs_q < 0 ? 0 : (cs_q > 48 ? 48 : cs_q);
      int rs0 = ra - 4; rs0 = rs0 < 0 ? 0 : (rs0 > 120 ? 120 : rs0);
      int rs1 = ra - 3; rs1 = rs1 < 0 ? 0 : (rs1 > 120 ? 120 : rs1);
      int cw = c0 - 8; cw = cw < 0 ? 0 : (cw > 32 ? 32 : cw);
      const int ntiles = 8 + (rs1 - rs0) + 8;
      const bf16_t* Kb = nk + (size_t)bh * NKEY * 64; const bf16_t* Vb = nv + (size_t)bh * NKEY * 64;
      bf16x8 qr[4];
      { const bf16_t* qp = nq + ((size_t)bh * SEQ + qrow * 64 + qc) * 64 + hi * 8;
#pragma unroll
        for (int d0 = 0; d0 < 4; ++d0) qr[d0] = *(const bf16x8*)(qp + d0 * 16); }
      f32x16 o[2];
#pragma unroll
      for (int r = 0; r < 16; ++r) { o[0][r] = 0.f; o[1][r] = 0.f; }
      float m_reg = -1e30f, l_reg = 0.f;
      int kwo[4], vwo[4];
#pragma unroll
      for (int i = 0; i < 4; ++i) { const int q = lane + 64 * i, row = q >> 3, c = q & 7; kwo[i] = row * 128 + ((c ^ ((row >> 1) & 7)) << 4); vwo[i] = v_st64(row, c * 8); }
      uint4 sk0, sk1, sk2, sk3, sv0, sv1, sv2, sv3;
#define NA_KBASE(tl) ((tl) < 8 ? (tl) * 32 : CT + (rs0 + (tl) - 8) * 64 + cw)
#define NA_L1(i) sk##i = *(const uint4*)(Kb + kb_ + (i) * 512); sv##i = *(const uint4*)(Vb + kb_ + (i) * 512);
#define NA_LOAD(tl) do { const size_t kb_ = (size_t)NA_KBASE(tl) * 64 + lane * 8; NA_L1(0) NA_L1(1) NA_L1(2) NA_L1(3) } while (0)
#define NA_W1(i) *(uint4*)(Kw + kwo[i]) = sk##i; *(uint4*)(Vw + vwo[i]) = sv##i;
#define NA_WRITE() do { NA_W1(0) NA_W1(1) NA_W1(2) NA_W1(3) } while (0)
      NA_LOAD(0); NA_WRITE();
      for (int tl = 0; tl < ntiles; ++tl) {
        if (tl + 1 < ntiles) NA_LOAD(tl + 1);
        f32x16 pt;
#pragma unroll
        for (int r = 0; r < 16; ++r) pt[r] = 0.f;
#pragma unroll
        for (int d0 = 0; d0 < 4; ++d0) { const bf16x8 kf = *(const bf16x8*)(Kw + j * 128 + (((d0 * 2 + hi) ^ ((j >> 1) & 7)) << 4)); pt = MFMA32(kf, qr[d0], pt); }
        if (tl >= 8) {
          const int kr = rs0 + tl - 8; const bool rowok = (kr >= rs_q) && (kr < rs_q + 8);
          int dr = kr - qrow + 7; dr = dr < 0 ? 0 : (dr > 14 ? 14 : dr);
          const float* bp = rpbs + dr * 64 + (cw - qc + 15 + 16) + 4 * hi; const int kc0 = cw + 4 * hi;
#pragma unroll
          for (int r = 0; r < 16; ++r) { const int cr = (r & 3) + 8 * (r >> 2); const int kc = kc0 + cr;
            const bool ok = rowok && (kc >= cs_q) && (kc < cs_q + 16); pt[r] = ok ? pt[r] + bp[cr] : -1e30f; }
        }
        float pmax = pt[0];
#pragma unroll
        for (int r = 1; r < 16; ++r) pmax = fmaxf(pmax, pt[r]);
        { auto rr = __builtin_amdgcn_permlane32_swap(__float_as_uint(pmax), __float_as_uint(pmax), false, false); pmax = fmaxf(__uint_as_float(rr[0]), __uint_as_float(rr[1])); }
        float mn, alpha;
        if (__all(pmax - m_reg <= ATT_THR)) { mn = m_reg; alpha = 1.f; }
        else { mn = fmaxf(m_reg, pmax); alpha = __builtin_amdgcn_exp2f(m_reg - mn); m_reg = mn; }
        float ps = 0.f;
#pragma unroll
        for (int r = 0; r < 16; ++r) { pt[r] = __builtin_amdgcn_exp2f(pt[r] - mn); ps += pt[r]; }
        { auto rr = __builtin_amdgcn_permlane32_swap(__float_as_uint(ps), __float_as_uint(ps), false, false); ps = __uint_as_float(rr[0]) + __uint_as_float(rr[1]); }
        l_reg = l_reg * alpha + ps;
        bf16x8 pa0, pa1; PK4(pt, 0, pa0); PK4(pt, 8, pa1);
        if (__any(alpha < 1.f)) { if (hi == 0) al_l[j] = alpha; asm volatile("s_waitcnt lgkmcnt(0)" ::: "memory");
#pragma unroll
          for (int d = 0; d < 2; ++d)
#pragma unroll
            for (int r = 0; r < 16; ++r) o[d][r] *= al_l[crow(r, hi)]; }
        pv_one32<0>(o[0], vb0, pa0, pa1); pv_one32<1>(o[1], vb0, pa0, pa1);
        if (tl + 1 < ntiles) NA_WRITE();
      }
#undef NA_LOAD
#undef NA_WRITE
#undef NA_KBASE
      if (hi == 0) li_l[j] = l_reg; asm volatile("s_waitcnt lgkmcnt(0)" ::: "memory");
#pragma unroll
      for (int r = 0; r < 16; ++r) { const int qq = crow(r, hi); const float rl = __builtin_amdgcn_rcpf(li_l[qq]);
        bf16_t* op = A + ((size_t)b * SEQ + (ra + (qq >> 4)) * 64 + c0 + (qq & 15)) * D + h * 64 + j;
        op[0] = f2bf(o[0][r] * rl); op[32] = f2bf(o[1][r] * rl); }
      __syncthreads();
    }
  }

__device__ __forceinline__ void ph_na_simple(const MP& p) {
  const bf16_t* nq = (const bf16_t*)(p.ws + WS_NQ); const bf16_t* nk = (const bf16_t*)(p.ws + WS_NK); const bf16_t* nv = (const bf16_t*)(p.ws + WS_NV);
  const float* rpb = p.in[16]; bf16_t* A = (bf16_t*)(p.ws + WS_A);
  for (int item = blockIdx.x; item < 256; item += gridDim.x) {
    const int bh = item >> 4, t = (item & 15) * 512 + tidx(), b = bh >> 3, hh = bh & 7;
    const int r = t >> 6, c = t & 63;
    int rs = r - 4; rs = rs < 0 ? 0 : (rs > 120 ? 120 : rs);
    int cs = c - 8; cs = cs < 0 ? 0 : (cs > 48 ? 48 : cs);
    float q[64], o[64];
    const bf16_t* qp = nq + ((size_t)bh * SEQ + t) * 64;
#pragma unroll
    for (int d = 0; d < 64; ++d) { q[d] = bf2f(qp[d]); o[d] = 0.f; }
    const bf16_t* Kb = nk + (size_t)bh * NKEY * 64; const bf16_t* Vb = nv + (size_t)bh * NKEY * 64;
    float mx = -3.0e38f, l = 0.f;
    for (int kk = 0; kk < 128 + CT; ++kk) {
      int key; float bias = 0.f;
      if (kk < 128) { const int kr_ = rs + (kk >> 4), kc = cs + (kk & 15); key = CT + kr_ * 64 + kc; bias = rpb[(hh * 15 + (kr_ - r + 7)) * 31 + (kc - c + 15)] * LOG2E; }
      else key = kk - 128;
      const bf16_t* kp = Kb + (size_t)key * 64; float s = bias;
#pragma unroll
      for (int d = 0; d < 64; d += 2) { const unsigned w = *(const unsigned*)(kp + d); s += q[d] * __uint_as_float(w << 16) + q[d + 1] * __uint_as_float(w & 0xFFFF0000u); }
      const float mn = fmaxf(mx, s), alpha = exp2f(mx - mn), pe = exp2f(s - mn);
      l = l * alpha + pe; mx = mn;
      const bf16_t* vp = Vb + (size_t)key * 64;
#pragma unroll
      for (int d = 0; d < 64; d += 2) { const unsigned w = *(const unsigned*)(vp + d); o[d] = o[d] * alpha + pe * __uint_as_float(w << 16); o[d + 1] = o[d + 1] * alpha + pe * __uint_as_float(w & 0xFFFF0000u); }
    }
    const float il = 1.f / l;
    bf16_t* op = A + (size_t)(b * SEQ + t) * D + hh * 64;
#pragma unroll
    for (int d = 0; d < 64; d += 2) *(unsigned*)(op + d) = pack2(o[d] * il, o[d + 1] * il);
  }
}

};

enum { PH_PRE = 0, PH_N1_0, PH_G1_0, PH_HA, PH_HB, PH_HC, PH_G2_0, PH_ROUTE_0, PH_MOE1_0, PH_MOE2_0, PH_COMB_0, PH_G1_1, PH_MLAUP, PH_MLA, PH_G2_1, PH_ROUTE_1, PH_MOE1_1, PH_MOE2_1, PH_FINAL, PH_COUNT };

#ifndef PROBE_PHASE
#define PROBE_PHASE (-1)
#endif
#define PROBE_SUB(id, ...) do { if (PROBE_PHASE == (id)) { __syncthreads(); pt0 = __builtin_amdgcn_s_memrealtime(); __VA_ARGS__; __syncthreads(); pt1 = __builtin_amdgcn_s_memrealtime(); } else { __VA_ARGS__; } } while (0)
__global__ __launch_bounds__(512) void mega(MP p) {
  unsigned long long pt0 = 0, pt1 = 0;
  extern __shared__ __attribute__((aligned(16))) char smem[];
  char* ws = p.ws;
  MK k; k.wv = __builtin_amdgcn_readfirstlane((int)(threadIdx.x >> 6));
  volatile LAS unsigned* xbw = (volatile LAS unsigned*)(smem + LDS_BYTES - 16);
  if (k.tidx() == 0) { xbw[0] = 0u; xbw[1] = 0u; }
  __syncthreads();
  MK::XcdBarrier bar; bar.bar = (unsigned*)(ws + WS_CTL); bar.x = 0; bar.st = xbw;
  if (p.ph_hi - p.ph_lo > 1) bar = k.xcd_barrier_post((unsigned*)(ws + WS_CTL), xbw);
  const float* mods0 = (const float*)(ws + WS_MODS); const float* mods1 = mods0 + 3 * 6144;
  bf16_t* hbuf = (bf16_t*)(ws + WS_H); bf16_t* abuf = (bf16_t*)(ws + WS_A); bf16_t* U = (bf16_t*)(ws + WS_U); float* xc = (float*)(ws + WS_XC);
  if (p.ph_lo <= PH_PRE && PH_PRE < p.ph_hi) { if (PROBE_PHASE == PH_PRE) pt0 = __builtin_amdgcn_s_memrealtime(); PROBE_SUB(112, k.ph_ada(p, smem)); PROBE_SUB(113, k.ph_conv_all(p, smem));
    if (PH_PRE + 1 < p.ph_hi) k.xcd_barrier(bar);
    if (PROBE_PHASE == PH_PRE) pt1 = __builtin_amdgcn_s_memrealtime();
  }
  if (p.ph_lo <= PH_N1_0 && PH_N1_0 < p.ph_hi) { if (PROBE_PHASE == PH_N1_0) pt0 = __builtin_amdgcn_s_memrealtime(); k.ph_norm_mod(p.in[0], p.in[2], p.in[6], mods0, 0, 1024, hbuf, MROWS);
    if (PH_N1_0 + 1 < p.ph_hi) k.xcd_barrier(bar);
    if (PROBE_PHASE == PH_N1_0) pt1 = __builtin_amdgcn_s_memrealtime();
  }
  if (p.ph_lo <= PH_G1_0 && PH_G1_0 < p.ph_hi) { if (PROBE_PHASE == PH_G1_0) pt0 = __builtin_amdgcn_s_memrealtime(); { EpiABIn e; e.U = U; e.LF = (float*)(ws + WS_LF); e.lb = (const float*)(ws + WS_LB);
        k.gemm_phase8(hbuf, (const bf16_t*)(ws + WS_WT_ABIN), NLAT, MROWS, 3072, 1024, e, smem, 0, 3072); }
    if (PH_G1_0 + 1 < p.ph_hi) k.xcd_barrier(bar);
    if (PROBE_PHASE == PH_G1_0) pt1 = __builtin_amdgcn_s_memrealtime();
  }
  if (p.ph_lo <= PH_HA && PH_HA < p.ph_hi) { if (PROBE_PHASE == PH_HA) pt0 = __builtin_amdgcn_s_memrealtime(); PROBE_SUB(100, k.ph_hgrn_a(p, smem)); PROBE_SUB(101, k.ph_pool_prep(U + 5 * (size_t)MROWS * 512, hbuf));
    if (PH_HA + 1 < p.ph_hi) k.xcd_barrier(bar);
    if (PROBE_PHASE == PH_HA) pt1 = __builtin_amdgcn_s_memrealtime();
  }
  if (p.ph_lo <= PH_HB && PH_HB < p.ph_hi) { if (PROBE_PHASE == PH_HB) pt0 = __builtin_amdgcn_s_memrealtime(); k.ph_hgrn_b(p);
    if (PH_HB + 1 < p.ph_hi) k.xcd_barrier(bar);
    if (PROBE_PHASE == PH_HB) pt1 = __builtin_amdgcn_s_memrealtime();
  }
  if (p.ph_lo <= PH_HC && PH_HC < p.ph_hi) { if (PROBE_PHASE == PH_HC) pt0 = __builtin_amdgcn_s_memrealtime(); PROBE_SUB(102, k.ph_hgrn_c(p, smem));
    for (int tile = (int)gridDim.x - 1 - (int)blockIdx.x; tile < 4 * (MROWS / 256); tile += gridDim.x) { const int gi = tile / (MROWS / 256), mt = tile - gi * (MROWS / 256);
      MK::EpiEach<EpiPool> e; e.e.A = abuf; e.e.scale = p.in[13]; e.e.gi = gi; e.e.pad = 0;
      k.template gemm_tile<4>(hbuf + gi * 128, 512, nullptr, 0, MROWS, (const bf16_t*)(ws + WS_WT_POOL) + (size_t)gi * 128 * 128, 128, 128, mt * 256, 0, smem, e); }
    if (PH_HC + 1 < p.ph_hi) k.xcd_barrier(bar);
    if (PROBE_PHASE == PH_HC) pt1 = __builtin_amdgcn_s_memrealtime();
  }
  if (p.ph_lo <= PH_G2_0 && PH_G2_0 < p.ph_hi) { if (PROBE_PHASE == PH_G2_0) pt0 = __builtin_amdgcn_s_memrealtime(); { EpiOutRes e; e.base_lat = p.in[0]; e.base_ctx = p.in[2]; e.out_lat = p.out; e.out_ctx = xc; e.modl = mods0; e.g_off = 2048; e.pad = 0;
        k.gemm_phase8(abuf, (const bf16_t*)(ws + WS_WT_ABOUT), NLAT, MROWS, 1024, 1024, e, smem, 0, 1024); }
    if (PH_G2_0 + 1 < p.ph_hi) k.xcd_barrier(bar);
    if (PROBE_PHASE == PH_G2_0) pt1 = __builtin_amdgcn_s_memrealtime();
  }
  if (p.ph_lo <= PH_ROUTE_0 && PH_ROUTE_0 < p.ph_hi) { if (PROBE_PHASE == PH_ROUTE_0) pt0 = __builtin_amdgcn_s_memrealtime(); k.ph_router(p, 0, MROWS, smem);
    if (PH_ROUTE_0 + 1 < p.ph_hi) k.xcd_barrier(bar);
    if (PROBE_PHASE == PH_ROUTE_0) pt1 = __builtin_amdgcn_s_memrealtime();
  }
  if (p.ph_lo <= PH_MOE1_0 && PH_MOE1_0 < p.ph_hi) { if (PROBE_PHASE == PH_MOE1_0) pt0 = __builtin_amdgcn_s_memrealtime(); k.ph_moe1g(p, 0, smem);
    if (PH_MOE1_0 + 1 < p.ph_hi) k.xcd_barrier(bar);
    if (PROBE_PHASE == PH_MOE1_0) pt1 = __builtin_amdgcn_s_memrealtime();
  }
  if (p.ph_lo <= PH_MOE2_0 && PH_MOE2_0 < p.ph_hi) { if (PROBE_PHASE == PH_MOE2_0) pt0 = __builtin_amdgcn_s_memrealtime(); k.ph_moe2g(p, 0, smem);
    if (PH_MOE2_0 + 1 < p.ph_hi) k.xcd_barrier(bar);
    if (PROBE_PHASE == PH_MOE2_0) pt1 = __builtin_amdgcn_s_memrealtime();
  }
  if (p.ph_lo <= PH_COMB_0 && PH_COMB_0 < p.ph_hi) { if (PROBE_PHASE == PH_COMB_0) pt0 = __builtin_amdgcn_s_memrealtime(); k.ph_combine(p, 0, MROWS, 0);
    if (PH_COMB_0 + 1 < p.ph_hi) k.xcd_barrier(bar);
    if (PROBE_PHASE == PH_COMB_0) pt1 = __builtin_amdgcn_s_memrealtime();
  }
  if (p.ph_lo <= PH_G1_1 && PH_G1_1 < p.ph_hi) { if (PROBE_PHASE == PH_G1_1) pt0 = __builtin_amdgcn_s_memrealtime(); { EpiCDIn e; e.nq = (bf16_t*)(ws + WS_NQ); e.nk = (bf16_t*)(ws + WS_NK); e.nv = (bf16_t*)(ws + WS_NV); e.cq = (bf16_t*)(ws + WS_CQ); e.ckv = (bf16_t*)(ws + WS_CKV); e.kr = (float*)(ws + WS_KR);
        k.gemm_phase8(hbuf, (const bf16_t*)(ws + WS_WT_CDIN), NLAT, MROWS, 2048, 1024, e, smem, 512, 2048); }
    if (PH_G1_1 + 1 < p.ph_hi) k.xcd_barrier(bar);
    if (PROBE_PHASE == PH_G1_1) pt1 = __builtin_amdgcn_s_memrealtime();
  }
  if (p.ph_lo <= PH_MLAUP && PH_MLAUP < p.ph_hi) { if (PROBE_PHASE == PH_MLAUP) pt0 = __builtin_amdgcn_s_memrealtime(); {
        { MK::EpiMlaQ2 eq; eq.dq = (bf16_t*)(ws + WS_DQ); eq.cq = (const bf16_t*)(ws + WS_CQ);
          MK::EpiMlaKV2 ek; ek.dk = (bf16_t*)(ws + WS_DK); ek.dv = (bf16_t*)(ws + WS_DV); ek.ckv = (const bf16_t*)(ws + WS_CKV);
          constexpr int NQ = (NLAT / 256) * 6, NKV = (MROWS / 256) * 8;
          for (int tile = blockIdx.x; tile < NQ + NKV; tile += gridDim.x) {
            if (tile < NQ) { const int mt = tile / 6, nt = tile - mt * 6;
              k.template gemm_tile<4>(eq.cq, 256, nullptr, 0, NLAT, (const bf16_t*)(ws + WS_WT_UQ), 256, 256, mt * 256, nt * 128, smem, eq); }
            else { const int t2 = tile - NQ, mt = t2 >> 3, nt = t2 & 7;
              k.template gemm_tile<4>(ek.ckv, 128, nullptr, 0, MROWS, (const bf16_t*)(ws + WS_WT_UKV), 128, 128, mt * 256, nt * 128, smem, ek); } } }
        k.ph_kr_rope((const float*)(ws + WS_KR), (bf16_t*)(ws + WS_DK));
      }
    if (PH_MLAUP + 1 < p.ph_hi) k.xcd_barrier(bar);
    if (PROBE_PHASE == PH_MLAUP) pt1 = __builtin_amdgcn_s_memrealtime();
  }
  if (p.ph_lo <= PH_MLA && PH_MLA < p.ph_hi) { if (PROBE_PHASE == PH_MLA) pt0 = __builtin_amdgcn_s_memrealtime(); PROBE_SUB(104, k.ph_mla(p, smem)); PROBE_SUB(105, k.ph_na(p, smem)); PROBE_SUB(106, k.ph_conv_moe(p, 1, smem));
    if (PH_MLA + 1 < p.ph_hi) k.xcd_barrier(bar);
    if (PROBE_PHASE == PH_MLA) pt1 = __builtin_amdgcn_s_memrealtime();
  }
  if (p.ph_lo <= PH_G2_1 && PH_G2_1 < p.ph_hi) { if (PROBE_PHASE == PH_G2_1) pt0 = __builtin_amdgcn_s_memrealtime(); { EpiOutRes e; e.base_lat = p.out; e.base_ctx = xc; e.out_lat = p.out; e.out_ctx = xc; e.modl = mods1; e.g_off = 2048; e.pad = 0;
        k.gemm_phase8(abuf, (const bf16_t*)(ws + WS_WT_CDOUT), NLAT, NLAT, 1024, 1024, e, smem, 0, 1024); }
    if (PH_G2_1 + 1 < p.ph_hi) k.xcd_barrier(bar);
    if (PROBE_PHASE == PH_G2_1) pt1 = __builtin_amdgcn_s_memrealtime();
  }
  if (p.ph_lo <= PH_ROUTE_1 && PH_ROUTE_1 < p.ph_hi) { if (PROBE_PHASE == PH_ROUTE_1) pt0 = __builtin_amdgcn_s_memrealtime(); k.ph_router(p, 1, NLAT, smem);
    if (PH_ROUTE_1 + 1 < p.ph_hi) k.xcd_barrier(bar);
    if (PROBE_PHASE == PH_ROUTE_1) pt1 = __builtin_amdgcn_s_memrealtime();
  }
  if (p.ph_lo <= PH_MOE1_1 && PH_MOE1_1 < p.ph_hi) { if (PROBE_PHASE == PH_MOE1_1) pt0 = __builtin_amdgcn_s_memrealtime(); k.ph_moe1g(p, 1, smem);
    if (PH_MOE1_1 + 1 < p.ph_hi) k.xcd_barrier(bar);
    if (PROBE_PHASE == PH_MOE1_1) pt1 = __builtin_amdgcn_s_memrealtime();
  }
  if (p.ph_lo <= PH_MOE2_1 && PH_MOE2_1 < p.ph_hi) { if (PROBE_PHASE == PH_MOE2_1) pt0 = __builtin_amdgcn_s_memrealtime(); k.ph_moe2g(p, 1, smem);
    if (PH_MOE2_1 + 1 < p.ph_hi) k.xcd_barrier(bar);
    if (PROBE_PHASE == PH_MOE2_1) pt1 = __builtin_amdgcn_s_memrealtime();
  }
  if (p.ph_lo <= PH_FINAL && PH_FINAL < p.ph_hi) { if (PROBE_PHASE == PH_FINAL) pt0 = __builtin_amdgcn_s_memrealtime(); k.ph_combine(p, 1, NLAT, 1);
    if (PH_FINAL + 1 < p.ph_hi) k.xcd_barrier(bar);
    if (PROBE_PHASE == PH_FINAL) pt1 = __builtin_amdgcn_s_memrealtime();
  }
  if (PROBE_PHASE >= 0 && blockIdx.x == 0) { const unsigned long long te = __builtin_amdgcn_s_memrealtime(), span = (pt1 - pt0) * 8ull; while (__builtin_amdgcn_s_memrealtime() - te < span) __builtin_amdgcn_s_sleep(32); }
}

static void run_phases(hipStream_t st, MP p, int lo, int hi) {
  for (int ph = lo; ph < hi; ++ph) { p.ph_lo = ph; p.ph_hi = ph + 1; hipLaunchKernelGGL(mega, dim3(256), dim3(512), LDS_BYTES, st, p); }
}

extern "C" void kernel_launch(void* const* d_in, const int* in_sizes, int n_in, void* d_out, int out_size, void* d_ws, size_t ws_size, hipStream_t stream) {
  static int ok = 0;
  if (!ok) {
    if (n_in != 29 || in_sizes[0] != NLAT * D || out_size != NLAT * D || ws_size < WS_END) {
      fprintf(stderr, "kernel_launch: unexpected shapes (n_in %d, in0 %d, out %d, ws %zu, need %zu)\n", n_in, n_in > 0 ? in_sizes[0] : -1, out_size, ws_size, (size_t)WS_END);
      return; }
    if (hipFuncSetAttribute((const void*)mega, hipFuncAttributeMaxDynamicSharedMemorySize, LDS_BYTES) != hipSuccess) { fprintf(stderr, "kernel_launch: hipFuncSetAttribute failed\n"); return; }
    ok = 1;
  }
  char* ws = (char*)d_ws; float* out = (float*)d_out;
  MP p; memset(&p, 0, sizeof(p));
  for (int i = 0; i < 29; ++i) p.in[i] = (const float*)d_in[i];
  p.out = out; p.ws = ws;
  hipMemsetAsync(ws + WS_CTL, 0, WS_MODS + 2 * 3 * 6144 * 4, stream);
  float* odir_ctx = (float*)(ws + WS_ODIR_CTX);
  bf16_t* abuf = (bf16_t*)(ws + WS_A); bf16_t* U = (bf16_t*)(ws + WS_U); float* LF = (float*)(ws + WS_LF);
  bf16_t* nq = (bf16_t*)(ws + WS_NQ); bf16_t* nk = (bf16_t*)(ws + WS_NK); bf16_t* nv = (bf16_t*)(ws + WS_NV);
  bf16_t* dq = (bf16_t*)(ws + WS_DQ); bf16_t* dk = (bf16_t*)(ws + WS_DK); bf16_t* dv = (bf16_t*)(ws + WS_DV);

  p.ph_lo = 0; p.ph_hi = PH_COUNT;
  void* args[] = {&p};
  const hipError_t le = hipLaunchCooperativeKernel((const void*)mega, dim3(256), dim3(512), args, LDS_BYTES, stream);
  if (le != hipSuccess) fprintf(stderr, "kernel_launch: cooperative launch failed: %s\n", hipGetErrorString(le));
}
```
